# Optimizing an MI355X kernel written in HIP

```python
import math
import numpy as np
import jax
import jax.numpy as jnp
from jax import lax

D_MODEL = 1024
BATCH = 32
SEQ = 2048
DEPTH = 2

GRID_W = 64
CTX_LEN = 256
N_BRANCH = 3
BRANCH_W = D_MODEL // 2
RMS_EPS = 1e-6
NEG = -1e30
MLA_HEADS = BRANCH_W // 64
MLA_NOPE = 64
MLA_ROPE = 32
MLA_QK = MLA_NOPE + MLA_ROPE
MLA_V = BRANCH_W // MLA_HEADS
KV_LORA = 4 * MLA_V
Q_LORA = 3 * KV_LORA
Q_BLOCK = 128
ROPE_THETA = 10000.0
NAT_HEADS = BRANCH_W // 64
NAT_DIM = 64
WIN_H = 8
WIN_W = 16
COL_BLOCK = 16
COL_BAND = 2 * WIN_W
N_COL_BLOCKS = GRID_W // COL_BLOCK
S5_W = BRANCH_W
S5_GROUP = 16
S5_GROUPS = S5_W // S5_GROUP
S5_STATE = 64
N_GROUPS = 4
EXPERTS_PER_GROUP = 8
N_EXPERTS = N_GROUPS * EXPERTS_PER_GROUP
EXPERT_HIDDEN = D_MODEL // 2
TOP_K = 2
MOE_BLOCK = 256
C_KV = 0
C_KR = C_KV + KV_LORA
C_NK = C_KR + MLA_ROPE
C_NV = C_NK + NAT_HEADS * NAT_DIM
C_S5 = C_NV + NAT_HEADS * NAT_DIM
C_CTX_END = C_S5 + S5_W
C_QL = C_CTX_END
C_NQ = C_QL + Q_LORA
C_GATE = C_NQ + NAT_HEADS * NAT_DIM
N_IN = C_GATE + N_BRANCH * D_MODEL

kernel_name = 'hybrid_mla_nat_s5_hmoe_dit'


def rmsnorm(x, g):
    xf = x.astype(jnp.float32)
    y = xf * lax.rsqrt(jnp.mean(xf * xf, axis=-1, keepdims=True) + RMS_EPS)
    return (y * g.astype(jnp.float32)).astype(x.dtype)


def modulate(x, g, shift, scale):
    return rmsnorm(x, g) * (1 + scale) + shift


def axial_rope_tables(L):
    t = jnp.arange(L)
    nf = MLA_ROPE // 4
    inv = ROPE_THETA ** (-jnp.arange(nf, dtype=jnp.float32) / nf)
    ang = jnp.concatenate([(t // GRID_W).astype(jnp.float32)[:, None] * inv,
                           (t % GRID_W).astype(jnp.float32)[:, None] * inv], axis=-1)
    return jnp.cos(ang), jnp.sin(ang)


def apply_axial_rope(x, cos, sin):
    B, L, H, R = x.shape
    nf = R // 4
    xr = x.astype(jnp.float32).reshape(B, L, H, 2, 2, nf)
    x1, x2 = xr[..., 0, :], xr[..., 1, :]
    cs = cos.reshape(L, 1, 2, nf)
    sn = sin.reshape(L, 1, 2, nf)
    out = jnp.stack([x1 * cs - x2 * sn, x1 * sn + x2 * cs], axis=-2)
    return out.reshape(B, L, H, R).astype(x.dtype)


def dense_attn(q, k, v):
    scale = q.shape[-1] ** -0.5
    s = jnp.einsum('bqhd,bkhd->bhqk', q, k).astype(jnp.float32) * scale
    p = jax.nn.softmax(s, axis=-1).astype(v.dtype)
    return jnp.einsum('bhqk,bkhe->bqhe', p, v)


def blocked_attn(q, k, v):
    B, L, H, dq = q.shape
    qb = q.reshape(B, L // Q_BLOCK, Q_BLOCK, H, dq).swapaxes(0, 1)
    ob = lax.map(lambda qi: dense_attn(qi, k, v), qb)
    return ob.swapaxes(0, 1).reshape(B, L, H * v.shape[-1])


def mla_keys(kv_lat, k_rope, w_ukv, g_kva, g_kn, rope):
    B, L, _ = kv_lat.shape
    kv = (rmsnorm(kv_lat, g_kva) @ w_ukv).reshape(B, L, MLA_HEADS, MLA_NOPE + MLA_V)
    k_nope, v = kv[..., :MLA_NOPE], kv[..., MLA_NOPE:]
    k_r = jnp.broadcast_to(k_rope[:, :, None, :], (B, L, MLA_HEADS, MLA_ROPE))
    k = rmsnorm(jnp.concatenate([k_nope, k_r], axis=-1), g_kn)
    if rope is not None:
        k = jnp.concatenate([k[..., :MLA_NOPE], apply_axial_rope(k[..., MLA_NOPE:], *rope)], axis=-1)
    return k, v


def mla_queries(q_lat, w_uq, g_qa, g_qn, rope):
    B, L, _ = q_lat.shape
    q = (rmsnorm(q_lat, g_qa) @ w_uq).reshape(B, L, MLA_HEADS, MLA_QK)
    q = rmsnorm(q, g_qn)
    if rope is not None:
        q = jnp.concatenate([q[..., :MLA_NOPE], apply_axial_rope(q[..., MLA_NOPE:], *rope)], axis=-1)
    return q


def nat_col_tables():
    cols = np.arange(GRID_W)
    cs = np.clip(cols - WIN_W // 2, 0, GRID_W - WIN_W)
    band_start = np.clip(np.arange(N_COL_BLOCKS) * COL_BLOCK - WIN_W // 2, 0, GRID_W - COL_BAND)
    band_idx = band_start[:, None] + np.arange(COL_BAND)
    qcol = cols.reshape(N_COL_BLOCKS, COL_BLOCK)
    kcol = band_idx[:, None, :]
    qs = cs[qcol][..., None]
    valid = (kcol >= qs) & (kcol < qs + WIN_W)
    dcol = np.clip(kcol - qcol[..., None] + WIN_W - 1, 0, 2 * WIN_W - 2)
    return band_idx, valid, dcol


def nat_latent(q, k, v, kc, vc, rpb, rows):
    B, L, H, d = q.shape
    kh = min(WIN_H, rows)
    band_idx, valid, dcol = nat_col_tables()
    qg = q.reshape(B, rows, GRID_W, H, d)
    kg = k.reshape(B, rows, GRID_W, H, d)
    vg = v.reshape(B, rows, GRID_W, H, d)
    rpb_c = jnp.where(valid, rpb.astype(jnp.float32)[:, :, dcol], NEG)
    scale = d ** -0.5
    n_lat = kh * COL_BAND

    def row_block(r):
        rs = jnp.clip(r - kh // 2, 0, rows - kh)
        krow = lax.dynamic_slice_in_dim(kg, rs, kh, axis=1)
        vrow = lax.dynamic_slice_in_dim(vg, rs, kh, axis=1)
        kb = krow[:, :, band_idx].transpose(0, 2, 1, 3, 4, 5).reshape(B, N_COL_BLOCKS, n_lat, H, d)
        vb = vrow[:, :, band_idx].transpose(0, 2, 1, 3, 4, 5).reshape(B, N_COL_BLOCKS, n_lat, H, d)
        qr = lax.dynamic_index_in_dim(qg, r, axis=1, keepdims=False).reshape(B, N_COL_BLOCKS, COL_BLOCK, H, d)
        drow = rs + jnp.arange(kh) - r + WIN_H - 1
        bias = rpb_c[:, drow].transpose(0, 2, 3, 1, 4).reshape(H, N_COL_BLOCKS, COL_BLOCK, n_lat)
        s_lat = jnp.einsum('bjqhd,bjkhd->bhjqk', qr, kb).astype(jnp.float32) * scale + bias[None]
        s_ctx = jnp.einsum('bjqhd,bkhd->bhjqk', qr, kc).astype(jnp.float32) * scale
        p = jax.nn.softmax(jnp.concatenate([s_lat, s_ctx], axis=-1), axis=-1).astype(v.dtype)
        o = (jnp.einsum('bhjqk,bjkhd->bjqhd', p[..., :n_lat], vb)
             + jnp.einsum('bhjqk,bkhd->bjqhd', p[..., n_lat:], vc))
        return o.reshape(B, GRID_W, H, d)

    out = lax.map(row_block, jnp.arange(rows))
    return out.transpose(1, 0, 2, 3, 4).reshape(B, L, H * d)


def s5_discretize(a_re, a_im, log_dt, b_re, b_im):
    lam_re = jnp.minimum(a_re.astype(jnp.float32), -1e-4)
    lam_im = a_im.astype(jnp.float32)
    dt = jnp.exp(log_dt.astype(jnp.float32))[:, None]
    mag = jnp.exp(lam_re * dt)
    ab_re = mag * jnp.cos(lam_im * dt)
    ab_im = mag * jnp.sin(lam_im * dt)
    den = lam_re * lam_re + lam_im * lam_im
    n_re = ab_re - 1.0
    f_re = (n_re * lam_re + ab_im * lam_im) / den
    f_im = (ab_im * lam_re - n_re * lam_im) / den
    br = b_re.astype(jnp.float32)
    bi = b_im.astype(jnp.float32)
    bb_re = f_re[..., None] * br - f_im[..., None] * bi
    bb_im = f_re[..., None] * bi + f_im[..., None] * br
    return ab_re, ab_im, bb_re, bb_im


def _complex_affine_combine(e1, e2):
    a1r, a1i, b1r, b1i = e1
    a2r, a2i, b2r, b2i = e2
    return (a1r * a2r - a1i * a2i, a1r * a2i + a1i * a2r,
            a2r * b1r - a2i * b1i + b2r, a2r * b1i + a2i * b1r + b2i)


def s5_scan(ab_re, ab_im, bu_re, bu_im, h0, reverse):
    T = bu_re.shape[0]
    if h0 is not None:
        i0 = T - 1 if reverse else 0
        h0_re, h0_im = h0
        bu_re = bu_re.at[i0].add(ab_re * h0_re - ab_im * h0_im)
        bu_im = bu_im.at[i0].add(ab_re * h0_im + ab_im * h0_re)
    a_re = jnp.broadcast_to(ab_re, (T, 1) + ab_re.shape)
    a_im = jnp.broadcast_to(ab_im, (T, 1) + ab_im.shape)
    _, _, h_re, h_im = lax.associative_scan(_complex_affine_combine, (a_re, a_im, bu_re, bu_im),
                                            reverse=reverse, axis=0)
    return h_re, h_im


def s5_branch(u, uc, a_re, a_im, log_dt, b_re, b_im, c_re, c_im, d_skip, w_glu, need_ctx):
    B, L, _ = u.shape
    Cx = uc.shape[1]
    ug = u.astype(jnp.float32).reshape(B, L, S5_GROUPS, S5_GROUP)
    ucg = uc.astype(jnp.float32).reshape(B, Cx, S5_GROUPS, S5_GROUP)
    d_g = d_skip.astype(jnp.float32).reshape(S5_GROUPS, S5_GROUP)
    y = ug * d_g
    yc = ucg * d_g if need_ctx else None
    for di, rev in ((0, False), (1, True)):
        ab_re, ab_im, bb_re, bb_im = s5_discretize(a_re[di], a_im[di], log_dt[di], b_re[di], b_im[di])
        cr = c_re[di].astype(jnp.float32)
        ci = c_im[di].astype(jnp.float32)

        def drive(v):
            return (jnp.einsum('btgn,gpn->tbgp', v, bb_re), jnp.einsum('btgn,gpn->tbgp', v, bb_im))

        def readout(hr, hi):
            return jnp.einsum('tbgp,gnp->btgn', hr, cr) - jnp.einsum('tbgp,gnp->btgn', hi, ci)

        hc_re, hc_im = s5_scan(ab_re, ab_im, *drive(ucg), None, rev)
        last = 0 if rev else Cx - 1
        h_re, h_im = s5_scan(ab_re, ab_im, *drive(ug), (hc_re[last], hc_im[last]), rev)
        y = y + readout(h_re, h_im)
        if need_ctx:
            yc = yc + readout(hc_re, hc_im)

    def glu(t):
        z = jax.nn.gelu(t.reshape(t.shape[0], t.shape[1], S5_W)).astype(u.dtype) @ w_glu
        return z[..., :S5_W] * jax.nn.sigmoid(z[..., S5_W:])

    return glu(y), (glu(yc) if need_ctx else None)


def merge_branches(gate_cols, outs, w_branch, w_out):
    g = jax.nn.sigmoid(gate_cols.reshape(gate_cols.shape[:-1] + (N_BRANCH, D_MODEL)))
    y = g[..., 0, :] * (outs[0] @ w_branch[0])
    for i in range(1, N_BRANCH):
        y = y + g[..., i, :] * (outs[i] @ w_branch[i])
    return y @ w_out


def hier_moe(h, w_group, b_group, w_expert, b_expert, w_up, w_down):
    T, D = h.shape
    g_logit = (h @ w_group).astype(jnp.float32) + b_group.astype(jnp.float32)
    grp = jnp.argmax(g_logit, axis=-1)
    p_grp = jnp.take_along_axis(jax.nn.softmax(g_logit, axis=-1), grp[:, None], axis=-1)[:, 0]
    e_logit = ((h @ w_expert).astype(jnp.float32) + b_expert.astype(jnp.float32)).reshape(
        T, N_GROUPS, EXPERTS_PER_GROUP)
    e_logit = jnp.take_along_axis(e_logit, grp[:, None, None], axis=1)[:, 0]
    top_v, top_i = lax.top_k(e_logit, TOP_K)
    gate = p_grp[:, None] * jax.nn.softmax(top_v, axis=-1)
    eid = grp[:, None] * EXPERTS_PER_GROUP + top_i
    S = T * TOP_K
    e_flat = eid.reshape(S)
    tok_flat = jnp.repeat(jnp.arange(T, dtype=jnp.int32), TOP_K)
    order = jnp.argsort(e_flat)
    e_s, tok_s, w_s = e_flat[order], tok_flat[order], gate.reshape(S)[order]
    counts = jnp.bincount(e_flat, length=N_EXPERTS)
    start = jnp.cumsum(counts) - counts
    padded = (counts + MOE_BLOCK - 1) // MOE_BLOCK * MOE_BLOCK
    p_end = jnp.cumsum(padded)
    p_start = p_end - padded
    dest = p_start[e_s] + jnp.arange(S) - start[e_s]
    n_blk = -(-(S + N_EXPERTS * (MOE_BLOCK - 1)) // MOE_BLOCK)
    buf_tok = jnp.full((n_blk * MOE_BLOCK,), T, jnp.int32).at[dest].set(tok_s)
    buf_w = jnp.zeros((n_blk * MOE_BLOCK,), jnp.float32).at[dest].set(w_s)
    blk_e = jnp.minimum(jnp.searchsorted(p_end, jnp.arange(n_blk) * MOE_BLOCK, side='right'), N_EXPERTS - 1)
    h_ext = jnp.concatenate([h, jnp.zeros((1, D), h.dtype)], axis=0)

    def expert_block(args):
        tb, wb, eb = args
        a = h_ext[tb] @ w_up[eb]
        hid = jax.nn.silu(a[:, :EXPERT_HIDDEN]) * a[:, EXPERT_HIDDEN:]
        return (hid @ w_down[eb]) * wb[:, None].astype(h.dtype)

    y = lax.map(expert_block, (buf_tok.reshape(n_blk, MOE_BLOCK), buf_w.reshape(n_blk, MOE_BLOCK), blk_e))
    out = jnp.zeros((T + 1, D), h.dtype).at[buf_tok].add(y.reshape(-1, D))
    return out[:T]


def setup_inputs(seed: int = 0) -> dict:
    key = jax.random.key(seed)
    ks = iter(jax.random.split(key, 48))

    def nrm(shape, s):
        return jax.random.normal(next(ks), shape, jnp.float32) * s

    def gain(shape):
        return 1.0 + nrm(shape, 0.02)

    s5_shape = (DEPTH, 2, S5_GROUPS, S5_STATE)
    return {
        'x': nrm((BATCH, SEQ, D_MODEL), 1.0),
        'c': nrm((BATCH, D_MODEL), 1.0),
        'ctx': nrm((BATCH, CTX_LEN, D_MODEL), 1.0),
        'c_ctx': nrm((D_MODEL,), 1.0),
        'w_ada': nrm((DEPTH, D_MODEL, 6 * D_MODEL), 0.5 * D_MODEL ** -0.5),
        'b_ada': nrm((DEPTH, 6 * D_MODEL), 0.02),
        'g_norm1': gain((DEPTH, D_MODEL)),
        'w_in': nrm((DEPTH, D_MODEL, N_IN), D_MODEL ** -0.5),
        'g_q_lat': gain((DEPTH, Q_LORA)),
        'w_uq': nrm((DEPTH, Q_LORA, MLA_HEADS * MLA_QK), Q_LORA ** -0.5),
        'g_kv_lat': gain((DEPTH, KV_LORA)),
        'w_ukv': nrm((DEPTH, KV_LORA, MLA_HEADS * (MLA_NOPE + MLA_V)), KV_LORA ** -0.5),
        'g_qn_mla': gain((DEPTH, MLA_QK)),
        'g_kn_mla': gain((DEPTH, MLA_QK)),
        'g_qn_nat': gain((DEPTH, NAT_DIM)),
        'g_kn_nat': gain((DEPTH, NAT_DIM)),
        'nat_rpb': nrm((DEPTH, NAT_HEADS, 2 * WIN_H - 1, 2 * WIN_W - 1), 0.1),
        's5_a_re': -0.5 + nrm(s5_shape, 0.01),
        's5_a_im': jnp.pi * jnp.arange(S5_STATE, dtype=jnp.float32) + nrm(s5_shape, 0.01),
        's5_log_dt': jax.random.uniform(next(ks), (DEPTH, 2, S5_GROUPS), jnp.float32,
                                        math.log(1e-3), math.log(1e-1)),
        's5_b_re': nrm(s5_shape + (S5_GROUP,), (2 * S5_GROUP) ** -0.5),
        's5_b_im': nrm(s5_shape + (S5_GROUP,), (2 * S5_GROUP) ** -0.5),
        's5_c_re': nrm((DEPTH, 2, S5_GROUPS, S5_GROUP, S5_STATE), 0.25),
        's5_c_im': nrm((DEPTH, 2, S5_GROUPS, S5_GROUP, S5_STATE), 0.25),
        's5_d': nrm((DEPTH, S5_W), 0.5),
        'w_glu': nrm((DEPTH, S5_W, 2 * S5_W), S5_W ** -0.5),
        'w_branch': nrm((DEPTH, N_BRANCH, BRANCH_W, D_MODEL), BRANCH_W ** -0.5),
        'w_out': nrm((DEPTH, D_MODEL, D_MODEL), D_MODEL ** -0.5),
        'g_norm2': gain((DEPTH, D_MODEL)),
        'w_group': nrm((DEPTH, D_MODEL, N_GROUPS), D_MODEL ** -0.5),
        'b_group': nrm((DEPTH, N_GROUPS), 0.01),
        'w_expert': nrm((DEPTH, D_MODEL, N_EXPERTS), D_MODEL ** -0.5),
        'b_expert': nrm((DEPTH, N_EXPERTS), 0.01),
        'w_up': nrm((DEPTH, N_EXPERTS, D_MODEL, 2 * EXPERT_HIDDEN), D_MODEL ** -0.5),
        'w_down': nrm((DEPTH, N_EXPERTS, EXPERT_HIDDEN, D_MODEL), EXPERT_HIDDEN ** -0.5),
    }


def reference(x, c, ctx, c_ctx, w_ada, b_ada, g_norm1, w_in, g_q_lat, w_uq, g_kv_lat, w_ukv,
              g_qn_mla, g_kn_mla, g_qn_nat, g_kn_nat, nat_rpb, s5_a_re, s5_a_im, s5_log_dt,
              s5_b_re, s5_b_im, s5_c_re, s5_c_im, s5_d, w_glu, w_branch, w_out, g_norm2,
              w_group, b_group, w_expert, b_expert, w_up, w_down):
    B, L, D = x.shape
    Cx = ctx.shape[1]
    rows = L // GRID_W
    rope = axial_rope_tables(L)
    s_c = jax.nn.silu(c)
    s_cc = jax.nn.silu(c_ctx)
    xc = ctx

    def nat_heads(t):
        return t.reshape(t.shape[0], t.shape[1], NAT_HEADS, NAT_DIM)

    for l in range(DEPTH):
        need_ctx = l < DEPTH - 1
        mod = (s_c @ w_ada[l] + b_ada[l])[:, None, :]
        sh1, sc1, gt1, sh2, sc2, gt2 = jnp.split(mod, 6, axis=-1)
        n_mc = 6 if need_ctx else 2
        modc = jnp.split(s_cc @ w_ada[l][:, :n_mc * D] + b_ada[l][:n_mc * D], n_mc)

        h = modulate(x, g_norm1[l], sh1, sc1)
        hc = modulate(xc, g_norm1[l], modc[0], modc[1])
        p = h @ w_in[l]
        pc = hc @ (w_in[l] if need_ctx else w_in[l][:, :C_CTX_END])

        k_a, v_a = mla_keys(p[..., C_KV:C_KR], p[..., C_KR:C_NK], w_ukv[l], g_kv_lat[l], g_kn_mla[l], rope)
        kc_a, vc_a = mla_keys(pc[..., C_KV:C_KR], pc[..., C_KR:C_NK], w_ukv[l], g_kv_lat[l], g_kn_mla[l], None)
        q_a = mla_queries(p[..., C_QL:C_NQ], w_uq[l], g_q_lat[l], g_qn_mla[l], rope)
        o_a = blocked_attn(q_a, jnp.concatenate([k_a, kc_a], axis=1), jnp.concatenate([v_a, vc_a], axis=1))

        q_b = rmsnorm(nat_heads(p[..., C_NQ:C_GATE]), g_qn_nat[l])
        k_b = rmsnorm(nat_heads(p[..., C_NK:C_NV]), g_kn_nat[l])
        v_b = nat_heads(p[..., C_NV:C_S5])
        kc_b = rmsnorm(nat_heads(pc[..., C_NK:C_NV]), g_kn_nat[l])
        vc_b = nat_heads(pc[..., C_NV:C_S5])
        o_b = nat_latent(q_b, k_b, v_b, kc_b, vc_b, nat_rpb[l], rows)

        o_c, oc_c = s5_branch(p[..., C_S5:C_CTX_END], pc[..., C_S5:C_CTX_END], s5_a_re[l], s5_a_im[l],
                              s5_log_dt[l], s5_b_re[l], s5_b_im[l], s5_c_re[l], s5_c_im[l], s5_d[l],
                              w_glu[l], need_ctx)

        y = merge_branches(p[..., C_GATE:], (o_a, o_b, o_c), w_branch[l], w_out[l])
        if need_ctx:
            qc_a = mla_queries(pc[..., C_QL:C_NQ], w_uq[l], g_q_lat[l], g_qn_mla[l], None)
            oc_a = dense_attn(qc_a, kc_a, vc_a).reshape(B, Cx, -1)
            qc_b = rmsnorm(nat_heads(pc[..., C_NQ:C_GATE]), g_qn_nat[l])
            oc_b = dense_attn(qc_b, kc_b, vc_b).reshape(B, Cx, -1)
            yc = merge_branches(pc[..., C_GATE:], (oc_a, oc_b, oc_c), w_branch[l], w_out[l])
            xc = xc + modc[2] * yc
        x = x + gt1 * y

        h2 = modulate(x, g_norm2[l], sh2, sc2).reshape(B * L, D)
        moe_w = (w_group[l], b_group[l], w_expert[l], b_expert[l], w_up[l], w_down[l])
        if need_ctx:
            h2c = modulate(xc, g_norm2[l], modc[3], modc[4]).reshape(B * Cx, D)
            f = hier_moe(jnp.concatenate([h2, h2c], axis=0), *moe_w)
            x = x + gt2 * f[:B * L].reshape(B, L, D)
            xc = xc + modc[5] * f[B * L:].reshape(B, Cx, D)
        else:
            x = x + gt2 * hier_moe(h2, *moe_w).reshape(B, L, D)
    return x
```

```cpp
#include <hip/hip_runtime.h>
#include <cstdio>
#include <cstdint>

#ifndef DBG_EPI_TWICE
#define DBG_EPI_TWICE 0
#endif
#ifndef MK_SINGLE
#define MK_SINGLE 1
#endif

#define GAS __attribute__((address_space(1)))
#define LAS __attribute__((address_space(3)))
typedef unsigned short bf16;
typedef short bf16x8 __attribute__((ext_vector_type(8)));
typedef short bf16x4 __attribute__((ext_vector_type(4)));
typedef float f32x4 __attribute__((ext_vector_type(4)));
typedef float f32x2 __attribute__((ext_vector_type(2)));
typedef float f32x16 __attribute__((ext_vector_type(16)));
typedef unsigned u32x4 __attribute__((ext_vector_type(4)));
typedef unsigned u32x2 __attribute__((ext_vector_type(2)));
typedef int i32x4 __attribute__((ext_vector_type(4)));

constexpr int D = 1024, BATCH = 32, SEQ = 2048, CTXL = 256, DEPTH = 2;
constexpr int NB = 8, NCH = BATCH / NB;
constexpr int RL = NB * SEQ, RC = NB * CTXL, RR = RL + RC;
constexpr int NINP = 6400;
constexpr int NTOK_LAT = BATCH * SEQ, NTOK_CTX = BATCH * CTXL, NTOK = NTOK_LAT + NTOK_CTX;
constexpr int S5ROWS = 1280;
constexpr int KEYS = SEQ + CTXL;
constexpr int MOE_ROWS = 2 * NTOK + 64 * 256;
constexpr float RMS_EPS = 1e-6f;
constexpr float LOG2E = 1.4426950408889634f;

constexpr size_t al256(size_t x) { return (x + 255) & ~(size_t)255; }
constexpr size_t WS_CTL = 0, CTL_BYTES = 1u << 20;
constexpr size_t WS_WINT = WS_CTL + CTL_BYTES;
constexpr size_t WS_UQT = WS_WINT + (size_t)2 * NINP * 1024 * 2;
constexpr size_t WS_UKVT = WS_UQT + (size_t)2 * 768 * 768 * 2;
constexpr size_t WS_GLUT = WS_UKVT + (size_t)2 * 1024 * 256 * 2;
constexpr size_t WS_BRT = WS_GLUT + (size_t)2 * 1024 * 512 * 2;
constexpr size_t WS_OUTT = WS_BRT + (size_t)2 * 3 * 1024 * 512 * 2;
constexpr size_t WS_UPT = WS_OUTT + (size_t)2 * 1024 * 1024 * 2;
constexpr size_t WS_DOWNT = WS_UPT + (size_t)2 * 32 * 1024 * 1024 * 2;
constexpr size_t WS_BTY = WS_DOWNT + (size_t)2 * 32 * 1024 * 512 * 2;
constexpr size_t WS_BTS = WS_BTY + (size_t)2 * 32 * 256 * 512 * 2;
constexpr size_t WS_A16 = WS_BTS + (size_t)2 * 32 * 256 * 256 * 2;
constexpr size_t WS_MODP = WS_A16 + (size_t)2 * 2 * 32 * 64 * 2 * 4;
constexpr size_t WS_MOD = WS_MODP + (size_t)8 * 2 * 33 * 6144 * 4;
constexpr size_t WS_ROPE = WS_MOD + (size_t)2 * 33 * 6144 * 4;
constexpr size_t WS_WGT = WS_ROPE + (size_t)2048 * 32 * 4;
constexpr size_t WS_WET = WS_WGT + (size_t)2 * 4 * 1024 * 4;
constexpr size_t WS_XC = WS_WET + (size_t)2 * 32 * 1024 * 4;
constexpr size_t WS_CHUNK = al256(WS_XC + (size_t)NTOK_CTX * 1024 * 4);
constexpr size_t UB = (size_t)RR * 1024 * 2;
constexpr size_t C_HB = 0;
constexpr size_t C_KVL = C_HB + UB;
constexpr size_t C_QL = C_KVL + UB / 4;
constexpr size_t C_YM = C_HB;
constexpr size_t C_QR = C_QL + UB * 3 / 4;
constexpr size_t C_KN = C_QR + UB * 3 / 4;
constexpr size_t C_YMB = C_QR;
constexpr size_t C_KRP = C_KN + UB / 2;
constexpr size_t C_NQ = al256(C_KRP + (size_t)RR * 32 * 2);
constexpr size_t C_NK = C_NQ + UB / 2;
constexpr size_t C_NV = C_NK + UB / 2;
constexpr size_t C_GT = C_NV + UB / 2;
constexpr size_t C_AS5 = C_GT + UB * 3;
constexpr size_t C_SS = C_AS5 + (size_t)S5ROWS * 32 * 512 * 2;
constexpr size_t C_VV = C_SS + (size_t)S5ROWS * 32 * 256 * 4;
constexpr size_t C_QF = C_VV + UB / 2;
constexpr size_t C_KF = C_QF + UB * 3 / 4;
constexpr size_t C_VT = C_KF + UB * 3 / 4;
constexpr size_t C_NVT = C_VT + (size_t)NB * 8 * 64 * KEYS * 2;
constexpr size_t C_OA = C_NVT + (size_t)NB * 8 * 64 * KEYS * 2;
constexpr size_t C_OB = C_OA + UB / 2;
constexpr size_t C_OC = C_OB + UB / 2;
constexpr size_t C_YG = C_OC + UB / 2;
constexpr size_t C_SSKV = C_YG + UB / 2;
constexpr size_t C_SSQL = C_SSKV + (size_t)RR * 4 * 4;
constexpr size_t C_END = al256(C_SSQL + (size_t)RR * 12 * 4);
constexpr size_t M_HID = 0;
constexpr size_t M_Y = M_HID + (size_t)MOE_ROWS * 512 * 2;
constexpr size_t M_H2 = M_Y;
constexpr size_t M_ROWTOK = M_Y + (size_t)2 * NTOK * 1024 * 2;
constexpr size_t M_ROWW = M_ROWTOK + (size_t)MOE_ROWS * 4;
constexpr size_t M_TOKE = M_ROWW + (size_t)MOE_ROWS * 4;
constexpr size_t M_TOKW = M_TOKE + (size_t)NTOK * 16;
constexpr size_t M_WGBASE = M_TOKW + (size_t)NTOK * 8;
constexpr size_t M_END = M_WGBASE + (size_t)1024 * 64 * 4;
static_assert(M_END <= C_END, "MoE buffers fit in the chunk region");
constexpr size_t WS_HBALL = WS_CHUNK + C_END;
constexpr size_t WS_END = WS_HBALL + (size_t)NTOK * 1024 * 2;
constexpr size_t X_YG = WS_HBALL, X_OA = X_YG + (size_t)NTOK_CTX * 512 * 2, X_OB = X_OA + (size_t)NTOK_CTX * 512 * 2, X_OC = X_OB + (size_t)NTOK_CTX * 512 * 2;
constexpr size_t X_GT = X_OC + (size_t)NTOK_CTX * 512 * 2, X_YMB = X_GT + (size_t)NTOK_CTX * 3072 * 2, X_END = X_YMB + (size_t)NTOK_CTX * 1024 * 2;
static_assert(X_END <= WS_END, "ctx-tail buffers fit inside HB_ALL");
static_assert(WS_END <= ((size_t)1 << 30), "workspace within 1 GiB");
constexpr int CW_BAR = 4096;
constexpr int CW_CNT = 16384;

constexpr int LDS_MISC = 143360;
constexpr int LDS_TAB = LDS_MISC + 256;
constexpr int LDS_BYTES = 147456;

__device__ __forceinline__ unsigned f2bf(float f) { unsigned u = __builtin_bit_cast(unsigned, f); return (u + 0x7fffu + ((u >> 16) & 1u)) >> 16; }
typedef __bf16 bf2n_t __attribute__((ext_vector_type(2)));
__device__ __forceinline__ unsigned pk2(float lo, float hi) { const f32x2 v = {lo, hi}; return __builtin_bit_cast(unsigned, __builtin_convertvector(v, bf2n_t)); }
__device__ __forceinline__ float bflo(unsigned u) { return __builtin_bit_cast(float, u << 16); }
__device__ __forceinline__ float bfhi(unsigned u) { return __builtin_bit_cast(float, u & 0xffff0000u); }
__device__ __forceinline__ float bf2f(bf16 h) { return __builtin_bit_cast(float, ((unsigned)h) << 16); }
template <class T> __device__ __forceinline__ T ldg(const void* p) { return *(const GAS T*)p; }
template <class T> __device__ __forceinline__ void stg(void* p, T v) { *(GAS T*)p = v; }
template <int K> __device__ __forceinline__ float shx_sum(float v) {
    if constexpr (K == 32) { float a = v, b = v; asm volatile("s_nop 1\n\tv_permlane32_swap_b32 %0, %1" : "+v"(a), "+v"(b)); return a + b; }
    else return v + __builtin_bit_cast(float, __builtin_amdgcn_ds_swizzle(__builtin_bit_cast(int, v), (K << 10) | 0x1f));
}
template <int K> __device__ __forceinline__ float shx_max(float v) {
    if constexpr (K == 32) { float a = v, b = v; asm volatile("s_nop 1\n\tv_permlane32_swap_b32 %0, %1" : "+v"(a), "+v"(b)); return fmaxf(a, b); }
    else return fmaxf(v, __builtin_bit_cast(float, __builtin_amdgcn_ds_swizzle(__builtin_bit_cast(int, v), (K << 10) | 0x1f)));
}
__device__ __forceinline__ float wave_sum(float v) { v = shx_sum<1>(v); v = shx_sum<2>(v); v = shx_sum<4>(v); v = shx_sum<8>(v); v = shx_sum<16>(v); return shx_sum<32>(v); }
__device__ __forceinline__ float hx32(float a, float b) { asm volatile("s_nop 1\n\tv_permlane32_swap_b32 %0, %1" : "+v"(a), "+v"(b)); return a + b; }
__device__ __forceinline__ float hx16(float a, float b) { asm volatile("s_nop 1\n\tv_permlane16_swap_b32 %0, %1" : "+v"(a), "+v"(b)); return a + b; }
template <int N> __device__ __forceinline__ float dpp_ror(float v) { return __builtin_bit_cast(float, __builtin_amdgcn_update_dpp(0, __builtin_bit_cast(int, v), 0x120 + N, 0xf, 0xf, false)); }
__device__ __forceinline__ float row_sum16(float v) { v += dpp_ror<8>(v); v += dpp_ror<4>(v); v += dpp_ror<2>(v); v += dpp_ror<1>(v); return v; }
__device__ __forceinline__ float red4(float v0, float v1, float v2, float v3) { return row_sum16(hx16(hx32(v0, v2), hx32(v1, v3))); }
__device__ __forceinline__ float lane_bcast(float v, int srclane) { return __builtin_bit_cast(float, __builtin_amdgcn_readlane(__builtin_bit_cast(int, v), srclane)); }
__device__ __forceinline__ float fast_exp2(float x) { return __builtin_amdgcn_exp2f(x); }
__device__ __forceinline__ float sigmoidf(float x) { return __builtin_amdgcn_rcpf(1.0f + __builtin_amdgcn_exp2f(-LOG2E * x)); }
__device__ __forceinline__ float gelu_tanh(float x) { const float u = 0.7978845608028654f * (x + 0.044715f * x * x * x); return x * sigmoidf(2.0f * u); }

#define XB_TMO      128
#define XB_XCNT(j)  (256  + 64 * (j))
#define XB_XSUB(j)  (1280 + 64 * (j))
#define XB_XGEN(j)  (2304 + 64 * (j))
#define XB_TOP      3328
#define XB_TOPGEN   3392
#define XCD_BAR_WORDS 3456
#define XB_SPIN_CAP (1u << 22)

__device__ __forceinline__ unsigned xb_ld(unsigned* p)              { return __hip_atomic_load(p, __ATOMIC_RELAXED, __HIP_MEMORY_SCOPE_AGENT); }
__device__ __forceinline__ unsigned xb_add(unsigned* p, unsigned v) { return __hip_atomic_fetch_add(p, v, __ATOMIC_RELAXED, __HIP_MEMORY_SCOPE_AGENT); }
__device__ __forceinline__ unsigned xb_xcc_id() { return (unsigned)__builtin_amdgcn_s_getreg((3 << 11) | 20) & 0xFu; }
#define XB_SPIN(cond, bar) do { unsigned _sp = 0; while (cond) { __builtin_amdgcn_s_sleep(1); \
    if ((++_sp & 255u) == 0u) { if (xb_ld(&(bar)[XB_TMO])) break; if (_sp > XB_SPIN_CAP) { atomicAdd(&(bar)[XB_TMO], 1u); break; } } } } while (0)

struct XcdBarrier { unsigned* bar; unsigned x; volatile LAS unsigned* st; };

__device__ __forceinline__ XcdBarrier xcd_barrier_post(unsigned* bar, volatile LAS unsigned* st) {
    XcdBarrier b; b.bar = bar; b.x = xb_xcc_id(); b.st = st;
    if (threadIdx.x == 0) (void)xb_add(&bar[XB_XCNT(b.x)], 1u);
    return b;
}
__device__ __forceinline__ void xcd_barrier_complete(unsigned* bar, unsigned x, unsigned& nloc, unsigned& nx) {
    const unsigned G = gridDim.x * gridDim.y * gridDim.z;
    unsigned sum, cnt, mine, sp = 0u;
    for (;;) {
        sum = 0u; cnt = 0u; mine = 0u;
#pragma unroll
        for (unsigned j = 0; j < 16; ++j) { const unsigned c = xb_ld(&bar[XB_XCNT(j)]); sum += c; cnt += (c > 0u) ? 1u : 0u; mine = (j == x) ? c : mine; }
        if (sum == G) break;
        __builtin_amdgcn_s_sleep(1);
        if ((++sp & 255u) == 0u) { if (xb_ld(&bar[XB_TMO])) break; if (sp > XB_SPIN_CAP) { atomicAdd(&bar[XB_TMO], 1u); break; } }
    }
    nloc = mine > 0u ? mine : 1u; nx = cnt > 0u ? cnt : 1u;
}
__device__ __forceinline__ void xcd_barrier(const XcdBarrier& b, bool thread0) {
    asm volatile("s_waitcnt vmcnt(0)" ::: "memory");
    __syncthreads();
    if (thread0) {
        unsigned* bar = b.bar;
        __builtin_amdgcn_s_waitcnt(0);
        unsigned nloc = b.st[0], nx = b.st[1];
        if (nloc == 0u) { xcd_barrier_complete(bar, b.x, nloc, nx); b.st[0] = nloc; b.st[1] = nx; }
        const unsigned old = xb_add(&bar[XB_XSUB(b.x)], 1u);
        const unsigned gen = old / nloc;
        if (old + 1u == (gen + 1u) * nloc) {
            __builtin_amdgcn_fence(__ATOMIC_RELEASE, "agent");
            asm volatile("s_waitcnt vmcnt(0)" ::: "memory");
            const unsigned og = xb_add(&bar[XB_TOP], 1u);
            const unsigned tg = og / nx;
            if (og + 1u == (tg + 1u) * nx) xb_add(&bar[XB_TOPGEN], 1u);
            else XB_SPIN(xb_ld(&bar[XB_TOPGEN]) == tg, bar);
            __builtin_amdgcn_fence(__ATOMIC_ACQUIRE, "agent");
            xb_add(&bar[XB_XGEN(b.x)], 1u);
            asm volatile("s_waitcnt vmcnt(0)" ::: "memory");
        } else {
            XB_SPIN(xb_ld(&bar[XB_XGEN(b.x)]) == gen, bar);
            __builtin_amdgcn_fence(__ATOMIC_ACQUIRE, "agent");
            asm volatile("s_waitcnt vmcnt(0)" ::: "memory");
        }
    }
    __syncthreads();
}

namespace pg8 {
constexpr int BM = 256, BK = 64, HALF = 128, HTB = HALF * BK * 2, STAGE_BYTES = 8 * HTB, NXCD = 8, WGM = 2;
__host__ __device__ __forceinline__ int lds_byte(int r, int c) { const int st = (r >> 4) * 2 + (c >> 5), rr = r & 15, cc = c & 31, ob = rr * 64 + cc * 2; return st * 1024 + (ob ^ (((ob >> 9) & 1) << 5)); }
__host__ __device__ __forceinline__ void stage_rc(int b, int& R, int& C) { const int st = b / 1024, sb = b % 1024, swz = sb ^ (((sb >> 9) & 1) << 5); R = (st >> 1) * 16 + swz / 64; C = (st & 1) * 32 + (swz % 64) / 2; }
__host__ __device__ __forceinline__ int perm32(int rho) { const int n = rho >> 4, i = rho & 15; return 8 * (i >> 2) + 4 * n + (i & 3); }
struct Unit { int pm, pn, z; };
__device__ __forceinline__ bool tile_map(long L, int nM, int nN, int& pm, int& pn) {
    const int nwg = nM * nN; if (L >= nwg) return false;
    int wgid = (int)L; { const int q = nwg / NXCD, r = nwg % NXCD, xcd = wgid % NXCD, off = wgid / NXCD; wgid = (xcd < r ? xcd * (q + 1) : r * (q + 1) + (xcd - r) * q) + off; }
    const int nig = WGM * nN, gid = wgid / nig, fm = gid * WGM, gsz = (nM - fm) < WGM ? (nM - fm) : WGM;
    pm = fm + ((wgid % nig) % gsz); pn = (wgid % nig) / gsz; return true;
}
typedef __bf16 bf2_t __attribute__((ext_vector_type(2)));
__device__ __forceinline__ unsigned cvt_pk_bf16(float lo, float hi) { const f32x2 v = {lo, hi}; return __builtin_bit_cast(unsigned, __builtin_convertvector(v, bf2_t)); }

template <class Prob, class Epi>
__device__ __forceinline__ void gemm_phase(LAS unsigned char* lds, const Prob& P, const Epi& E, int tid_in) {
    int tid_ = tid_in; asm volatile("" : "+v"(tid_));
    const int tid = tid_, wid = __builtin_amdgcn_readfirstlane(tid >> 6), lane = tid & 63, wr = wid >> 2, wc = wid & 3, fr = lane & 15, fq = lane >> 4;
    const int K = P.K, nt = K / BK;
    int sR[2], sC[2]; unsigned voffB[2], voffA[2];
#pragma unroll
    for (int i = 0; i < 2; ++i) { int R, C; stage_rc(tid * 16 + i * 8192, R, C); sR[i] = R; sC[i] = C; const int Rb = Epi::PERM ? ((R & ~31) + perm32(R & 31)) : R;
        voffA[i] = (unsigned)(R * P.lda + C) * 2u; voffB[i] = (unsigned)(Rb * P.ldb + C) * 2u; }
    const size_t kstep = (size_t)(BK * 2);
    const unsigned hstepA = (unsigned)HALF * (unsigned)P.lda * 2u; const size_t hstepB = (size_t)HALF * P.ldb * 2;
    const unsigned ldsw = (unsigned)wid * 1024u;
    const int aoff = lds_byte(wr * 64 + fr, fq * 8), boff = lds_byte(wc * 32 + fr, fq * 8);
#define PG8_SA(b, h) (((b) * 2 + (h)) * HTB)
#define PG8_SB(b, h) ((4 + (b) * 2 + (h)) * HTB)
#define PG8_STAGE2(bufoff, gbase, o0, o1) do { \
        __builtin_amdgcn_global_load_lds((const GAS unsigned*)((const char*)(gbase) + (o0)), (LAS unsigned*)(lds + (bufoff) + ldsw), 16, 0, 0); \
        __builtin_amdgcn_global_load_lds((const GAS unsigned*)((const char*)(gbase) + (o1)), (LAS unsigned*)(lds + (bufoff) + ldsw + 8192), 16, 0, 0); } while (0)
#define PG8_STAGEB(bufoff, gbase) PG8_STAGE2(bufoff, gbase, voffB[0], voffB[1])
#define PG8_STAGEA(bufoff, gbase, OA, h) do { if constexpr (Prob::GATHER) { PG8_STAGE2(bufoff, gbase, OA[h][0], OA[h][1]); } else { PG8_STAGE2(bufoff, (gbase) + (h) * (size_t)hstepA, voffA[0], voffA[1]); } } while (0)
#define PG8_LDA(dst, b, h) do { _Pragma("unroll") for (int m = 0; m < 4; ++m) _Pragma("unroll") for (int k = 0; k < 2; ++k) dst[m][k] = *(const LAS bf16x8*)(lds + PG8_SA(b, h) + aoff + m * 2048 + k * 1024); } while (0)
#define PG8_LDB(dst, b, h) do { _Pragma("unroll") for (int n = 0; n < 2; ++n) _Pragma("unroll") for (int k = 0; k < 2; ++k) dst[n][k] = *(const LAS bf16x8*)(lds + PG8_SB(b, h) + boff + n * 2048 + k * 1024); } while (0)
#define PG8_MMA(ai, bj, At, Bt) do { __builtin_amdgcn_s_setprio(1); _Pragma("unroll") for (int m = 0; m < 4; ++m) _Pragma("unroll") for (int n = 0; n < 2; ++n) _Pragma("unroll") for (int k = 0; k < 2; ++k) \
        acc[ai][bj][m][n] = __builtin_amdgcn_mfma_f32_16x16x32_bf16(Bt[n][k], At[m][k], acc[ai][bj][m][n], 0, 0, 0); __builtin_amdgcn_s_setprio(0); } while (0)
#define PG8_WAIT_V(n) asm volatile("s_waitcnt vmcnt(" #n ")" ::: "memory")
#define PG8_WAIT_L(n) asm volatile("s_waitcnt lgkmcnt(" #n ")" ::: "memory")
#define PG8_BAR __builtin_amdgcn_s_barrier()
#define PG8_SCHED __builtin_amdgcn_sched_barrier(0)
    Unit cur, nxt; int ui = 0;
    if (!P.next(0, cur)) return;
    f32x4 acc[2][2][4][2];
    bf16x8 At[4][2], B0[2][2], B1[2][2];
    const char* cA = P.a_base(cur); const char* cB = P.b_base(cur);
    unsigned cOA[2][2];
#pragma unroll
    for (int h = 0; h < 2; ++h)
#pragma unroll
        for (int i = 0; i < 2; ++i) {
            if constexpr (Prob::GATHER) cOA[h][i] = P.a_rowoff(cur, h * HALF + sR[i]) + (unsigned)sC[i] * 2u;
            else cOA[h][i] = 0u;
        }
    PG8_STAGEB(PG8_SB(0, 0), cB); PG8_STAGEB(PG8_SB(0, 1), cB + hstepB); PG8_STAGEA(PG8_SA(0, 0), cA, cOA, 0); PG8_STAGEA(PG8_SA(0, 1), cA, cOA, 1);
    if (wr == 1) PG8_BAR;
    PG8_WAIT_V(2); PG8_BAR;
    PG8_STAGEB(PG8_SB(1, 0), cB + kstep); PG8_STAGEA(PG8_SA(1, 0), cA + kstep, cOA, 0); PG8_STAGEB(PG8_SB(1, 1), cB + hstepB + kstep);
    PG8_WAIT_V(6); PG8_BAR;
    for (;;) {
        const bool has_next = P.next(ui + 1, nxt);
        const char* nA = has_next ? P.a_base(nxt) : cA; const char* nB = has_next ? P.b_base(nxt) : cB;
        if constexpr (Prob::GATHER) {
            u32x4 nv = (u32x4){cOA[0][0], cOA[0][1], cOA[1][0], cOA[1][1]};
            if (has_next) {
                int t2 = tid; asm volatile("" : "+v"(t2));
#pragma unroll
                for (int i = 0; i < 2; ++i) { int R2, C2; stage_rc(t2 * 16 + i * 8192, R2, C2);
                    nv[i] = P.a_rowoff(nxt, R2) + (unsigned)C2 * 2u; nv[2 + i] = P.a_rowoff(nxt, HALF + R2) + (unsigned)C2 * 2u; }
            }
            *(LAS u32x4*)(lds + STAGE_BYTES + tid * 16) = nv;
        }
#pragma unroll
        for (int a = 0; a < 2; ++a)
#pragma unroll
            for (int b = 0; b < 2; ++b)
#pragma unroll
                for (int m = 0; m < 4; ++m)
#pragma unroll
                    for (int n = 0; n < 2; ++n) acc[a][b][m][n] = (f32x4){0.f, 0.f, 0.f, 0.f};
        for (int t = 0; t < nt; t += 2) {
            const bool last = (t == nt - 2);
            const char* a1 = cA + (size_t)(t + 1) * kstep;
            const char* a2 = last ? nA : cA + (size_t)(t + 2) * kstep; const char* b2 = last ? nB : cB + (size_t)(t + 2) * kstep;
            const char* a3 = a2 + kstep; const char* b3 = b2 + kstep;
            unsigned oa2[2][2];
#pragma unroll
            for (int h = 0; h < 2; ++h)
#pragma unroll
                for (int i = 0; i < 2; ++i) oa2[h][i] = Prob::GATHER ? cOA[h][i] : 0u;
            if constexpr (Prob::GATHER) { if (last) { const u32x4 nv = *(const LAS u32x4*)(lds + STAGE_BYTES + tid * 16); oa2[0][0] = nv.x; oa2[0][1] = nv.y; oa2[1][0] = nv.z; oa2[1][1] = nv.w; } }
            PG8_LDB(B0, 0, 0); PG8_LDB(B1, 0, 1); PG8_SCHED; PG8_LDA(At, 0, 0); PG8_STAGEA(PG8_SA(1, 1), a1, cOA, 1);
            PG8_WAIT_V(8); PG8_WAIT_L(0); PG8_BAR; PG8_MMA(0, 0, At, B0); PG8_MMA(0, 1, At, B1); PG8_BAR; PG8_SCHED;
            PG8_LDA(At, 0, 1); PG8_STAGEB(PG8_SB(0, 0), b2); PG8_STAGEB(PG8_SB(0, 1), b2 + hstepB); PG8_STAGEA(PG8_SA(0, 0), a2, oa2, 0);
            PG8_WAIT_V(8); PG8_WAIT_L(0); PG8_BAR; PG8_MMA(1, 0, At, B0); PG8_MMA(1, 1, At, B1); PG8_BAR; PG8_SCHED;
            PG8_LDB(B0, 1, 0); PG8_LDB(B1, 1, 1); PG8_SCHED; PG8_LDA(At, 1, 0); PG8_STAGEA(PG8_SA(0, 1), a2, oa2, 1);
            PG8_WAIT_V(8); PG8_WAIT_L(0); PG8_BAR; PG8_MMA(0, 0, At, B0); PG8_MMA(0, 1, At, B1); PG8_BAR; PG8_SCHED;
            PG8_LDA(At, 1, 1); PG8_STAGEB(PG8_SB(1, 0), b3); PG8_STAGEB(PG8_SB(1, 1), b3 + hstepB); PG8_STAGEA(PG8_SA(1, 0), a3, oa2, 0);
            PG8_WAIT_V(8); PG8_WAIT_L(0); PG8_BAR; PG8_MMA(1, 0, At, B0); PG8_MMA(1, 1, At, B1); PG8_BAR; PG8_SCHED;
        }
        if (wr == 0) PG8_BAR;
        E(acc, cur, wr, wc, fr, fq);
#if DBG_EPI_TWICE
        if constexpr (Epi::IDEMP) E(acc, cur, wr, wc, fr, fq);
#endif
        if (!has_next) break;
        cur = nxt; cA = nA; cB = nB; ++ui;
        if constexpr (Prob::GATHER) { const u32x4 nv = *(const LAS u32x4*)(lds + STAGE_BYTES + tid * 16); cOA[0][0] = nv.x; cOA[0][1] = nv.y; cOA[1][0] = nv.z; cOA[1][1] = nv.w; }
        if (wr == 1) PG8_BAR;
    }
    PG8_WAIT_V(0);
    PG8_BAR;
#undef PG8_SA
#undef PG8_SB
#undef PG8_STAGE2
#undef PG8_STAGEB
#undef PG8_STAGEA
#undef PG8_LDA
#undef PG8_LDB
#undef PG8_MMA
#undef PG8_WAIT_V
#undef PG8_WAIT_L
#undef PG8_BAR
#undef PG8_SCHED
}
}
using pg8::Unit;

struct Args { const float* in[35]; float* out; unsigned char* ws; int lo, hi; };

struct Frame {
    LAS unsigned char* lds;
    int tid, lane, wave, G, c;
    const float* const* in;
    float* out; unsigned char* ws; unsigned char* ck;
    float* MOD; float* XC;
};
__device__ __forceinline__ bool row_is_ctx(int row) { return row >= RL; }

struct ProbPlain {
    static constexpr bool GATHER = false;
    const bf16* A; const bf16* Bt; int K, lda, ldb, nM, nN, G, c, a_pn_stride;
    __device__ __forceinline__ bool next(int i, Unit& u) const { u.z = 0; return pg8::tile_map((long)i * G + c, nM, nN, u.pm, u.pn); }
    __device__ __forceinline__ const char* a_base(const Unit& u) const { return (const char*)(A + (size_t)u.pm * 256 * lda + (size_t)u.pn * a_pn_stride); }
    __device__ __forceinline__ const char* b_base(const Unit& u) const { return (const char*)(Bt + (size_t)u.pn * 256 * ldb); }
    __device__ __forceinline__ unsigned a_rowoff(const Unit&, int) const { return 0u; }
};
struct ProbG1 {
    static constexpr bool GATHER = false;
    const bf16* A; const bf16* Actx; const bf16* Bt; int K, lda, ldb, G, c, nctx;
    __device__ __forceinline__ bool next(int i, Unit& u) const {
        u.z = 0; const long L = (long)i * G + c; const int n1 = 64 * 25;
        if (L < n1) return pg8::tile_map(L, 64, 25, u.pm, u.pn);
        const int l2 = (int)(L - n1); if (l2 >= 8 * nctx) return false;
        u.pm = 64 + (l2 & 7); const int idx = l2 >> 3;
        u.pn = (nctx == 24) ? idx : (idx < 3 ? idx : (idx < 7 ? idx + 5 : 24));
        return true;
    }
    __device__ __forceinline__ const char* a_base(const Unit& u) const { return u.pm < 64 ? (const char*)(A + (size_t)u.pm * 256 * lda) : (const char*)(Actx + (size_t)(u.pm - 64) * 256 * lda); }
    __device__ __forceinline__ const char* b_base(const Unit& u) const { return (const char*)(Bt + (size_t)u.pn * 256 * ldb); }
    __device__ __forceinline__ unsigned a_rowoff(const Unit&, int) const { return 0u; }
};
struct ProbMerge {
    static constexpr bool GATHER = false;
    const bf16* O[3]; const bf16* Bt; int K, lda, ldb, nM, nN, G, c;
    __device__ __forceinline__ bool next(int i, Unit& u) const { u.z = i % 3; return pg8::tile_map((long)(i / 3) * G + c, nM, nN, u.pm, u.pn); }
    __device__ __forceinline__ const char* a_base(const Unit& u) const { const bf16* o = u.z == 0 ? O[0] : (u.z == 1 ? O[1] : O[2]); return (const char*)(o + (size_t)u.pm * 256 * lda); }
    __device__ __forceinline__ const char* b_base(const Unit& u) const { return (const char*)(Bt + ((size_t)u.z * 1024 + (size_t)u.pn * 256) * ldb); }
    __device__ __forceinline__ unsigned a_rowoff(const Unit&, int) const { return 0u; }
};
__device__ __forceinline__ void moe_tables(const unsigned* cnt, LAS int* T, int tid_in) {
    int t_ = tid_in; asm volatile("" : "+v"(t_));
    __syncthreads();
    if (t_ < 64) T[706 + t_] = (int)__hip_atomic_load(cnt + t_, __ATOMIC_RELAXED, __HIP_MEMORY_SCOPE_AGENT);
    __syncthreads();
    if (t_ == 0) {
        int row = 0, t = 0;
#pragma nounroll
        for (int ge = 0; ge < 64; ++ge) {
            const int cn = T[706 + ge];
            T[2 + ge] = row; const int nt = (cn + 255) >> 8;
#pragma nounroll
            for (int k = 0; k < nt && t < 640; ++k) T[66 + (t++)] = ge & 31;
            row += nt * 256;
            if (ge == 31) T[1] = t;
        }
        T[0] = t;
    }
    __syncthreads();
}
struct ProbUp {
    static constexpr bool GATHER = true;
    const bf16* A; const bf16* Bt; const int* rowtok; LAS int* T; int K, lda, ldb, G, c;
    __device__ __forceinline__ bool next(int i, Unit& u) const {
        const int nwg = T[0] * 4; const long L = (long)i * G + c; if (L >= nwg) return false;
        int w = (int)L; { const int q = nwg / 8, r = nwg % 8, xcd = w % 8, off = w / 8; w = (xcd < r ? xcd * (q + 1) : r * (q + 1) + (xcd - r) * q) + off; }
        u.pm = w >> 2; u.pn = w & 3; u.z = T[66 + u.pm]; return true;
    }
    __device__ __forceinline__ const char* a_base(const Unit&) const { return (const char*)A; }
    __device__ __forceinline__ const char* b_base(const Unit& u) const { return (const char*)(Bt + ((size_t)u.z * 1024 + (size_t)u.pn * 256) * ldb); }
    __device__ __forceinline__ unsigned a_rowoff(const Unit& u, int r) const { const GAS int* base = (const GAS int*)(rowtok + (size_t)u.pm * 256); int t = base[(unsigned)r]; t = t < 0 ? 0 : t; return (unsigned)t * (unsigned)lda * 2u; }
};
struct ProbDown {
    static constexpr bool GATHER = false;
    const bf16* A; const bf16* Bt; LAS int* T; int K, lda, ldb, G, c, t0, t1;
    __device__ __forceinline__ bool next(int i, Unit& u) const {
        const int nwg = (t1 - t0) * 4; const long L = (long)i * G + c; if (L >= nwg) return false;
        int w = (int)L; { const int q = nwg / 8, r = nwg % 8, xcd = w % 8, off = w / 8; w = (xcd < r ? xcd * (q + 1) : r * (q + 1) + (xcd - r) * q) + off; }
        u.pm = t0 + (w >> 2); u.pn = w & 3; u.z = T[66 + u.pm]; return true;
    }
    __device__ __forceinline__ const char* a_base(const Unit& u) const { return (const char*)(A + (size_t)u.pm * 256 * lda); }
    __device__ __forceinline__ const char* b_base(const Unit& u) const { return (const char*)(Bt + ((size_t)u.z * 1024 + (size_t)u.pn * 256) * ldb); }
    __device__ __forceinline__ unsigned a_rowoff(const Unit&, int) const { return 0u; }
};

typedef f32x4 AccT[2][2][4][2];
#define EPI_ROWS_BEGIN  _Pragma("unroll") for (int ai = 0; ai < 2; ++ai) _Pragma("unroll") for (int m = 0; m < 4; ++m) { const int row = row0 + ai * 128 + m * 16;
#define EPI_ROWS_END    }
__device__ __forceinline__ u32x4 pack8(const f32x4& a, const f32x4& b) { u32x4 w; w.x = pg8::cvt_pk_bf16(a[0], a[1]); w.y = pg8::cvt_pk_bf16(a[2], a[3]); w.z = pg8::cvt_pk_bf16(b[0], b[1]); w.w = pg8::cvt_pk_bf16(b[2], b[3]); return w; }

__device__ __forceinline__ void s5_row_of(int row, int& rho, int& s) {
    if (row < RL) { const int b = row >> 11, t = row & 2047; rho = b * 128 + (t >> 4); s = t & 15; }
    else { const int rc = row - RL, b = rc >> 8, t = rc & 255; rho = 1024 + b * 16 + (t >> 4); s = t & 15; }
}
struct EpiG1 {
    static constexpr bool IDEMP = true;
    static constexpr bool PERM = true;
    unsigned char* ck; const float* gqn; const float* gkn;
    bf16* gtc;
    __device__ __forceinline__ void operator()(const AccT& acc, const Unit& u, int wr, int wc, int fr, int fq) const {
        const int pn = u.pn, row0 = u.pm * 256 + wr * 64 + fr, cin = wc * 32 + 8 * fq;
        if (pn == 1 || pn == 2) {
            bf16* AS5 = (bf16*)(ck + C_AS5);
            EPI_ROWS_BEGIN
                int rho, s; s5_row_of(row, rho, s);
#pragma unroll
                for (int bj = 0; bj < 2; ++bj) { const int c512 = (pn - 1) * 256 + bj * 128 + cin, g = c512 >> 4, n0 = c512 & 15;
                    stg<u32x4>(AS5 + ((size_t)rho * 32 + g) * 512 + s * 16 + n0, pack8(acc[ai][bj][m][0], acc[ai][bj][m][1])); }
            EPI_ROWS_END
            return;
        }
        if (pn == 24) {
            bf16* KRP = (bf16*)(ck + C_KRP);
            if (wc == 0) { EPI_ROWS_BEGIN stg<u32x4>(KRP + (size_t)row * 32 + 8 * fq, pack8(acc[ai][0][m][0], acc[ai][0][m][1])); EPI_ROWS_END }
            return;
        }
        if (pn >= 6 && pn < 10) {
            const bool isq = pn < 8; const int head = 4 * (isq ? pn - 6 : pn - 8) + wc;
            bf16* dst = (bf16*)(ck + (isq ? C_NQ : C_NK)) + head * 64 + 8 * fq; const float* gn = isq ? gqn : gkn;
            f32x4 g[2][2];
#pragma unroll
            for (int bj = 0; bj < 2; ++bj)
#pragma unroll
                for (int n = 0; n < 2; ++n) g[bj][n] = ldg<f32x4>(gn + bj * 32 + 8 * fq + 4 * n);
            const float osc = isq ? 0.125f * LOG2E : 1.0f;
            EPI_ROWS_BEGIN
                float ss = 0.f;
#pragma unroll
                for (int bj = 0; bj < 2; ++bj)
#pragma unroll
                    for (int n = 0; n < 2; ++n) { const f32x4 v = acc[ai][bj][m][n]; ss += v[0] * v[0] + v[1] * v[1] + v[2] * v[2] + v[3] * v[3]; }
                ss = shx_sum<16>(ss); ss = shx_sum<32>(ss);
                const float sc = rsqrtf(ss * (1.0f / 64.0f) + RMS_EPS) * osc;
#pragma unroll
                for (int bj = 0; bj < 2; ++bj) stg<u32x4>(dst + (size_t)row * 512 + bj * 32, pack8(acc[ai][bj][m][0] * sc * g[bj][0], acc[ai][bj][m][1] * sc * g[bj][1]));
            EPI_ROWS_END
            return;
        }
        bf16* dst; int ld, col0; bool sig = false; float* ssq = nullptr; int ssld = 0;
        if (pn == 0) { dst = (bf16*)(ck + C_KVL); ld = 256; col0 = 0; ssq = (float*)(ck + C_SSKV) + wc; ssld = 4; }
        else if (pn < 6) { dst = (bf16*)(ck + C_QL); ld = 768; col0 = (pn - 3) * 256; ssq = (float*)(ck + C_SSQL) + (pn - 3) * 4 + wc; ssld = 12; }
        else if (pn < 12) { dst = (bf16*)(ck + C_NV); ld = 512; col0 = (pn - 10) * 256; }
        else { dst = u.pm >= 64 ? gtc : (bf16*)(ck + C_GT); ld = 3072; col0 = (pn - 12) * 256; sig = true; }
        EPI_ROWS_BEGIN
            float ss = 0.f;
#pragma unroll
            for (int bj = 0; bj < 2; ++bj) {
                f32x4 v0 = acc[ai][bj][m][0], v1 = acc[ai][bj][m][1];
                if (sig) {
#pragma unroll
                    for (int j = 0; j < 4; ++j) { v0[j] = sigmoidf(v0[j]); v1[j] = sigmoidf(v1[j]); } }
                ss += v0[0] * v0[0] + v0[1] * v0[1] + v0[2] * v0[2] + v0[3] * v0[3] + v1[0] * v1[0] + v1[1] * v1[1] + v1[2] * v1[2] + v1[3] * v1[3];
                stg<u32x4>(dst + (size_t)row * ld + col0 + bj * 128 + cin, pack8(v0, v1));
            }
            if (ssq) { ss = shx_sum<16>(ss); ss = shx_sum<32>(ss); if (fq == 0) stg<float>(ssq + (size_t)row * ssld, ss); }
        EPI_ROWS_END
    }
};
struct EpiStore {
    static constexpr bool IDEMP = true;
    static constexpr bool PERM = true;
    bf16* D0; bf16* D1; int ld, split;
    __device__ __forceinline__ void operator()(const AccT& acc, const Unit& u, int wr, int wc, int fr, int fq) const {
        const int row0 = u.pm * 256 + wr * 64 + fr, cin = wc * 32 + 8 * fq;
        bf16* dst = u.pn < split ? D0 : D1; const int col0 = (u.pn < split ? u.pn : u.pn - split) * 256;
        EPI_ROWS_BEGIN
#pragma unroll
            for (int bj = 0; bj < 2; ++bj) stg<u32x4>(dst + (size_t)row * ld + col0 + bj * 128 + cin, pack8(acc[ai][bj][m][0], acc[ai][bj][m][1]));
        EPI_ROWS_END
    }
};
template <int NP> struct EpiStoreRs {
    static constexpr bool IDEMP = true;
    static constexpr bool PERM = true;
    bf16* D0; bf16* D1; int ld, split; const float* ssq; float inv_width;
    __device__ __forceinline__ void operator()(const AccT& acc, const Unit& u, int wr, int wc, int fr, int fq) const {
        const int row0 = u.pm * 256 + wr * 64 + fr, cin = wc * 32 + 8 * fq;
        bf16* dst = u.pn < split ? D0 : D1; const int col0 = (u.pn < split ? u.pn : u.pn - split) * 256;
        float rs[2][4];
#pragma unroll
        for (int ai = 0; ai < 2; ++ai)
#pragma unroll
            for (int m = 0; m < 4; ++m) { const float* p = ssq + (size_t)(row0 + ai * 128 + m * 16) * NP; float t = 0.f;
#pragma unroll
                for (int k = 0; k < NP; k += 4) { const f32x4 q = ldg<f32x4>(p + k); t += (q[0] + q[1]) + (q[2] + q[3]); }
                rs[ai][m] = rsqrtf(t * inv_width + RMS_EPS); }
        EPI_ROWS_BEGIN
            const float r = rs[ai][m];
#pragma unroll
            for (int bj = 0; bj < 2; ++bj) stg<u32x4>(dst + (size_t)row * ld + col0 + bj * 128 + cin, pack8(acc[ai][bj][m][0] * r, acc[ai][bj][m][1] * r));
        EPI_ROWS_END
    }
};
struct EpiS5S {
    static constexpr bool IDEMP = true;
    static constexpr bool PERM = false;
    float* SS;
    __device__ __forceinline__ void operator()(const AccT& acc, const Unit& u, int wr, int wc, int fr, int fq) const {
        const int row0 = u.pm * 256 + wr * 64 + fr, cin = wc * 32 + 4 * fq;
        EPI_ROWS_BEGIN
#pragma unroll
            for (int bj = 0; bj < 2; ++bj)
#pragma unroll
                for (int n = 0; n < 2; ++n) stg<f32x4>(SS + ((size_t)row * 32 + u.pn) * 256 + bj * 128 + cin + 16 * n, acc[ai][bj][m][n]);
        EPI_ROWS_END
    }
};
struct EpiS5Y {
    static constexpr bool IDEMP = true;
    static constexpr bool PERM = true;
    bf16* YG; bf16* YGc;
    __device__ __forceinline__ void operator()(const AccT& acc, const Unit& u, int wr, int wc, int fr, int fq) const {
        const int row0 = u.pm * 256 + wr * 64 + fr, cin = wc * 32 + 8 * fq, g = u.pn;
        EPI_ROWS_BEGIN
            const int rho = row;
            if (rho < 1152) {
                int base; bf16* yg = YG; if (rho < 1024) base = (rho >> 7) * 2048 + (rho & 127) * 16; else { base = ((rho - 1024) >> 4) * 256 + ((rho - 1024) & 15) * 16; yg = YGc; }
#pragma unroll
                for (int bj = 0; bj < 2; ++bj) { const int col = bj * 128 + cin, t = col >> 4, n0 = col & 15;
                    f32x4 v0 = acc[ai][bj][m][0], v1 = acc[ai][bj][m][1];
#pragma unroll
                    for (int j = 0; j < 4; ++j) { v0[j] = gelu_tanh(v0[j]); v1[j] = gelu_tanh(v1[j]); }
                    stg<u32x4>(yg + (size_t)(base + t) * 512 + g * 16 + n0, pack8(v0, v1)); }
            }
        EPI_ROWS_END
    }
};
template <int MODE> struct EpiPair {
    static constexpr bool IDEMP = true;
    static constexpr bool PERM = true;
    bf16* Dst; int ld;
    __device__ __forceinline__ void operator()(const AccT& acc, const Unit& u, int wr, int wc, int fr, int fq) const {
        const int row0 = u.pm * 256 + wr * 64 + fr, cin = wc * 32 + 8 * fq;
        EPI_ROWS_BEGIN
            f32x4 r0, r1;
#pragma unroll
            for (int j = 0; j < 4; ++j) {
                const float a0 = acc[ai][0][m][0][j], a1 = acc[ai][0][m][1][j], b0 = acc[ai][1][m][0][j], b1 = acc[ai][1][m][1][j];
                if (MODE == 0) { r0[j] = a0 * sigmoidf(b0); r1[j] = a1 * sigmoidf(b1); }
                else { r0[j] = a0 * sigmoidf(a0) * b0; r1[j] = a1 * sigmoidf(a1) * b1; }
            }
            stg<u32x4>(Dst + (size_t)row * ld + u.pn * 128 + cin, pack8(r0, r1));
        EPI_ROWS_END
    }
};
struct EpiMerge {
    static constexpr bool IDEMP = false;
    static constexpr bool PERM = true;
    const bf16* GT; bf16* YMB;
    __device__ __forceinline__ void operator()(const AccT& acc, const Unit& u, int wr, int wc, int fr, int fq) const {
        const int row0 = u.pm * 256 + wr * 64 + fr, cin = wc * 32 + 8 * fq, z = u.z;
        if (z == 0) {
#pragma unroll
            for (int ai = 0; ai < 2; ++ai) {
                u32x4 gw[4][2];
#pragma unroll
                for (int m = 0; m < 4; ++m)
#pragma unroll
                    for (int bj = 0; bj < 2; ++bj) gw[m][bj] = ldg<u32x4>(GT + (size_t)(row0 + ai * 128 + m * 16) * 3072 + u.pn * 256 + bj * 128 + cin);
#pragma unroll
                for (int m = 0; m < 4; ++m)
#pragma unroll
                    for (int bj = 0; bj < 2; ++bj) { const u32x4 g = gw[m][bj]; f32x4 v0 = acc[ai][bj][m][0], v1 = acc[ai][bj][m][1];
                        v0[0] *= bflo(g.x); v0[1] *= bfhi(g.x); v0[2] *= bflo(g.y); v0[3] *= bfhi(g.y); v1[0] *= bflo(g.z); v1[1] *= bfhi(g.z); v1[2] *= bflo(g.w); v1[3] *= bfhi(g.w);
                        stg<u32x4>(YMB + (size_t)(row0 + ai * 128 + m * 16) * 1024 + u.pn * 256 + bj * 128 + cin, pack8(v0, v1)); }
            }
            return;
        }
#pragma unroll
        for (int ai = 0; ai < 2; ++ai) {
            u32x4 gw[4][2], yp[4][2];
#pragma unroll
            for (int m = 0; m < 4; ++m)
#pragma unroll
                for (int bj = 0; bj < 2; ++bj) { const int row = row0 + ai * 128 + m * 16, col = u.pn * 256 + bj * 128 + cin;
                    gw[m][bj] = ldg<u32x4>(GT + (size_t)row * 3072 + z * 1024 + col); yp[m][bj] = ldg<u32x4>(YMB + (size_t)row * 1024 + col); }
#pragma unroll
            for (int m = 0; m < 4; ++m)
#pragma unroll
                for (int bj = 0; bj < 2; ++bj) { const u32x4 g = gw[m][bj], y = yp[m][bj]; f32x4 v0 = acc[ai][bj][m][0], v1 = acc[ai][bj][m][1];
                    v0[0] = v0[0] * bflo(g.x) + bflo(y.x); v0[1] = v0[1] * bfhi(g.x) + bfhi(y.x); v0[2] = v0[2] * bflo(g.y) + bflo(y.y); v0[3] = v0[3] * bfhi(g.y) + bfhi(y.y);
                    v1[0] = v1[0] * bflo(g.z) + bflo(y.z); v1[1] = v1[1] * bfhi(g.z) + bfhi(y.z); v1[2] = v1[2] * bflo(g.w) + bflo(y.w); v1[3] = v1[3] * bfhi(g.w) + bfhi(y.w);
                    stg<u32x4>(YMB + (size_t)(row0 + ai * 128 + m * 16) * 1024 + u.pn * 256 + bj * 128 + cin, pack8(v0, v1)); }
        }
    }
};
struct EpiOut {
    static constexpr bool IDEMP = false;
    static constexpr bool PERM = false;
    const float* xl_old; const float* xc_old; float* xl_new; float* xc_new; const float* MODL; int b0;
    __device__ __forceinline__ void operator()(const AccT& acc, const Unit& u, int wr, int wc, int fr, int fq) const {
        const int row0 = u.pm * 256 + wr * 64 + fr, cin = wc * 32 + 4 * fq, trow = u.pm * 256;
        const float* xo; float* xn; int mrow;
        if (b0 < 0) { xo = xc_old + (size_t)trow * 1024; xn = xc_new + (size_t)trow * 1024; mrow = 32; }
        else if (trow < RL) { const size_t tok = (size_t)(b0 + (trow >> 11)) * 2048 + (trow & 2047); xo = xl_old + tok * 1024; xn = xl_new + tok * 1024; mrow = b0 + (trow >> 11); }
        else { const int rc = trow - RL; const size_t tok = (size_t)(b0 + (rc >> 8)) * 256 + (rc & 255); xo = xc_old + tok * 1024; xn = xc_new + tok * 1024; mrow = 32; }
        const float* gt = MODL + (size_t)mrow * 6144 + 2 * 1024 + u.pn * 256 + cin;
        f32x4 g[2][2];
#pragma unroll
        for (int bj = 0; bj < 2; ++bj)
#pragma unroll
            for (int n = 0; n < 2; ++n) g[bj][n] = ldg<f32x4>(gt + bj * 128 + 16 * n);
#pragma unroll
        for (int ai = 0; ai < 2; ++ai)
#pragma unroll
            for (int mp = 0; mp < 2; ++mp) {
                f32x4 xv[2][2][2];
#pragma unroll
                for (int mm = 0; mm < 2; ++mm)
#pragma unroll
                    for (int bj = 0; bj < 2; ++bj)
#pragma unroll
                        for (int n = 0; n < 2; ++n) xv[mm][bj][n] = ldg<f32x4>(xo + (size_t)(row0 - trow + ai * 128 + (2 * mp + mm) * 16) * 1024 + u.pn * 256 + bj * 128 + cin + 16 * n);
#pragma unroll
                for (int mm = 0; mm < 2; ++mm)
#pragma unroll
                    for (int bj = 0; bj < 2; ++bj)
#pragma unroll
                        for (int n = 0; n < 2; ++n) stg<f32x4>(xn + (size_t)(row0 - trow + ai * 128 + (2 * mp + mm) * 16) * 1024 + u.pn * 256 + bj * 128 + cin + 16 * n, xv[mm][bj][n] + g[bj][n] * acc[ai][bj][2 * mp + mm][n]);
            }
    }
};
struct EpiDown {
    static constexpr bool IDEMP = false;
    static constexpr bool PERM = false;
    const int* rowtok; const float* roww; float* xl; float* xc; const float* MODL; float wscale;
    __device__ __forceinline__ void operator()(const AccT& acc, const Unit& u, int wr, int wc, int fr, int fq) const {
        const int row0 = u.pm * 256 + wr * 64 + fr, cin = wc * 32 + 4 * fq, cbase = u.pn * 256 + cin;
        int tk[2][4]; float ww[2][4];
#pragma unroll
        for (int ai = 0; ai < 2; ++ai)
#pragma unroll
            for (int m = 0; m < 4; ++m) { const int row = row0 + ai * 128 + m * 16; tk[ai][m] = ldg<int>(rowtok + row); ww[ai][m] = ldg<float>(roww + row) * wscale; }
#pragma unroll
        for (int ai = 0; ai < 2; ++ai)
#pragma unroll
            for (int mp = 0; mp < 2; ++mp) {
                f32x4 xv[2][2][2], gv[2][2][2]; float* xp[2];
#pragma unroll
                for (int mm = 0; mm < 2; ++mm) { const int tok = tk[ai][2 * mp + mm]; const int t0 = tok < 0 ? 0 : tok;
                    int mrow; if (t0 < NTOK_LAT) { xp[mm] = xl + (size_t)t0 * 1024 + cbase; mrow = t0 >> 11; } else { xp[mm] = xc + (size_t)(t0 - NTOK_LAT) * 1024 + cbase; mrow = 32; }
                    const float* gt = MODL + (size_t)mrow * 6144 + 5 * 1024 + cbase;
#pragma unroll
                    for (int bj = 0; bj < 2; ++bj)
#pragma unroll
                        for (int n = 0; n < 2; ++n) { xv[mm][bj][n] = ldg<f32x4>(xp[mm] + bj * 128 + 16 * n); gv[mm][bj][n] = ldg<f32x4>(gt + bj * 128 + 16 * n); } }
#pragma unroll
                for (int mm = 0; mm < 2; ++mm) { const int m = 2 * mp + mm;
                    if (tk[ai][m] >= 0) { const float w = ww[ai][m];
#pragma unroll
                        for (int bj = 0; bj < 2; ++bj)
#pragma unroll
                            for (int n = 0; n < 2; ++n) stg<f32x4>(xp[mm] + bj * 128 + 16 * n, xv[mm][bj][n] + (gv[mm][bj][n] * w) * acc[ai][bj][m][n]); } }
            }
    }
};

struct EpiDownY {
    static constexpr bool IDEMP = true;
    static constexpr bool PERM = true;
    const int* rowtok; const float* roww; bf16* Y; int nt0;
    __device__ __forceinline__ void operator()(const AccT& acc, const Unit& u, int wr, int wc, int fr, int fq) const {
        const int row0 = u.pm * 256 + wr * 64 + fr, cin = wc * 32 + 8 * fq;
        bf16* Yp = Y + (u.pm < nt0 ? (size_t)0 : (size_t)NTOK * 1024) + u.pn * 256 + cin;
        int tk[2][4]; float ww[2][4];
#pragma unroll
        for (int ai = 0; ai < 2; ++ai)
#pragma unroll
            for (int m = 0; m < 4; ++m) { const int row = row0 + ai * 128 + m * 16; tk[ai][m] = ldg<int>(rowtok + row); ww[ai][m] = ldg<float>(roww + row); }
#pragma unroll
        for (int ai = 0; ai < 2; ++ai)
#pragma unroll
            for (int m = 0; m < 4; ++m) if (tk[ai][m] >= 0) { const float w = ww[ai][m];
#pragma unroll
                for (int bj = 0; bj < 2; ++bj) stg<u32x4>(Yp + (size_t)tk[ai][m] * 1024 + bj * 128, pack8(acc[ai][bj][m][0] * w, acc[ai][bj][m][1] * w)); }
    }
};

__device__ __forceinline__ void tr_item(const float* W, int K, int Nsrc, int scol0, const float* kscale, bf16* WT, int drow0, int k0, LAS float* scr, int lane) {
#pragma unroll
    for (int i = 0; i < 8; ++i) { const int kk = 8 * i + (lane >> 3), n4 = (lane & 7) * 4;
        f32x4 v = {0.f, 0.f, 0.f, 0.f}; if (scol0 >= 0) { v = ldg<f32x4>(W + (size_t)(k0 + kk) * Nsrc + scol0 + n4); if (kscale) v = v * ldg<float>(kscale + k0 + kk); }
        scr[kk * 33 + n4] = v[0]; scr[kk * 33 + n4 + 1] = v[1]; scr[kk * 33 + n4 + 2] = v[2]; scr[kk * 33 + n4 + 3] = v[3]; }
    asm volatile("s_waitcnt lgkmcnt(0)" ::: "memory");
    const int c = lane & 7;
#pragma unroll
    for (int j = 0; j < 4; ++j) { const int n = (lane >> 3) + 8 * j; const LAS float* s = scr + (8 * c) * 33 + n;
        u32x4 o; o.x = pk2(s[0 * 33], s[1 * 33]); o.y = pk2(s[2 * 33], s[3 * 33]); o.z = pk2(s[4 * 33], s[5 * 33]); o.w = pk2(s[6 * 33], s[7 * 33]);
        stg<u32x4>(WT + (size_t)(drow0 + n) * K + k0 + 8 * c, o); }
    asm volatile("s_waitcnt lgkmcnt(0)" ::: "memory");
}
__device__ __forceinline__ int win_src_col(int n) {
    if (n < 256) return n;
    if (n < 768) return 1312 + (n - 256);
    if (n < 1536) return 1824 + (n - 768);
    if (n < 2560) {
        const int base = n < 2048 ? 2592 : 288, r = n < 2048 ? n - 1536 : n - 2048, t = r >> 8, c = r & 255;
        return base + (4 * t + ((c & 127) >> 5)) * 64 + (c >> 7) * 32 + (c & 31); }
    if (n < 3072) return 800 + (n - 2560);
    if (n < 6144) return 3104 + (n - 3072);
    if (n < 6176) return 256 + (n - 6144);
    return -1;
}
__device__ __forceinline__ int pair_src_col(int n) { const int pn = n >> 8, jj = n & 255; return jj < 128 ? 128 * pn + jj : 512 + 128 * pn + (jj - 128); }

__device__ __forceinline__ void prologue_transposes(Frame& F, int cu_lo) {
    LAS float* scr = (LAS float*)(F.lds + F.wave * 16384);
    const int gw = (F.c - cu_lo) * 8 + F.wave, NGW = (F.G - cu_lo) * 8;
    constexpr int I_IN = (NINP / 32) * 16, I_UQ = 24 * 12, I_UKV = 32 * 4, I_GLU = 32 * 8, I_BR = 3 * 32 * 8, I_OUT = 32 * 16, I_UP = 32 * 32 * 16, I_DN = 32 * 32 * 8;
    constexpr int PER_L = I_IN + I_UQ + I_UKV + I_GLU + I_BR + I_OUT;
    for (int it = gw; it < 2 * PER_L; it += NGW) {
        const int l = it / PER_L; int r = it % PER_L;
        if (r < I_IN) { const int nb = r / 16, kb = r % 16; tr_item(F.in[7] + (size_t)l * 1024 * 6176, 1024, 6176, win_src_col(nb * 32), nullptr, (bf16*)(F.ws + WS_WINT) + (size_t)l * NINP * 1024, nb * 32, kb * 64, scr, F.lane); continue; } r -= I_IN;
        if (r < I_UQ) { const int nb = r / 12, kb = r % 12; tr_item(F.in[9] + (size_t)l * 768 * 768, 768, 768, nb * 32, F.in[8] + l * 768, (bf16*)(F.ws + WS_UQT) + (size_t)l * 768 * 768, nb * 32, kb * 64, scr, F.lane); continue; } r -= I_UQ;
        if (r < I_UKV) { const int nb = r / 4, kb = r % 4, n = nb * 32; const int sc = n < 512 ? (n >> 6) * 128 + (n & 63) : ((n - 512) >> 6) * 128 + 64 + (n & 63);
            tr_item(F.in[11] + (size_t)l * 256 * 1024, 256, 1024, sc, F.in[10] + l * 256, (bf16*)(F.ws + WS_UKVT) + (size_t)l * 1024 * 256, n, kb * 64, scr, F.lane); continue; } r -= I_UKV;
        if (r < I_GLU) { const int nb = r / 8, kb = r % 8; tr_item(F.in[25] + (size_t)l * 512 * 1024, 512, 1024, pair_src_col(nb * 32), nullptr, (bf16*)(F.ws + WS_GLUT) + (size_t)l * 1024 * 512, nb * 32, kb * 64, scr, F.lane); continue; } r -= I_GLU;
        if (r < I_BR) { const int z = r / 256, q = r % 256, nb = q / 8, kb = q % 8; tr_item(F.in[26] + ((size_t)l * 3 + z) * 512 * 1024, 512, 1024, nb * 32, nullptr, (bf16*)(F.ws + WS_BRT) + ((size_t)l * 3 + z) * 1024 * 512, nb * 32, kb * 64, scr, F.lane); continue; } r -= I_BR;
        { const int nb = r / 16, kb = r % 16; tr_item(F.in[27] + (size_t)l * 1024 * 1024, 1024, 1024, nb * 32, nullptr, (bf16*)(F.ws + WS_OUTT) + (size_t)l * 1024 * 1024, nb * 32, kb * 64, scr, F.lane); }
    }
}
constexpr int MOE_I_UP = 32 * 32 * 16, MOE_I_DN = 32 * 32 * 8, MOE_ITEMS = MOE_I_UP + MOE_I_DN;
__device__ __forceinline__ void tr_moe_items(Frame& F, int l, int first, int count, int cu_lo) {
    if (F.G <= cu_lo) cu_lo = 0;
    if (F.c < cu_lo) return;
    __syncthreads();
    LAS float* scr = (LAS float*)(F.lds + F.wave * 16384);
    const int gw = (F.c - cu_lo) * 8 + F.wave, NGW = (F.G - cu_lo) * 8;
#pragma nounroll
    for (int it = first + gw; it < first + count; it += NGW) {
        if (it < MOE_I_UP) { const int e = it / 512, q = it % 512, nb = q / 16, kb = q % 16; tr_item(F.in[33] + ((size_t)l * 32 + e) * 1024 * 1024, 1024, 1024, pair_src_col(nb * 32), nullptr, (bf16*)(F.ws + WS_UPT) + ((size_t)l * 32 + e) * 1024 * 1024, nb * 32, kb * 64, scr, F.lane); }
        else { const int r = it - MOE_I_UP, e = r / 256, q = r % 256, nb = q / 8, kb = q % 8; tr_item(F.in[34] + ((size_t)l * 32 + e) * 512 * 1024, 512, 1024, nb * 32, nullptr, (bf16*)(F.ws + WS_DOWNT) + ((size_t)l * 32 + e) * 1024 * 512, nb * 32, kb * 64, scr, F.lane); }
    }
}
__device__ __forceinline__ void prologue_small(Frame& F, int cu_lo) {
    const int gt = (F.c - cu_lo) * 512 + F.tid, NT = (F.G - cu_lo) * 512;
    float* ROPE = (float*)(F.ws + WS_ROPE);
    for (int i = gt; i < 2048 * 16; i += NT) { const int t = i >> 4, a = (i >> 3) & 1, f = i & 7;
        const float inv = powf(10000.0f, -(float)f / 8.0f); const float pos = a == 0 ? (float)(t >> 6) : (float)(t & 63); const float ang = pos * inv;
        ROPE[2 * i] = cosf(ang); ROPE[2 * i + 1] = sinf(ang); }
    float* WGT = (float*)(F.ws + WS_WGT); float* WET = (float*)(F.ws + WS_WET);
    for (int i = gt; i < 2 * 4 * 1024; i += NT) { const int l = i / 4096, e = (i >> 10) & 3, k = i & 1023; WGT[i] = F.in[29][((size_t)l * 1024 + k) * 4 + e]; }
    for (int i = gt; i < 2 * 32 * 1024; i += NT) { const int l = i / 32768, e = (i >> 10) & 31, k = i & 1023; WET[i] = F.in[31][((size_t)l * 1024 + k) * 32 + e]; }
}
__device__ __forceinline__ void prologue_mod(Frame& F, int cu_lo) {
    LAS float* SC = (LAS float*)F.lds;
    __syncthreads();
#pragma unroll 11
    for (int q = 0; q < 66; ++q) { const int i = F.tid + 512 * q, r = i >> 10, k = i & 1023; const float v = r < 32 ? ldg<float>(F.in[1] + r * 1024 + k) : ldg<float>(F.in[3] + k); SC[i] = v * sigmoidf(v); }
    __syncthreads();
    float* MODP = (float*)(F.ws + WS_MODP);
    const int gw = (F.c - cu_lo) * 8 + F.wave, NGW = (F.G - cu_lo) * 8;
    for (int task = gw; task < 2 * 96 * 8; task += NGW) {
        const int ks = task & 7, nb = (task >> 3) % 96, l = task / 768; const int n = nb * 64 + F.lane;
        f32x2 acc[33];
#pragma unroll
        for (int r = 0; r < 33; ++r) acc[r] = (f32x2){0.f, 0.f};
        const float* Wl = F.in[4] + (size_t)l * 1024 * 6144;
#pragma nounroll
        for (int kb = 0; kb < 4; ++kb) { const int k0 = ks * 128 + kb * 32;
            const float* Wk = Wl + (size_t)k0 * 6144;
            f32x2 w[16];
#pragma unroll
            for (int j = 0; j < 16; ++j) { w[j][0] = ldg<float>(Wk + (2 * j) * 6144 + n); w[j][1] = ldg<float>(Wk + (2 * j + 1) * 6144 + n); }
            const LAS float* s0 = SC + k0; const LAS float* s1 = s0 + 16 * 1024; const LAS float* s2 = s0 + 32 * 1024;
            asm volatile("" : "+v"(s0), "+v"(s1), "+v"(s2));
#pragma unroll
            for (int j4 = 0; j4 < 8; ++j4) {
#pragma unroll
                for (int r = 0; r < 33; ++r) { const f32x4 sv = *(const LAS f32x4*)((r < 16 ? s0 : (r < 32 ? s1 : s2)) + (r & 15) * 1024 + 4 * j4);
                    acc[r] += (f32x2){sv[0], sv[1]} * w[2 * j4]; acc[r] += (f32x2){sv[2], sv[3]} * w[2 * j4 + 1]; } } }
#pragma unroll
        for (int r = 0; r < 33; ++r) MODP[(((size_t)ks * 2 + l) * 33 + r) * 6144 + n] = acc[r][0] + acc[r][1];
    }
    __syncthreads();
}
__device__ __forceinline__ void prologue_mod_final(Frame& F) {
    const float* MODP = (const float*)(F.ws + WS_MODP);
    for (int i = F.c * 512 + F.tid; i < 2 * 33 * 6144; i += F.G * 512) { const int l = i / (33 * 6144), n = i % 6144;
        float s = F.in[5][l * 6144 + n];
#pragma unroll
        for (int ks = 0; ks < 8; ++ks) s += MODP[(size_t)ks * 2 * 33 * 6144 + i];
        F.MOD[i] = s; }
}
__device__ __forceinline__ void prologue_s5(Frame& F, int l, int g) {
    LAS float* AP = (LAS float*)F.lds;
    LAS float* BB = AP + 2 * 17 * 64 * 2;
    LAS float* CC = BB + 2 * 64 * 16 * 2;
    LAS float* KJ = CC + 2 * 16 * 64 * 2;
    __syncthreads();
    const float* a_re = F.in[17]; const float* a_im = F.in[18]; const float* ldt = F.in[19]; const float* b_re = F.in[20]; const float* b_im = F.in[21];
    const float* c_re = F.in[22]; const float* c_im = F.in[23]; const float* dsk = F.in[24];
    for (int i = F.tid; i < 2 * 17 * 64; i += 512) { const int dir = i / (17 * 64), j = (i / 64) % 17, p = i & 63;
        const size_t ia = (((size_t)l * 2 + dir) * 32 + g) * 64 + p;
        const float lre = fminf(a_re[ia], -1e-4f), lim = a_im[ia], dt = expf(ldt[((size_t)l * 2 + dir) * 32 + g]);
        const float mag = expf((float)j * (lre * dt)); const float ang = (float)j * (lim * dt);
        AP[2 * i] = mag * cosf(ang); AP[2 * i + 1] = mag * sinf(ang); }
    for (int i = F.tid; i < 2 * 64 * 16; i += 512) { const int dir = i / 1024, p = (i >> 4) & 63, m = i & 15;
        const size_t ia = (((size_t)l * 2 + dir) * 32 + g) * 64 + p;
        const float lre = fminf(a_re[ia], -1e-4f), lim = a_im[ia], dt = expf(ldt[((size_t)l * 2 + dir) * 32 + g]);
        const float mag = expf(lre * dt), abr = mag * cosf(lim * dt), abi = mag * sinf(lim * dt);
        const float den = lre * lre + lim * lim, nre = abr - 1.0f;
        const float fre = (nre * lre + abi * lim) / den, fim = (abi * lre - nre * lim) / den;
        const float br = b_re[ia * 16 + m], bi = b_im[ia * 16 + m];
        BB[2 * i] = fre * br - fim * bi; BB[2 * i + 1] = fre * bi + fim * br; }
    for (int i = F.tid; i < 2 * 16 * 64; i += 512) { const int dir = i / 1024, n = (i >> 6) & 15, p = i & 63;
        const size_t ic = ((((size_t)l * 2 + dir) * 32 + g) * 16 + n) * 64 + p;
        CC[2 * i] = c_re[ic]; CC[2 * i + 1] = c_im[ic]; }
    __syncthreads();
    { const int n = (F.tid >> 4) & 15, m = F.tid & 15, jh = F.tid >> 8;
#pragma nounroll
        for (int dir = 0; dir < 2; ++dir) {
            float sj[8];
#pragma unroll
            for (int q = 0; q < 8; ++q) sj[q] = 0.f;
#pragma unroll 4
            for (int p = 0; p < 64; ++p) {
                const f32x2 b = *(const LAS f32x2*)(BB + ((dir * 64 + p) * 16 + m) * 2), cc = *(const LAS f32x2*)(CC + ((dir * 16 + n) * 64 + p) * 2);
                const float tr = cc[0] * b[0] - cc[1] * b[1], ti = cc[0] * b[1] + cc[1] * b[0];
#pragma unroll
                for (int q = 0; q < 8; ++q) { const f32x2 a = *(const LAS f32x2*)(AP + ((dir * 17 + jh + 2 * q) * 64 + p) * 2); sj[q] += tr * a[0] - ti * a[1]; } }
#pragma unroll
            for (int q = 0; q < 8; ++q) KJ[((dir * 16 + jh + 2 * q) * 16 + n) * 16 + m] = sj[q]; } }
    __syncthreads();
    bf16* BTY = (bf16*)(F.ws + WS_BTY) + ((size_t)l * 32 + g) * 256 * 512;
    for (int i = F.tid; i < 256 * 512; i += 512) { const int row = i >> 9, k = i & 511, t = row >> 4, n = row & 15; float v;
        if (k < 256) { const int s = k >> 4, m = k & 15; v = 0.f;
            if (t >= s) v += KJ[((0 * 16 + (t - s)) * 16 + n) * 16 + m];
            if (s >= t) v += KJ[((1 * 16 + (s - t)) * 16 + n) * 16 + m];
            if (k == row) v += dsk[l * 512 + g * 16 + n]; }
        else { const int kk = k - 256, dir = kk >> 7, im = (kk >> 6) & 1, p = kk & 63, j = dir == 0 ? t + 1 : 16 - t;
            const float ar = AP[((dir * 17 + j) * 64 + p) * 2], ai = AP[((dir * 17 + j) * 64 + p) * 2 + 1];
            const float cr = CC[((dir * 16 + n) * 64 + p) * 2], ci = CC[((dir * 16 + n) * 64 + p) * 2 + 1];
            v = im == 0 ? (cr * ar - ci * ai) : -(cr * ai + ci * ar); }
        BTY[i] = (bf16)f2bf(v); }
    bf16* BTS = (bf16*)(F.ws + WS_BTS) + ((size_t)l * 32 + g) * 256 * 256;
    for (int i = F.tid; i < 256 * 256; i += 512) { const int row = i >> 8, k = i & 255, s = k >> 4, m = k & 15, dir = row >> 7, im = (row >> 6) & 1, p = row & 63, j = dir == 0 ? 15 - s : s;
        const float ar = AP[((dir * 17 + j) * 64 + p) * 2], ai = AP[((dir * 17 + j) * 64 + p) * 2 + 1];
        const float br = BB[((dir * 64 + p) * 16 + m) * 2], bi = BB[((dir * 64 + p) * 16 + m) * 2 + 1];
        const float v = im == 0 ? (ar * br - ai * bi) : (ar * bi + ai * br);
        BTS[i] = (bf16)f2bf(v); }
    float* A16 = (float*)(F.ws + WS_A16);
    for (int i = F.tid; i < 2 * 64; i += 512) { const int dir = i >> 6, p = i & 63;
        A16[((((size_t)l * 2 + dir) * 32 + g) * 64 + p) * 2] = AP[((dir * 17 + 16) * 64 + p) * 2];
        A16[((((size_t)l * 2 + dir) * 32 + g) * 64 + p) * 2 + 1] = AP[((dir * 17 + 16) * 64 + p) * 2 + 1]; }
    __syncthreads();
}

__device__ __forceinline__ void phase_h(Frame& F, int l, int b0, const float* xl, const float* xc, int nrows) {
    bf16* HB = (bf16*)(F.ck + C_HB);
    const float* g1 = F.in[6] + l * 1024;
    const int gw = F.c * 8 + F.wave, NGW = F.G * 8;
    for (int row = gw; row < nrows; row += NGW) {
        const float* xs; int mrow;
        if (row < RL) { mrow = b0 + (row >> 11); xs = xl + ((size_t)mrow * 2048 + (row & 2047)) * 1024; }
        else { const int rc = row - RL; xs = xc + ((size_t)(b0 + (rc >> 8)) * 256 + (rc & 255)) * 1024; mrow = 32; }
        const float* md = F.MOD + ((size_t)l * 33 + mrow) * 6144;
        f32x4 v[4]; float ss = 0.f;
#pragma unroll
        for (int j = 0; j < 4; ++j) { v[j] = ldg<f32x4>(xs + 4 * F.lane + 256 * j); ss += v[j][0] * v[j][0] + v[j][1] * v[j][1] + v[j][2] * v[j][2] + v[j][3] * v[j][3]; }
        const float rstd = rsqrtf(wave_sum(ss) * (1.0f / 1024.0f) + RMS_EPS);
#pragma unroll
        for (int j = 0; j < 4; ++j) { const int col = 4 * F.lane + 256 * j;
            const f32x4 g = ldg<f32x4>(g1 + col), sh = ldg<f32x4>(md + col), sc = ldg<f32x4>(md + 1024 + col);
            const f32x4 h = (v[j] * rstd * g) * (sc + 1.0f) + sh;
            u32x2 o; o.x = pk2(h[0], h[1]); o.y = pk2(h[2], h[3]); stg<u32x2>(HB + (size_t)row * 1024 + col, o); }
    }
}
__device__ __forceinline__ void vt_item(const bf16* src, int ldsrc, bf16* dst, LAS unsigned* scr, int lane) {
    const int r8 = lane >> 3, c8 = lane & 7;
#pragma unroll
    for (int i = 0; i < 8; ++i) { const int key = 8 * i + r8; const u32x4 v = ldg<u32x4>(src + (size_t)key * ldsrc + c8 * 8);
        scr[key * 33 + c8 * 4 + 0] = v.x; scr[key * 33 + c8 * 4 + 1] = v.y; scr[key * 33 + c8 * 4 + 2] = v.z; scr[key * 33 + c8 * 4 + 3] = v.w; }
    asm volatile("s_waitcnt lgkmcnt(0)" ::: "memory");
    const LAS unsigned short* s16 = (const LAS unsigned short*)scr;
#pragma unroll
    for (int i = 0; i < 8; ++i) { const int d = 8 * i + r8; unsigned w[4];
#pragma unroll
        for (int q = 0; q < 4; ++q) { const int k0 = c8 * 8 + q * 2; w[q] = (unsigned)s16[(k0 * 33) * 2 + d] | ((unsigned)s16[((k0 + 1) * 33) * 2 + d] << 16); }
        stg<u32x4>(dst + (size_t)d * KEYS + c8 * 8, (u32x4){w[0], w[1], w[2], w[3]}); }
    asm volatile("s_waitcnt lgkmcnt(0)" ::: "memory");
}
__device__ __forceinline__ void phase_p1(Frame& F, int l, bool ctx_q) {
    bf16* KVL = (bf16*)(F.ck + C_KVL); bf16* QL = (bf16*)(F.ck + C_QL); bf16* NQ = (bf16*)(F.ck + C_NQ); bf16* NK = (bf16*)(F.ck + C_NK);
    const float* gq = F.in[14] + l * 64; const float* gk = F.in[15] + l * 64;
    const int gw = F.c * 8 + F.wave, NGW = F.G * 8, lane = F.lane;
    for (int row = gw; row < RR; row += NGW) {
        { bf16* p = KVL + (size_t)row * 256 + 4 * lane; const u32x2 w = ldg<u32x2>(p);
          const float a = bflo(w.x), b = bfhi(w.x), c = bflo(w.y), d = bfhi(w.y);
          const float rstd = rsqrtf(wave_sum(a * a + b * b + c * c + d * d) * (1.0f / 256.0f) + RMS_EPS);
          stg<u32x2>(p, (u32x2){pk2(a * rstd, b * rstd), pk2(c * rstd, d * rstd)}); }
        { bf16* p = NK + (size_t)row * 512 + 8 * lane; const u32x4 w = ldg<u32x4>(p);
          float v[8] = {bflo(w.x), bfhi(w.x), bflo(w.y), bfhi(w.y), bflo(w.z), bfhi(w.z), bflo(w.w), bfhi(w.w)}; float ss = 0.f;
#pragma unroll
          for (int j = 0; j < 8; ++j) ss += v[j] * v[j];
          ss = shx_sum<1>(ss); ss = shx_sum<2>(ss); ss = shx_sum<4>(ss);
          const float rstd = rsqrtf(ss * (1.0f / 64.0f) + RMS_EPS); const int d0 = 8 * (lane & 7);
#pragma unroll
          for (int j = 0; j < 8; ++j) v[j] *= rstd * ldg<float>(gk + d0 + j);
          stg<u32x4>(p, (u32x4){pk2(v[0], v[1]), pk2(v[2], v[3]), pk2(v[4], v[5]), pk2(v[6], v[7])}); }
        if (row < RL || ctx_q) {
            { bf16* p = QL + (size_t)row * 768 + 12 * lane; u32x2 w[3]; float v[12]; float ss = 0.f;
#pragma unroll
              for (int j = 0; j < 3; ++j) { w[j] = ldg<u32x2>(p + 4 * j); v[4 * j] = bflo(w[j].x); v[4 * j + 1] = bfhi(w[j].x); v[4 * j + 2] = bflo(w[j].y); v[4 * j + 3] = bfhi(w[j].y); }
#pragma unroll
              for (int j = 0; j < 12; ++j) ss += v[j] * v[j];
              const float rstd = rsqrtf(wave_sum(ss) * (1.0f / 768.0f) + RMS_EPS);
#pragma unroll
              for (int j = 0; j < 3; ++j) stg<u32x2>(p + 4 * j, (u32x2){pk2(v[4 * j] * rstd, v[4 * j + 1] * rstd), pk2(v[4 * j + 2] * rstd, v[4 * j + 3] * rstd)}); }
            { bf16* p = NQ + (size_t)row * 512 + 8 * lane; const u32x4 w = ldg<u32x4>(p);
              float v[8] = {bflo(w.x), bfhi(w.x), bflo(w.y), bfhi(w.y), bflo(w.z), bfhi(w.z), bflo(w.w), bfhi(w.w)}; float ss = 0.f;
#pragma unroll
              for (int j = 0; j < 8; ++j) ss += v[j] * v[j];
              ss = shx_sum<1>(ss); ss = shx_sum<2>(ss); ss = shx_sum<4>(ss);
              const float rstd = rsqrtf(ss * (1.0f / 64.0f) + RMS_EPS) * (0.125f * LOG2E); const int d0 = 8 * (lane & 7);
#pragma unroll
              for (int j = 0; j < 8; ++j) v[j] *= rstd * ldg<float>(gq + d0 + j);
              stg<u32x4>(p, (u32x4){pk2(v[0], v[1]), pk2(v[2], v[3]), pk2(v[4], v[5]), pk2(v[6], v[7])}); }
        }
    }
    const bf16* NV = (const bf16*)(F.ck + C_NV); bf16* NVT = (bf16*)(F.ck + C_NVT);
    LAS unsigned* scr = (LAS unsigned*)(F.lds + F.wave * 16384);
    for (int it = gw; it < NB * 8 * 36; it += NGW) { const int kb = it % 36, h = (it / 36) & 7, b = it / 288;
        const int srow = kb < 32 ? b * 2048 + 64 * kb : RL + b * 256 + 64 * (kb - 32);
        vt_item(NV + (size_t)srow * 512 + h * 64, 512, NVT + ((size_t)(b * 8 + h) * 64) * KEYS + 64 * kb, scr, lane); }
}
__device__ __forceinline__ void ctx_krope(Frame& F, const bf16* HBc  , const bf16* WKR  ) {
    bf16* KRP = (bf16*)(F.ck + C_KRP); const int gw = F.c * 8 + F.wave, NGW = F.G * 8, lane = F.lane;
    for (int rc = gw; rc < RC; rc += NGW) {
        const u32x4 h0 = ldg<u32x4>(HBc + (size_t)rc * 1024 + 16 * lane), h1 = ldg<u32x4>(HBc + (size_t)rc * 1024 + 16 * lane + 8);
        float hv[16] = {bflo(h0.x), bfhi(h0.x), bflo(h0.y), bfhi(h0.y), bflo(h0.z), bfhi(h0.z), bflo(h0.w), bfhi(h0.w), bflo(h1.x), bfhi(h1.x), bflo(h1.y), bfhi(h1.y), bflo(h1.z), bfhi(h1.z), bflo(h1.w), bfhi(h1.w)};
        float mine = 0.f;
#pragma unroll 4
        for (int j = 0; j < 32; ++j) {
            const u32x4 w0 = ldg<u32x4>(WKR + (size_t)j * 1024 + 16 * lane), w1 = ldg<u32x4>(WKR + (size_t)j * 1024 + 16 * lane + 8);
            float p = hv[0] * bflo(w0.x) + hv[1] * bfhi(w0.x) + hv[2] * bflo(w0.y) + hv[3] * bfhi(w0.y) + hv[4] * bflo(w0.z) + hv[5] * bfhi(w0.z) + hv[6] * bflo(w0.w) + hv[7] * bfhi(w0.w)
                    + hv[8] * bflo(w1.x) + hv[9] * bfhi(w1.x) + hv[10] * bflo(w1.y) + hv[11] * bfhi(w1.y) + hv[12] * bflo(w1.z) + hv[13] * bfhi(w1.z) + hv[14] * bflo(w1.w) + hv[15] * bfhi(w1.w);
            p = wave_sum(p); if (lane == j) mine = p; }
        if (lane < 32) KRP[(size_t)(RL + rc) * 32 + lane] = (bf16)f2bf(mine);
    }
}
__device__ __forceinline__ void phase_p2(Frame& F, int l, bool ctx_q) {
    const int gt = F.tid >= 128 ? F.c * 384 + (F.tid - 128) : 0x7fffffff - 1024, NT = F.G * 384;
    const float* ROPE = (const float*)(F.ws + WS_ROPE);
    if (F.tid < 128) { const float* SS = (const float*)(F.ck + C_SS); bf16* AS5 = (bf16*)(F.ck + C_AS5); const float* A16 = (const float*)(F.ws + WS_A16);
      for (int i = F.c * 128 + F.tid; i < NB * 32 * 2 * 64; i += F.G * 128) { const int p = i & 63, dir = (i >> 6) & 1, g = (i >> 7) & 31, b = i >> 12;
          const float ar = A16[((((size_t)l * 2 + dir) * 32 + g) * 64 + p) * 2], ai = A16[((((size_t)l * 2 + dir) * 32 + g) * 64 + p) * 2 + 1];
          float hr = 0.f, hi = 0.f;
          for (int c0 = 0; c0 < 144; c0 += 24) {
              float sr[24], si[24]; int rho[24];
#pragma unroll
              for (int k = 0; k < 24; ++k) { const int c = c0 + k;
                  rho[k] = dir == 0 ? (c < 16 ? 1024 + b * 16 + c : b * 128 + (c - 16)) : (c < 16 ? 1024 + b * 16 + (15 - c) : b * 128 + (127 - (c - 16)));
                  const float* sp = SS + ((size_t)rho[k] * 32 + g) * 256 + dir * 128 + p; sr[k] = ldg<float>(sp); si[k] = ldg<float>(sp + 64); }
#pragma unroll
              for (int k = 0; k < 24; ++k) { bf16* ap = AS5 + ((size_t)rho[k] * 32 + g) * 512 + 256 + dir * 128 + p;
                  ap[0] = (bf16)f2bf(hr); ap[64] = (bf16)f2bf(hi);
                  const float nr = ar * hr - ai * hi + sr[k], ni = ar * hi + ai * hr + si[k]; hr = nr; hi = ni; }
          } } }
#define UNPK(PW, FA) do { const u32x4 pw_ = (PW); FA[0] = bflo(pw_.x); FA[1] = bfhi(pw_.x); FA[2] = bflo(pw_.y); FA[3] = bfhi(pw_.y); FA[4] = bflo(pw_.z); FA[5] = bfhi(pw_.z); FA[6] = bflo(pw_.w); FA[7] = bfhi(pw_.w); } while (0)
#define PK8(FA) ((u32x4){pk2(FA[0], FA[1]), pk2(FA[2], FA[3]), pk2(FA[4], FA[5]), pk2(FA[6], FA[7])})
    { const bf16* QR = (const bf16*)(F.ck + C_QR); const bf16* KN = (const bf16*)(F.ck + C_KN); const bf16* KRP = (const bf16*)(F.ck + C_KRP);
      bf16* QF = (bf16*)(F.ck + C_QF); bf16* KF = (bf16*)(F.ck + C_KF);
      const int nq = (ctx_q ? RR : RL) * 8, ntot = nq + RR * 8;
      LAS unsigned char* st = F.lds + F.wave * 16384;
      for (int i = gt; i < ntot; i += NT) {
          const bool isq = __builtin_amdgcn_readfirstlane(i) < nq;
          const int ii = isq ? i : i - nq, row = ii >> 3, h = ii & 7;
          int ln = F.lane; asm volatile("" : "+v"(ln));
          const int i0 = ii - ln;
          const float* gn = isq ? F.in[12] + l * 96 : F.in[13] + l * 96;
          const float osc = isq ? 0.10206207261596575f * LOG2E : 1.0f;
          bf16* dst0 = (isq ? QF : KF) + (size_t)i0 * 96;
          u32x4 w[12];
          if (isq) { const bf16* s0 = QR + (size_t)i0 * 96;
#pragma unroll
              for (int j = 0; j < 12; ++j) { const int idx = j * 64 + ln; w[j] = ldg<u32x4>(s0 + idx * 8); }
#pragma unroll
              for (int j = 0; j < 12; ++j) { const int idx = j * 64 + ln; *(LAS u32x4*)(st + 16 * (idx + idx / 12)) = w[j]; }
          } else { const bf16* s0 = KN + (size_t)i0 * 64;
#pragma unroll
              for (int j = 0; j < 8; ++j) { const int idx = j * 64 + ln; w[j] = ldg<u32x4>(s0 + idx * 8); }
#pragma unroll
              for (int c = 0; c < 4; ++c) w[8 + c] = ldg<u32x4>(KRP + (size_t)row * 32 + c * 8);
#pragma unroll
              for (int j = 0; j < 8; ++j) { const int idx = j * 64 + ln; *(LAS u32x4*)(st + 16 * idx + 80 * (idx >> 3)) = w[j]; }
          }
          asm volatile("s_waitcnt lgkmcnt(0)" ::: "memory");
          if (isq) {
#pragma unroll
              for (int c = 0; c < 12; ++c) w[c] = *(const LAS u32x4*)(st + ln * 208 + c * 16);
          } else {
#pragma unroll
              for (int c = 0; c < 8; ++c) w[c] = *(const LAS u32x4*)(st + ln * 208 + c * 16);
          }
          float ss = 0.f;
#pragma unroll
          for (int c = 0; c < 12; ++c) { float f[8]; UNPK(w[c], f);
#pragma unroll
              for (int j = 0; j < 8; ++j) ss += f[j] * f[j]; }
          const float rstd = rsqrtf(ss * (1.0f / 96.0f) + RMS_EPS);
          LAS unsigned char* mine = st + ln * 208;
#pragma unroll
          for (int c = 0; c < 8; ++c) { float f[8]; UNPK(w[c], f);
#pragma unroll
              for (int j = 0; j < 8; ++j) f[j] *= rstd * gn[8 * c + j] * osc;
              *(LAS u32x4*)(mine + c * 16) = PK8(f); }
          const float* rp = ROPE + (size_t)(row & 2047) * 32; const bool rope = row < RL;
#pragma unroll
          for (int a = 0; a < 2; ++a) { float x1[8], x2[8]; UNPK(w[8 + 2 * a], x1); UNPK(w[9 + 2 * a], x2);
#pragma unroll
              for (int f = 0; f < 8; ++f) {
                  float cs = 1.0f, sn = 0.0f; if (rope) { const f32x2 t = ldg<f32x2>(rp + (a * 8 + f) * 2); cs = t[0]; sn = t[1]; }
                  const float v1 = x1[f] * rstd * gn[64 + a * 16 + f], v2 = x2[f] * rstd * gn[64 + a * 16 + 8 + f];
                  x1[f] = (v1 * cs - v2 * sn) * osc; x2[f] = (v1 * sn + v2 * cs) * osc; }
              *(LAS u32x4*)(mine + (8 + 2 * a) * 16) = PK8(x1); *(LAS u32x4*)(mine + (9 + 2 * a) * 16) = PK8(x2); }
          asm volatile("s_waitcnt lgkmcnt(0)" ::: "memory");
          int lo = ln; asm volatile("" : "+v"(lo));
#pragma unroll
          for (int j = 0; j < 12; ++j) { const int idx = j * 64 + lo; stg<u32x4>(dst0 + idx * 8, *(const LAS u32x4*)(st + 16 * (idx + idx / 12))); }
          asm volatile("s_waitcnt lgkmcnt(0)" ::: "memory");
      } }
#undef UNPK
#undef PK8
    { const bf16* VV = (const bf16*)(F.ck + C_VV); bf16* VT = (bf16*)(F.ck + C_VT); LAS unsigned* scr = (LAS unsigned*)(F.lds + F.wave * 16384);
      const int gw = F.wave >= 2 ? F.c * 6 + (F.wave - 2) : 0x7fffffff - 1024, NGW = F.G * 6;
      for (int it = gw; it < NB * 8 * 36; it += NGW) { const int kb = it % 36, h = (it / 36) & 7, b = it / 288;
          const int srow = kb < 32 ? b * 2048 + 64 * kb : RL + b * 256 + 64 * (kb - 32);
          vt_item(VV + (size_t)srow * 512 + h * 64, 512, VT + ((size_t)(b * 8 + h) * 64) * KEYS + 64 * kb, scr, F.lane); }
      const bf16* NV = (const bf16*)(F.ck + C_NV); bf16* NVT = (bf16*)(F.ck + C_NVT);
      for (int it = gw; it < NB * 8 * 36; it += NGW) { const int kb = it % 36, h = (it / 36) & 7, b = it / 288;
          const int srow = kb < 32 ? b * 2048 + 64 * kb : RL + b * 256 + 64 * (kb - 32);
          vt_item(NV + (size_t)srow * 512 + h * 64, 512, NVT + ((size_t)(b * 8 + h) * 64) * KEYS + 64 * kb, scr, F.lane); } }
}


constexpr int AT_KROW = 208, AT_VROW = 136, AT_KB = 64 * AT_KROW, AT_VB = 64 * AT_VROW, AT_SLOT = AT_KB + AT_VB;
__device__ __forceinline__ void mla_unit(Frame& F, const bf16* Qh  , const bf16* KFh  , const bf16* VTh  ,
                                         bf16* Oh  , int b, int kt0, int kt1) {
    LAS unsigned char* lds = F.lds; const int tid = F.tid, lane = F.lane, w = F.wave, r32 = lane & 31, hh = lane >> 5;
    const int kr0 = tid / 12, kc0 = tid % 12, kr1 = (tid + 512) / 12, kc1 = (tid + 512) % 12, vd = tid >> 3, vc = tid & 7;
    u32x4 sk0, sk1, sv;
#define AT_KROWIDX(kt) ((kt) < 32 ? b * 2048 + 64 * (kt) : RL + b * 256 + 64 * ((kt) - 32))
#define AT_LOAD(kt) do { const int kr_ = AT_KROWIDX(kt); sk0 = ldg<u32x4>(KFh + (size_t)(kr_ + kr0) * 768 + kc0 * 8); if (tid < 256) sk1 = ldg<u32x4>(KFh + (size_t)(kr_ + kr1) * 768 + kc1 * 8); \
        sv = ldg<u32x4>(VTh + (size_t)vd * KEYS + 64 * (kt) + vc * 8); } while (0)
#define AT_WRITE(slot) do { LAS unsigned char* s_ = lds + (slot) * AT_SLOT; *(LAS u32x4*)(s_ + kr0 * AT_KROW + kc0 * 16) = sk0; if (tid < 256) *(LAS u32x4*)(s_ + kr1 * AT_KROW + kc1 * 16) = sk1; \
        *(LAS u32x2*)(s_ + AT_KB + vd * AT_VROW + vc * 16) = (u32x2){sv.x, sv.y}; *(LAS u32x2*)(s_ + AT_KB + vd * AT_VROW + vc * 16 + 8) = (u32x2){sv.z, sv.w}; } while (0)
    bf16x8 qf[6];
#pragma unroll
    for (int ks = 0; ks < 6; ++ks) qf[ks] = ldg<bf16x8>(Qh + (size_t)(32 * w + r32) * 768 + 16 * ks + 8 * hh);
    f32x16 o0, o1;
#pragma unroll
    for (int r = 0; r < 16; ++r) { o0[r] = 0.f; o1[r] = 0.f; }
    float mrun = 0.f, lrun = 0.f;
    __syncthreads();
    AT_LOAD(kt0); AT_WRITE(0);
    __syncthreads();
    for (int kt = kt0; kt < kt1; ++kt) {
        const int slot = (kt - kt0) & 1;
        if (kt + 1 < kt1) AT_LOAD(kt + 1);
        const LAS unsigned char* ks_ = lds + slot * AT_SLOT; const LAS unsigned char* vs_ = ks_ + AT_KB;
        f32x16 s0, s1;
        bf16x8 kf[12];
#pragma unroll
        for (int ks = 0; ks < 6; ++ks) { kf[2 * ks] = *(const LAS bf16x8*)(ks_ + r32 * AT_KROW + (16 * ks + 8 * hh) * 2); kf[2 * ks + 1] = *(const LAS bf16x8*)(ks_ + (32 + r32) * AT_KROW + (16 * ks + 8 * hh) * 2); }
        __builtin_amdgcn_sched_barrier(0);
#pragma unroll
        for (int ks = 0; ks < 6; ++ks) {
            if (ks == 0) { const f32x16 z16 = {}; s0 = __builtin_amdgcn_mfma_f32_32x32x16_bf16(kf[0], qf[0], z16, 0, 0, 0); s1 = __builtin_amdgcn_mfma_f32_32x32x16_bf16(kf[1], qf[0], z16, 0, 0, 0); }
            else { s0 = __builtin_amdgcn_mfma_f32_32x32x16_bf16(kf[2 * ks], qf[ks], s0, 0, 0, 0); s1 = __builtin_amdgcn_mfma_f32_32x32x16_bf16(kf[2 * ks + 1], qf[ks], s1, 0, 0, 0); }
        }
        u32x2 vfa[4][2], vfc[4][2];
#pragma unroll
        for (int kh = 0; kh < 2; ++kh)
#pragma unroll
            for (int s = 0; s < 2; ++s) { const int kk = 32 * kh + 16 * s + 4 * hh;
#pragma unroll
                for (int dt = 0; dt < 2; ++dt) { vfa[kh * 2 + s][dt] = *(const LAS u32x2*)(vs_ + (32 * dt + r32) * AT_VROW + kk * 2); vfc[kh * 2 + s][dt] = *(const LAS u32x2*)(vs_ + (32 * dt + r32) * AT_VROW + (kk + 8) * 2); } }
        __builtin_amdgcn_sched_barrier(0);
        { const f32x2 m2 = {mrun, mrun};
#pragma unroll
          for (int r = 0; r < 16; r += 2) { const f32x2 a = (f32x2){s0[r], s0[r + 1]} - m2, c = (f32x2){s1[r], s1[r + 1]} - m2; s0[r] = a[0]; s0[r + 1] = a[1]; s1[r] = c[0]; s1[r + 1] = c[1]; } }
        float ma = fmaxf(fmaxf(s0[0], s0[1]), s0[2]), mb = fmaxf(fmaxf(s1[0], s1[1]), s1[2]);
#pragma unroll
        for (int r = 3; r < 15; r += 2) { ma = fmaxf(fmaxf(ma, s0[r]), s0[r + 1]); mb = fmaxf(fmaxf(mb, s1[r]), s1[r + 1]); }
        float mx = fmaxf(fmaxf(ma, mb), fmaxf(s0[15], s1[15]));
        mx = shx_max<32>(mx);
        if (kt == kt0 || __any(mx > 8.0f)) {
            const float d = kt == kt0 ? mx : fmaxf(mx, 0.0f), alpha = fast_exp2(-d); mrun += d; lrun *= alpha;
#pragma unroll
            for (int r = 0; r < 16; ++r) { o0[r] *= alpha; o1[r] *= alpha; s0[r] -= d; s1[r] -= d; }
        }
        f32x2 rs2 = {0.f, 0.f};
#pragma unroll
        for (int r = 0; r < 16; ++r) { s0[r] = fast_exp2(s0[r]); s1[r] = fast_exp2(s1[r]); }
#pragma unroll
        for (int r = 0; r < 16; r += 2) { rs2 += (f32x2){s0[r], s0[r + 1]}; rs2 += (f32x2){s1[r], s1[r + 1]}; }
        lrun += rs2[0] + rs2[1];
#pragma unroll
        for (int kh = 0; kh < 2; ++kh)
#pragma unroll
            for (int s = 0; s < 2; ++s) {
                u32x4 pw;
                if (kh == 0) { pw.x = pg8::cvt_pk_bf16(s0[8 * s], s0[8 * s + 1]); pw.y = pg8::cvt_pk_bf16(s0[8 * s + 2], s0[8 * s + 3]); pw.z = pg8::cvt_pk_bf16(s0[8 * s + 4], s0[8 * s + 5]); pw.w = pg8::cvt_pk_bf16(s0[8 * s + 6], s0[8 * s + 7]); }
                else { pw.x = pg8::cvt_pk_bf16(s1[8 * s], s1[8 * s + 1]); pw.y = pg8::cvt_pk_bf16(s1[8 * s + 2], s1[8 * s + 3]); pw.z = pg8::cvt_pk_bf16(s1[8 * s + 4], s1[8 * s + 5]); pw.w = pg8::cvt_pk_bf16(s1[8 * s + 6], s1[8 * s + 7]); }
                const bf16x8 pb = __builtin_bit_cast(bf16x8, pw);
                {   const u32x2 a = vfa[kh * 2 + s][0], c = vfc[kh * 2 + s][0];
                    const bf16x8 vf = __builtin_bit_cast(bf16x8, (u32x4){a.x, a.y, c.x, c.y});
                    o0 = __builtin_amdgcn_mfma_f32_32x32x16_bf16(vf, pb, o0, 0, 0, 0); }
                {   const u32x2 a = vfa[kh * 2 + s][1], c = vfc[kh * 2 + s][1];
                    const bf16x8 vf = __builtin_bit_cast(bf16x8, (u32x4){a.x, a.y, c.x, c.y});
                    o1 = __builtin_amdgcn_mfma_f32_32x32x16_bf16(vf, pb, o1, 0, 0, 0); }
            }
        if (kt + 1 < kt1) AT_WRITE(slot ^ 1);
        __syncthreads();
    }
    const float ltot = shx_sum<32>(lrun), inv = 1.0f / ltot;
    bf16* orow = Oh + (size_t)(32 * w + r32) * 512;
#pragma unroll
    for (int g4 = 0; g4 < 4; ++g4) {
        stg<u32x2>(orow + 8 * g4 + 4 * hh, (u32x2){pk2(o0[4 * g4] * inv, o0[4 * g4 + 1] * inv), pk2(o0[4 * g4 + 2] * inv, o0[4 * g4 + 3] * inv)});
        stg<u32x2>(orow + 32 + 8 * g4 + 4 * hh, (u32x2){pk2(o1[4 * g4] * inv, o1[4 * g4 + 1] * inv), pk2(o1[4 * g4 + 2] * inv, o1[4 * g4 + 3] * inv)});
    }
#undef AT_KROWIDX
#undef AT_LOAD
#undef AT_WRITE
}
__device__ __forceinline__ void phase_mla(Frame& F, bool ctx_q, bf16* OAc  ) {
    const bf16* QF = (const bf16*)(F.ck + C_QF); const bf16* KF = (const bf16*)(F.ck + C_KF); const bf16* VT = (const bf16*)(F.ck + C_VT); bf16* OA = (bf16*)(F.ck + C_OA);
    const int nlat = NB * 8 * 8, ntot = nlat + (ctx_q ? NB * 8 : 0);
    for (int u0 = F.c; u0 < ntot; u0 += F.G) {
        int u = u0;
        if (F.G == 256 && u0 < nlat) { const int x = u0 & 7, slot = ((u0 & 255) >> 3) + 32 * (u0 >> 8); u = ((x * 8 + (slot >> 3)) << 3) | (slot & 7); }
        if (u < nlat) { const int b = u >> 6, h = (u >> 3) & 7, qb = u & 7; const int row0 = b * 2048 + qb * 256;
            mla_unit(F, QF + (size_t)row0 * 768 + h * 96, KF + h * 96, VT + ((size_t)(b * 8 + h) * 64) * KEYS, OA + (size_t)row0 * 512 + h * 64, b, 0, 36); }
        else { const int v = u - nlat, b = v >> 3, h = v & 7; const int row0 = RL + b * 256;
            mla_unit(F, QF + (size_t)row0 * 768 + h * 96, KF + h * 96, VT + ((size_t)(b * 8 + h) * 64) * KEYS, OAc + (size_t)(b * 256) * 512 + h * 64, b, 32, 36); }
    }
    __syncthreads();
}

struct NatOps { bf16x8 k[2][2]; u32x2 v[4][2]; };
__device__ __forceinline__ void nat_load(NatOps& o, const bf16* Kp  , const bf16* VTp  , int g) {
#pragma unroll
    for (int sub = 0; sub < 2; ++sub) { o.k[sub][0] = ldg<bf16x8>(Kp + (size_t)sub * 16 * 512 + 8 * g); o.k[sub][1] = ldg<bf16x8>(Kp + (size_t)sub * 16 * 512 + 32 + 8 * g); }
#pragma unroll
    for (int dt = 0; dt < 4; ++dt) { o.v[dt][0] = ldg<u32x2>(VTp + (size_t)dt * 16 * KEYS); o.v[dt][1] = ldg<u32x2>(VTp + (size_t)dt * 16 * KEYS + 16); }
}
__device__ __forceinline__ void nat_compute(const NatOps& ops, const bf16x8 (&qf)[2], f32x4 (&o)[4], float& mrun, float& lrun, const float (&bias)[2][4], const bool (&valid)[2][4], bool masked) {
    f32x4 s[2];
#pragma unroll
    for (int sub = 0; sub < 2; ++sub) {
        s[sub] = (f32x4){0.f, 0.f, 0.f, 0.f};
        s[sub] = __builtin_amdgcn_mfma_f32_16x16x32_bf16(ops.k[sub][0], qf[0], s[sub], 0, 0, 0);
        s[sub] = __builtin_amdgcn_mfma_f32_16x16x32_bf16(ops.k[sub][1], qf[1], s[sub], 0, 0, 0);
    }
    if (masked) {
#pragma unroll
        for (int sub = 0; sub < 2; ++sub)
#pragma unroll
            for (int r = 0; r < 4; ++r) s[sub][r] = valid[sub][r] ? s[sub][r] + bias[sub][r] : -1e30f;
    }
    float mx = fmaxf(fmaxf(fmaxf(s[0][0], s[0][1]), fmaxf(s[0][2], s[0][3])), fmaxf(fmaxf(s[1][0], s[1][1]), fmaxf(s[1][2], s[1][3])));
    mx = shx_max<16>(mx); mx = shx_max<32>(mx);
    const float mn = fmaxf(mrun, mx), alpha = fast_exp2(mrun - mn); mrun = mn;
    float rs = 0.f;
#pragma unroll
    for (int sub = 0; sub < 2; ++sub)
#pragma unroll
        for (int r = 0; r < 4; ++r) { s[sub][r] = fast_exp2(s[sub][r] - mn); rs += s[sub][r]; }
    lrun = lrun * alpha + rs;
    u32x4 pw; pw.x = pg8::cvt_pk_bf16(s[0][0], s[0][1]); pw.y = pg8::cvt_pk_bf16(s[0][2], s[0][3]); pw.z = pg8::cvt_pk_bf16(s[1][0], s[1][1]); pw.w = pg8::cvt_pk_bf16(s[1][2], s[1][3]);
    const bf16x8 pb = __builtin_bit_cast(bf16x8, pw);
#pragma unroll
    for (int dt = 0; dt < 4; ++dt) {
        const bf16x8 vf = __builtin_bit_cast(bf16x8, (u32x4){ops.v[dt][0].x, ops.v[dt][0].y, ops.v[dt][1].x, ops.v[dt][1].y});
        o[dt] = o[dt] * alpha;
        o[dt] = __builtin_amdgcn_mfma_f32_16x16x32_bf16(vf, pb, o[dt], 0, 0, 0);
    }
}
constexpr int NL_KS = 144, NL_CVS = 528;
constexpr int NL_CK = 0, NL_CV = 256 * NL_KS, NL_SLOT0 = NL_CV + 64 * NL_CVS, NL_SLOTB = 2 * 64 * NL_KS, NL_RPB = NL_SLOT0 + 2 * NL_SLOTB;
__device__ __forceinline__ void nat_lds_ops(NatOps& o, const LAS unsigned char* Kt  , const LAS unsigned char* Vt  , int vstride, int qi, int g) {
#pragma unroll
    for (int sub = 0; sub < 2; ++sub) { o.k[sub][0] = *(const LAS bf16x8*)(Kt + (16 * sub + qi) * NL_KS + 16 * g); o.k[sub][1] = *(const LAS bf16x8*)(Kt + (16 * sub + qi) * NL_KS + 64 + 16 * g); }
#pragma unroll
    for (int dt = 0; dt < 4; ++dt) { o.v[dt][0] = *(const LAS u32x2*)(Vt + (16 * dt + qi) * vstride + 8 * g); o.v[dt][1] = *(const LAS u32x2*)(Vt + (16 * dt + qi) * vstride + 32 + 8 * g); }
}
__device__ __forceinline__ void nat_unit(Frame& F, const bf16* NQ, const bf16* NK, const bf16* NVT, bf16* OB, bf16* OBc, const float* rpb_h  , int b, int h, int q, bool ctx_q) {
    LAS unsigned char* lds = F.lds; const int tid = F.tid, lane = F.lane, w = F.wave, qi = lane & 15, g = lane >> 4, j = w & 3;
    LAS float* RPB = (LAS float*)(lds + NL_RPB);
    const bf16* VTb = NVT + (size_t)(b * 8 + h) * 64 * KEYS;
    __syncthreads();
    { u32x4 ck[4], cv[4];
#pragma unroll
      for (int k = 0; k < 4; ++k) { const int idx = tid + 512 * k; ck[k] = ldg<u32x4>(NK + (size_t)(RL + b * 256 + (idx >> 3)) * 512 + h * 64 + (idx & 7) * 8); cv[k] = ldg<u32x4>(VTb + (size_t)(idx >> 5) * KEYS + 2048 + (idx & 31) * 8); }
#pragma unroll
      for (int k = 0; k < 4; ++k) { const int idx = tid + 512 * k; *(LAS u32x4*)(lds + NL_CK + (idx >> 3) * NL_KS + (idx & 7) * 16) = ck[k]; *(LAS u32x4*)(lds + NL_CV + (idx >> 5) * NL_CVS + (idx & 31) * 16) = cv[k]; }
      if (tid < 15 * 31) RPB[tid] = ldg<float>(rpb_h + tid) * LOG2E; }
    bf16x8 qf[4][2]; f32x4 o[4][4]; float mrun[4], lrun[4]; int rs_[4];
#pragma unroll
    for (int i = 0; i < 4; ++i) { const int row = 8 * q + (w >> 2) + 2 * i; rs_[i] = min(max(row - 4, 0), 24);
        const bf16* qp = NQ + (size_t)(b * 2048 + row * 64 + 16 * j + qi) * 512 + h * 64;
        qf[i][0] = ldg<bf16x8>(qp + 8 * g); qf[i][1] = ldg<bf16x8>(qp + 32 + 8 * g); mrun[i] = -1e30f; lrun[i] = 0.f;
#pragma unroll
        for (int dt = 0; dt < 4; ++dt) o[i][dt] = (f32x4){0.f, 0.f, 0.f, 0.f}; }
    const int bs = min(max(16 * j - 8, 0), 32), qc = 16 * j + qi, cs = min(max(qc - 8, 0), 48);
    bool valid[2][4]; int dcl[2][4];
#pragma unroll
    for (int sub = 0; sub < 2; ++sub)
#pragma unroll
        for (int rg = 0; rg < 4; ++rg) { const int kc = bs + 16 * sub + 4 * g + rg; valid[sub][rg] = (unsigned)(kc - cs) < 16u; dcl[sub][rg] = min(max(kc - qc + 15, 0), 30); }
    const int kr_lo = min(max(8 * q - 4, 0), 24), kr_hi = min(max(8 * q + 3, 0), 24) + 7, nkr = kr_hi - kr_lo + 1;
    const int tk = tid >> 3, tc = tid & 7;
    u32x4 sk, sv;
#define NL_LOAD(kr) do { sk = ldg<u32x4>(NK + (size_t)(b * 2048 + (kr) * 64 + tk) * 512 + h * 64 + tc * 8); sv = ldg<u32x4>(VTb + (size_t)tk * KEYS + (kr) * 64 + tc * 8); } while (0)
#define NL_WRITE(slot) do { *(LAS u32x4*)(lds + NL_SLOT0 + (slot) * NL_SLOTB + tk * NL_KS + tc * 16) = sk; *(LAS u32x4*)(lds + NL_SLOT0 + (slot) * NL_SLOTB + 64 * NL_KS + tk * NL_KS + tc * 16) = sv; } while (0)
    NL_LOAD(kr_lo); NL_WRITE(0);
    __syncthreads();
    for (int t = 0; t < nkr; ++t) {
        const int kr = kr_lo + t, slot = t & 1;
        if (t + 1 < nkr) NL_LOAD(kr + 1);
        const LAS unsigned char* Kt = lds + NL_SLOT0 + slot * NL_SLOTB + bs * NL_KS; const LAS unsigned char* Vt = Kt - bs * NL_KS + 64 * NL_KS + bs * 2;
        if (kr >= rs_[0] && kr < rs_[3] + 8) {
            NatOps ops; nat_lds_ops(ops, Kt, Vt, NL_KS, qi, g);
#pragma unroll
            for (int i = 0; i < 4; ++i) {
                if (kr >= rs_[i] && kr < rs_[i] + 8) {
                    const int drow = kr - (8 * q + (w >> 2) + 2 * i) + 7;
                    float bias[2][4];
#pragma unroll
                    for (int sub = 0; sub < 2; ++sub)
#pragma unroll
                        for (int rg = 0; rg < 4; ++rg) bias[sub][rg] = RPB[drow * 31 + dcl[sub][rg]];
                    nat_compute(ops, qf[i], o[i], mrun[i], lrun[i], bias, valid, true);
                }
            }
        }
        if (t + 1 < nkr) NL_WRITE(slot ^ 1);
        __syncthreads();
    }
#undef NL_LOAD
#undef NL_WRITE
    { float bias[2][4];
#pragma unroll
      for (int sub = 0; sub < 2; ++sub)
#pragma unroll
          for (int rg = 0; rg < 4; ++rg) bias[sub][rg] = 0.f;
      for (int cb = 0; cb < 8; ++cb) {
          NatOps ops; nat_lds_ops(ops, lds + NL_CK + 32 * cb * NL_KS, lds + NL_CV + 64 * cb, NL_CVS, qi, g);
#pragma unroll
          for (int i = 0; i < 4; ++i) nat_compute(ops, qf[i], o[i], mrun[i], lrun[i], bias, valid, false);
      }
#pragma unroll
      for (int i = 0; i < 4; ++i) { const int row = 8 * q + (w >> 2) + 2 * i; const size_t qrow = (size_t)(b * 2048 + row * 64 + 16 * j + qi);
          float lt = shx_sum<32>(shx_sum<16>(lrun[i])); const float inv = 1.0f / lt;
#pragma unroll
          for (int dt = 0; dt < 4; ++dt) stg<u32x2>(OB + qrow * 512 + h * 64 + 16 * dt + 4 * g, (u32x2){pk2(o[i][dt][0] * inv, o[i][dt][1] * inv), pk2(o[i][dt][2] * inv, o[i][dt][3] * inv)}); }
      if (ctx_q && w < 4) {
          const size_t qrow = (size_t)(RL + b * 256 + 16 * (4 * q + w) + qi); const bf16* qp = NQ + qrow * 512 + h * 64;
          bf16x8 cq[2]; cq[0] = ldg<bf16x8>(qp + 8 * g); cq[1] = ldg<bf16x8>(qp + 32 + 8 * g);
          f32x4 co[4]; float cm = -1e30f, cl = 0.f;
#pragma unroll
          for (int dt = 0; dt < 4; ++dt) co[dt] = (f32x4){0.f, 0.f, 0.f, 0.f};
          for (int cb = 0; cb < 8; ++cb) { NatOps ops; nat_lds_ops(ops, lds + NL_CK + 32 * cb * NL_KS, lds + NL_CV + 64 * cb, NL_CVS, qi, g); nat_compute(ops, cq, co, cm, cl, bias, valid, false); }
          float lt = shx_sum<32>(shx_sum<16>(cl)); const float inv = 1.0f / lt;
#pragma unroll
          for (int dt = 0; dt < 4; ++dt) stg<u32x2>(OBc + (qrow - RL) * 512 + h * 64 + 16 * dt + 4 * g, (u32x2){pk2(co[dt][0] * inv, co[dt][1] * inv), pk2(co[dt][2] * inv, co[dt][3] * inv)});
      } }
}
__device__ __forceinline__ void phase_nat(Frame& F, int l, bool ctx_q, bf16* OBc) {
    const bf16* NQ = (const bf16*)(F.ck + C_NQ); const bf16* NK = (const bf16*)(F.ck + C_NK); const bf16* NVT = (const bf16*)(F.ck + C_NVT); bf16* OB = (bf16*)(F.ck + C_OB);
    for (int u0 = F.c; u0 < NB * 32; u0 += F.G) { int u = u0; if (F.G == 256) { const int x = u0 & 7, j = u0 >> 3; u = ((x * 8 + (j >> 2)) << 2) | (j & 3); }
        const int b = u >> 5, h = (u >> 2) & 7, q = u & 3;
        nat_unit(F, NQ, NK, NVT, OB, OBc, F.in[16] + ((size_t)l * 8 + h) * 15 * 31, b, h, q, ctx_q); }
    __syncthreads();
}

__device__ __forceinline__ void phase_router(Frame& F, int l, int ntok, int cnt_off = 0) {
    bf16* H2 = (bf16*)(F.ck + M_H2); int* ROWTOK = (int*)(F.ck + M_ROWTOK); i32x4* TOKE = (i32x4*)(F.ck + M_TOKE); f32x2* TOKW = (f32x2*)(F.ck + M_TOKW);
    unsigned* cnt = (unsigned*)(F.ws + WS_CTL) + CW_CNT + l * 64 + cnt_off;
    const float* g2 = F.in[28] + l * 1024; const float* WGT = (const float*)(F.ws + WS_WGT) + (size_t)l * 4 * 1024; const float* WET = (const float*)(F.ws + WS_WET) + (size_t)l * 32 * 1024;
    const float* bg = F.in[30] + l * 4; const float* be = F.in[32] + l * 32;
    for (int i = F.c * 512 + F.tid; i < MOE_ROWS; i += F.G * 512) ROWTOK[i] = -1;
    LAS float* WEL = (LAS float*)F.lds;
    LAS unsigned* LCNT = (LAS unsigned*)(F.lds + 131072);
    __syncthreads();
    for (int i = F.tid; i < 32 * 1024 / 4; i += 512) *(LAS f32x4*)(WEL + 4 * i) = ldg<f32x4>(WET + 4 * i);
    if (F.tid < 64) LCNT[F.tid] = 0u;
    __syncthreads();
    const int gw = F.c * 8 + F.wave, NGW = F.G * 8, lane = F.lane;
    for (int tok0 = gw * 4; tok0 < ntok; tok0 += NGW * 4) {
        const float* xs; int mrow;
        if (tok0 < NTOK_LAT) { xs = F.out + (size_t)tok0 * 1024; mrow = tok0 >> 11; } else { xs = F.XC + (size_t)(tok0 - NTOK_LAT) * 1024; mrow = 32; }
        const float* md = F.MOD + ((size_t)l * 33 + mrow) * 6144;
        f32x4 v[4][4]; float ss[4];
#pragma unroll
        for (int t = 0; t < 4; ++t) { ss[t] = 0.f;
#pragma unroll
            for (int j = 0; j < 4; ++j) { v[t][j] = ldg<f32x4>(xs + (size_t)t * 1024 + 4 * lane + 256 * j); ss[t] += v[t][j][0] * v[t][j][0] + v[t][j][1] * v[t][j][1] + v[t][j][2] * v[t][j][2] + v[t][j][3] * v[t][j][3]; } }
        float rstd[4];
        { const float rs_own = rsqrtf(red4(ss[0], ss[1], ss[2], ss[3]) * (1.0f / 1024.0f) + RMS_EPS);
#pragma unroll
          for (int t = 0; t < 4; ++t) rstd[t] = lane_bcast(rs_own, 16 * t); }
#pragma unroll
        for (int j = 0; j < 4; ++j) { const int col = 4 * lane + 256 * j;
            const f32x4 g = ldg<f32x4>(g2 + col), sh = ldg<f32x4>(md + 3 * 1024 + col), sc = ldg<f32x4>(md + 4 * 1024 + col) + 1.0f;
#pragma unroll
            for (int t = 0; t < 4; ++t) { v[t][j] = (v[t][j] * rstd[t] * g) * sc + sh;
                stg<u32x2>(H2 + (size_t)(tok0 + t) * 1024 + col, (u32x2){pk2(v[t][j][0], v[t][j][1]), pk2(v[t][j][2], v[t][j][3])}); } }
        float glo[4];
#pragma unroll
        for (int e = 0; e < 4; ++e) { float p[4] = {0.f, 0.f, 0.f, 0.f};
#pragma unroll
            for (int j = 0; j < 4; ++j) { const f32x4 w = ldg<f32x4>(WGT + e * 1024 + 4 * lane + 256 * j);
#pragma unroll
                for (int t = 0; t < 4; ++t) p[t] += v[t][j][0] * w[0] + v[t][j][1] * w[1] + v[t][j][2] * w[2] + v[t][j][3] * w[3]; }
            glo[e] = red4(p[0], p[1], p[2], p[3]) + bg[e]; }
        int gi = 0; float gm = glo[0];
#pragma unroll
        for (int e = 1; e < 4; ++e) if (glo[e] > gm) { gm = glo[e]; gi = e; }
        float gs = 0.f;
#pragma unroll
        for (int e = 0; e < 4; ++e) gs += __expf(glo[e] - gm);
        const float pgrp = 1.0f / gs;
        int grp[4];
#pragma unroll
        for (int t = 0; t < 4; ++t) grp[t] = __builtin_amdgcn_readlane(gi, 16 * t);
        float elo[8];
#pragma unroll
        for (int eh = 0; eh < 2; ++eh) {
            float p[4][4];
#pragma unroll
            for (int t = 0; t < 4; ++t)
#pragma unroll
                for (int e = 0; e < 4; ++e) { float q = 0.f; const LAS float* wr = WEL + (grp[t] * 8 + eh * 4 + e) * 1024;
#pragma unroll
                    for (int j = 0; j < 4; ++j) { const f32x4 w = *(const LAS f32x4*)(wr + 4 * lane + 256 * j); q += v[t][j][0] * w[0] + v[t][j][1] * w[1] + v[t][j][2] * w[2] + v[t][j][3] * w[3]; }
                    p[t][e] = q; }
#pragma unroll
            for (int e = 0; e < 4; ++e) elo[eh * 4 + e] = red4(p[0][e], p[1][e], p[2][e], p[3][e]);
            __builtin_amdgcn_sched_barrier(0);
        }
#pragma unroll
        for (int e = 0; e < 8; ++e) elo[e] += ldg<float>(be + gi * 8 + e);
        int i1 = 0; float v1 = elo[0];
#pragma unroll
        for (int e = 1; e < 8; ++e) if (elo[e] > v1) { v1 = elo[e]; i1 = e; }
        int i2 = -1; float v2 = -3.0e38f;
#pragma unroll
        for (int e = 0; e < 8; ++e) if (e != i1 && elo[e] > v2) { v2 = elo[e]; i2 = e; }
        const float ex = __expf(v2 - v1), mw1 = pgrp / (1.0f + ex), mw2 = pgrp * ex / (1.0f + ex);
        const int me1 = gi * 8 + i1, me2 = gi * 8 + i2;
        if ((lane & 15) == 0) {
            const int s1 = (int)__hip_atomic_fetch_add(LCNT + me1, 1u, __ATOMIC_RELAXED, __HIP_MEMORY_SCOPE_WORKGROUP), s2 = (int)__hip_atomic_fetch_add(LCNT + 32 + me2, 1u, __ATOMIC_RELAXED, __HIP_MEMORY_SCOPE_WORKGROUP);
            TOKE[tok0 + (lane >> 4)] = (i32x4){me1, s1, me2, s2}; TOKW[tok0 + (lane >> 4)] = (f32x2){mw1, mw2};
        }
    }
    __syncthreads();
    if (F.tid < 64) { const unsigned n = LCNT[F.tid]; const unsigned base = n ? atomicAdd(cnt + F.tid, n) : 0u; ((unsigned*)(F.ck + M_WGBASE))[(size_t)F.c * 64 + F.tid] = base; }
    __syncthreads();
}
__device__ __forceinline__ void phase_assign(Frame& F, int l, int ntok) {
    LAS int* T = (LAS int*)(F.lds + LDS_TAB);
    moe_tables((unsigned*)(F.ws + WS_CTL) + CW_CNT + l * 64, T, F.tid);
    int* ROWTOK = (int*)(F.ck + M_ROWTOK); float* ROWW = (float*)(F.ck + M_ROWW); const i32x4* TOKE = (const i32x4*)(F.ck + M_TOKE); const f32x2* TOKW = (const f32x2*)(F.ck + M_TOKW);
    for (int tok = F.c * 512 + F.tid; tok < ntok; tok += F.G * 512) {
        const i32x4 e = TOKE[tok]; const f32x2 w = TOKW[tok];
        const int wg = ((tok >> 2) % (F.G * 8)) >> 3;
        const unsigned* wb = (const unsigned*)(F.ck + M_WGBASE) + (size_t)wg * 64;
        const int r1 = T[2 + e.x] + (int)wb[e.x] + e.y, r2 = T[2 + 32 + e.z] + (int)wb[32 + e.z] + e.w;
        ROWTOK[r1] = tok; ROWW[r1] = w.x; ROWTOK[r2] = tok; ROWW[r2] = w.y;
    }
}

template <bool WITH_H>
__device__ __forceinline__ void phase_comb(Frame& F, int l, int ntok) {
    const bf16* Y = (const bf16*)(F.ck + M_Y); bf16* HBA = (bf16*)(F.ws + WS_HBALL);
    const float* g1n = F.in[6] + (l + 1 < DEPTH ? (l + 1) : l) * 1024;
    const int gw = F.c * 8 + F.wave, NGW = F.G * 8, lane = F.lane;
    for (int tok0 = gw * 4; tok0 < ntok; tok0 += NGW * 4) {
        float* xs; int mrow;
        if (tok0 < NTOK_LAT) { xs = F.out + (size_t)tok0 * 1024; mrow = tok0 >> 11; } else { xs = F.XC + (size_t)(tok0 - NTOK_LAT) * 1024; mrow = 32; }
        const float* gt2 = F.MOD + ((size_t)l * 33 + mrow) * 6144 + 5 * 1024;
        f32x4 v[4][4]; u32x2 y0[4][4], y1[4][4];
        f32x4 gv[4];
#pragma unroll
        for (int j = 0; j < 4; ++j) gv[j] = ldg<f32x4>(gt2 + 4 * lane + 256 * j);
#pragma unroll
        for (int t = 0; t < 4; ++t)
#pragma unroll
            for (int j = 0; j < 4; ++j) { const size_t o = (size_t)(tok0 + t) * 1024 + 4 * lane + 256 * j;
                v[t][j] = ldg<f32x4>(xs + (size_t)t * 1024 + 4 * lane + 256 * j); y0[t][j] = ldg<u32x2>(Y + o); y1[t][j] = ldg<u32x2>(Y + (size_t)NTOK * 1024 + o); }
        float ss[4];
#pragma unroll
        for (int t = 0; t < 4; ++t) { ss[t] = 0.f;
#pragma unroll
            for (int j = 0; j < 4; ++j) {
                f32x4 ysum; ysum[0] = bflo(y0[t][j].x) + bflo(y1[t][j].x); ysum[1] = bfhi(y0[t][j].x) + bfhi(y1[t][j].x); ysum[2] = bflo(y0[t][j].y) + bflo(y1[t][j].y); ysum[3] = bfhi(y0[t][j].y) + bfhi(y1[t][j].y);
                v[t][j] = v[t][j] + gv[j] * ysum;
                stg<f32x4>(xs + (size_t)t * 1024 + 4 * lane + 256 * j, v[t][j]);
                ss[t] += v[t][j][0] * v[t][j][0] + v[t][j][1] * v[t][j][1] + v[t][j][2] * v[t][j][2] + v[t][j][3] * v[t][j][3]; } }
        if constexpr (WITH_H) {
            const float* md = F.MOD + ((size_t)(l + 1) * 33 + mrow) * 6144;
#pragma unroll
            for (int t = 0; t < 4; ++t) ss[t] = rsqrtf(wave_sum(ss[t]) * (1.0f / 1024.0f) + RMS_EPS);
#pragma unroll
            for (int j = 0; j < 4; ++j) { const int col = 4 * lane + 256 * j;
                const f32x4 gg = ldg<f32x4>(g1n + col), sh = ldg<f32x4>(md + col), sc = ldg<f32x4>(md + 1024 + col) + 1.0f;
#pragma unroll
                for (int t = 0; t < 4; ++t) { const f32x4 h = (v[t][j] * ss[t] * gg) * sc + sh;
                    stg<u32x2>(HBA + (size_t)(tok0 + t) * 1024 + col, (u32x2){pk2(h[0], h[1]), pk2(h[2], h[3])}); } }
        }
    }
}

constexpr int MIX_PH = 8, MOE_PH = 5, NSTEPS = 2 + DEPTH * (NCH * MIX_PH + MOE_PH);
__global__ void __launch_bounds__(512, 2) fwd(Args args) {
    extern __shared__ __attribute__((aligned(16))) unsigned char lds_raw[];
    Frame F;
    F.lds = (LAS unsigned char*)lds_raw; F.tid = threadIdx.x; F.lane = F.tid & 63; F.wave = __builtin_amdgcn_readfirstlane(F.tid >> 6); F.G = gridDim.x; F.c = blockIdx.x;
    F.in = args.in; F.out = args.out; F.ws = args.ws; F.ck = args.ws + WS_CHUNK; F.MOD = (float*)(args.ws + WS_MOD); F.XC = (float*)(args.ws + WS_XC);
    for (int u = F.tid; u < (LDS_BYTES - LDS_MISC) / 4; u += 512) ((LAS unsigned*)(F.lds + LDS_MISC))[u] = 0u;
    __syncthreads();
    const int lo = args.lo, hi = args.hi;
    const int wave_id0 = __builtin_amdgcn_readfirstlane((int)threadIdx.x >> 6);
    XcdBarrier bar; bar.bar = (unsigned*)(F.ws + WS_CTL) + CW_BAR; bar.x = 0; bar.st = (volatile LAS unsigned*)(F.lds + LDS_MISC + 32);
    if (hi - lo > 1) bar = xcd_barrier_post((unsigned*)(F.ws + WS_CTL) + CW_BAR, (volatile LAS unsigned*)(F.lds + LDS_MISC + 32));
    int step = 0;
#ifndef SITE_ONLY
#define SITE_ONLY -1
#endif
#ifndef DBG_SKIP_MASK
#define DBG_SKIP_MASK 0u
#endif
#define SITE_ON(id) ((SITE_ONLY < 0 || SITE_ONLY == (id)) && !((DBG_SKIP_MASK >> (id)) & 1u))
#ifndef DBG_REPEAT_MASK
#define DBG_REPEAT_MASK 0x0u
#endif
#define SITE_REPS(id) (((DBG_REPEAT_MASK >> (id)) & 1u) ? 2 : 1)
#define PH_BEGIN(id) if (step >= lo && step < hi) { if (SITE_ON(id)) for (int rep_ = 0; rep_ < SITE_REPS(id); ++rep_) { if (rep_ > 0) xcd_barrier(bar, F.tid == 0); { int t_; asm volatile("v_mbcnt_lo_u32_b32 %0, -1, 0\n\tv_mbcnt_hi_u32_b32 %0, -1, %0" : "=v"(t_)); t_ += wave_id0 * 64; F.tid = t_; F.lane = t_ & 63; F.wave = __builtin_amdgcn_readfirstlane(t_ >> 6); \
        int c_ = blockIdx.x, g_ = gridDim.x; unsigned long long w_ = (unsigned long long)args.ws, o_ = (unsigned long long)args.out; asm volatile("" : "+s"(c_), "+s"(g_), "+s"(w_), "+s"(o_)); \
        F.c = c_; F.G = g_; F.ws = (unsigned char*)w_; F.out = (float*)o_; F.ck = F.ws + WS_CHUNK; F.MOD = (float*)(F.ws + WS_MOD); F.XC = (float*)(F.ws + WS_XC); }
#ifndef DBG_DOUBLE_BAR
#define DBG_DOUBLE_BAR 0
#endif
#define PH_END   } if (step + 1 < hi) { xcd_barrier(bar, F.tid == 0); if (DBG_DOUBLE_BAR) xcd_barrier(bar, F.tid == 0); } } ++step;
    LAS int* TAB = (LAS int*)(F.lds + LDS_TAB);

    PH_BEGIN(0)
        if (F.G >= 128) {
            if (F.c < 64) prologue_s5(F, F.c >> 5, F.c & 31);
            else { prologue_mod(F, 64); prologue_transposes(F, 64); prologue_small(F, 64); }
        } else {
            for (int q = F.c; q < 64; q += F.G) prologue_s5(F, q >> 5, q & 31);
            prologue_mod(F, 0); prologue_transposes(F, 0); prologue_small(F, 0);
        }
    PH_END
    PH_BEGIN(1) prologue_mod_final(F); PH_END

    for (int l = 0; l < DEPTH; ++l) {
        const bool need_ctx = (l == 0);
        const float* xl_old = l == 0 ? F.in[0] : (const float*)F.out; const float* xc_old = l == 0 ? F.in[2] : (const float*)F.XC;
        const float* MODL = F.MOD + (size_t)l * 33 * 6144;
        const int nMrows = need_ctx ? 72 : 64;
        for (int ch = 0; ch < NCH; ++ch) {
            const int b0 = ch * NB;
            if (l == 0 && ch == 0) { PH_BEGIN(2) phase_h(F, l, b0, xl_old, xc_old, RR); PH_END }
            PH_BEGIN(3)
                const bf16* Alat = l == 0 ? (const bf16*)(F.ck + C_HB) : (const bf16*)(F.ws + WS_HBALL) + (size_t)b0 * 2048 * 1024;
                const bf16* Actx = l == 0 ? (const bf16*)(F.ck + C_HB) + (size_t)RL * 1024 : (const bf16*)(F.ws + WS_HBALL) + ((size_t)NTOK_LAT + (size_t)b0 * 256) * 1024;
                ProbG1 P{Alat, Actx, (const bf16*)(F.ws + WS_WINT) + (size_t)l * NINP * 1024, 1024, 1024, 1024, F.G, F.c, need_ctx ? 24 : 8};
                EpiG1 E{F.ck, F.in[14] + l * 64, F.in[15] + l * 64, (bf16*)(F.ws + X_GT) + ((ptrdiff_t)b0 * 256 - RL) * 3072};
                pg8::gemm_phase(F.lds, P, E, F.tid);
                if (l == 1) tr_moe_items(F, 1, ch * (MOE_ITEMS / 4), MOE_ITEMS / 4, 128);
            PH_END
            PH_BEGIN(5)
                if (need_ctx) ctx_krope(F, (const bf16*)(F.ck + C_HB) + (size_t)RL * 1024, (const bf16*)(F.ws + WS_WINT) + ((size_t)l * NINP + 6144) * 1024);
                { ProbPlain P{(const bf16*)(F.ck + C_KVL), (const bf16*)(F.ws + WS_UKVT) + (size_t)l * 1024 * 256, 256, 256, 256, 72, 4, F.G, F.c, 0};
                  EpiStoreRs<4> E{(bf16*)(F.ck + C_KN), (bf16*)(F.ck + C_VV), 512, 2, (const float*)(F.ck + C_SSKV), 1.0f / 256.0f}; pg8::gemm_phase(F.lds, P, E, F.tid); }
                { ProbPlain P{(const bf16*)(F.ck + C_QL), (const bf16*)(F.ws + WS_UQT) + (size_t)l * 768 * 768, 768, 768, 768, nMrows, 3, F.G, (F.c + F.G - 32) % F.G, 0};
                  EpiStoreRs<12> E{(bf16*)(F.ck + C_QR), (bf16*)(F.ck + C_QR), 768, 3, (const float*)(F.ck + C_SSQL), 1.0f / 768.0f}; pg8::gemm_phase(F.lds, P, E, F.tid); }
                { ProbPlain P{(const bf16*)(F.ck + C_AS5), (const bf16*)(F.ws + WS_BTS) + (size_t)l * 32 * 256 * 256, 256, 16384, 256, 5, 32, F.G, (F.c + 8) % F.G, 512};
                  EpiS5S E{(float*)(F.ck + C_SS)}; pg8::gemm_phase(F.lds, P, E, F.tid); }
            PH_END
            PH_BEGIN(6) phase_p2(F, l, need_ctx); PH_END
            PH_BEGIN(7)
#ifndef DBG_REP_MLA
#define DBG_REP_MLA 0
#endif
#ifndef DBG_REP_NAT
#define DBG_REP_NAT 0
#endif
                phase_mla(F, need_ctx, (bf16*)(F.ws + X_OA) + (size_t)b0 * 256 * 512); if (DBG_REP_MLA) phase_mla(F, need_ctx, (bf16*)(F.ws + X_OA) + (size_t)b0 * 256 * 512);
                phase_nat(F, l, need_ctx, (bf16*)(F.ws + X_OB) + (size_t)b0 * 256 * 512); if (DBG_REP_NAT) phase_nat(F, l, need_ctx, (bf16*)(F.ws + X_OB) + (size_t)b0 * 256 * 512);
                { ProbPlain P{(const bf16*)(F.ck + C_AS5), (const bf16*)(F.ws + WS_BTY) + (size_t)l * 32 * 256 * 512, 512, 16384, 512, need_ctx ? 5 : 4, 32, F.G, F.c, 512};
                  EpiS5Y E{(bf16*)(F.ck + C_YG), (bf16*)(F.ws + X_YG) + (size_t)b0 * 256 * 512}; pg8::gemm_phase(F.lds, P, E, F.tid); }
                if (l == 0) tr_moe_items(F, 0, ch * 3072, 3072, 160);
            PH_END
            PH_BEGIN(8)
                ProbPlain P{(const bf16*)(F.ck + C_YG), (const bf16*)(F.ws + WS_GLUT) + (size_t)l * 1024 * 512, 512, 512, 512, 64, 4, F.G, F.c, 0};
                EpiPair<0> E{(bf16*)(F.ck + C_OC), 512}; pg8::gemm_phase(F.lds, P, E, F.tid);
            PH_END
            PH_BEGIN(9)
                ProbMerge P{{(const bf16*)(F.ck + C_OA), (const bf16*)(F.ck + C_OB), (const bf16*)(F.ck + C_OC)}, (const bf16*)(F.ws + WS_BRT) + (size_t)l * 3 * 1024 * 512, 512, 512, 512, 64, 4, F.G, F.c};
                EpiMerge E{(const bf16*)(F.ck + C_GT), (bf16*)(F.ck + C_YMB)}; pg8::gemm_phase(F.lds, P, E, F.tid);
            PH_END
#ifndef DBG_REP_OUT0
#define DBG_REP_OUT0 0
#endif
            PH_BEGIN(10)
              for (int rr_ = 0; rr_ < ((DBG_REP_OUT0 && l == 0) ? 2 : 1); ++rr_) {
                if (rr_) xcd_barrier(bar, F.tid == 0);
                ProbPlain P{(const bf16*)(F.ck + C_YMB), (const bf16*)(F.ws + WS_OUTT) + (size_t)l * 1024 * 1024, 1024, 1024, 1024, 64, 4, F.G, F.c, 0};
                EpiOut E{xl_old, xc_old, F.out, F.XC, MODL, b0}; pg8::gemm_phase(F.lds, P, E, F.tid);
              }
              if (l == 0 && ch + 1 < NCH) phase_h(F, l, b0 + NB, xl_old, xc_old, RR);
            PH_END
        }
        if (need_ctx) {
            PH_BEGIN(16)
                ProbPlain P{(const bf16*)(F.ws + X_YG), (const bf16*)(F.ws + WS_GLUT) + (size_t)l * 1024 * 512, 512, 512, 512, 32, 4, F.G, F.c, 0};
                EpiPair<0> E{(bf16*)(F.ws + X_OC), 512}; pg8::gemm_phase(F.lds, P, E, F.tid);
                tr_moe_items(F, l, 12288, 2560, 128);
            PH_END
            PH_BEGIN(17)
                ProbMerge P{{(const bf16*)(F.ws + X_OA), (const bf16*)(F.ws + X_OB), (const bf16*)(F.ws + X_OC)}, (const bf16*)(F.ws + WS_BRT) + (size_t)l * 3 * 1024 * 512, 512, 512, 512, 32, 4, F.G, F.c};
                EpiMerge E{(const bf16*)(F.ws + X_GT), (bf16*)(F.ws + X_YMB)}; pg8::gemm_phase(F.lds, P, E, F.tid);
                tr_moe_items(F, l, 14848, 4864, 128);
            PH_END
            PH_BEGIN(18)
                ProbPlain P{(const bf16*)(F.ws + X_YMB), (const bf16*)(F.ws + WS_OUTT) + (size_t)l * 1024 * 1024, 1024, 1024, 1024, 32, 4, F.G, F.c, 0};
                EpiOut E{xl_old, xc_old, F.out, F.XC, MODL, -1}; pg8::gemm_phase(F.lds, P, E, F.tid);
                tr_moe_items(F, l, 19712, 4864, 128);
            PH_END
        }
        const int ntok = need_ctx ? NTOK : NTOK_LAT;
        unsigned* cnt = (unsigned*)(F.ws + WS_CTL) + CW_CNT + l * 64;
#ifndef DBG_ROUTER_DRY
#define DBG_ROUTER_DRY 0
#endif
        PH_BEGIN(11) if (DBG_ROUTER_DRY) { phase_router(F, l, ntok, 1024); xcd_barrier(bar, F.tid == 0); } phase_router(F, l, ntok); PH_END
        PH_BEGIN(12) phase_assign(F, l, ntok); PH_END
        PH_BEGIN(13)
            moe_tables(cnt, TAB, F.tid);
            ProbUp P{(const bf16*)(F.ck + M_H2), (const bf16*)(F.ws + WS_UPT) + (size_t)l * 32 * 1024 * 1024, (const int*)(F.ck + M_ROWTOK), TAB, 1024, 1024, 1024, F.G, F.c};
            EpiPair<1> E{(bf16*)(F.ck + M_HID), 512}; pg8::gemm_phase(F.lds, P, E, F.tid);
        PH_END
        PH_BEGIN(14)
            moe_tables(cnt, TAB, F.tid);
            ProbDown P{(const bf16*)(F.ck + M_HID), (const bf16*)(F.ws + WS_DOWNT) + (size_t)l * 32 * 1024 * 512, TAB, 512, 512, 512, F.G, F.c, 0, TAB[0]};
            EpiDownY E{(const int*)(F.ck + M_ROWTOK), (const float*)(F.ck + M_ROWW), (bf16*)(F.ck + M_Y), TAB[1]}; pg8::gemm_phase(F.lds, P, E, F.tid);
        PH_END
        PH_BEGIN(15) if (l + 1 < DEPTH) phase_comb<true>(F, l, ntok); else phase_comb<false>(F, l, ntok); PH_END
    }
#undef PH_BEGIN
#undef PH_END
}

extern "C" void kernel_launch(void* const* d_in, const int* in_sizes, int n_in, void* d_out, int out_size, void* d_ws, size_t ws_size, hipStream_t stream) {
    static int grid = 0;
    if (grid == 0) {
        if (n_in != 35 || out_size != BATCH * SEQ * D || ws_size < WS_END) { fprintf(stderr, "kernel_launch: unexpected shapes (n_in %d, out %d, ws %zu, need %zu)\n", n_in, out_size, ws_size, (size_t)WS_END); grid = -1; return; }
        int dev = 0, cus = 0, per_cu = 0;
        if (hipGetDevice(&dev) != hipSuccess || hipDeviceGetAttribute(&cus, hipDeviceAttributeMultiprocessorCount, dev) != hipSuccess) { grid = -1; return; }
        if (hipFuncSetAttribute((const void*)fwd, hipFuncAttributeMaxDynamicSharedMemorySize, LDS_BYTES) != hipSuccess) { fprintf(stderr, "kernel_launch: hipFuncSetAttribute failed\n"); grid = -1; return; }
        if (hipOccupancyMaxActiveBlocksPerMultiprocessor(&per_cu, (const void*)fwd, 512, LDS_BYTES) != hipSuccess || per_cu < 1) fprintf(stderr, "kernel_launch: occupancy query reports %d\n", per_cu);
        (void)hipGetLastError();
        grid = cus;
    }
    if (grid < 0) return;
    (void)in_sizes;
    hipMemsetAsync((char*)d_ws + WS_CTL, 0, CTL_BYTES, stream);
    Args a{};
    for (int i = 0; i < 35; ++i) a.in[i] = (const float*)d_in[i];
    a.out = (float*)d_out; a.ws = (unsigned char*)d_ws;
#if MK_SINGLE
    a.lo = 0; a.hi = NSTEPS;
    hipLaunchKernelGGL(fwd, dim3(grid), dim3(512), LDS_BYTES, stream, a);
#else
    for (int s = 0; s < NSTEPS; ++s) { a.lo = s; a.hi = s + 1; hipLaunchKernelGGL(fwd, dim3(grid), dim3(512), LDS_BYTES, stream, a);
    }
#endif
}
```

```cpp
#include <hip/hip_runtime.h>
#include <cstdio>
#include <cstdint>

#ifndef DBG_EPI_TWICE
#define DBG_EPI_TWICE 0
#endif
#ifndef MK_SINGLE
#define MK_SINGLE 1
#endif

#define GAS __attribute__((address_space(1)))
#define LAS __attribute__((address_space(3)))
typedef unsigned short bf16;
typedef short bf16x8 __attribute__((ext_vector_type(8)));
typedef short bf16x4 __attribute__((ext_vector_type(4)));
typedef float f32x4 __attribute__((ext_vector_type(4)));
typedef float f32x2 __attribute__((ext_vector_type(2)));
typedef float f32x16 __attribute__((ext_vector_type(16)));
typedef unsigned u32x4 __attribute__((ext_vector_type(4)));
typedef unsigned u32x2 __attribute__((ext_vector_type(2)));
typedef int i32x4 __attribute__((ext_vector_type(4)));

#define MLA_PAD_N 12
#define STR2(x) #x
#define STR(x) STR2(x)
constexpr int D = 1024, BATCH = 32, SEQ = 2048, CTXL = 256, DEPTH = 2;
constexpr int NB = 8, NCH = BATCH / NB;
constexpr int RL = NB * SEQ, RC = NB * CTXL, RR = RL + RC;
constexpr int NINP = 6400;
constexpr int NTOK_LAT = BATCH * SEQ, NTOK_CTX = BATCH * CTXL, NTOK = NTOK_LAT + NTOK_CTX;
constexpr int S5ROWS = 1280;
constexpr int KEYS = SEQ + CTXL;
constexpr int MOE_ROWS = 2 * NTOK + 64 * 256;
constexpr float RMS_EPS = 1e-6f;
constexpr float LOG2E = 1.4426950408889634f;

constexpr size_t al256(size_t x) { return (x + 255) & ~(size_t)255; }
constexpr size_t WS_CTL = 0, CTL_BYTES = 1u << 20;
constexpr size_t WS_WINT = WS_CTL + CTL_BYTES;
constexpr size_t WS_UQT = WS_WINT + (size_t)2 * NINP * 1024 * 2;
constexpr size_t WS_UKVT = WS_UQT + (size_t)2 * 768 * 768 * 2;
constexpr size_t WS_GLUT = WS_UKVT + (size_t)2 * 1024 * 256 * 2;
constexpr size_t WS_BRT = WS_GLUT + (size_t)2 * 1024 * 512 * 2;
constexpr size_t WS_OUTT = WS_BRT + (size_t)2 * 3 * 1024 * 512 * 2;
constexpr size_t WS_UPT = WS_OUTT + (size_t)2 * 1024 * 1024 * 2;
constexpr size_t WS_DOWNT = WS_UPT + (size_t)2 * 32 * 1024 * 1024 * 2;
constexpr size_t WS_BTY = WS_DOWNT + (size_t)2 * 32 * 1024 * 512 * 2;
constexpr size_t WS_BTS = WS_BTY + (size_t)2 * 32 * 256 * 512 * 2;
constexpr size_t WS_A16 = WS_BTS + (size_t)2 * 32 * 256 * 256 * 2;
constexpr size_t WS_MODP = WS_A16 + (size_t)2 * 2 * 32 * 64 * 2 * 4;
constexpr size_t WS_MOD = WS_MODP + (size_t)8 * 2 * 33 * 6144 * 4;
constexpr size_t WS_ROPE = WS_MOD + (size_t)2 * 33 * 6144 * 4;
constexpr size_t WS_WGT = WS_ROPE + (size_t)2048 * 32 * 4;
constexpr size_t WS_WET = WS_WGT + (size_t)2 * 4 * 1024 * 4;
constexpr size_t WS_XC = WS_WET + (size_t)2 * 32 * 1024 * 4;
constexpr size_t WS_CHUNK = al256(WS_XC + (size_t)NTOK_CTX * 1024 * 4);
constexpr size_t UB = (size_t)RR * 1024 * 2;
constexpr size_t C_HB = 0;
constexpr size_t C_KVL = C_HB + UB;
constexpr size_t C_QL = C_KVL + UB / 4;
constexpr size_t C_YM = C_HB;
constexpr size_t C_QR = C_QL + UB * 3 / 4;
constexpr size_t C_KN = C_QR + UB * 3 / 4;
constexpr size_t C_YMB = C_QR;
constexpr size_t C_KRP = C_KN + UB / 2;
constexpr size_t C_NQ = al256(C_KRP + (size_t)RR * 32 * 2);
constexpr size_t C_NK = C_NQ + UB / 2;
constexpr size_t C_NV = C_NK + UB / 2;
constexpr size_t C_GT = C_NV + UB / 2;
constexpr size_t C_AS5 = C_GT + UB * 3;
constexpr size_t C_SS = C_AS5 + (size_t)S5ROWS * 32 * 512 * 2;
constexpr size_t C_VV = C_SS + (size_t)S5ROWS * 32 * 256 * 4;
constexpr size_t C_QF = C_VV + UB / 2;
constexpr size_t C_KF = C_QF + UB * 3 / 4;
constexpr size_t C_VT = C_KF + UB * 3 / 4;
constexpr size_t C_NVT = C_VT + (size_t)NB * 8 * 64 * KEYS * 2;
constexpr size_t C_OA = C_NVT + (size_t)NB * 8 * 64 * KEYS * 2;
constexpr size_t C_OB = C_OA + UB / 2;
constexpr size_t C_OC = C_OB + UB / 2;
constexpr size_t C_YG = C_OC + UB / 2;
constexpr size_t C_SSKV = C_YG + UB / 2;
constexpr size_t C_SSQL = C_SSKV + (size_t)RR * 4 * 4;
constexpr size_t C_END = al256(C_SSQL + (size_t)RR * 12 * 4);
constexpr size_t M_HID = 0;
constexpr size_t M_Y = M_HID + (size_t)MOE_ROWS * 512 * 2;
constexpr size_t M_H2 = M_Y;
constexpr size_t M_ROWTOK = M_Y + (size_t)2 * NTOK * 1024 * 2;
constexpr size_t M_ROWW = M_ROWTOK + (size_t)MOE_ROWS * 4;
constexpr size_t M_TOKE = M_ROWW + (size_t)MOE_ROWS * 4;
constexpr size_t M_TOKW = M_TOKE + (size_t)NTOK * 16;
constexpr size_t M_WGBASE = M_TOKW + (size_t)NTOK * 8;
constexpr size_t M_END = M_WGBASE + (size_t)1024 * 64 * 4;
static_assert(M_END <= C_END, "MoE buffers fit in the chunk region");
constexpr size_t WS_HBALL = WS_CHUNK + C_END;
constexpr size_t WS_END = WS_HBALL + (size_t)NTOK * 1024 * 2;
constexpr size_t X_YG = WS_HBALL, X_OA = X_YG + (size_t)NTOK_CTX * 512 * 2, X_OB = X_OA + (size_t)NTOK_CTX * 512 * 2, X_OC = X_OB + (size_t)NTOK_CTX * 512 * 2;
constexpr size_t X_GT = X_OC + (size_t)NTOK_CTX * 512 * 2, X_YMB = X_GT + (size_t)NTOK_CTX * 3072 * 2, X_END = X_YMB + (size_t)NTOK_CTX * 1024 * 2;
static_assert(X_END <= WS_END, "ctx-tail buffers fit inside HB_ALL");
static_assert(WS_END <= ((size_t)1 << 30), "workspace within 1 GiB");
constexpr int CW_BAR = 4096;
constexpr int CW_CNT = 16384;

constexpr int LDS_MISC = 143360;
constexpr int LDS_TAB = LDS_MISC + 256;
constexpr int LDS_BYTES = 147456;

__device__ __forceinline__ unsigned f2bf(float f) { unsigned u = __builtin_bit_cast(unsigned, f); return (u + 0x7fffu + ((u >> 16) & 1u)) >> 16; }
typedef __bf16 bf2n_t __attribute__((ext_vector_type(2)));
__device__ __forceinline__ unsigned pk2(float lo, float hi) { const f32x2 v = {lo, hi}; return __builtin_bit_cast(unsigned, __builtin_convertvector(v, bf2n_t)); }
__device__ __forceinline__ float bflo(unsigned u) { return __builtin_bit_cast(float, u << 16); }
__device__ __forceinline__ float bfhi(unsigned u) { return __builtin_bit_cast(float, u & 0xffff0000u); }
__device__ __forceinline__ float bf2f(bf16 h) { return __builtin_bit_cast(float, ((unsigned)h) << 16); }
template <class T> __device__ __forceinline__ T ldg(const void* p) { return *(const GAS T*)p; }
template <class T> __device__ __forceinline__ void stg(void* p, T v) { *(GAS T*)p = v; }
template <int K> __device__ __forceinline__ float shx_sum(float v) {
    if constexpr (K == 32) { float a = v, b = v; asm volatile("s_nop 1\n\tv_permlane32_swap_b32 %0, %1" : "+v"(a), "+v"(b)); return a + b; }
    else return v + __builtin_bit_cast(float, __builtin_amdgcn_ds_swizzle(__builtin_bit_cast(int, v), (K << 10) | 0x1f));
}
template <int K> __device__ __forceinline__ float shx_max(float v) {
    if constexpr (K == 32) { float a = v, b = v; asm volatile("s_nop 1\n\tv_permlane32_swap_b32 %0, %1" : "+v"(a), "+v"(b)); return fmaxf(a, b); }
    else return fmaxf(v, __builtin_bit_cast(float, __builtin_amdgcn_ds_swizzle(__builtin_bit_cast(int, v), (K << 10) | 0x1f)));
}
__device__ __forceinline__ float wave_sum(float v) { v = shx_sum<1>(v); v = shx_sum<2>(v); v = shx_sum<4>(v); v = shx_sum<8>(v); v = shx_sum<16>(v); return shx_sum<32>(v); }
__device__ __forceinline__ float hx32(float a, float b) { asm volatile("s_nop 1\n\tv_permlane32_swap_b32 %0, %1" : "+v"(a), "+v"(b)); return a + b; }
__device__ __forceinline__ float hx16(float a, float b) { asm volatile("s_nop 1\n\tv_permlane16_swap_b32 %0, %1" : "+v"(a), "+v"(b)); return a + b; }
template <int N> __device__ __forceinline__ float dpp_ror(float v) { return __builtin_bit_cast(float, __builtin_amdgcn_update_dpp(0, __builtin_bit_cast(int, v), 0x120 + N, 0xf, 0xf, false)); }
__device__ __forceinline__ float row_sum16(float v) { v += dpp_ror<8>(v); v += dpp_ror<4>(v); v += dpp_ror<2>(v); v += dpp_ror<1>(v); return v; }
__device__ __forceinline__ float red4(float v0, float v1, float v2, float v3) { return row_sum16(hx16(hx32(v0, v2), hx32(v1, v3))); }
__device__ __forceinline__ float lane_bcast(float v, int srclane) { return __builtin_bit_cast(float, __builtin_amdgcn_readlane(__builtin_bit_cast(int, v), srclane)); }
__device__ __forceinline__ float fast_exp2(float x) { return __builtin_amdgcn_exp2f(x); }
__device__ __forceinline__ float sigmoidf(float x) { return __builtin_amdgcn_rcpf(1.0f + __builtin_amdgcn_exp2f(-LOG2E * x)); }
__device__ __forceinline__ float gelu_tanh(float x) { const float u = 0.7978845608028654f * (x + 0.044715f * x * x * x); return x * sigmoidf(2.0f * u); }

#define XB_TMO      128
#define XB_XCNT(j)  (256  + 64 * (j))
#define XB_XSUB(j)  (1280 + 64 * (j))
#define XB_XGEN(j)  (2304 + 64 * (j))
#define XB_TOP      3328
#define XB_TOPGEN   3392
#define XCD_BAR_WORDS 3456
#define XB_SPIN_CAP (1u << 22)

__device__ __forceinline__ unsigned xb_ld(unsigned* p)              { return __hip_atomic_load(p, __ATOMIC_RELAXED, __HIP_MEMORY_SCOPE_AGENT); }
__device__ __forceinline__ unsigned xb_add(unsigned* p, unsigned v) { return __hip_atomic_fetch_add(p, v, __ATOMIC_RELAXED, __HIP_MEMORY_SCOPE_AGENT); }
__device__ __forceinline__ unsigned xb_xcc_id() { return (unsigned)__builtin_amdgcn_s_getreg((3 << 11) | 20) & 0xFu; }
#define XB_SPIN(cond, bar) do { unsigned _sp = 0; while (cond) { __builtin_amdgcn_s_sleep(1); \
    if ((++_sp & 255u) == 0u) { if (xb_ld(&(bar)[XB_TMO])) break; if (_sp > XB_SPIN_CAP) { atomicAdd(&(bar)[XB_TMO], 1u); break; } } } } while (0)

struct XcdBarrier { unsigned* bar; unsigned x; volatile LAS unsigned* st; };

__device__ __forceinline__ XcdBarrier xcd_barrier_post(unsigned* bar, volatile LAS unsigned* st) {
    XcdBarrier b; b.bar = bar; b.x = xb_xcc_id(); b.st = st;
    if (threadIdx.x == 0) (void)xb_add(&bar[XB_XCNT(b.x)], 1u);
    return b;
}
__device__ __forceinline__ void xcd_barrier_complete(unsigned* bar, unsigned x, unsigned& nloc, unsigned& nx) {
    const unsigned G = gridDim.x * gridDim.y * gridDim.z;
    unsigned sum, cnt, mine, sp = 0u;
    for (;;) {
        sum = 0u; cnt = 0u; mine = 0u;
#pragma unroll
        for (unsigned j = 0; j < 16; ++j) { const unsigned c = xb_ld(&bar[XB_XCNT(j)]); sum += c; cnt += (c > 0u) ? 1u : 0u; mine = (j == x) ? c : mine; }
        if (sum == G) break;
        __builtin_amdgcn_s_sleep(1);
        if ((++sp & 255u) == 0u) { if (xb_ld(&bar[XB_TMO])) break; if (sp > XB_SPIN_CAP) { atomicAdd(&bar[XB_TMO], 1u); break; } }
    }
    nloc = mine > 0u ? mine : 1u; nx = cnt > 0u ? cnt : 1u;
}
__device__ __forceinline__ void xcd_barrier(const XcdBarrier& b, bool thread0) {
    asm volatile("s_waitcnt vmcnt(0)" ::: "memory");
    __syncthreads();
    if (thread0) {
        unsigned* bar = b.bar;
        __builtin_amdgcn_s_waitcnt(0);
        unsigned nloc = b.st[0], nx = b.st[1];
        if (nloc == 0u) { xcd_barrier_complete(bar, b.x, nloc, nx); b.st[0] = nloc; b.st[1] = nx; }
        const unsigned old = xb_add(&bar[XB_XSUB(b.x)], 1u);
        const unsigned gen = old / nloc;
        if (old + 1u == (gen + 1u) * nloc) {
            __builtin_amdgcn_fence(__ATOMIC_RELEASE, "agent");
            asm volatile("s_waitcnt vmcnt(0)" ::: "memory");
            const unsigned og = xb_add(&bar[XB_TOP], 1u);
            const unsigned tg = og / nx;
            if (og + 1u == (tg + 1u) * nx) xb_add(&bar[XB_TOPGEN], 1u);
            else XB_SPIN(xb_ld(&bar[XB_TOPGEN]) == tg, bar);
            __builtin_amdgcn_fence(__ATOMIC_ACQUIRE, "agent");
            xb_add(&bar[XB_XGEN(b.x)], 1u);
            asm volatile("s_waitcnt vmcnt(0)" ::: "memory");
        } else {
            XB_SPIN(xb_ld(&bar[XB_XGEN(b.x)]) == gen, bar);
            __builtin_amdgcn_fence(__ATOMIC_ACQUIRE, "agent");
            asm volatile("s_waitcnt vmcnt(0)" ::: "memory");
        }
    }
    __syncthreads();
}

namespace pg8 {
constexpr int BM = 256, BK = 64, HALF = 128, HTB = HALF * BK * 2, STAGE_BYTES = 8 * HTB, NXCD = 8, WGM = 2;
__host__ __device__ __forceinline__ int lds_byte(int r, int c) { const int st = (r >> 4) * 2 + (c >> 5), rr = r & 15, cc = c & 31, ob = rr * 64 + cc * 2; return st * 1024 + (ob ^ (((ob >> 9) & 1) << 5)); }
__host__ __device__ __forceinline__ void stage_rc(int b, int& R, int& C) { const int st = b / 1024, sb = b % 1024, swz = sb ^ (((sb >> 9) & 1) << 5); R = (st >> 1) * 16 + swz / 64; C = (st & 1) * 32 + (swz % 64) / 2; }
__host__ __device__ __forceinline__ int perm32(int rho) { const int n = rho >> 4, i = rho & 15; return 8 * (i >> 2) + 4 * n + (i & 3); }
struct Unit { int pm, pn, z; };
__device__ __forceinline__ bool tile_map(long L, int nM, int nN, int& pm, int& pn) {
    const int nwg = nM * nN; if (L >= nwg) return false;
    int wgid = (int)L; { const int q = nwg / NXCD, r = nwg % NXCD, xcd = wgid % NXCD, off = wgid / NXCD; wgid = (xcd < r ? xcd * (q + 1) : r * (q + 1) + (xcd - r) * q) + off; }
    const int nig = WGM * nN, gid = wgid / nig, fm = gid * WGM, gsz = (nM - fm) < WGM ? (nM - fm) : WGM;
    pm = fm + ((wgid % nig) % gsz); pn = (wgid % nig) / gsz; return true;
}
typedef __bf16 bf2_t __attribute__((ext_vector_type(2)));
__device__ __forceinline__ unsigned cvt_pk_bf16(float lo, float hi) { const f32x2 v = {lo, hi}; return __builtin_bit_cast(unsigned, __builtin_convertvector(v, bf2_t)); }

template <class Prob, class Epi>
__device__ __forceinline__ void gemm_phase(LAS unsigned char* lds, const Prob& P, const Epi& E, int tid_in) {
    int tid_ = tid_in; asm volatile("" : "+v"(tid_));
    const int tid = tid_, wid = __builtin_amdgcn_readfirstlane(tid >> 6), lane = tid & 63, wr = wid >> 2, wc = wid & 3, fr = lane & 15, fq = lane >> 4;
    const int K = P.K, nt = K / BK;
    int sR[2], sC[2]; unsigned voffB[2], voffA[2];
#pragma unroll
    for (int i = 0; i < 2; ++i) { int R, C; stage_rc(tid * 16 + i * 8192, R, C); sR[i] = R; sC[i] = C; const int Rb = Epi::PERM ? ((R & ~31) + perm32(R & 31)) : R;
        voffA[i] = (unsigned)(R * P.lda + C) * 2u; voffB[i] = (unsigned)(Rb * P.ldb + C) * 2u; }
    const size_t kstep = (size_t)(BK * 2);
    const unsigned hstepA = (unsigned)HALF * (unsigned)P.lda * 2u; const size_t hstepB = (size_t)HALF * P.ldb * 2;
    const unsigned ldsw = (unsigned)wid * 1024u;
    const int aoff = lds_byte(wr * 64 + fr, fq * 8), boff = lds_byte(wc * 32 + fr, fq * 8);
#define PG8_SA(b, h) (((b) * 2 + (h)) * HTB)
#define PG8_SB(b, h) ((4 + (b) * 2 + (h)) * HTB)
#define PG8_STAGE2(bufoff, gbase, o0, o1) do { \
        __builtin_amdgcn_global_load_lds((const GAS unsigned*)((const char*)(gbase) + (o0)), (LAS unsigned*)(lds + (bufoff) + ldsw), 16, 0, 0); \
        __builtin_amdgcn_global_load_lds((const GAS unsigned*)((const char*)(gbase) + (o1)), (LAS unsigned*)(lds + (bufoff) + ldsw + 8192), 16, 0, 0); } while (0)
#define PG8_STAGEB(bufoff, gbase) PG8_STAGE2(bufoff, gbase, voffB[0], voffB[1])
#define PG8_STAGEA(bufoff, gbase, OA, h) do { if constexpr (Prob::GATHER) { PG8_STAGE2(bufoff, gbase, OA[h][0], OA[h][1]); } else { PG8_STAGE2(bufoff, (gbase) + (h) * (size_t)hstepA, voffA[0], voffA[1]); } } while (0)
#define PG8_LDA(dst, b, h) do { _Pragma("unroll") for (int m = 0; m < 4; ++m) _Pragma("unroll") for (int k = 0; k < 2; ++k) dst[m][k] = *(const LAS bf16x8*)(lds + PG8_SA(b, h) + aoff + m * 2048 + k * 1024); } while (0)
#define PG8_LDB(dst, b, h) do { _Pragma("unroll") for (int n = 0; n < 2; ++n) _Pragma("unroll") for (int k = 0; k < 2; ++k) dst[n][k] = *(const LAS bf16x8*)(lds + PG8_SB(b, h) + boff + n * 2048 + k * 1024); } while (0)
#define PG8_MMA(ai, bj, At, Bt) do { __builtin_amdgcn_s_setprio(1); _Pragma("unroll") for (int m = 0; m < 4; ++m) _Pragma("unroll") for (int n = 0; n < 2; ++n) _Pragma("unroll") for (int k = 0; k < 2; ++k) \
        acc[ai][bj][m][n] = __builtin_amdgcn_mfma_f32_16x16x32_bf16(Bt[n][k], At[m][k], acc[ai][bj][m][n], 0, 0, 0); __builtin_amdgcn_s_setprio(0); } while (0)
#define PG8_WAIT_V(n) asm volatile("s_waitcnt vmcnt(" #n ")" ::: "memory")
#define PG8_WAIT_L(n) asm volatile("s_waitcnt lgkmcnt(" #n ")" ::: "memory")
#define PG8_BAR __builtin_amdgcn_s_barrier()
#define PG8_SCHED __builtin_amdgcn_sched_barrier(0)
    Unit cur, nxt; int ui = 0;
    if (!P.next(0, cur)) return;
    f32x4 acc[2][2][4][2];
    bf16x8 At[4][2], B0[2][2], B1[2][2];
    const char* cA = P.a_base(cur); const char* cB = P.b_base(cur);
    unsigned cOA[2][2];
#pragma unroll
    for (int h = 0; h < 2; ++h)
#pragma unroll
        for (int i = 0; i < 2; ++i) {
            if constexpr (Prob::GATHER) cOA[h][i] = P.a_rowoff(cur, h * HALF + sR[i]) + (unsigned)sC[i] * 2u;
            else cOA[h][i] = 0u;
        }
    PG8_STAGEB(PG8_SB(0, 0), cB); PG8_STAGEB(PG8_SB(0, 1), cB + hstepB); PG8_STAGEA(PG8_SA(0, 0), cA, cOA, 0); PG8_STAGEA(PG8_SA(0, 1), cA, cOA, 1);
    if (wr == 1) PG8_BAR;
    PG8_WAIT_V(2); PG8_BAR;
    PG8_STAGEB(PG8_SB(1, 0), cB + kstep); PG8_STAGEA(PG8_SA(1, 0), cA + kstep, cOA, 0); PG8_STAGEB(PG8_SB(1, 1), cB + hstepB + kstep);
    PG8_WAIT_V(6); PG8_BAR;
    for (;;) {
        const bool has_next = P.next(ui + 1, nxt);
        const char* nA = has_next ? P.a_base(nxt) : cA; const char* nB = has_next ? P.b_base(nxt) : cB;
        if constexpr (Prob::GATHER) {
            u32x4 nv = (u32x4){cOA[0][0], cOA[0][1], cOA[1][0], cOA[1][1]};
            if (has_next) {
                int t2 = tid; asm volatile("" : "+v"(t2));
#pragma unroll
                for (int i = 0; i < 2; ++i) { int R2, C2; stage_rc(t2 * 16 + i * 8192, R2, C2);
                    nv[i] = P.a_rowoff(nxt, R2) + (unsigned)C2 * 2u; nv[2 + i] = P.a_rowoff(nxt, HALF + R2) + (unsigned)C2 * 2u; }
            }
            *(LAS u32x4*)(lds + STAGE_BYTES + tid * 16) = nv;
        }
        float zero_ = 0.f; asm volatile("" : "+v"(zero_));
#pragma unroll
        for (int a = 0; a < 2; ++a)
#pragma unroll
            for (int b = 0; b < 2; ++b)
#pragma unroll
                for (int m = 0; m < 4; ++m)
#pragma unroll
                    for (int n = 0; n < 2; ++n) acc[a][b][m][n] = (f32x4){zero_, zero_, zero_, zero_};
        asm volatile("" : "+v"(acc[0][0][0][0]), "+v"(acc[0][0][0][1]), "+v"(acc[0][0][1][0]), "+v"(acc[0][0][1][1]), "+v"(acc[0][0][2][0]), "+v"(acc[0][0][2][1]), "+v"(acc[0][0][3][0]), "+v"(acc[0][0][3][1]),
                          "+v"(acc[0][1][0][0]), "+v"(acc[0][1][0][1]), "+v"(acc[0][1][1][0]), "+v"(acc[0][1][1][1]), "+v"(acc[0][1][2][0]), "+v"(acc[0][1][2][1]), "+v"(acc[0][1][3][0]), "+v"(acc[0][1][3][1]));
        asm volatile(".p2align 6" : "+v"(acc[1][0][0][0]), "+v"(acc[1][0][0][1]), "+v"(acc[1][0][1][0]), "+v"(acc[1][0][1][1]), "+v"(acc[1][0][2][0]), "+v"(acc[1][0][2][1]), "+v"(acc[1][0][3][0]), "+v"(acc[1][0][3][1]),
                          "+v"(acc[1][1][0][0]), "+v"(acc[1][1][0][1]), "+v"(acc[1][1][1][0]), "+v"(acc[1][1][1][1]), "+v"(acc[1][1][2][0]), "+v"(acc[1][1][2][1]), "+v"(acc[1][1][3][0]), "+v"(acc[1][1][3][1]));
        for (int t = 0; t < nt; t += 2) {
            const bool last = (t == nt - 2);
            const char* a1 = cA + (size_t)(t + 1) * kstep;
            const char* a2 = last ? nA : cA + (size_t)(t + 2) * kstep; const char* b2 = last ? nB : cB + (size_t)(t + 2) * kstep;
            const char* a3 = a2 + kstep; const char* b3 = b2 + kstep;
            unsigned oa2[2][2];
#pragma unroll
            for (int h = 0; h < 2; ++h)
#pragma unroll
                for (int i = 0; i < 2; ++i) oa2[h][i] = Prob::GATHER ? cOA[h][i] : 0u;
            if constexpr (Prob::GATHER) { if (last) { const u32x4 nv = *(const LAS u32x4*)(lds + STAGE_BYTES + tid * 16); oa2[0][0] = nv.x; oa2[0][1] = nv.y; oa2[1][0] = nv.z; oa2[1][1] = nv.w; } }
            PG8_LDB(B0, 0, 0); PG8_LDB(B1, 0, 1); PG8_SCHED; PG8_LDA(At, 0, 0); PG8_STAGEA(PG8_SA(1, 1), a1, cOA, 1);
            PG8_WAIT_V(8); PG8_WAIT_L(0); PG8_BAR; PG8_MMA(0, 0, At, B0); PG8_MMA(0, 1, At, B1); PG8_BAR; PG8_SCHED;
            PG8_LDA(At, 0, 1); PG8_STAGEB(PG8_SB(0, 0), b2); PG8_STAGEB(PG8_SB(0, 1), b2 + hstepB); PG8_STAGEA(PG8_SA(0, 0), a2, oa2, 0);
            PG8_WAIT_V(8); PG8_WAIT_L(0); PG8_BAR; PG8_MMA(1, 0, At, B0); PG8_MMA(1, 1, At, B1); PG8_BAR; PG8_SCHED;
            PG8_LDB(B0, 1, 0); PG8_LDB(B1, 1, 1); PG8_SCHED; PG8_LDA(At, 1, 0); PG8_STAGEA(PG8_SA(0, 1), a2, oa2, 1);
            PG8_WAIT_V(8); PG8_WAIT_L(0); PG8_BAR; PG8_MMA(0, 0, At, B0); PG8_MMA(0, 1, At, B1); PG8_BAR; PG8_SCHED;
            PG8_LDA(At, 1, 1); PG8_STAGEB(PG8_SB(1, 0), b3); PG8_STAGEB(PG8_SB(1, 1), b3 + hstepB); PG8_STAGEA(PG8_SA(1, 0), a3, oa2, 0);
            PG8_WAIT_V(8); PG8_WAIT_L(0); PG8_BAR; PG8_MMA(1, 0, At, B0); PG8_MMA(1, 1, At, B1); PG8_BAR; PG8_SCHED;
        }
        if (wr == 0) PG8_BAR;
        E(acc, cur, wr, wc, fr, fq);
#if DBG_EPI_TWICE
        if constexpr (Epi::IDEMP) E(acc, cur, wr, wc, fr, fq);
#endif
        if (!has_next) break;
        cur = nxt; cA = nA; cB = nB; ++ui;
        if constexpr (Prob::GATHER) { const u32x4 nv = *(const LAS u32x4*)(lds + STAGE_BYTES + tid * 16); cOA[0][0] = nv.x; cOA[0][1] = nv.y; cOA[1][0] = nv.z; cOA[1][1] = nv.w; }
        if (wr == 1) PG8_BAR;
    }
    PG8_WAIT_V(0);
    PG8_BAR;
#undef PG8_SA
#undef PG8_SB
#undef PG8_STAGE2
#undef PG8_STAGEB
#undef PG8_STAGEA
#undef PG8_LDA
#undef PG8_LDB
#undef PG8_MMA
#undef PG8_WAIT_V
#undef PG8_WAIT_L
#undef PG8_BAR
#undef PG8_SCHED
}
}
using pg8::Unit;

struct Args { const float* in[35]; float* out; unsigned char* ws; int lo, hi; };

struct Frame {
    LAS unsigned char* lds;
    int tid, lane, wave, G, c;
    const float* const* in;
    float* out; unsigned char* ws; unsigned char* ck;
    float* MOD; float* XC;
};
__device__ __forceinline__ bool row_is_ctx(int row) { return row >= RL; }

struct ProbPlain {
    static constexpr bool GATHER = false;
    const bf16* A; const bf16* Bt; int K, lda, ldb, nM, nN, G, c, a_pn_stride;
    __device__ __forceinline__ bool next(int i, Unit& u) const { u.z = 0; return pg8::tile_map((long)i * G + c, nM, nN, u.pm, u.pn); }
    __device__ __forceinline__ const char* a_base(const Unit& u) const { return (const char*)(A + (size_t)u.pm * 256 * lda + (size_t)u.pn * a_pn_stride); }
    __device__ __forceinline__ const char* b_base(const Unit& u) const { return (const char*)(Bt + (size_t)u.pn * 256 * ldb); }
    __device__ __forceinline__ unsigned a_rowoff(const Unit&, int) const { return 0u; }
};
struct ProbG1 {
    static constexpr bool GATHER = false;
    const bf16* A; const bf16* Actx; const bf16* Bt; int K, lda, ldb, G, c, nctx;
    __device__ __forceinline__ bool next(int i, Unit& u) const {
        u.z = 0; const long L = (long)i * G + c; const int n1 = 64 * 25;
        if (L < n1) return pg8::tile_map(L, 64, 25, u.pm, u.pn);
        const int l2 = (int)(L - n1); if (l2 >= 8 * nctx) return false;
        u.pm = 64 + (l2 & 7); const int idx = l2 >> 3;
        u.pn = (nctx == 24) ? idx : (idx < 3 ? idx : (idx < 7 ? idx + 5 : 24));
        return true;
    }
    __device__ __forceinline__ const char* a_base(const Unit& u) const { return u.pm < 64 ? (const char*)(A + (size_t)u.pm * 256 * lda) : (const char*)(Actx + (size_t)(u.pm - 64) * 256 * lda); }
    __device__ __forceinline__ const char* b_base(const Unit& u) const { return (const char*)(Bt + (size_t)u.pn * 256 * ldb); }
    __device__ __forceinline__ unsigned a_rowoff(const Unit&, int) const { return 0u; }
};
struct ProbMerge {
    static constexpr bool GATHER = false;
    const bf16* O[3]; const bf16* Bt; int K, lda, ldb, nM, nN, G, c;
    __device__ __forceinline__ bool next(int i, Unit& u) const { u.z = i % 3; return pg8::tile_map((long)(i / 3) * G + c, nM, nN, u.pm, u.pn); }
    __device__ __forceinline__ const char* a_base(const Unit& u) const { const bf16* o = u.z == 0 ? O[0] : (u.z == 1 ? O[1] : O[2]); return (const char*)(o + (size_t)u.pm * 256 * lda); }
    __device__ __forceinline__ const char* b_base(const Unit& u) const { return (const char*)(Bt + ((size_t)u.z * 1024 + (size_t)u.pn * 256) * ldb); }
    __device__ __forceinline__ unsigned a_rowoff(const Unit&, int) const { return 0u; }
};
__device__ __forceinline__ void moe_tables(const unsigned* cnt, LAS int* T, int tid_in) {
    int t_ = tid_in; asm volatile("" : "+v"(t_));
    __syncthreads();
    if (t_ < 64) T[706 + t_] = (int)__hip_atomic_load(cnt + t_, __ATOMIC_RELAXED, __HIP_MEMORY_SCOPE_AGENT);
    __syncthreads();
    if (t_ == 0) {
        int row = 0, t = 0;
#pragma nounroll
        for (int ge = 0; ge < 64; ++ge) {
            const int cn = T[706 + ge];
            T[2 + ge] = row; const int nt = (cn + 255) >> 8;
#pragma nounroll
            for (int k = 0; k < nt && t < 640; ++k) T[66 + (t++)] = ge & 31;
            row += nt * 256;
            if (ge == 31) T[1] = t;
        }
        T[0] = t;
    }
    __syncthreads();
}
struct ProbUp {
    static constexpr bool GATHER = true;
    const bf16* A; const bf16* Bt; const int* rowtok; LAS int* T; int K, lda, ldb, G, c;
    __device__ __forceinline__ bool next(int i, Unit& u) const {
        const int nwg = T[0] * 4; const long L = (long)i * G + c; if (L >= nwg) return false;
        int w = (int)L; { const int q = nwg / 8, r = nwg % 8, xcd = w % 8, off = w / 8; w = (xcd < r ? xcd * (q + 1) : r * (q + 1) + (xcd - r) * q) + off; }
        u.pm = w >> 2; u.pn = w & 3; u.z = T[66 + u.pm]; return true;
    }
    __device__ __forceinline__ const char* a_base(const Unit&) const { return (const char*)A; }
    __device__ __forceinline__ const char* b_base(const Unit& u) const { return (const char*)(Bt + ((size_t)u.z * 1024 + (size_t)u.pn * 256) * ldb); }
    __device__ __forceinline__ unsigned a_rowoff(const Unit& u, int r) const { const GAS int* base = (const GAS int*)(rowtok + (size_t)u.pm * 256); int t = base[(unsigned)r]; t = t < 0 ? 0 : t; return (unsigned)t * (unsigned)lda * 2u; }
};
struct ProbDown {
    static constexpr bool GATHER = false;
    const bf16* A; const bf16* Bt; LAS int* T; int K, lda, ldb, G, c, t0, t1;
    __device__ __forceinline__ bool next(int i, Unit& u) const {
        const int nwg = (t1 - t0) * 4; const long L = (long)i * G + c; if (L >= nwg) return false;
        int w = (int)L; { const int q = nwg / 8, r = nwg % 8, xcd = w % 8, off = w / 8; w = (xcd < r ? xcd * (q + 1) : r * (q + 1) + (xcd - r) * q) + off; }
        u.pm = t0 + (w >> 2); u.pn = w & 3; u.z = T[66 + u.pm]; return true;
    }
    __device__ __forceinline__ const char* a_base(const Unit& u) const { return (const char*)(A + (size_t)u.pm * 256 * lda); }
    __device__ __forceinline__ const char* b_base(const Unit& u) const { return (const char*)(Bt + ((size_t)u.z * 1024 + (size_t)u.pn * 256) * ldb); }
    __device__ __forceinline__ unsigned a_rowoff(const Unit&, int) const { return 0u; }
};

typedef f32x4 AccT[2][2][4][2];
#define EPI_ROWS_BEGIN  _Pragma("unroll") for (int ai = 0; ai < 2; ++ai) _Pragma("unroll") for (int m = 0; m < 4; ++m) { const int row = row0 + ai * 128 + m * 16;
#define EPI_ROWS_END    }
__device__ __forceinline__ u32x4 pack8(const f32x4& a, const f32x4& b) { u32x4 w; w.x = pg8::cvt_pk_bf16(a[0], a[1]); w.y = pg8::cvt_pk_bf16(a[2], a[3]); w.z = pg8::cvt_pk_bf16(b[0], b[1]); w.w = pg8::cvt_pk_bf16(b[2], b[3]); return w; }

__device__ __forceinline__ void s5_row_of(int row, int& rho, int& s) {
    if (row < RL) { const int b = row >> 11, t = row & 2047; rho = b * 128 + (t >> 4); s = t & 15; }
    else { const int rc = row - RL, b = rc >> 8, t = rc & 255; rho = 1024 + b * 16 + (t >> 4); s = t & 15; }
}
struct EpiG1 {
    static constexpr bool IDEMP = true;
    static constexpr bool PERM = true;
    unsigned char* ck; const float* gqn; const float* gkn;
    bf16* gtc;
    __device__ __forceinline__ void operator()(const AccT& acc, const Unit& u, int wr, int wc, int fr, int fq) const {
        const int pn = u.pn, row0 = u.pm * 256 + wr * 64 + fr, cin = wc * 32 + 8 * fq;
        if (pn == 1 || pn == 2) {
            bf16* AS5 = (bf16*)(ck + C_AS5);
            EPI_ROWS_BEGIN
                int rho, s; s5_row_of(row, rho, s);
#pragma unroll
                for (int bj = 0; bj < 2; ++bj) { const int c512 = (pn - 1) * 256 + bj * 128 + cin, g = c512 >> 4, n0 = c512 & 15;
                    stg<u32x4>(AS5 + ((size_t)rho * 32 + g) * 512 + s * 16 + n0, pack8(acc[ai][bj][m][0], acc[ai][bj][m][1])); }
            EPI_ROWS_END
            return;
        }
        if (pn == 24) {
            bf16* KRP = (bf16*)(ck + C_KRP);
            if (wc == 0) { EPI_ROWS_BEGIN stg<u32x4>(KRP + (size_t)row * 32 + 8 * fq, pack8(acc[ai][0][m][0], acc[ai][0][m][1])); EPI_ROWS_END }
            return;
        }
        if (pn >= 6 && pn < 10) {
            const bool isq = pn < 8; const int head = 4 * (isq ? pn - 6 : pn - 8) + wc;
            bf16* dst = (bf16*)(ck + (isq ? C_NQ : C_NK)) + head * 64 + 8 * fq; const float* gn = isq ? gqn : gkn;
            f32x4 g[2][2];
#pragma unroll
            for (int bj = 0; bj < 2; ++bj)
#pragma unroll
                for (int n = 0; n < 2; ++n) g[bj][n] = ldg<f32x4>(gn + bj * 32 + 8 * fq + 4 * n);
            const float osc = isq ? 0.125f * LOG2E : 1.0f;
            EPI_ROWS_BEGIN
                float ss = 0.f;
#pragma unroll
                for (int bj = 0; bj < 2; ++bj)
#pragma unroll
                    for (int n = 0; n < 2; ++n) { const f32x4 v = acc[ai][bj][m][n]; ss += v[0] * v[0] + v[1] * v[1] + v[2] * v[2] + v[3] * v[3]; }
                ss = shx_sum<16>(ss); ss = shx_sum<32>(ss);
                const float sc = rsqrtf(ss * (1.0f / 64.0f) + RMS_EPS) * osc;
#pragma unroll
                for (int bj = 0; bj < 2; ++bj) stg<u32x4>(dst + (size_t)row * 512 + bj * 32, pack8(acc[ai][bj][m][0] * sc * g[bj][0], acc[ai][bj][m][1] * sc * g[bj][1]));
            EPI_ROWS_END
            return;
        }
        bf16* dst; int ld, col0; bool sig = false; float* ssq = nullptr; int ssld = 0;
        if (pn == 0) { dst = (bf16*)(ck + C_KVL); ld = 256; col0 = 0; ssq = (float*)(ck + C_SSKV) + wc; ssld = 4; }
        else if (pn < 6) { dst = (bf16*)(ck + C_QL); ld = 768; col0 = (pn - 3) * 256; ssq = (float*)(ck + C_SSQL) + (pn - 3) * 4 + wc; ssld = 12; }
        else if (pn < 12) { dst = (bf16*)(ck + C_NV); ld = 512; col0 = (pn - 10) * 256; }
        else { dst = u.pm >= 64 ? gtc : (bf16*)(ck + C_GT); ld = 3072; col0 = (pn - 12) * 256; sig = true; }
        EPI_ROWS_BEGIN
            float ss = 0.f;
#pragma unroll
            for (int bj = 0; bj < 2; ++bj) {
                f32x4 v0 = acc[ai][bj][m][0], v1 = acc[ai][bj][m][1];
                if (sig) {
#pragma unroll
                    for (int j = 0; j < 4; ++j) { v0[j] = sigmoidf(v0[j]); v1[j] = sigmoidf(v1[j]); } }
                ss += v0[0] * v0[0] + v0[1] * v0[1] + v0[2] * v0[2] + v0[3] * v0[3] + v1[0] * v1[0] + v1[1] * v1[1] + v1[2] * v1[2] + v1[3] * v1[3];
                stg<u32x4>(dst + (size_t)row * ld + col0 + bj * 128 + cin, pack8(v0, v1));
            }
            if (ssq) { ss = shx_sum<16>(ss); ss = shx_sum<32>(ss); if (fq == 0) stg<float>(ssq + (size_t)row * ssld, ss); }
        EPI_ROWS_END
    }
};
struct EpiStore {
    static constexpr bool IDEMP = true;
    static constexpr bool PERM = true;
    bf16* D0; bf16* D1; int ld, split;
    __device__ __forceinline__ void operator()(const AccT& acc, const Unit& u, int wr, int wc, int fr, int fq) const {
        const int row0 = u.pm * 256 + wr * 64 + fr, cin = wc * 32 + 8 * fq;
        bf16* dst = u.pn < split ? D0 : D1; const int col0 = (u.pn < split ? u.pn : u.pn - split) * 256;
        EPI_ROWS_BEGIN
#pragma unroll
            for (int bj = 0; bj < 2; ++bj) stg<u32x4>(dst + (size_t)row * ld + col0 + bj * 128 + cin, pack8(acc[ai][bj][m][0], acc[ai][bj][m][1]));
        EPI_ROWS_END
    }
};
template <int NP> struct EpiStoreRs {
    static constexpr bool IDEMP = true;
    static constexpr bool PERM = true;
    bf16* D0; bf16* D1; int ld, split; const float* ssq; float inv_width;
    __device__ __forceinline__ void operator()(const AccT& acc, const Unit& u, int wr, int wc, int fr, int fq) const {
        const int row0 = u.pm * 256 + wr * 64 + fr, cin = wc * 32 + 8 * fq;
        bf16* dst = u.pn < split ? D0 : D1; const int col0 = (u.pn < split ? u.pn : u.pn - split) * 256;
        float rs[2][4];
#pragma unroll
        for (int ai = 0; ai < 2; ++ai)
#pragma unroll
            for (int m = 0; m < 4; ++m) { const float* p = ssq + (size_t)(row0 + ai * 128 + m * 16) * NP; float t = 0.f;
#pragma unroll
                for (int k = 0; k < NP; k += 4) { const f32x4 q = ldg<f32x4>(p + k); t += (q[0] + q[1]) + (q[2] + q[3]); }
                rs[ai][m] = rsqrtf(t * inv_width + RMS_EPS); }
        EPI_ROWS_BEGIN
            const float r = rs[ai][m];
#pragma unroll
            for (int bj = 0; bj < 2; ++bj) stg<u32x4>(dst + (size_t)row * ld + col0 + bj * 128 + cin, pack8(acc[ai][bj][m][0] * r, acc[ai][bj][m][1] * r));
        EPI_ROWS_END
    }
};
struct EpiS5S {
    static constexpr bool IDEMP = true;
    static constexpr bool PERM = false;
    float* SS;
    __device__ __forceinline__ void operator()(const AccT& acc, const Unit& u, int wr, int wc, int fr, int fq) const {
        const int row0 = u.pm * 256 + wr * 64 + fr, cin = wc * 32 + 4 * fq;
        EPI_ROWS_BEGIN
#pragma unroll
            for (int bj = 0; bj < 2; ++bj)
#pragma unroll
                for (int n = 0; n < 2; ++n) stg<f32x4>(SS + ((size_t)row * 32 + u.pn) * 256 + bj * 128 + cin + 16 * n, acc[ai][bj][m][n]);
        EPI_ROWS_END
    }
};
struct EpiS5Y {
    static constexpr bool IDEMP = true;
    static constexpr bool PERM = true;
    bf16* YG; bf16* YGc;
    __device__ __forceinline__ void operator()(const AccT& acc, const Unit& u, int wr, int wc, int fr, int fq) const {
        const int row0 = u.pm * 256 + wr * 64 + fr, cin = wc * 32 + 8 * fq, g = u.pn;
        EPI_ROWS_BEGIN
            const int rho = row;
            if (rho < 1152) {
                int base; bf16* yg = YG; if (rho < 1024) base = (rho >> 7) * 2048 + (rho & 127) * 16; else { base = ((rho - 1024) >> 4) * 256 + ((rho - 1024) & 15) * 16; yg = YGc; }
#pragma unroll
                for (int bj = 0; bj < 2; ++bj) { const int col = bj * 128 + cin, t = col >> 4, n0 = col & 15;
                    f32x4 v0 = acc[ai][bj][m][0], v1 = acc[ai][bj][m][1];
#pragma unroll
                    for (int j = 0; j < 4; ++j) { v0[j] = gelu_tanh(v0[j]); v1[j] = gelu_tanh(v1[j]); }
                    stg<u32x4>(yg + (size_t)(base + t) * 512 + g * 16 + n0, pack8(v0, v1)); }
            }
        EPI_ROWS_END
    }
};
template <int MODE> struct EpiPair {
    static constexpr bool IDEMP = true;
    static constexpr bool PERM = true;
    bf16* Dst; int ld;
    __device__ __forceinline__ void operator()(const AccT& acc, const Unit& u, int wr, int wc, int fr, int fq) const {
        const int row0 = u.pm * 256 + wr * 64 + fr, cin = wc * 32 + 8 * fq;
        EPI_ROWS_BEGIN
            f32x4 r0, r1;
#pragma unroll
            for (int j = 0; j < 4; ++j) {
                const float a0 = acc[ai][0][m][0][j], a1 = acc[ai][0][m][1][j], b0 = acc[ai][1][m][0][j], b1 = acc[ai][1][m][1][j];
                if (MODE == 0) { r0[j] = a0 * sigmoidf(b0); r1[j] = a1 * sigmoidf(b1); }
                else { r0[j] = a0 * sigmoidf(a0) * b0; r1[j] = a1 * sigmoidf(a1) * b1; }
            }
            stg<u32x4>(Dst + (size_t)row * ld + u.pn * 128 + cin, pack8(r0, r1));
        EPI_ROWS_END
    }
};
struct EpiMerge {
    static constexpr bool IDEMP = false;
    static constexpr bool PERM = true;
    const bf16* GT; bf16* YMB;
    __device__ __forceinline__ void operator()(const AccT& acc, const Unit& u, int wr, int wc, int fr, int fq) const {
        const int row0 = u.pm * 256 + wr * 64 + fr, cin = wc * 32 + 8 * fq, z = u.z;
        if (z == 0) {
#pragma unroll
            for (int ai = 0; ai < 2; ++ai) {
                u32x4 gw[4][2];
#pragma unroll
                for (int m = 0; m < 4; ++m)
#pragma unroll
                    for (int bj = 0; bj < 2; ++bj) gw[m][bj] = ldg<u32x4>(GT + (size_t)(row0 + ai * 128 + m * 16) * 3072 + u.pn * 256 + bj * 128 + cin);
#pragma unroll
                for (int m = 0; m < 4; ++m)
#pragma unroll
                    for (int bj = 0; bj < 2; ++bj) { const u32x4 g = gw[m][bj]; f32x4 v0 = acc[ai][bj][m][0], v1 = acc[ai][bj][m][1];
                        v0[0] *= bflo(g.x); v0[1] *= bfhi(g.x); v0[2] *= bflo(g.y); v0[3] *= bfhi(g.y); v1[0] *= bflo(g.z); v1[1] *= bfhi(g.z); v1[2] *= bflo(g.w); v1[3] *= bfhi(g.w);
                        stg<u32x4>(YMB + (size_t)(row0 + ai * 128 + m * 16) * 1024 + u.pn * 256 + bj * 128 + cin, pack8(v0, v1)); }
            }
            return;
        }
#pragma unroll
        for (int ai = 0; ai < 2; ++ai) {
            u32x4 gw[4][2], yp[4][2];
#pragma unroll
            for (int m = 0; m < 4; ++m)
#pragma unroll
                for (int bj = 0; bj < 2; ++bj) { const int row = row0 + ai * 128 + m * 16, col = u.pn * 256 + bj * 128 + cin;
                    gw[m][bj] = ldg<u32x4>(GT + (size_t)row * 3072 + z * 1024 + col); yp[m][bj] = ldg<u32x4>(YMB + (size_t)row * 1024 + col); }
#pragma unroll
            for (int m = 0; m < 4; ++m)
#pragma unroll
                for (int bj = 0; bj < 2; ++bj) { const u32x4 g = gw[m][bj], y = yp[m][bj]; f32x4 v0 = acc[ai][bj][m][0], v1 = acc[ai][bj][m][1];
                    v0[0] = v0[0] * bflo(g.x) + bflo(y.x); v0[1] = v0[1] * bfhi(g.x) + bfhi(y.x); v0[2] = v0[2] * bflo(g.y) + bflo(y.y); v0[3] = v0[3] * bfhi(g.y) + bfhi(y.y);
                    v1[0] = v1[0] * bflo(g.z) + bflo(y.z); v1[1] = v1[1] * bfhi(g.z) + bfhi(y.z); v1[2] = v1[2] * bflo(g.w) + bflo(y.w); v1[3] = v1[3] * bfhi(g.w) + bfhi(y.w);
                    stg<u32x4>(YMB + (size_t)(row0 + ai * 128 + m * 16) * 1024 + u.pn * 256 + bj * 128 + cin, pack8(v0, v1)); }
        }
    }
};
struct EpiOut {
    static constexpr bool IDEMP = false;
    static constexpr bool PERM = false;
    const float* xl_old; const float* xc_old; float* xl_new; float* xc_new; const float* MODL; int b0;
    __device__ __forceinline__ void operator()(const AccT& acc, const Unit& u, int wr, int wc, int fr, int fq) const {
        const int row0 = u.pm * 256 + wr * 64 + fr, cin = wc * 32 + 4 * fq, trow = u.pm * 256;
        const float* xo; float* xn; int mrow;
        if (b0 < 0) { xo = xc_old + (size_t)trow * 1024; xn = xc_new + (size_t)trow * 1024; mrow = 32; }
        else if (trow < RL) { const size_t tok = (size_t)(b0 + (trow >> 11)) * 2048 + (trow & 2047); xo = xl_old + tok * 1024; xn = xl_new + tok * 1024; mrow = b0 + (trow >> 11); }
        else { const int rc = trow - RL; const size_t tok = (size_t)(b0 + (rc >> 8)) * 256 + (rc & 255); xo = xc_old + tok * 1024; xn = xc_new + tok * 1024; mrow = 32; }
        const float* gt = MODL + (size_t)mrow * 6144 + 2 * 1024 + u.pn * 256 + cin;
        f32x4 g[2][2];
#pragma unroll
        for (int bj = 0; bj < 2; ++bj)
#pragma unroll
            for (int n = 0; n < 2; ++n) g[bj][n] = ldg<f32x4>(gt + bj * 128 + 16 * n);
#pragma unroll
        for (int ai = 0; ai < 2; ++ai)
#pragma unroll
            for (int mp = 0; mp < 2; ++mp) {
                f32x4 xv[2][2][2];
#pragma unroll
                for (int mm = 0; mm < 2; ++mm)
#pragma unroll
                    for (int bj = 0; bj < 2; ++bj)
#pragma unroll
                        for (int n = 0; n < 2; ++n) xv[mm][bj][n] = ldg<f32x4>(xo + (size_t)(row0 - trow + ai * 128 + (2 * mp + mm) * 16) * 1024 + u.pn * 256 + bj * 128 + cin + 16 * n);
#pragma unroll
                for (int mm = 0; mm < 2; ++mm)
#pragma unroll
                    for (int bj = 0; bj < 2; ++bj)
#pragma unroll
                        for (int n = 0; n < 2; ++n) stg<f32x4>(xn + (size_t)(row0 - trow + ai * 128 + (2 * mp + mm) * 16) * 1024 + u.pn * 256 + bj * 128 + cin + 16 * n, xv[mm][bj][n] + g[bj][n] * acc[ai][bj][2 * mp + mm][n]);
            }
    }
};
struct EpiDown {
    static constexpr bool IDEMP = false;
    static constexpr bool PERM = false;
    const int* rowtok; const float* roww; float* xl; float* xc; const float* MODL; float wscale;
    __device__ __forceinline__ void operator()(const AccT& acc, const Unit& u, int wr, int wc, int fr, int fq) const {
        const int row0 = u.pm * 256 + wr * 64 + fr, cin = wc * 32 + 4 * fq, cbase = u.pn * 256 + cin;
        int tk[2][4]; float ww[2][4];
#pragma unroll
        for (int ai = 0; ai < 2; ++ai)
#pragma unroll
            for (int m = 0; m < 4; ++m) { const int row = row0 + ai * 128 + m * 16; tk[ai][m] = ldg<int>(rowtok + row); ww[ai][m] = ldg<float>(roww + row) * wscale; }
#pragma unroll
        for (int ai = 0; ai < 2; ++ai)
#pragma unroll
            for (int mp = 0; mp < 2; ++mp) {
                f32x4 xv[2][2][2], gv[2][2][2]; float* xp[2];
#pragma unroll
                for (int mm = 0; mm < 2; ++mm) { const int tok = tk[ai][2 * mp + mm]; const int t0 = tok < 0 ? 0 : tok;
                    int mrow; if (t0 < NTOK_LAT) { xp[mm] = xl + (size_t)t0 * 1024 + cbase; mrow = t0 >> 11; } else { xp[mm] = xc + (size_t)(t0 - NTOK_LAT) * 1024 + cbase; mrow = 32; }
                    const float* gt = MODL + (size_t)mrow * 6144 + 5 * 1024 + cbase;
#pragma unroll
                    for (int bj = 0; bj < 2; ++bj)
#pragma unroll
                        for (int n = 0; n < 2; ++n) { xv[mm][bj][n] = ldg<f32x4>(xp[mm] + bj * 128 + 16 * n); gv[mm][bj][n] = ldg<f32x4>(gt + bj * 128 + 16 * n); } }
#pragma unroll
                for (int mm = 0; mm < 2; ++mm) { const int m = 2 * mp + mm;
                    if (tk[ai][m] >= 0) { const float w = ww[ai][m];
#pragma unroll
                        for (int bj = 0; bj < 2; ++bj)
#pragma unroll
                            for (int n = 0; n < 2; ++n) stg<f32x4>(xp[mm] + bj * 128 + 16 * n, xv[mm][bj][n] + (gv[mm][bj][n] * w) * acc[ai][bj][m][n]); } }
            }
    }
};

struct EpiDownY {
    static constexpr bool IDEMP = true;
    static constexpr bool PERM = true;
    const int* rowtok; const float* roww; bf16* Y; int nt0;
    __device__ __forceinline__ void operator()(const AccT& acc, const Unit& u, int wr, int wc, int fr, int fq) const {
        const int row0 = u.pm * 256 + wr * 64 + fr, cin = wc * 32 + 8 * fq;
        bf16* Yp = Y + (u.pm < nt0 ? (size_t)0 : (size_t)NTOK * 1024) + u.pn * 256 + cin;
        int tk[2][4]; float ww[2][4];
#pragma unroll
        for (int ai = 0; ai < 2; ++ai)
#pragma unroll
            for (int m = 0; m < 4; ++m) { const int row = row0 + ai * 128 + m * 16; tk[ai][m] = ldg<int>(rowtok + row); ww[ai][m] = ldg<float>(roww + row); }
#pragma unroll
        for (int ai = 0; ai < 2; ++ai)
#pragma unroll
            for (int m = 0; m < 4; ++m) if (tk[ai][m] >= 0) { const float w = ww[ai][m];
#pragma unroll
                for (int bj = 0; bj < 2; ++bj) stg<u32x4>(Yp + (size_t)tk[ai][m] * 1024 + bj * 128, pack8(acc[ai][bj][m][0] * w, acc[ai][bj][m][1] * w)); }
    }
};

__device__ __forceinline__ void tr_item(const float* W, int K, int Nsrc, int scol0, const float* kscale, bf16* WT, int drow0, int k0, LAS float* scr, int lane) {
#pragma unroll
    for (int i = 0; i < 8; ++i) { const int kk = 8 * i + (lane >> 3), n4 = (lane & 7) * 4;
        f32x4 v = {0.f, 0.f, 0.f, 0.f}; if (scol0 >= 0) { v = ldg<f32x4>(W + (size_t)(k0 + kk) * Nsrc + scol0 + n4); if (kscale) v = v * ldg<float>(kscale + k0 + kk); }
        scr[kk * 33 + n4] = v[0]; scr[kk * 33 + n4 + 1] = v[1]; scr[kk * 33 + n4 + 2] = v[2]; scr[kk * 33 + n4 + 3] = v[3]; }
    asm volatile("s_waitcnt lgkmcnt(0)" ::: "memory");
    const int c = lane & 7;
#pragma unroll
    for (int j = 0; j < 4; ++j) { const int n = (lane >> 3) + 8 * j; const LAS float* s = scr + (8 * c) * 33 + n;
        u32x4 o; o.x = pk2(s[0 * 33], s[1 * 33]); o.y = pk2(s[2 * 33], s[3 * 33]); o.z = pk2(s[4 * 33], s[5 * 33]); o.w = pk2(s[6 * 33], s[7 * 33]);
        stg<u32x4>(WT + (size_t)(drow0 + n) * K + k0 + 8 * c, o); }
    asm volatile("s_waitcnt lgkmcnt(0)" ::: "memory");
}
__device__ __forceinline__ int win_src_col(int n) {
    if (n < 256) return n;
    if (n < 768) return 1312 + (n - 256);
    if (n < 1536) return 1824 + (n - 768);
    if (n < 2560) {
        const int base = n < 2048 ? 2592 : 288, r = n < 2048 ? n - 1536 : n - 2048, t = r >> 8, c = r & 255;
        return base + (4 * t + ((c & 127) >> 5)) * 64 + (c >> 7) * 32 + (c & 31); }
    if (n < 3072) return 800 + (n - 2560);
    if (n < 6144) return 3104 + (n - 3072);
    if (n < 6176) return 256 + (n - 6144);
    return -1;
}
__device__ __forceinline__ int pair_src_col(int n) { const int pn = n >> 8, jj = n & 255; return jj < 128 ? 128 * pn + jj : 512 + 128 * pn + (jj - 128); }

__device__ __forceinline__ void prologue_transposes(Frame& F, int cu_lo) {
    LAS float* scr = (LAS float*)(F.lds + F.wave * 16384);
    const int gw = (F.c - cu_lo) * 8 + F.wave, NGW = (F.G - cu_lo) * 8;
    constexpr int I_IN = (NINP / 32) * 16, I_UQ = 24 * 12, I_UKV = 32 * 4, I_GLU = 32 * 8, I_BR = 3 * 32 * 8, I_OUT = 32 * 16, I_UP = 32 * 32 * 16, I_DN = 32 * 32 * 8;
    constexpr int PER_L = I_IN + I_UQ + I_UKV + I_GLU + I_BR + I_OUT;
    for (int it = gw; it < 2 * PER_L; it += NGW) {
        const int l = it / PER_L; int r = it % PER_L;
        if (r < I_IN) { const int nb = r / 16, kb = r % 16; tr_item(F.in[7] + (size_t)l * 1024 * 6176, 1024, 6176, win_src_col(nb * 32), nullptr, (bf16*)(F.ws + WS_WINT) + (size_t)l * NINP * 1024, nb * 32, kb * 64, scr, F.lane); continue; } r -= I_IN;
        if (r < I_UQ) { const int nb = r / 12, kb = r % 12; tr_item(F.in[9] + (size_t)l * 768 * 768, 768, 768, nb * 32, F.in[8] + l * 768, (bf16*)(F.ws + WS_UQT) + (size_t)l * 768 * 768, nb * 32, kb * 64, scr, F.lane); continue; } r -= I_UQ;
        if (r < I_UKV) { const int nb = r / 4, kb = r % 4, n = nb * 32; const int sc = n < 512 ? (n >> 6) * 128 + (n & 63) : ((n - 512) >> 6) * 128 + 64 + (n & 63);
            tr_item(F.in[11] + (size_t)l * 256 * 1024, 256, 1024, sc, F.in[10] + l * 256, (bf16*)(F.ws + WS_UKVT) + (size_t)l * 1024 * 256, n, kb * 64, scr, F.lane); continue; } r -= I_UKV;
        if (r < I_GLU) { const int nb = r / 8, kb = r % 8; tr_item(F.in[25] + (size_t)l * 512 * 1024, 512, 1024, pair_src_col(nb * 32), nullptr, (bf16*)(F.ws + WS_GLUT) + (size_t)l * 1024 * 512, nb * 32, kb * 64, scr, F.lane); continue; } r -= I_GLU;
        if (r < I_BR) { const int z = r / 256, q = r % 256, nb = q / 8, kb = q % 8; tr_item(F.in[26] + ((size_t)l * 3 + z) * 512 * 1024, 512, 1024, nb * 32, nullptr, (bf16*)(F.ws + WS_BRT) + ((size_t)l * 3 + z) * 1024 * 512, nb * 32, kb * 64, scr, F.lane); continue; } r -= I_BR;
        { const int nb = r / 16, kb = r % 16; tr_item(F.in[27] + (size_t)l * 1024 * 1024, 1024, 1024, nb * 32, nullptr, (bf16*)(F.ws + WS_OUTT) + (size_t)l * 1024 * 1024, nb * 32, kb * 64, scr, F.lane); }
    }
}
constexpr int MOE_I_UP = 32 * 32 * 16, MOE_I_DN = 32 * 32 * 8, MOE_ITEMS = MOE_I_UP + MOE_I_DN;
__device__ __forceinline__ void tr_moe_items(Frame& F, int l, int first, int count, int cu_lo) {
    if (F.c < cu_lo) return;
    __syncthreads();
    LAS float* scr = (LAS float*)(F.lds + F.wave * 16384);
    const int gw = (F.c - cu_lo) * 8 + F.wave, NGW = (F.G - cu_lo) * 8;
#pragma nounroll
    for (int it = first + gw; it < first + count; it += NGW) {
        if (it < MOE_I_UP) { const int e = it / 512, q = it % 512, nb = q / 16, kb = q % 16; tr_item(F.in[33] + ((size_t)l * 32 + e) * 1024 * 1024, 1024, 1024, pair_src_col(nb * 32), nullptr, (bf16*)(F.ws + WS_UPT) + ((size_t)l * 32 + e) * 1024 * 1024, nb * 32, kb * 64, scr, F.lane); }
        else { const int r = it - MOE_I_UP, e = r / 256, q = r % 256, nb = q / 8, kb = q % 8; tr_item(F.in[34] + ((size_t)l * 32 + e) * 512 * 1024, 512, 1024, nb * 32, nullptr, (bf16*)(F.ws + WS_DOWNT) + ((size_t)l * 32 + e) * 1024 * 512, nb * 32, kb * 64, scr, F.lane); }
    }
}
__device__ __forceinline__ void prologue_small(Frame& F, int cu_lo) {
    const int gt = (F.c - cu_lo) * 512 + F.tid, NT = (F.G - cu_lo) * 512;
    float* ROPE = (float*)(F.ws + WS_ROPE);
    for (int i = gt; i < 2048 * 16; i += NT) { const int t = i >> 4, a = (i >> 3) & 1, f = i & 7;
        const float inv = powf(10000.0f, -(float)f / 8.0f); const float pos = a == 0 ? (float)(t >> 6) : (float)(t & 63); const float ang = pos * inv;
        ROPE[2 * i] = cosf(ang); ROPE[2 * i + 1] = sinf(ang); }
    float* WGT = (float*)(F.ws + WS_WGT); float* WET = (float*)(F.ws + WS_WET);
    for (int i = gt; i < 2 * 4 * 1024; i += NT) { const int l = i / 4096, e = (i >> 10) & 3, k = i & 1023; WGT[i] = F.in[29][((size_t)l * 1024 + k) * 4 + e]; }
    for (int i = gt; i < 2 * 32 * 1024; i += NT) { const int l = i / 32768, e = (i >> 10) & 31, k = i & 1023; WET[i] = F.in[31][((size_t)l * 1024 + k) * 32 + e]; }
}
__device__ __forceinline__ void prologue_mod(Frame& F, int cu_lo) {
    LAS float* SC = (LAS float*)F.lds;
    __syncthreads();
#pragma unroll 11
    for (int q = 0; q < 66; ++q) { const int i = F.tid + 512 * q, r = i >> 10, k = i & 1023; const float v = r < 32 ? ldg<float>(F.in[1] + r * 1024 + k) : ldg<float>(F.in[3] + k); SC[i] = v * sigmoidf(v); }
    __syncthreads();
    float* MODP = (float*)(F.ws + WS_MODP);
    const int gw = (F.c - cu_lo) * 8 + F.wave, NGW = (F.G - cu_lo) * 8;
    for (int task = gw; task < 2 * 96 * 8; task += NGW) {
        const int ks = task & 7, nb = (task >> 3) % 96, l = task / 768; const int n = nb * 64 + F.lane;
        f32x2 acc[33];
#pragma unroll
        for (int r = 0; r < 33; ++r) acc[r] = (f32x2){0.f, 0.f};
        const float* Wl = F.in[4] + (size_t)l * 1024 * 6144;
#pragma nounroll
        for (int kb = 0; kb < 4; ++kb) { const int k0 = ks * 128 + kb * 32;
            const float* Wk = Wl + (size_t)k0 * 6144;
            f32x2 w[16];
#pragma unroll
            for (int j = 0; j < 16; ++j) { w[j][0] = ldg<float>(Wk + (2 * j) * 6144 + n); w[j][1] = ldg<float>(Wk + (2 * j + 1) * 6144 + n); }
            const LAS float* s0 = SC + k0; const LAS float* s1 = s0 + 16 * 1024; const LAS float* s2 = s0 + 32 * 1024;
            asm volatile("" : "+v"(s0), "+v"(s1), "+v"(s2));
#pragma unroll
            for (int j4 = 0; j4 < 8; ++j4) {
#pragma unroll
                for (int r = 0; r < 33; ++r) { const f32x4 sv = *(const LAS f32x4*)((r < 16 ? s0 : (r < 32 ? s1 : s2)) + (r & 15) * 1024 + 4 * j4);
                    acc[r] += (f32x2){sv[0], sv[1]} * w[2 * j4]; acc[r] += (f32x2){sv[2], sv[3]} * w[2 * j4 + 1]; } } }
#pragma unroll
        for (int r = 0; r < 33; ++r) MODP[(((size_t)ks * 2 + l) * 33 + r) * 6144 + n] = acc[r][0] + acc[r][1];
    }
    __syncthreads();
}
__device__ __forceinline__ void prologue_mod_final(Frame& F) {
    const float* MODP = (const float*)(F.ws + WS_MODP);
    for (int i = F.c * 512 + F.tid; i < 2 * 33 * 6144; i += F.G * 512) { const int l = i / (33 * 6144), n = i % 6144;
        float s = F.in[5][l * 6144 + n];
#pragma unroll
        for (int ks = 0; ks < 8; ++ks) s += MODP[(size_t)ks * 2 * 33 * 6144 + i];
        F.MOD[i] = s; }
}
__device__ __forceinline__ void prologue_s5(Frame& F, int l, int g) {
    LAS float* AP = (LAS float*)F.lds;
    LAS float* BB = AP + 2 * 17 * 64 * 2;
    LAS float* CC = BB + 2 * 64 * 16 * 2;
    LAS float* KJ = CC + 2 * 16 * 64 * 2;
    __syncthreads();
    const float* a_re = F.in[17]; const float* a_im = F.in[18]; const float* ldt = F.in[19]; const float* b_re = F.in[20]; const float* b_im = F.in[21];
    const float* c_re = F.in[22]; const float* c_im = F.in[23]; const float* dsk = F.in[24];
    for (int i = F.tid; i < 2 * 17 * 64; i += 512) { const int dir = i / (17 * 64), j = (i / 64) % 17, p = i & 63;
        const size_t ia = (((size_t)l * 2 + dir) * 32 + g) * 64 + p;
        const float lre = fminf(a_re[ia], -1e-4f), lim = a_im[ia], dt = expf(ldt[((size_t)l * 2 + dir) * 32 + g]);
        const float mag = expf((float)j * (lre * dt)); const float ang = (float)j * (lim * dt);
        AP[2 * i] = mag * cosf(ang); AP[2 * i + 1] = mag * sinf(ang); }
    for (int i = F.tid; i < 2 * 64 * 16; i += 512) { const int dir = i / 1024, p = (i >> 4) & 63, m = i & 15;
        const size_t ia = (((size_t)l * 2 + dir) * 32 + g) * 64 + p;
        const float lre = fminf(a_re[ia], -1e-4f), lim = a_im[ia], dt = expf(ldt[((size_t)l * 2 + dir) * 32 + g]);
        const float mag = expf(lre * dt), abr = mag * cosf(lim * dt), abi = mag * sinf(lim * dt);
        const float den = lre * lre + lim * lim, nre = abr - 1.0f;
        const float fre = (nre * lre + abi * lim) / den, fim = (abi * lre - nre * lim) / den;
        const float br = b_re[ia * 16 + m], bi = b_im[ia * 16 + m];
        BB[2 * i] = fre * br - fim * bi; BB[2 * i + 1] = fre * bi + fim * br; }
    for (int i = F.tid; i < 2 * 16 * 64; i += 512) { const int dir = i / 1024, n = (i >> 6) & 15, p = i & 63;
        const size_t ic = ((((size_t)l * 2 + dir) * 32 + g) * 16 + n) * 64 + p;
        CC[2 * i] = c_re[ic]; CC[2 * i + 1] = c_im[ic]; }
    __syncthreads();
    { const int n = (F.tid >> 4) & 15, m = F.tid & 15, jh = F.tid >> 8;
#pragma nounroll
        for (int dir = 0; dir < 2; ++dir) {
            float sj[8];
#pragma unroll
            for (int q = 0; q < 8; ++q) sj[q] = 0.f;
#pragma unroll 4
            for (int p = 0; p < 64; ++p) {
                const f32x2 b = *(const LAS f32x2*)(BB + ((dir * 64 + p) * 16 + m) * 2), cc = *(const LAS f32x2*)(CC + ((dir * 16 + n) * 64 + p) * 2);
                const float tr = cc[0] * b[0] - cc[1] * b[1], ti = cc[0] * b[1] + cc[1] * b[0];
#pragma unroll
                for (int q = 0; q < 8; ++q) { const f32x2 a = *(const LAS f32x2*)(AP + ((dir * 17 + jh + 2 * q) * 64 + p) * 2); sj[q] += tr * a[0] - ti * a[1]; } }
#pragma unroll
            for (int q = 0; q < 8; ++q) KJ[((dir * 16 + jh + 2 * q) * 16 + n) * 16 + m] = sj[q]; } }
    __syncthreads();
    bf16* BTY = (bf16*)(F.ws + WS_BTY) + ((size_t)l * 32 + g) * 256 * 512;
    for (int i = F.tid; i < 256 * 512; i += 512) { const int row = i >> 9, k = i & 511, t = row >> 4, n = row & 15; float v;
        if (k < 256) { const int s = k >> 4, m = k & 15; v = 0.f;
            if (t >= s) v += KJ[((0 * 16 + (t - s)) * 16 + n) * 16 + m];
            if (s >= t) v += KJ[((1 * 16 + (s - t)) * 16 + n) * 16 + m];
            if (k == row) v += dsk[l * 512 + g * 16 + n]; }
        else { const int kk = k - 256, dir = kk >> 7, im = (kk >> 6) & 1, p = kk & 63, j = dir == 0 ? t + 1 : 16 - t;
            const float ar = AP[((dir * 17 + j) * 64 + p) * 2], ai = AP[((dir * 17 + j) * 64 + p) * 2 + 1];
            const float cr = CC[((dir * 16 + n) * 64 + p) * 2], ci = CC[((dir * 16 + n) * 64 + p) * 2 + 1];
            v = im == 0 ? (cr * ar - ci * ai) : -(cr * ai + ci * ar); }
        BTY[i] = (bf16)f2bf(v); }
    bf16* BTS = (bf16*)(F.ws + WS_BTS) + ((size_t)l * 32 + g) * 256 * 256;
    for (int i = F.tid; i < 256 * 256; i += 512) { const int row = i >> 8, k = i & 255, s = k >> 4, m = k & 15, dir = row >> 7, im = (row >> 6) & 1, p = row & 63, j = dir == 0 ? 15 - s : s;
        const float ar = AP[((dir * 17 + j) * 64 + p) * 2], ai = AP[((dir * 17 + j) * 64 + p) * 2 + 1];
        const float br = BB[((dir * 64 + p) * 16 + m) * 2], bi = BB[((dir * 64 + p) * 16 + m) * 2 + 1];
        const float v = im == 0 ? (ar * br - ai * bi) : (ar * bi + ai * br);
        BTS[i] = (bf16)f2bf(v); }
    float* A16 = (float*)(F.ws + WS_A16);
    for (int i = F.tid; i < 2 * 64; i += 512) { const int dir = i >> 6, p = i & 63;
        A16[((((size_t)l * 2 + dir) * 32 + g) * 64 + p) * 2] = AP[((dir * 17 + 16) * 64 + p) * 2];
        A16[((((size_t)l * 2 + dir) * 32 + g) * 64 + p) * 2 + 1] = AP[((dir * 17 + 16) * 64 + p) * 2 + 1]; }
    __syncthreads();
}

__device__ __forceinline__ void phase_h(Frame& F, int l, int b0, const float* xl, const float* xc, int nrows) {
    bf16* HB = (bf16*)(F.ck + C_HB);
    const float* g1 = F.in[6] + l * 1024;
    const int gw = F.c * 8 + F.wave, NGW = F.G * 8;
    for (int row = gw; row < nrows; row += NGW) {
        const float* xs; int mrow;
        if (row < RL) { mrow = b0 + (row >> 11); xs = xl + ((size_t)mrow * 2048 + (row & 2047)) * 1024; }
        else { const int rc = row - RL; xs = xc + ((size_t)(b0 + (rc >> 8)) * 256 + (rc & 255)) * 1024; mrow = 32; }
        const float* md = F.MOD + ((size_t)l * 33 + mrow) * 6144;
        f32x4 v[4]; float ss = 0.f;
#pragma unroll
        for (int j = 0; j < 4; ++j) { v[j] = ldg<f32x4>(xs + 4 * F.lane + 256 * j); ss += v[j][0] * v[j][0] + v[j][1] * v[j][1] + v[j][2] * v[j][2] + v[j][3] * v[j][3]; }
        const float rstd = rsqrtf(wave_sum(ss) * (1.0f / 1024.0f) + RMS_EPS);
#pragma unroll
        for (int j = 0; j < 4; ++j) { const int col = 4 * F.lane + 256 * j;
            const f32x4 g = ldg<f32x4>(g1 + col), sh = ldg<f32x4>(md + col), sc = ldg<f32x4>(md + 1024 + col);
            const f32x4 h = (v[j] * rstd * g) * (sc + 1.0f) + sh;
            u32x2 o; o.x = pk2(h[0], h[1]); o.y = pk2(h[2], h[3]); stg<u32x2>(HB + (size_t)row * 1024 + col, o); }
    }
}
__device__ __forceinline__ void vt_item(const bf16* src, int ldsrc, bf16* dst, LAS unsigned* scr, int lane) {
    const int r8 = lane >> 3, c8 = lane & 7;
#pragma unroll
    for (int i = 0; i < 8; ++i) { const int key = 8 * i + r8; const u32x4 v = ldg<u32x4>(src + (size_t)key * ldsrc + c8 * 8);
        scr[key * 33 + c8 * 4 + 0] = v.x; scr[key * 33 + c8 * 4 + 1] = v.y; scr[key * 33 + c8 * 4 + 2] = v.z; scr[key * 33 + c8 * 4 + 3] = v.w; }
    asm volatile("s_waitcnt lgkmcnt(0)" ::: "memory");
    const LAS unsigned short* s16 = (const LAS unsigned short*)scr;
#pragma unroll
    for (int i = 0; i < 8; ++i) { const int d = 8 * i + r8; unsigned w[4];
#pragma unroll
        for (int q = 0; q < 4; ++q) { const int k0 = c8 * 8 + q * 2; w[q] = (unsigned)s16[(k0 * 33) * 2 + d] | ((unsigned)s16[((k0 + 1) * 33) * 2 + d] << 16); }
        stg<u32x4>(dst + (size_t)d * KEYS + c8 * 8, (u32x4){w[0], w[1], w[2], w[3]}); }
    asm volatile("s_waitcnt lgkmcnt(0)" ::: "memory");
}
__device__ __forceinline__ void phase_p1(Frame& F, int l, bool ctx_q) {
    bf16* KVL = (bf16*)(F.ck + C_KVL); bf16* QL = (bf16*)(F.ck + C_QL); bf16* NQ = (bf16*)(F.ck + C_NQ); bf16* NK = (bf16*)(F.ck + C_NK);
    const float* gq = F.in[14] + l * 64; const float* gk = F.in[15] + l * 64;
    const int gw = F.c * 8 + F.wave, NGW = F.G * 8, lane = F.lane;
    for (int row = gw; row < RR; row += NGW) {
        { bf16* p = KVL + (size_t)row * 256 + 4 * lane; const u32x2 w = ldg<u32x2>(p);
          const float a = bflo(w.x), b = bfhi(w.x), c = bflo(w.y), d = bfhi(w.y);
          const float rstd = rsqrtf(wave_sum(a * a + b * b + c * c + d * d) * (1.0f / 256.0f) + RMS_EPS);
          stg<u32x2>(p, (u32x2){pk2(a * rstd, b * rstd), pk2(c * rstd, d * rstd)}); }
        { bf16* p = NK + (size_t)row * 512 + 8 * lane; const u32x4 w = ldg<u32x4>(p);
          float v[8] = {bflo(w.x), bfhi(w.x), bflo(w.y), bfhi(w.y), bflo(w.z), bfhi(w.z), bflo(w.w), bfhi(w.w)}; float ss = 0.f;
#pragma unroll
          for (int j = 0; j < 8; ++j) ss += v[j] * v[j];
          ss = shx_sum<1>(ss); ss = shx_sum<2>(ss); ss = shx_sum<4>(ss);
          const float rstd = rsqrtf(ss * (1.0f / 64.0f) + RMS_EPS); const int d0 = 8 * (lane & 7);
#pragma unroll
          for (int j = 0; j < 8; ++j) v[j] *= rstd * ldg<float>(gk + d0 + j);
          stg<u32x4>(p, (u32x4){pk2(v[0], v[1]), pk2(v[2], v[3]), pk2(v[4], v[5]), pk2(v[6], v[7])}); }
        if (row < RL || ctx_q) {
            { bf16* p = QL + (size_t)row * 768 + 12 * lane; u32x2 w[3]; float v[12]; float ss = 0.f;
#pragma unroll
              for (int j = 0; j < 3; ++j) { w[j] = ldg<u32x2>(p + 4 * j); v[4 * j] = bflo(w[j].x); v[4 * j + 1] = bfhi(w[j].x); v[4 * j + 2] = bflo(w[j].y); v[4 * j + 3] = bfhi(w[j].y); }
#pragma unroll
              for (int j = 0; j < 12; ++j) ss += v[j] * v[j];
              const float rstd = rsqrtf(wave_sum(ss) * (1.0f / 768.0f) + RMS_EPS);
#pragma unroll
              for (int j = 0; j < 3; ++j) stg<u32x2>(p + 4 * j, (u32x2){pk2(v[4 * j] * rstd, v[4 * j + 1] * rstd), pk2(v[4 * j + 2] * rstd, v[4 * j + 3] * rstd)}); }
            { bf16* p = NQ + (size_t)row * 512 + 8 * lane; const u32x4 w = ldg<u32x4>(p);
              float v[8] = {bflo(w.x), bfhi(w.x), bflo(w.y), bfhi(w.y), bflo(w.z), bfhi(w.z), bflo(w.w), bfhi(w.w)}; float ss = 0.f;
#pragma unroll
              for (int j = 0; j < 8; ++j) ss += v[j] * v[j];
              ss = shx_sum<1>(ss); ss = shx_sum<2>(ss); ss = shx_sum<4>(ss);
              const float rstd = rsqrtf(ss * (1.0f / 64.0f) + RMS_EPS) * (0.125f * LOG2E); const int d0 = 8 * (lane & 7);
#pragma unroll
              for (int j = 0; j < 8; ++j) v[j] *= rstd * ldg<float>(gq + d0 + j);
              stg<u32x4>(p, (u32x4){pk2(v[0], v[1]), pk2(v[2], v[3]), pk2(v[4], v[5]), pk2(v[6], v[7])}); }
        }
    }
    const bf16* NV = (const bf16*)(F.ck + C_NV); bf16* NVT = (bf16*)(F.ck + C_NVT);
    LAS unsigned* scr = (LAS unsigned*)(F.lds + F.wave * 16384);
    for (int it = gw; it < NB * 8 * 36; it += NGW) { const int kb = it % 36, h = (it / 36) & 7, b = it / 288;
        const int srow = kb < 32 ? b * 2048 + 64 * kb : RL + b * 256 + 64 * (kb - 32);
        vt_item(NV + (size_t)srow * 512 + h * 64, 512, NVT + ((size_t)(b * 8 + h) * 64) * KEYS + 64 * kb, scr, lane); }
}
__device__ __forceinline__ void ctx_krope(Frame& F, const bf16* HBc  , const bf16* WKR  ) {
    bf16* KRP = (bf16*)(F.ck + C_KRP); const int gw = F.c * 8 + F.wave, NGW = F.G * 8, lane = F.lane;
    for (int rc = gw; rc < RC; rc += NGW) {
        const u32x4 h0 = ldg<u32x4>(HBc + (size_t)rc * 1024 + 16 * lane), h1 = ldg<u32x4>(HBc + (size_t)rc * 1024 + 16 * lane + 8);
        float hv[16] = {bflo(h0.x), bfhi(h0.x), bflo(h0.y), bfhi(h0.y), bflo(h0.z), bfhi(h0.z), bflo(h0.w), bfhi(h0.w), bflo(h1.x), bfhi(h1.x), bflo(h1.y), bfhi(h1.y), bflo(h1.z), bfhi(h1.z), bflo(h1.w), bfhi(h1.w)};
        float p[32];
#pragma unroll
        for (int jb = 0; jb < 4; ++jb) {
            u32x4 w0[8], w1[8];
#pragma unroll
            for (int j8 = 0; j8 < 8; ++j8) { w0[j8] = ldg<u32x4>(WKR + (size_t)(jb * 8 + j8) * 1024 + 16 * lane); w1[j8] = ldg<u32x4>(WKR + (size_t)(jb * 8 + j8) * 1024 + 16 * lane + 8); }
#pragma unroll
            for (int j8 = 0; j8 < 8; ++j8) { const u32x4 a0 = w0[j8], a1 = w1[j8];
                p[jb * 8 + j8] = hv[0] * bflo(a0.x) + hv[1] * bfhi(a0.x) + hv[2] * bflo(a0.y) + hv[3] * bfhi(a0.y) + hv[4] * bflo(a0.z) + hv[5] * bfhi(a0.z) + hv[6] * bflo(a0.w) + hv[7] * bfhi(a0.w)
                                + hv[8] * bflo(a1.x) + hv[9] * bfhi(a1.x) + hv[10] * bflo(a1.y) + hv[11] * bfhi(a1.y) + hv[12] * bflo(a1.z) + hv[13] * bfhi(a1.z) + hv[14] * bflo(a1.w) + hv[15] * bfhi(a1.w); }
            __builtin_amdgcn_sched_barrier(0);
        }
        float r8[8];
#pragma unroll
        for (int k = 0; k < 8; ++k) r8[k] = row_sum16(hx16(hx32(p[k], p[k + 16]), hx32(p[k + 8], p[k + 24])));
        if ((lane & 15) == 0) stg<u32x4>(KRP + (size_t)(RL + rc) * 32 + 8 * (lane >> 4), (u32x4){pk2(r8[0], r8[1]), pk2(r8[2], r8[3]), pk2(r8[4], r8[5]), pk2(r8[6], r8[7])});
    }
}
__device__ __forceinline__ void phase_p2(Frame& F, int l, bool ctx_q) {
    const int gt = F.tid >= 128 ? F.c * 384 + (F.tid - 128) : 0x7fffffff - 1024, NT = F.G * 384;
    const float* ROPE = (const float*)(F.ws + WS_ROPE);
    if (F.tid < 128) { const float* SS = (const float*)(F.ck + C_SS); bf16* AS5 = (bf16*)(F.ck + C_AS5); const float* A16 = (const float*)(F.ws + WS_A16);
      for (int i = F.c * 128 + F.tid; i < NB * 32 * 2 * 64; i += F.G * 128) { const int p = i & 63, dir = (i >> 6) & 1, g = (i >> 7) & 31, b = i >> 12;
          const float ar = A16[((((size_t)l * 2 + dir) * 32 + g) * 64 + p) * 2], ai = A16[((((size_t)l * 2 + dir) * 32 + g) * 64 + p) * 2 + 1];
          float hr = 0.f, hi = 0.f;
          for (int c0 = 0; c0 < 144; c0 += 24) {
              float sr[24], si[24]; int rho[24];
#pragma unroll
              for (int k = 0; k < 24; ++k) { const int c = c0 + k;
                  rho[k] = dir == 0 ? (c < 16 ? 1024 + b * 16 + c : b * 128 + (c - 16)) : (c < 16 ? 1024 + b * 16 + (15 - c) : b * 128 + (127 - (c - 16)));
                  const float* sp = SS + ((size_t)rho[k] * 32 + g) * 256 + dir * 128 + p; sr[k] = ldg<float>(sp); si[k] = ldg<float>(sp + 64); }
#pragma unroll
              for (int k = 0; k < 24; ++k) { bf16* ap = AS5 + ((size_t)rho[k] * 32 + g) * 512 + 256 + dir * 128 + p;
                  ap[0] = (bf16)f2bf(hr); ap[64] = (bf16)f2bf(hi);
                  const float nr = ar * hr - ai * hi + sr[k], ni = ar * hi + ai * hr + si[k]; hr = nr; hi = ni; }
          } } }
#define UNPK(PW, FA) do { const u32x4 pw_ = (PW); FA[0] = bflo(pw_.x); FA[1] = bfhi(pw_.x); FA[2] = bflo(pw_.y); FA[3] = bfhi(pw_.y); FA[4] = bflo(pw_.z); FA[5] = bfhi(pw_.z); FA[6] = bflo(pw_.w); FA[7] = bfhi(pw_.w); } while (0)
#define PK8(FA) ((u32x4){pk2(FA[0], FA[1]), pk2(FA[2], FA[3]), pk2(FA[4], FA[5]), pk2(FA[6], FA[7])})
    { const bf16* QR = (const bf16*)(F.ck + C_QR); const bf16* KN = (const bf16*)(F.ck + C_KN); const bf16* KRP = (const bf16*)(F.ck + C_KRP);
      bf16* QF = (bf16*)(F.ck + C_QF); bf16* KF = (bf16*)(F.ck + C_KF);
      const int nq = 0, ntot = RR * 8;
      LAS unsigned char* st = F.lds + F.wave * 16384;
      for (int i = gt; i < ntot; i += NT) {
          const bool isq = __builtin_amdgcn_readfirstlane(i) < nq;
          const int ii = isq ? i : i - nq, row = ii >> 3, h = ii & 7;
          int ln = F.lane; asm volatile("" : "+v"(ln));
          const int i0 = ii - ln;
          const float* gn = isq ? F.in[12] + l * 96 : F.in[13] + l * 96;
          const float osc = isq ? 0.10206207261596575f * LOG2E : 1.0f;
          bf16* dst0 = (isq ? QF : KF) + (size_t)i0 * 96;
          u32x4 w[12];
          if (isq) { const bf16* s0 = QR + (size_t)i0 * 96;
#pragma unroll
              for (int j = 0; j < 12; ++j) { const int idx = j * 64 + ln; w[j] = ldg<u32x4>(s0 + idx * 8); }
#pragma unroll
              for (int j = 0; j < 12; ++j) { const int idx = j * 64 + ln; *(LAS u32x4*)(st + 16 * (idx + idx / 12)) = w[j]; }
          } else { const bf16* s0 = KN + (size_t)i0 * 64;
#pragma unroll
              for (int j = 0; j < 8; ++j) { const int idx = j * 64 + ln; w[j] = ldg<u32x4>(s0 + idx * 8); }
#pragma unroll
              for (int c = 0; c < 4; ++c) w[8 + c] = ldg<u32x4>(KRP + (size_t)row * 32 + c * 8);
#pragma unroll
              for (int j = 0; j < 8; ++j) { const int idx = j * 64 + ln; *(LAS u32x4*)(st + 16 * idx + 80 * (idx >> 3)) = w[j]; }
          }
          asm volatile("s_waitcnt lgkmcnt(0)" ::: "memory");
          if (isq) {
#pragma unroll
              for (int c = 0; c < 12; ++c) w[c] = *(const LAS u32x4*)(st + ln * 208 + c * 16);
          } else {
#pragma unroll
              for (int c = 0; c < 8; ++c) w[c] = *(const LAS u32x4*)(st + ln * 208 + c * 16);
          }
          float ss = 0.f;
#pragma unroll
          for (int c = 0; c < 12; ++c) { float f[8]; UNPK(w[c], f);
#pragma unroll
              for (int j = 0; j < 8; ++j) ss += f[j] * f[j]; }
          const float rstd = rsqrtf(ss * (1.0f / 96.0f) + RMS_EPS);
          LAS unsigned char* mine = st + ln * 208;
#pragma unroll
          for (int c = 0; c < 8; ++c) { float f[8]; UNPK(w[c], f);
#pragma unroll
              for (int j = 0; j < 8; ++j) f[j] *= rstd * gn[8 * c + j] * osc;
              *(LAS u32x4*)(mine + c * 16) = PK8(f); }
          const float* rp = ROPE + (size_t)(row & 2047) * 32; const bool rope = row < RL;
#pragma unroll
          for (int a = 0; a < 2; ++a) { float x1[8], x2[8]; UNPK(w[8 + 2 * a], x1); UNPK(w[9 + 2 * a], x2);
#pragma unroll
              for (int f = 0; f < 8; ++f) {
                  float cs = 1.0f, sn = 0.0f; if (rope) { const f32x2 t = ldg<f32x2>(rp + (a * 8 + f) * 2); cs = t[0]; sn = t[1]; }
                  const float v1 = x1[f] * rstd * gn[64 + a * 16 + f], v2 = x2[f] * rstd * gn[64 + a * 16 + 8 + f];
                  x1[f] = (v1 * cs - v2 * sn) * osc; x2[f] = (v1 * sn + v2 * cs) * osc; }
              *(LAS u32x4*)(mine + (8 + 2 * a) * 16) = PK8(x1); *(LAS u32x4*)(mine + (9 + 2 * a) * 16) = PK8(x2); }
          asm volatile("s_waitcnt lgkmcnt(0)" ::: "memory");
          int lo = ln; asm volatile("" : "+v"(lo));
#pragma unroll
          for (int j = 0; j < 12; ++j) { const int idx = j * 64 + lo; stg<u32x4>(dst0 + idx * 8, *(const LAS u32x4*)(st + 16 * (idx + idx / 12))); }
          asm volatile("s_waitcnt lgkmcnt(0)" ::: "memory");
      } }
#undef UNPK
#undef PK8
    { int lnv; asm volatile("v_mbcnt_lo_u32_b32 %0, -1, 0\n\tv_mbcnt_hi_u32_b32 %0, -1, %0" : "=v"(lnv));
      const bf16* VV = (const bf16*)(F.ck + C_VV); bf16* VT = (bf16*)(F.ck + C_VT); LAS unsigned* scr = (LAS unsigned*)(F.lds + F.wave * 16384);
      const int gw = F.wave >= 2 ? F.c * 6 + (F.wave - 2) : 0x7fffffff - 1024, NGW = F.G * 6;
      for (int it = gw; it < NB * 8 * 36; it += NGW) { const int kb = it % 36, h = (it / 36) & 7, b = it / 288;
          const int srow = kb < 32 ? b * 2048 + 64 * kb : RL + b * 256 + 64 * (kb - 32);
          vt_item(VV + (size_t)srow * 512 + h * 64, 512, VT + ((size_t)(b * 8 + h) * 64) * KEYS + 64 * kb, scr, lnv); }
      const bf16* NV = (const bf16*)(F.ck + C_NV); bf16* NVT = (bf16*)(F.ck + C_NVT);
      for (int it = gw; it < NB * 8 * 36; it += NGW) { const int kb = it % 36, h = (it / 36) & 7, b = it / 288;
          const int srow = kb < 32 ? b * 2048 + 64 * kb : RL + b * 256 + 64 * (kb - 32);
          vt_item(NV + (size_t)srow * 512 + h * 64, 512, NVT + ((size_t)(b * 8 + h) * 64) * KEYS + 64 * kb, scr, lnv); } }
}


constexpr int AT_KROW = 208, AT_VROW = 136, AT_KB = 64 * AT_KROW, AT_VB = 64 * AT_VROW, AT_SLOT = AT_KB + AT_VB;
__device__ __forceinline__ void mla_unit(Frame& F, const bf16* Qh  , const bf16* KFh  , const bf16* VTh  ,
                                         bf16* Oh  , int b, int kt0, int kt1, const float* gq  , const float* rope0  ) {
    int lane; asm volatile("v_mbcnt_lo_u32_b32 %0, -1, 0\n\tv_mbcnt_hi_u32_b32 %0, -1, %0" : "=v"(lane));
    LAS unsigned char* lds = F.lds; const int w = F.wave, tid = lane + 64 * w, r32 = lane & 31, hh = lane >> 5;
    const int kr0 = tid / 12, kc0 = tid % 12, kr1 = (tid + 512) / 12, kc1 = (tid + 512) % 12, vd = tid >> 3, vc = tid & 7;
    u32x4 sk0, sk1, sv;
#define AT_KROWIDX(kt) ((kt) < 32 ? b * 2048 + 64 * (kt) : RL + b * 256 + 64 * ((kt) - 32))
#define AT_LOAD(kt) do { const int kr_ = AT_KROWIDX(kt); sk0 = ldg<u32x4>(KFh + (size_t)(kr_ + kr0) * 768 + kc0 * 8); if (tid < 256) sk1 = ldg<u32x4>(KFh + (size_t)(kr_ + kr1) * 768 + kc1 * 8); \
        sv = ldg<u32x4>(VTh + (size_t)vd * KEYS + 64 * (kt) + vc * 8); } while (0)
#define AT_WRITE(slot) do { LAS unsigned char* s_ = lds + (slot) * AT_SLOT; *(LAS u32x4*)(s_ + kr0 * AT_KROW + kc0 * 16) = sk0; if (tid < 256) *(LAS u32x4*)(s_ + kr1 * AT_KROW + kc1 * 16) = sk1; \
        *(LAS u32x2*)(s_ + AT_KB + vd * AT_VROW + vc * 16) = (u32x2){sv.x, sv.y}; *(LAS u32x2*)(s_ + AT_KB + vd * AT_VROW + vc * 16 + 8) = (u32x2){sv.z, sv.w}; } while (0)
    bf16x8 qf[6];
    { u32x4 raw[6];
#pragma unroll
      for (int ks = 0; ks < 6; ++ks) raw[ks] = ldg<u32x4>(Qh + (size_t)(32 * w + r32) * 768 + 16 * ks + 8 * hh);
#define AT_UNPK(W, FA) do { FA[0] = bflo(W.x); FA[1] = bfhi(W.x); FA[2] = bflo(W.y); FA[3] = bfhi(W.y); FA[4] = bflo(W.z); FA[5] = bfhi(W.z); FA[6] = bflo(W.w); FA[7] = bfhi(W.w); } while (0)
#define AT_PK8(FA) __builtin_bit_cast(bf16x8, (u32x4){pk2(FA[0], FA[1]), pk2(FA[2], FA[3]), pk2(FA[4], FA[5]), pk2(FA[6], FA[7])})
      float ss = 0.f;
#pragma unroll
      for (int ks = 0; ks < 6; ++ks) { float f[8]; AT_UNPK(raw[ks], f);
#pragma unroll
          for (int j = 0; j < 8; ++j) ss += f[j] * f[j]; }
      ss = hx32(ss, ss);
      const float rq = rsqrtf(ss * (1.0f / 96.0f) + RMS_EPS) * (0.10206207261596575f * LOG2E);
#pragma unroll
      for (int ks = 0; ks < 4; ++ks) { float f[8]; AT_UNPK(raw[ks], f); const f32x4 g0 = ldg<f32x4>(gq + 16 * ks + 8 * hh), g1 = ldg<f32x4>(gq + 16 * ks + 8 * hh + 4);
#pragma unroll
          for (int j = 0; j < 4; ++j) { f[j] *= rq * g0[j]; f[4 + j] *= rq * g1[j]; }
          qf[ks] = AT_PK8(f); }
#pragma unroll
      for (int a = 0; a < 2; ++a) { float f[8]; AT_UNPK(raw[4 + a], f); const f32x4 g0 = ldg<f32x4>(gq + 64 + 16 * a + 8 * hh), g1 = ldg<f32x4>(gq + 64 + 16 * a + 8 * hh + 4);
#pragma unroll
          for (int j = 0; j < 4; ++j) { f[j] *= rq * g0[j]; f[4 + j] *= rq * g1[j]; }
          if (rope0) { const float* rp = rope0 + (size_t)(32 * w + r32) * 32 + a * 16;
#pragma unroll
              for (int j4 = 0; j4 < 4; ++j4) { const f32x4 cs = ldg<f32x4>(rp + 4 * j4);
#pragma unroll
                  for (int e = 0; e < 2; ++e) { const int j = 2 * j4 + e; float pa = f[j], pb = f[j];
                      asm volatile("s_nop 1\n\tv_permlane32_swap_b32 %0, %1" : "+v"(pa), "+v"(pb));
                      const float pv = hh ? pa : pb;
                      f[j] = f[j] * cs[2 * e] + (hh ? pv : -pv) * cs[2 * e + 1]; } } }
          qf[4 + a] = AT_PK8(f); }
#undef AT_UNPK
#undef AT_PK8
    }
    f32x16 o0, o1;
#pragma unroll
    for (int r = 0; r < 16; ++r) { o0[r] = 0.f; o1[r] = 0.f; }
    float mrun = 0.f, lrun = 0.f;
    __syncthreads();
    AT_LOAD(kt0); AT_WRITE(0);
    __syncthreads();
    asm volatile(".rept " STR(MLA_PAD_N) "\n\ts_nop 0\n\t.endr" ::: "memory");
    for (int kt = kt0; kt < kt1; ++kt) {
        const int slot = (kt - kt0) & 1;
        if (kt + 1 < kt1) AT_LOAD(kt + 1);
        const LAS unsigned char* ks_ = lds + slot * AT_SLOT; const LAS unsigned char* vs_ = ks_ + AT_KB;
        f32x16 s0, s1;
        bf16x8 kf[12];
#pragma unroll
        for (int ks = 0; ks < 6; ++ks) { kf[2 * ks] = *(const LAS bf16x8*)(ks_ + r32 * AT_KROW + (16 * ks + 8 * hh) * 2); kf[2 * ks + 1] = *(const LAS bf16x8*)(ks_ + (32 + r32) * AT_KROW + (16 * ks + 8 * hh) * 2); }
        __builtin_amdgcn_sched_barrier(0);
#pragma unroll
        for (int ks = 0; ks < 6; ++ks) {
            if (ks == 0) { const f32x16 z16 = {}; s0 = __builtin_amdgcn_mfma_f32_32x32x16_bf16(kf[0], qf[0], z16, 0, 0, 0); s1 = __builtin_amdgcn_mfma_f32_32x32x16_bf16(kf[1], qf[0], z16, 0, 0, 0); }
            else { s0 = __builtin_amdgcn_mfma_f32_32x32x16_bf16(kf[2 * ks], qf[ks], s0, 0, 0, 0); s1 = __builtin_amdgcn_mfma_f32_32x32x16_bf16(kf[2 * ks + 1], qf[ks], s1, 0, 0, 0); }
        }
        u32x2 vfa[4][2], vfc[4][2];
#pragma unroll
        for (int kh = 0; kh < 2; ++kh)
#pragma unroll
            for (int s = 0; s < 2; ++s) { const int kk = 32 * kh + 16 * s + 4 * hh;
#pragma unroll
                for (int dt = 0; dt < 2; ++dt) { vfa[kh * 2 + s][dt] = *(const LAS u32x2*)(vs_ + (32 * dt + r32) * AT_VROW + kk * 2); vfc[kh * 2 + s][dt] = *(const LAS u32x2*)(vs_ + (32 * dt + r32) * AT_VROW + (kk + 8) * 2); } }
        __builtin_amdgcn_sched_barrier(0);
        { const f32x2 m2 = {mrun, mrun};
#pragma unroll
          for (int r = 0; r < 16; r += 2) { const f32x2 a = (f32x2){s0[r], s0[r + 1]} - m2, c = (f32x2){s1[r], s1[r + 1]} - m2; s0[r] = a[0]; s0[r + 1] = a[1]; s1[r] = c[0]; s1[r + 1] = c[1]; } }
        float ma = fmaxf(fmaxf(s0[0], s0[1]), s0[2]), mb = fmaxf(fmaxf(s1[0], s1[1]), s1[2]);
#pragma unroll
        for (int r = 3; r < 15; r += 2) { ma = fmaxf(fmaxf(ma, s0[r]), s0[r + 1]); mb = fmaxf(fmaxf(mb, s1[r]), s1[r + 1]); }
        float mx = fmaxf(fmaxf(ma, mb), fmaxf(s0[15], s1[15]));
        mx = shx_max<32>(mx);
        if (kt == kt0 || __any(mx > 8.0f)) {
            const float d = kt == kt0 ? mx : fmaxf(mx, 0.0f), alpha = fast_exp2(-d); mrun += d; lrun *= alpha;
#pragma unroll
            for (int r = 0; r < 16; ++r) { o0[r] *= alpha; o1[r] *= alpha; s0[r] -= d; s1[r] -= d; }
        }
        f32x2 rs2 = {0.f, 0.f};
#pragma unroll
        for (int r = 0; r < 16; ++r) { s0[r] = fast_exp2(s0[r]); s1[r] = fast_exp2(s1[r]); }
#pragma unroll
        for (int r = 0; r < 16; r += 2) { rs2 += (f32x2){s0[r], s0[r + 1]}; rs2 += (f32x2){s1[r], s1[r + 1]}; }
        lrun += rs2[0] + rs2[1];
#pragma unroll
        for (int kh = 0; kh < 2; ++kh)
#pragma unroll
            for (int s = 0; s < 2; ++s) {
                u32x4 pw;
                if (kh == 0) { pw.x = pg8::cvt_pk_bf16(s0[8 * s], s0[8 * s + 1]); pw.y = pg8::cvt_pk_bf16(s0[8 * s + 2], s0[8 * s + 3]); pw.z = pg8::cvt_pk_bf16(s0[8 * s + 4], s0[8 * s + 5]); pw.w = pg8::cvt_pk_bf16(s0[8 * s + 6], s0[8 * s + 7]); }
                else { pw.x = pg8::cvt_pk_bf16(s1[8 * s], s1[8 * s + 1]); pw.y = pg8::cvt_pk_bf16(s1[8 * s + 2], s1[8 * s + 3]); pw.z = pg8::cvt_pk_bf16(s1[8 * s + 4], s1[8 * s + 5]); pw.w = pg8::cvt_pk_bf16(s1[8 * s + 6], s1[8 * s + 7]); }
                const bf16x8 pb = __builtin_bit_cast(bf16x8, pw);
                {   const u32x2 a = vfa[kh * 2 + s][0], c = vfc[kh * 2 + s][0];
                    const bf16x8 vf = __builtin_bit_cast(bf16x8, (u32x4){a.x, a.y, c.x, c.y});
                    o0 = __builtin_amdgcn_mfma_f32_32x32x16_bf16(vf, pb, o0, 0, 0, 0); }
                {   const u32x2 a = vfa[kh * 2 + s][1], c = vfc[kh * 2 + s][1];
                    const bf16x8 vf = __builtin_bit_cast(bf16x8, (u32x4){a.x, a.y, c.x, c.y});
                    o1 = __builtin_amdgcn_mfma_f32_32x32x16_bf16(vf, pb, o1, 0, 0, 0); }
            }
        if (kt + 1 < kt1) AT_WRITE(slot ^ 1);
        __syncthreads();
    }
    const float ltot = shx_sum<32>(lrun), inv = 1.0f / ltot;
    bf16* orow = Oh + (size_t)(32 * w + r32) * 512;
#pragma unroll
    for (int g4 = 0; g4 < 4; ++g4) {
        stg<u32x2>(orow + 8 * g4 + 4 * hh, (u32x2){pk2(o0[4 * g4] * inv, o0[4 * g4 + 1] * inv), pk2(o0[4 * g4 + 2] * inv, o0[4 * g4 + 3] * inv)});
        stg<u32x2>(orow + 32 + 8 * g4 + 4 * hh, (u32x2){pk2(o1[4 * g4] * inv, o1[4 * g4 + 1] * inv), pk2(o1[4 * g4 + 2] * inv, o1[4 * g4 + 3] * inv)});
    }
#undef AT_KROWIDX
#undef AT_LOAD
#undef AT_WRITE
}
__device__ __forceinline__ void phase_mla(Frame& F, int l, bool ctx_q, bf16* OAc  ) {
    const float* gq = F.in[12] + l * 96; const float* ROPE = (const float*)(F.ws + WS_ROPE);
    const bf16* QF = (const bf16*)(F.ck + C_QR);        const bf16* KF = (const bf16*)(F.ck + C_KF); const bf16* VT = (const bf16*)(F.ck + C_VT); bf16* OA = (bf16*)(F.ck + C_OA);
    const int nlat = NB * 8 * 8, ntot = nlat + (ctx_q ? NB * 8 : 0);
    for (int u0 = F.c; u0 < ntot; u0 += F.G) {
        int u = u0;
        if (F.G == 256 && u0 < nlat) { const int x = u0 & 7, slot = ((u0 & 255) >> 3) + 32 * (u0 >> 8); u = ((x * 8 + (slot >> 3)) << 3) | (slot & 7); }
        if (u < nlat) { const int b = u >> 6, h = (u >> 3) & 7, qb = u & 7; const int row0 = b * 2048 + qb * 256;
            mla_unit(F, QF + (size_t)row0 * 768 + h * 96, KF + h * 96, VT + ((size_t)(b * 8 + h) * 64) * KEYS, OA + (size_t)row0 * 512 + h * 64, b, 0, 36, gq, ROPE + (size_t)(qb * 256) * 32); }
        else { const int v = u - nlat, b = v >> 3, h = v & 7; const int row0 = RL + b * 256;
            mla_unit(F, QF + (size_t)row0 * 768 + h * 96, KF + h * 96, VT + ((size_t)(b * 8 + h) * 64) * KEYS, OAc + (size_t)(b * 256) * 512 + h * 64, b, 32, 36, gq, nullptr); }
    }
    __syncthreads();
}

struct NatOps { bf16x8 k[2][2]; u32x2 v[4][2]; };
__device__ __forceinline__ void nat_load(NatOps& o, const bf16* Kp  , const bf16* VTp  , int g) {
#pragma unroll
    for (int sub = 0; sub < 2; ++sub) { o.k[sub][0] = ldg<bf16x8>(Kp + (size_t)sub * 16 * 512 + 8 * g); o.k[sub][1] = ldg<bf16x8>(Kp + (size_t)sub * 16 * 512 + 32 + 8 * g); }
#pragma unroll
    for (int dt = 0; dt < 4; ++dt) { o.v[dt][0] = ldg<u32x2>(VTp + (size_t)dt * 16 * KEYS); o.v[dt][1] = ldg<u32x2>(VTp + (size_t)dt * 16 * KEYS + 16); }
}
__device__ __forceinline__ void nat_compute(const NatOps& ops, const bf16x8 (&qf)[2], f32x4 (&o)[4], float& mrun, float& lrun, const float (&bias)[2][4], const bool (&valid)[2][4], bool masked) {
    f32x4 s[2];
#pragma unroll
    for (int sub = 0; sub < 2; ++sub) {
        s[sub] = (f32x4){0.f, 0.f, 0.f, 0.f};
        s[sub] = __builtin_amdgcn_mfma_f32_16x16x32_bf16(ops.k[sub][0], qf[0], s[sub], 0, 0, 0);
        s[sub] = __builtin_amdgcn_mfma_f32_16x16x32_bf16(ops.k[sub][1], qf[1], s[sub], 0, 0, 0);
    }
    if (masked) {
#pragma unroll
        for (int sub = 0; sub < 2; ++sub)
#pragma unroll
            for (int r = 0; r < 4; ++r) s[sub][r] = valid[sub][r] ? s[sub][r] + bias[sub][r] : -1e30f;
    }
    float mx = fmaxf(fmaxf(fmaxf(s[0][0], s[0][1]), fmaxf(s[0][2], s[0][3])), fmaxf(fmaxf(s[1][0], s[1][1]), fmaxf(s[1][2], s[1][3])));
    mx = shx_max<16>(mx); mx = shx_max<32>(mx);
    const float mn = fmaxf(mrun, mx), alpha = fast_exp2(mrun - mn); mrun = mn;
    float rs = 0.f;
#pragma unroll
    for (int sub = 0; sub < 2; ++sub)
#pragma unroll
        for (int r = 0; r < 4; ++r) { s[sub][r] = fast_exp2(s[sub][r] - mn); rs += s[sub][r]; }
    lrun = lrun * alpha + rs;
    u32x4 pw; pw.x = pg8::cvt_pk_bf16(s[0][0], s[0][1]); pw.y = pg8::cvt_pk_bf16(s[0][2], s[0][3]); pw.z = pg8::cvt_pk_bf16(s[1][0], s[1][1]); pw.w = pg8::cvt_pk_bf16(s[1][2], s[1][3]);
    const bf16x8 pb = __builtin_bit_cast(bf16x8, pw);
#pragma unroll
    for (int dt = 0; dt < 4; ++dt) {
        const bf16x8 vf = __builtin_bit_cast(bf16x8, (u32x4){ops.v[dt][0].x, ops.v[dt][0].y, ops.v[dt][1].x, ops.v[dt][1].y});
        o[dt] = o[dt] * alpha;
        o[dt] = __builtin_amdgcn_mfma_f32_16x16x32_bf16(vf, pb, o[dt], 0, 0, 0);
    }
}
constexpr int NL_KS = 144, NL_CVS = 528;
constexpr int NL_CK = 0, NL_CV = 256 * NL_KS, NL_SLOT0 = NL_CV + 64 * NL_CVS, NL_SLOTB = 2 * 64 * NL_KS, NL_RPB = NL_SLOT0 + 2 * NL_SLOTB;
__device__ __forceinline__ void nat_lds_ops(NatOps& o, const LAS unsigned char* Kt  , const LAS unsigned char* Vt  , int vstride, int qi, int g) {
#pragma unroll
    for (int sub = 0; sub < 2; ++sub) { o.k[sub][0] = *(const LAS bf16x8*)(Kt + (16 * sub + qi) * NL_KS + 16 * g); o.k[sub][1] = *(const LAS bf16x8*)(Kt + (16 * sub + qi) * NL_KS + 64 + 16 * g); }
#pragma unroll
    for (int dt = 0; dt < 4; ++dt) { o.v[dt][0] = *(const LAS u32x2*)(Vt + (16 * dt + qi) * vstride + 8 * g); o.v[dt][1] = *(const LAS u32x2*)(Vt + (16 * dt + qi) * vstride + 32 + 8 * g); }
}
__device__ __forceinline__ void nat_unit(Frame& F, const bf16* NQ, const bf16* NK, const bf16* NVT, bf16* OB, bf16* OBc, const float* rpb_h  , int b, int h, int q, bool ctx_q) {
    LAS unsigned char* lds = F.lds; const int tid = F.tid, lane = F.lane, w = F.wave, qi = lane & 15, g = lane >> 4, j = w & 3;
    LAS float* RPB = (LAS float*)(lds + NL_RPB);
    const bf16* VTb = NVT + (size_t)(b * 8 + h) * 64 * KEYS;
    __syncthreads();
    { u32x4 ck[4], cv[4];
#pragma unroll
      for (int k = 0; k < 4; ++k) { const int idx = tid + 512 * k; ck[k] = ldg<u32x4>(NK + (size_t)(RL + b * 256 + (idx >> 3)) * 512 + h * 64 + (idx & 7) * 8); cv[k] = ldg<u32x4>(VTb + (size_t)(idx >> 5) * KEYS + 2048 + (idx & 31) * 8); }
#pragma unroll
      for (int k = 0; k < 4; ++k) { const int idx = tid + 512 * k; *(LAS u32x4*)(lds + NL_CK + (idx >> 3) * NL_KS + (idx & 7) * 16) = ck[k]; *(LAS u32x4*)(lds + NL_CV + (idx >> 5) * NL_CVS + (idx & 31) * 16) = cv[k]; }
      if (tid < 15 * 31) RPB[tid] = ldg<float>(rpb_h + tid) * LOG2E; }
    bf16x8 qf[4][2]; f32x4 o[4][4]; float mrun[4], lrun[4]; int rs_[4];
#pragma unroll
    for (int i = 0; i < 4; ++i) { const int row = 8 * q + (w >> 2) + 2 * i; rs_[i] = min(max(row - 4, 0), 24);
        const bf16* qp = NQ + (size_t)(b * 2048 + row * 64 + 16 * j + qi) * 512 + h * 64;
        qf[i][0] = ldg<bf16x8>(qp + 8 * g); qf[i][1] = ldg<bf16x8>(qp + 32 + 8 * g); mrun[i] = -1e30f; lrun[i] = 0.f;
#pragma unroll
        for (int dt = 0; dt < 4; ++dt) o[i][dt] = (f32x4){0.f, 0.f, 0.f, 0.f}; }
    const int bs = min(max(16 * j - 8, 0), 32), qc = 16 * j + qi, cs = min(max(qc - 8, 0), 48);
    bool valid[2][4]; int dcl[2][4];
#pragma unroll
    for (int sub = 0; sub < 2; ++sub)
#pragma unroll
        for (int rg = 0; rg < 4; ++rg) { const int kc = bs + 16 * sub + 4 * g + rg; valid[sub][rg] = (unsigned)(kc - cs) < 16u; dcl[sub][rg] = min(max(kc - qc + 15, 0), 30); }
    const int kr_lo = min(max(8 * q - 4, 0), 24), kr_hi = min(max(8 * q + 3, 0), 24) + 7, nkr = kr_hi - kr_lo + 1;
    const int tk = tid >> 3, tc = tid & 7;
    u32x4 sk, sv;
#define NL_LOAD(kr) do { sk = ldg<u32x4>(NK + (size_t)(b * 2048 + (kr) * 64 + tk) * 512 + h * 64 + tc * 8); sv = ldg<u32x4>(VTb + (size_t)tk * KEYS + (kr) * 64 + tc * 8); } while (0)
#define NL_WRITE(slot) do { *(LAS u32x4*)(lds + NL_SLOT0 + (slot) * NL_SLOTB + tk * NL_KS + tc * 16) = sk; *(LAS u32x4*)(lds + NL_SLOT0 + (slot) * NL_SLOTB + 64 * NL_KS + tk * NL_KS + tc * 16) = sv; } while (0)
    NL_LOAD(kr_lo); NL_WRITE(0);
    __syncthreads();
    for (int t = 0; t < nkr; ++t) {
        const int kr = kr_lo + t, slot = t & 1;
        if (t + 1 < nkr) NL_LOAD(kr + 1);
        const LAS unsigned char* Kt = lds + NL_SLOT0 + slot * NL_SLOTB + bs * NL_KS; const LAS unsigned char* Vt = Kt - bs * NL_KS + 64 * NL_KS + bs * 2;
        if (kr >= rs_[0] && kr < rs_[3] + 8) {
            NatOps ops; nat_lds_ops(ops, Kt, Vt, NL_KS, qi, g);
#pragma unroll
            for (int i = 0; i < 4; ++i) {
                if (kr >= rs_[i] && kr < rs_[i] + 8) {
                    const int drow = kr - (8 * q + (w >> 2) + 2 * i) + 7;
                    float bias[2][4];
#pragma unroll
                    for (int sub = 0; sub < 2; ++sub)
#pragma unroll
                        for (int rg = 0; rg < 4; ++rg) bias[sub][rg] = RPB[drow * 31 + dcl[sub][rg]];
                    nat_compute(ops, qf[i], o[i], mrun[i], lrun[i], bias, valid, true);
                }
            }
        }
        if (t + 1 < nkr) NL_WRITE(slot ^ 1);
        __syncthreads();
    }
#undef NL_LOAD
#undef NL_WRITE
    { float bias[2][4];
#pragma unroll
      for (int sub = 0; sub < 2; ++sub)
#pragma unroll
          for (int rg = 0; rg < 4; ++rg) bias[sub][rg] = 0.f;
      for (int cb = 0; cb < 8; ++cb) {
          NatOps ops; nat_lds_ops(ops, lds + NL_CK + 32 * cb * NL_KS, lds + NL_CV + 64 * cb, NL_CVS, qi, g);
#pragma unroll
          for (int i = 0; i < 4; ++i) nat_compute(ops, qf[i], o[i], mrun[i], lrun[i], bias, valid, false);
      }
#pragma unroll
      for (int i = 0; i < 4; ++i) { const int row = 8 * q + (w >> 2) + 2 * i; const size_t qrow = (size_t)(b * 2048 + row * 64 + 16 * j + qi);
          float lt = shx_sum<32>(shx_sum<16>(lrun[i])); const float inv = 1.0f / lt;
#pragma unroll
          for (int dt = 0; dt < 4; ++dt) stg<u32x2>(OB + qrow * 512 + h * 64 + 16 * dt + 4 * g, (u32x2){pk2(o[i][dt][0] * inv, o[i][dt][1] * inv), pk2(o[i][dt][2] * inv, o[i][dt][3] * inv)}); }
      if (ctx_q && w < 4) {
          const size_t qrow = (size_t)(RL + b * 256 + 16 * (4 * q + w) + qi); const bf16* qp = NQ + qrow * 512 + h * 64;
          bf16x8 cq[2]; cq[0] = ldg<bf16x8>(qp + 8 * g); cq[1] = ldg<bf16x8>(qp + 32 + 8 * g);
          f32x4 co[4]; float cm = -1e30f, cl = 0.f;
#pragma unroll
          for (int dt = 0; dt < 4; ++dt) co[dt] = (f32x4){0.f, 0.f, 0.f, 0.f};
          for (int cb = 0; cb < 8; ++cb) { NatOps ops; nat_lds_ops(ops, lds + NL_CK + 32 * cb * NL_KS, lds + NL_CV + 64 * cb, NL_CVS, qi, g); nat_compute(ops, cq, co, cm, cl, bias, valid, false); }
          float lt = shx_sum<32>(shx_sum<16>(cl)); const float inv = 1.0f / lt;
#pragma unroll
          for (int dt = 0; dt < 4; ++dt) stg<u32x2>(OBc + (qrow - RL) * 512 + h * 64 + 16 * dt + 4 * g, (u32x2){pk2(co[dt][0] * inv, co[dt][1] * inv), pk2(co[dt][2] * inv, co[dt][3] * inv)});
      } }
}
__device__ __forceinline__ void phase_nat(Frame& F, int l, bool ctx_q, bf16* OBc) {
    const bf16* NQ = (const bf16*)(F.ck + C_NQ); const bf16* NK = (const bf16*)(F.ck + C_NK); const bf16* NVT = (const bf16*)(F.ck + C_NVT); bf16* OB = (bf16*)(F.ck + C_OB);
    for (int u0 = F.c; u0 < NB * 32; u0 += F.G) { int u = u0; if (F.G == 256) { const int x = u0 & 7, j = u0 >> 3; u = ((x * 8 + (j >> 2)) << 2) | (j & 3); }
        const int b = u >> 5, h = (u >> 2) & 7, q = u & 3;
        nat_unit(F, NQ, NK, NVT, OB, OBc, F.in[16] + ((size_t)l * 8 + h) * 15 * 31, b, h, q, ctx_q); }
    __syncthreads();
}

__device__ __forceinline__ void phase_router(Frame& F, int l, int ntok, int cnt_off = 0) {
    bf16* H2 = (bf16*)(F.ck + M_H2); int* ROWTOK = (int*)(F.ck + M_ROWTOK); i32x4* TOKE = (i32x4*)(F.ck + M_TOKE); f32x2* TOKW = (f32x2*)(F.ck + M_TOKW);
    unsigned* cnt = (unsigned*)(F.ws + WS_CTL) + CW_CNT + l * 64 + cnt_off;
    const float* g2 = F.in[28] + l * 1024; const float* WGT = (const float*)(F.ws + WS_WGT) + (size_t)l * 4 * 1024; const float* WET = (const float*)(F.ws + WS_WET) + (size_t)l * 32 * 1024;
    const float* bg = F.in[30] + l * 4; const float* be = F.in[32] + l * 32;
    for (int i = F.c * 512 + F.tid; i < MOE_ROWS; i += F.G * 512) ROWTOK[i] = -1;
    LAS float* WEL = (LAS float*)F.lds;
    LAS unsigned* LCNT = (LAS unsigned*)(F.lds + 131072);
    __syncthreads();
    for (int i = F.tid; i < 32 * 1024 / 4; i += 512) *(LAS f32x4*)(WEL + 4 * i) = ldg<f32x4>(WET + 4 * i);
    if (F.tid < 64) LCNT[F.tid] = 0u;
    __syncthreads();
    const int gw = F.c * 8 + F.wave, NGW = F.G * 8, lane = F.lane;
    for (int tok0 = gw * 4; tok0 < ntok; tok0 += NGW * 4) {
        const float* xs; int mrow;
        if (tok0 < NTOK_LAT) { xs = F.out + (size_t)tok0 * 1024; mrow = tok0 >> 11; } else { xs = F.XC + (size_t)(tok0 - NTOK_LAT) * 1024; mrow = 32; }
        const float* md = F.MOD + ((size_t)l * 33 + mrow) * 6144;
        f32x4 v[4][4]; float ss[4];
#pragma unroll
        for (int t = 0; t < 4; ++t) { ss[t] = 0.f;
#pragma unroll
            for (int j = 0; j < 4; ++j) { v[t][j] = ldg<f32x4>(xs + (size_t)t * 1024 + 4 * lane + 256 * j); ss[t] += v[t][j][0] * v[t][j][0] + v[t][j][1] * v[t][j][1] + v[t][j][2] * v[t][j][2] + v[t][j][3] * v[t][j][3]; } }
        float rstd[4];
        { const float rs_own = rsqrtf(red4(ss[0], ss[1], ss[2], ss[3]) * (1.0f / 1024.0f) + RMS_EPS);
#pragma unroll
          for (int t = 0; t < 4; ++t) rstd[t] = lane_bcast(rs_own, 16 * t); }
#pragma unroll
        for (int j = 0; j < 4; ++j) { const int col = 4 * lane + 256 * j;
            const f32x4 g = ldg<f32x4>(g2 + col), sh = ldg<f32x4>(md + 3 * 1024 + col), sc = ldg<f32x4>(md + 4 * 1024 + col) + 1.0f;
#pragma unroll
            for (int t = 0; t < 4; ++t) { v[t][j] = (v[t][j] * rstd[t] * g) * sc + sh;
                stg<u32x2>(H2 + (size_t)(tok0 + t) * 1024 + col, (u32x2){pk2(v[t][j][0], v[t][j][1]), pk2(v[t][j][2], v[t][j][3])}); } }
        float glo[4];
#pragma unroll
        for (int e = 0; e < 4; ++e) { float p[4] = {0.f, 0.f, 0.f, 0.f};
#pragma unroll
            for (int j = 0; j < 4; ++j) { const f32x4 w = ldg<f32x4>(WGT + e * 1024 + 4 * lane + 256 * j);
#pragma unroll
                for (int t = 0; t < 4; ++t) p[t] += v[t][j][0] * w[0] + v[t][j][1] * w[1] + v[t][j][2] * w[2] + v[t][j][3] * w[3]; }
            glo[e] = red4(p[0], p[1], p[2], p[3]) + bg[e]; }
        int gi = 0; float gm = glo[0];
#pragma unroll
        for (int e = 1; e < 4; ++e) if (glo[e] > gm) { gm = glo[e]; gi = e; }
        float gs = 0.f;
#pragma unroll
        for (int e = 0; e < 4; ++e) gs += __expf(glo[e] - gm);
        const float pgrp = 1.0f / gs;
        int grp[4];
#pragma unroll
        for (int t = 0; t < 4; ++t) grp[t] = __builtin_amdgcn_readlane(gi, 16 * t);
        float elo[8];
#pragma unroll
        for (int eh = 0; eh < 2; ++eh) {
            float p[4][4];
#pragma unroll
            for (int t = 0; t < 4; ++t)
#pragma unroll
                for (int e = 0; e < 4; ++e) { float q = 0.f; const LAS float* wr = WEL + (grp[t] * 8 + eh * 4 + e) * 1024;
#pragma unroll
                    for (int j = 0; j < 4; ++j) { const f32x4 w = *(const LAS f32x4*)(wr + 4 * lane + 256 * j); q += v[t][j][0] * w[0] + v[t][j][1] * w[1] + v[t][j][2] * w[2] + v[t][j][3] * w[3]; }
                    p[t][e] = q; }
#pragma unroll
            for (int e = 0; e < 4; ++e) elo[eh * 4 + e] = red4(p[0][e], p[1][e], p[2][e], p[3][e]);
            __builtin_amdgcn_sched_barrier(0);
        }
#pragma unroll
        for (int e = 0; e < 8; ++e) elo[e] += ldg<float>(be + gi * 8 + e);
        int i1 = 0; float v1 = elo[0];
#pragma unroll
        for (int e = 1; e < 8; ++e) if (elo[e] > v1) { v1 = elo[e]; i1 = e; }
        int i2 = -1; float v2 = -3.0e38f;
#pragma unroll
        for (int e = 0; e < 8; ++e) if (e != i1 && elo[e] > v2) { v2 = elo[e]; i2 = e; }
        const float ex = __expf(v2 - v1), mw1 = pgrp / (1.0f + ex), mw2 = pgrp * ex / (1.0f + ex);
        const int me1 = gi * 8 + i1, me2 = gi * 8 + i2;
        if ((lane & 15) == 0) {
            const int s1 = (int)__hip_atomic_fetch_add(LCNT + me1, 1u, __ATOMIC_RELAXED, __HIP_MEMORY_SCOPE_WORKGROUP), s2 = (int)__hip_atomic_fetch_add(LCNT + 32 + me2, 1u, __ATOMIC_RELAXED, __HIP_MEMORY_SCOPE_WORKGROUP);
            TOKE[tok0 + (lane >> 4)] = (i32x4){me1, s1, me2, s2}; TOKW[tok0 + (lane >> 4)] = (f32x2){mw1, mw2};
        }
    }
    __syncthreads();
    if (F.tid < 64) { const unsigned n = LCNT[F.tid]; const unsigned base = n ? atomicAdd(cnt + F.tid, n) : 0u; ((unsigned*)(F.ck + M_WGBASE))[(size_t)F.c * 64 + F.tid] = base; }
    __syncthreads();
}
__device__ __forceinline__ void phase_assign(Frame& F, int l, int ntok) {
    LAS int* T = (LAS int*)(F.lds + LDS_TAB);
    moe_tables((unsigned*)(F.ws + WS_CTL) + CW_CNT + l * 64, T, F.tid);
    int* ROWTOK = (int*)(F.ck + M_ROWTOK); float* ROWW = (float*)(F.ck + M_ROWW); const i32x4* TOKE = (const i32x4*)(F.ck + M_TOKE); const f32x2* TOKW = (const f32x2*)(F.ck + M_TOKW);
    for (int tok = F.c * 512 + F.tid; tok < ntok; tok += F.G * 512) {
        const i32x4 e = TOKE[tok]; const f32x2 w = TOKW[tok];
        const int wg = ((tok >> 2) % (F.G * 8)) >> 3;
        const unsigned* wb = (const unsigned*)(F.ck + M_WGBASE) + (size_t)wg * 64;
        const int r1 = T[2 + e.x] + (int)wb[e.x] + e.y, r2 = T[2 + 32 + e.z] + (int)wb[32 + e.z] + e.w;
        ROWTOK[r1] = tok; ROWW[r1] = w.x; ROWTOK[r2] = tok; ROWW[r2] = w.y;
    }
}

template <bool WITH_H>
__device__ __forceinline__ void phase_comb(Frame& F, int l, int ntok) {
    const bf16* Y = (const bf16*)(F.ck + M_Y); bf16* HBA = (bf16*)(F.ws + WS_HBALL);
    const float* g1n = F.in[6] + (l + 1 < DEPTH ? (l + 1) : l) * 1024;
    const int gw = F.c * 8 + F.wave, NGW = F.G * 8, lane = F.lane;
    for (int tok0 = gw * 4; tok0 < ntok; tok0 += NGW * 4) {
        float* xs; int mrow;
        if (tok0 < NTOK_LAT) { xs = F.out + (size_t)tok0 * 1024; mrow = tok0 >> 11; } else { xs = F.XC + (size_t)(tok0 - NTOK_LAT) * 1024; mrow = 32; }
        const float* gt2 = F.MOD + ((size_t)l * 33 + mrow) * 6144 + 5 * 1024;
        f32x4 v[4][4]; u32x2 y0[4][4], y1[4][4];
        f32x4 gv[4];
#pragma unroll
        for (int j = 0; j < 4; ++j) gv[j] = ldg<f32x4>(gt2 + 4 * lane + 256 * j);
#pragma unroll
        for (int t = 0; t < 4; ++t)
#pragma unroll
            for (int j = 0; j < 4; ++j) { const size_t o = (size_t)(tok0 + t) * 1024 + 4 * lane + 256 * j;
                v[t][j] = ldg<f32x4>(xs + (size_t)t * 1024 + 4 * lane + 256 * j); y0[t][j] = ldg<u32x2>(Y + o); y1[t][j] = ldg<u32x2>(Y + (size_t)NTOK * 1024 + o); }
        float ss[4];
#pragma unroll
        for (int t = 0; t < 4; ++t) { ss[t] = 0.f;
#pragma unroll
            for (int j = 0; j < 4; ++j) {
                f32x4 ysum; ysum[0] = bflo(y0[t][j].x) + bflo(y1[t][j].x); ysum[1] = bfhi(y0[t][j].x) + bfhi(y1[t][j].x); ysum[2] = bflo(y0[t][j].y) + bflo(y1[t][j].y); ysum[3] = bfhi(y0[t][j].y) + bfhi(y1[t][j].y);
                v[t][j] = v[t][j] + gv[j] * ysum;
                stg<f32x4>(xs + (size_t)t * 1024 + 4 * lane + 256 * j, v[t][j]);
                ss[t] += v[t][j][0] * v[t][j][0] + v[t][j][1] * v[t][j][1] + v[t][j][2] * v[t][j][2] + v[t][j][3] * v[t][j][3]; } }
        if constexpr (WITH_H) {
            const float* md = F.MOD + ((size_t)(l + 1) * 33 + mrow) * 6144;
#pragma unroll
            for (int t = 0; t < 4; ++t) ss[t] = rsqrtf(wave_sum(ss[t]) * (1.0f / 1024.0f) + RMS_EPS);
#pragma unroll
            for (int j = 0; j < 4; ++j) { const int col = 4 * lane + 256 * j;
                const f32x4 gg = ldg<f32x4>(g1n + col), sh = ldg<f32x4>(md + col), sc = ldg<f32x4>(md + 1024 + col) + 1.0f;
#pragma unroll
                for (int t = 0; t < 4; ++t) { const f32x4 h = (v[t][j] * ss[t] * gg) * sc + sh;
                    stg<u32x2>(HBA + (size_t)(tok0 + t) * 1024 + col, (u32x2){pk2(h[0], h[1]), pk2(h[2], h[3])}); } }
        }
    }
}

constexpr int MIX_PH = 8, MOE_PH = 5, NSTEPS = 2 + DEPTH * (NCH * MIX_PH + MOE_PH);
__global__ void __launch_bounds__(512, 2) fwd(Args args) {
    extern __shared__ __attribute__((aligned(16))) unsigned char lds_raw[];
    Frame F;
    F.lds = (LAS unsigned char*)lds_raw; F.tid = threadIdx.x; F.lane = F.tid & 63; F.wave = __builtin_amdgcn_readfirstlane(F.tid >> 6); F.G = gridDim.x; F.c = blockIdx.x;
    F.in = args.in; F.out = args.out; F.ws = args.ws; F.ck = args.ws + WS_CHUNK; F.MOD = (float*)(args.ws + WS_MOD); F.XC = (float*)(args.ws + WS_XC);
    for (int u = F.tid; u < (LDS_BYTES - LDS_MISC) / 4; u += 512) ((LAS unsigned*)(F.lds + LDS_MISC))[u] = 0u;
    __syncthreads();
    const int lo = args.lo, hi = args.hi;
    const int wave_id0 = __builtin_amdgcn_readfirstlane((int)threadIdx.x >> 6);
    XcdBarrier bar; bar.bar = (unsigned*)(F.ws + WS_CTL) + CW_BAR; bar.x = 0; bar.st = (volatile LAS unsigned*)(F.lds + LDS_MISC + 32);
    if (hi - lo > 1) bar = xcd_barrier_post((unsigned*)(F.ws + WS_CTL) + CW_BAR, (volatile LAS unsigned*)(F.lds + LDS_MISC + 32));
    int step = 0;
#ifndef SITE_ONLY
#define SITE_ONLY -1
#endif
#ifndef DBG_SKIP_MASK
#define DBG_SKIP_MASK 0u
#endif
#define SITE_ON(id) ((SITE_ONLY < 0 || SITE_ONLY == (id)) && !((DBG_SKIP_MASK >> (id)) & 1u))
#ifndef DBG_REPEAT_MASK
#define DBG_REPEAT_MASK 0x0u
#endif
#define SITE_REPS(id) (((DBG_REPEAT_MASK >> (id)) & 1u) ? 2 : 1)
#define PH_BEGIN(id) if (step >= lo && step < hi) { if (SITE_ON(id)) for (int rep_ = 0; rep_ < SITE_REPS(id); ++rep_) { if (rep_ > 0) xcd_barrier(bar, F.tid == 0); { int t_; asm volatile("v_mbcnt_lo_u32_b32 %0, -1, 0\n\tv_mbcnt_hi_u32_b32 %0, -1, %0" : "=v"(t_)); t_ += wave_id0 * 64; F.tid = t_; F.lane = t_ & 63; F.wave = __builtin_amdgcn_readfirstlane(t_ >> 6); \
        int c_ = blockIdx.x, g_ = gridDim.x; unsigned long long w_ = (unsigned long long)args.ws, o_ = (unsigned long long)args.out; asm volatile("" : "+s"(c_), "+s"(g_), "+s"(w_), "+s"(o_)); \
        F.c = c_; F.G = g_; F.ws = (unsigned char*)w_; F.out = (float*)o_; F.ck = F.ws + WS_CHUNK; F.MOD = (float*)(F.ws + WS_MOD); F.XC = (float*)(F.ws + WS_XC); }
#ifndef DBG_DOUBLE_BAR
#define DBG_DOUBLE_BAR 0
#endif
#define PH_END   } if (step + 1 < hi) { xcd_barrier(bar, F.tid == 0); if (DBG_DOUBLE_BAR) xcd_barrier(bar, F.tid == 0); } } ++step;
    LAS int* TAB = (LAS int*)(F.lds + LDS_TAB);

    PH_BEGIN(0)
        if (F.c < 64) prologue_s5(F, F.c >> 5, F.c & 31);
        else { prologue_mod(F, 64); prologue_transposes(F, 64); prologue_small(F, 64); }
    PH_END
    PH_BEGIN(1) prologue_mod_final(F); PH_END

    for (int l = 0; l < DEPTH; ++l) {
        const bool need_ctx = (l == 0);
        const float* xl_old = l == 0 ? F.in[0] : (const float*)F.out; const float* xc_old = l == 0 ? F.in[2] : (const float*)F.XC;
        const float* MODL = F.MOD + (size_t)l * 33 * 6144;
        const int nMrows = need_ctx ? 72 : 64;
        for (int ch = 0; ch < NCH; ++ch) {
            const int b0 = ch * NB;
            if (l == 0 && ch == 0) { PH_BEGIN(2) phase_h(F, l, b0, xl_old, xc_old, RR); PH_END }
            PH_BEGIN(3)
                const bf16* Alat = l == 0 ? (const bf16*)(F.ck + C_HB) : (const bf16*)(F.ws + WS_HBALL) + (size_t)b0 * 2048 * 1024;
                const bf16* Actx = l == 0 ? (const bf16*)(F.ck + C_HB) + (size_t)RL * 1024 : (const bf16*)(F.ws + WS_HBALL) + ((size_t)NTOK_LAT + (size_t)b0 * 256) * 1024;
                ProbG1 P{Alat, Actx, (const bf16*)(F.ws + WS_WINT) + (size_t)l * NINP * 1024, 1024, 1024, 1024, F.G, F.c, need_ctx ? 24 : 8};
                EpiG1 E{F.ck, F.in[14] + l * 64, F.in[15] + l * 64, (bf16*)(F.ws + X_GT) + ((ptrdiff_t)b0 * 256 - RL) * 3072};
                pg8::gemm_phase(F.lds, P, E, F.tid);
                if (l == 1) tr_moe_items(F, 1, ch * (MOE_ITEMS / 4), MOE_ITEMS / 4, 128);
            PH_END
            PH_BEGIN(5)
                if (need_ctx) ctx_krope(F, (const bf16*)(F.ck + C_HB) + (size_t)RL * 1024, (const bf16*)(F.ws + WS_WINT) + ((size_t)l * NINP + 6144) * 1024);
                { ProbPlain P{(const bf16*)(F.ck + C_KVL), (const bf16*)(F.ws + WS_UKVT) + (size_t)l * 1024 * 256, 256, 256, 256, 72, 4, F.G, F.c, 0};
                  EpiStoreRs<4> E{(bf16*)(F.ck + C_KN), (bf16*)(F.ck + C_VV), 512, 2, (const float*)(F.ck + C_SSKV), 1.0f / 256.0f}; pg8::gemm_phase(F.lds, P, E, F.tid); }
                { ProbPlain P{(const bf16*)(F.ck + C_QL), (const bf16*)(F.ws + WS_UQT) + (size_t)l * 768 * 768, 768, 768, 768, nMrows, 3, F.G, (F.c + F.G - 32) % F.G, 0};
                  EpiStoreRs<12> E{(bf16*)(F.ck + C_QR), (bf16*)(F.ck + C_QR), 768, 3, (const float*)(F.ck + C_SSQL), 1.0f / 768.0f}; pg8::gemm_phase(F.lds, P, E, F.tid); }
                { ProbPlain P{(const bf16*)(F.ck + C_AS5), (const bf16*)(F.ws + WS_BTS) + (size_t)l * 32 * 256 * 256, 256, 16384, 256, 5, 32, F.G, (F.c + 8) % F.G, 512};
                  EpiS5S E{(float*)(F.ck + C_SS)}; pg8::gemm_phase(F.lds, P, E, F.tid); }
            PH_END
            PH_BEGIN(6) phase_p2(F, l, need_ctx); PH_END
            PH_BEGIN(7)
#ifndef DBG_REP_MLA
#define DBG_REP_MLA 0
#endif
#ifndef DBG_REP_NAT
#define DBG_REP_NAT 0
#endif
                phase_mla(F, l, need_ctx, (bf16*)(F.ws + X_OA) + (size_t)b0 * 256 * 512); if (DBG_REP_MLA) phase_mla(F, l, need_ctx, (bf16*)(F.ws + X_OA) + (size_t)b0 * 256 * 512);
                phase_nat(F, l, need_ctx, (bf16*)(F.ws + X_OB) + (size_t)b0 * 256 * 512); if (DBG_REP_NAT) phase_nat(F, l, need_ctx, (bf16*)(F.ws + X_OB) + (size_t)b0 * 256 * 512);
                { ProbPlain P{(const bf16*)(F.ck + C_AS5), (const bf16*)(F.ws + WS_BTY) + (size_t)l * 32 * 256 * 512, 512, 16384, 512, need_ctx ? 5 : 4, 32, F.G, need_ctx ? (F.c + F.G - 64) % F.G : F.c, 512};
                  EpiS5Y E{(bf16*)(F.ck + C_YG), (bf16*)(F.ws + X_YG) + (size_t)b0 * 256 * 512}; pg8::gemm_phase(F.lds, P, E, F.tid); }
            PH_END
            PH_BEGIN(8)
                ProbPlain P{(const bf16*)(F.ck + C_YG), (const bf16*)(F.ws + WS_GLUT) + (size_t)l * 1024 * 512, 512, 512, 512, 64, 4, F.G, F.c, 0};
                EpiPair<0> E{(bf16*)(F.ck + C_OC), 512}; pg8::gemm_phase(F.lds, P, E, F.tid);
            PH_END
            PH_BEGIN(9)
                ProbMerge P{{(const bf16*)(F.ck + C_OA), (const bf16*)(F.ck + C_OB), (const bf16*)(F.ck + C_OC)}, (const bf16*)(F.ws + WS_BRT) + (size_t)l * 3 * 1024 * 512, 512, 512, 512, 64, 4, F.G, F.c};
                EpiMerge E{(const bf16*)(F.ck + C_GT), (bf16*)(F.ck + C_YMB)}; pg8::gemm_phase(F.lds, P, E, F.tid);
            PH_END
#ifndef DBG_REP_OUT0
#define DBG_REP_OUT0 0
#endif
            PH_BEGIN(10)
              for (int rr_ = 0; rr_ < ((DBG_REP_OUT0 && l == 0) ? 2 : 1); ++rr_) {
                if (rr_) xcd_barrier(bar, F.tid == 0);
                ProbPlain P{(const bf16*)(F.ck + C_YMB), (const bf16*)(F.ws + WS_OUTT) + (size_t)l * 1024 * 1024, 1024, 1024, 1024, 64, 4, F.G, F.c, 0};
                EpiOut E{xl_old, xc_old, F.out, F.XC, MODL, b0}; pg8::gemm_phase(F.lds, P, E, F.tid);
              }
              if (l == 0 && ch + 1 < NCH) phase_h(F, l, b0 + NB, xl_old, xc_old, RR);
            PH_END
        }
        if (need_ctx) {
            PH_BEGIN(16)
                ProbPlain P{(const bf16*)(F.ws + X_YG), (const bf16*)(F.ws + WS_GLUT) + (size_t)l * 1024 * 512, 512, 512, 512, 32, 4, F.G, F.c, 0};
                EpiPair<0> E{(bf16*)(F.ws + X_OC), 512}; pg8::gemm_phase(F.lds, P, E, F.tid);
                tr_moe_items(F, l, 12288, 2560, 128);
            PH_END
            PH_BEGIN(17)
                ProbMerge P{{(const bf16*)(F.ws + X_OA), (const bf16*)(F.ws + X_OB), (const bf16*)(F.ws + X_OC)}, (const bf16*)(F.ws + WS_BRT) + (size_t)l * 3 * 1024 * 512, 512, 512, 512, 32, 4, F.G, F.c};
                EpiMerge E{(const bf16*)(F.ws + X_GT), (bf16*)(F.ws + X_YMB)}; pg8::gemm_phase(F.lds, P, E, F.tid);
                tr_moe_items(F, l, 0, 12288, 128); tr_moe_items(F, l, 14848, 4864, 128);
            PH_END
            PH_BEGIN(18)
                ProbPlain P{(const bf16*)(F.ws + X_YMB), (const bf16*)(F.ws + WS_OUTT) + (size_t)l * 1024 * 1024, 1024, 1024, 1024, 32, 4, F.G, F.c, 0};
                EpiOut E{xl_old, xc_old, F.out, F.XC, MODL, -1}; pg8::gemm_phase(F.lds, P, E, F.tid);
                tr_moe_items(F, l, 19712, 4864, 128);
            PH_END
        }
        const int ntok = need_ctx ? NTOK : NTOK_LAT;
        unsigned* cnt = (unsigned*)(F.ws + WS_CTL) + CW_CNT + l * 64;
#ifndef DBG_ROUTER_DRY
#define DBG_ROUTER_DRY 0
#endif
        PH_BEGIN(11) if (DBG_ROUTER_DRY) { phase_router(F, l, ntok, 1024); xcd_barrier(bar, F.tid == 0); } phase_router(F, l, ntok); PH_END
        PH_BEGIN(12) phase_assign(F, l, ntok); PH_END
        PH_BEGIN(13)
            moe_tables(cnt, TAB, F.tid);
            ProbUp P{(const bf16*)(F.ck + M_H2), (const bf16*)(F.ws + WS_UPT) + (size_t)l * 32 * 1024 * 1024, (const int*)(F.ck + M_ROWTOK), TAB, 1024, 1024, 1024, F.G, F.c};
            EpiPair<1> E{(bf16*)(F.ck + M_HID), 512}; pg8::gemm_phase(F.lds, P, E, F.tid);
        PH_END
        PH_BEGIN(14)
            moe_tables(cnt, TAB, F.tid);
            ProbDown P{(const bf16*)(F.ck + M_HID), (const bf16*)(F.ws + WS_DOWNT) + (size_t)l * 32 * 1024 * 512, TAB, 512, 512, 512, F.G, F.c, 0, TAB[0]};
            EpiDownY E{(const int*)(F.ck + M_ROWTOK), (const float*)(F.ck + M_ROWW), (bf16*)(F.ck + M_Y), TAB[1]}; pg8::gemm_phase(F.lds, P, E, F.tid);
        PH_END
        PH_BEGIN(15) if (l + 1 < DEPTH) phase_comb<true>(F, l, ntok); else phase_comb<false>(F, l, ntok); PH_END
    }
#undef PH_BEGIN
#undef PH_END
}

extern "C" void kernel_launch(void* const* d_in, const int* in_sizes, int n_in, void* d_out, int out_size, void* d_ws, size_t ws_size, hipStream_t stream) {
    static int grid = 0;
    if (grid == 0) {
        if (n_in != 35 || out_size != BATCH * SEQ * D || ws_size < WS_END) { fprintf(stderr, "kernel_launch: unexpected shapes (n_in %d, out %d, ws %zu, need %zu)\n", n_in, out_size, ws_size, (size_t)WS_END); grid = -1; return; }
        int dev = 0, cus = 0, per_cu = 0;
        if (hipGetDevice(&dev) != hipSuccess || hipDeviceGetAttribute(&cus, hipDeviceAttributeMultiprocessorCount, dev) != hipSuccess) { grid = -1; return; }
        if (hipFuncSetAttribute((const void*)fwd, hipFuncAttributeMaxDynamicSharedMemorySize, LDS_BYTES) != hipSuccess) { fprintf(stderr, "kernel_launch: hipFuncSetAttribute failed\n"); grid = -1; return; }
        if (hipOccupancyMaxActiveBlocksPerMultiprocessor(&per_cu, (const void*)fwd, 512, LDS_BYTES) != hipSuccess || per_cu < 1) fprintf(stderr, "kernel_launch: occupancy query reports %d\n", per_cu);
        (void)hipGetLastError();
        grid = cus;
    }
    if (grid < 0) return;
    (void)in_sizes;
    hipMemsetAsync((char*)d_ws + WS_CTL, 0, CTL_BYTES, stream);
    Args a{};
    for (int i = 0; i < 35; ++i) a.in[i] = (const float*)d_in[i];
    a.out = (float*)d_out; a.ws = (unsigned char*)d_ws;
#if MK_SINGLE
    a.lo = 0; a.hi = NSTEPS;
    hipLaunchKernelGGL(fwd, dim3(grid), dim3(512), LDS_BYTES, stream, a);
#else
    for (int s = 0; s < NSTEPS; ++s) { a.lo = s; a.hi = s + 1; hipLaunchKernelGGL(fwd, dim3(grid), dim3(512), LDS_BYTES, stream, a);
    }
#endif
}
```

```cpp
#include <hip/hip_runtime.h>
#include <cstdio>
#include <cstdint>

#ifndef DBG_EPI_TWICE
#define DBG_EPI_TWICE 0
#endif
#ifndef MK_SINGLE
#define MK_SINGLE 1
#endif

#define GAS __attribute__((address_space(1)))
#define LAS __attribute__((address_space(3)))
typedef unsigned short bf16;
typedef short bf16x8 __attribute__((ext_vector_type(8)));
typedef short bf16x4 __attribute__((ext_vector_type(4)));
typedef float f32x4 __attribute__((ext_vector_type(4)));
typedef float f32x2 __attribute__((ext_vector_type(2)));
typedef float f32x16 __attribute__((ext_vector_type(16)));
typedef unsigned u32x4 __attribute__((ext_vector_type(4)));
typedef unsigned u32x2 __attribute__((ext_vector_type(2)));
typedef int i32x4 __attribute__((ext_vector_type(4)));

#define MLA_PAD_N 12
#define NAT_PAD_N 12
#define STR2(x) #x
#define STR(x) STR2(x)
constexpr int D = 1024, BATCH = 32, SEQ = 2048, CTXL = 256, DEPTH = 2;
constexpr int NB = 8, NCH = BATCH / NB;
constexpr int RL = NB * SEQ, RC = NB * CTXL, RR = RL + RC;
constexpr int NINP = 6400;
constexpr int NTOK_LAT = BATCH * SEQ, NTOK_CTX = BATCH * CTXL, NTOK = NTOK_LAT + NTOK_CTX;
constexpr int S5ROWS = 1280;
constexpr int KEYS = SEQ + CTXL;
constexpr int MOE_ROWS = 2 * NTOK + 64 * 256;
constexpr float RMS_EPS = 1e-6f;
constexpr float LOG2E = 1.4426950408889634f;

constexpr size_t al256(size_t x) { return (x + 255) & ~(size_t)255; }
constexpr size_t WS_CTL = 0, CTL_BYTES = 1u << 20;
constexpr size_t WS_WINT = WS_CTL + CTL_BYTES;
constexpr size_t WS_UQT = WS_WINT + (size_t)2 * NINP * 1024 * 2;
constexpr size_t WS_UKVT = WS_UQT + (size_t)2 * 768 * 768 * 2;
constexpr size_t WS_GLUT = WS_UKVT + (size_t)2 * 1024 * 256 * 2;
constexpr size_t WS_BRT = WS_GLUT + (size_t)2 * 1024 * 512 * 2;
constexpr size_t WS_OUTT = WS_BRT + (size_t)2 * 3 * 1024 * 512 * 2;
constexpr size_t WS_UPT = WS_OUTT + (size_t)2 * 1024 * 1024 * 2;
constexpr size_t WS_DOWNT = WS_UPT + (size_t)2 * 32 * 1024 * 1024 * 2;
constexpr size_t WS_BTY = WS_DOWNT + (size_t)2 * 32 * 1024 * 512 * 2;
constexpr size_t WS_BTS = WS_BTY + (size_t)2 * 32 * 256 * 512 * 2;
constexpr size_t WS_A16 = WS_BTS + (size_t)2 * 32 * 256 * 256 * 2;
constexpr size_t WS_MODP = WS_A16 + (size_t)2 * 2 * 32 * 64 * 2 * 4;
constexpr size_t WS_MOD = WS_MODP + (size_t)8 * 2 * 33 * 6144 * 4;
constexpr size_t WS_ROPE = WS_MOD + (size_t)2 * 33 * 6144 * 4;
constexpr size_t WS_WGT = WS_ROPE + (size_t)2048 * 32 * 4;
constexpr size_t WS_WET = WS_WGT + (size_t)2 * 4 * 1024 * 4;
constexpr size_t WS_XC = WS_WET + (size_t)2 * 32 * 1024 * 4;
constexpr size_t WS_CHUNK = al256(WS_XC + (size_t)NTOK_CTX * 1024 * 4);
constexpr size_t UB = (size_t)RR * 1024 * 2;
constexpr size_t C_HB = 0;
constexpr size_t C_KVL = C_HB + UB;
constexpr size_t C_QL = C_KVL + UB / 4;
constexpr size_t C_YM = C_HB;
constexpr size_t C_QR = C_QL + UB * 3 / 4;
constexpr size_t C_KN = C_QR + UB * 3 / 4;
constexpr size_t C_YMB = C_QR;
constexpr size_t C_KRP = C_KN + UB / 2;
constexpr size_t C_NQ = al256(C_KRP + (size_t)RR * 32 * 2);
constexpr size_t C_NK = C_NQ + UB / 2;
constexpr size_t C_NV = C_NK + UB / 2;
constexpr size_t C_GT = C_NV + UB / 2;
constexpr size_t C_AS5 = C_GT + UB * 3;
constexpr size_t C_SS = C_AS5 + (size_t)S5ROWS * 32 * 512 * 2;
constexpr size_t C_VV = C_SS + (size_t)S5ROWS * 32 * 256 * 4;
constexpr size_t C_QF = C_VV + UB / 2;
constexpr size_t C_KF = C_QF + UB * 3 / 4;
constexpr size_t C_VT = C_KF + UB * 3 / 4;
constexpr size_t C_NVT = C_VT + (size_t)NB * 8 * 64 * KEYS * 2;
constexpr size_t C_OA = C_NVT + (size_t)NB * 8 * 64 * KEYS * 2;
constexpr size_t C_OB = C_OA + UB / 2;
constexpr size_t C_OC = C_OB + UB / 2;
constexpr size_t C_YG = C_OC + UB / 2;
constexpr size_t C_SSKV = C_YG + UB / 2;
constexpr size_t C_SSQL = C_SSKV + (size_t)RR * 4 * 4;
constexpr size_t C_END = al256(C_SSQL + (size_t)RR * 12 * 4);
constexpr size_t M_HID = 0;
constexpr size_t M_Y = M_HID + (size_t)MOE_ROWS * 512 * 2;
constexpr size_t M_H2 = M_Y;
constexpr size_t M_ROWTOK = M_Y + (size_t)2 * NTOK * 1024 * 2;
constexpr size_t M_ROWW = M_ROWTOK + (size_t)MOE_ROWS * 4;
constexpr size_t M_TOKE = M_ROWW + (size_t)MOE_ROWS * 4;
constexpr size_t M_TOKW = M_TOKE + (size_t)NTOK * 16;
constexpr size_t M_WGBASE = M_TOKW + (size_t)NTOK * 8;
constexpr size_t M_END = M_WGBASE + (size_t)1024 * 64 * 4;
static_assert(M_END <= C_END, "MoE buffers fit in the chunk region");
constexpr size_t WS_HBALL = WS_CHUNK + C_END;
constexpr size_t WS_END = WS_HBALL + (size_t)NTOK * 1024 * 2;
constexpr size_t X_YG = WS_HBALL, X_OA = X_YG + (size_t)NTOK_CTX * 512 * 2, X_OB = X_OA + (size_t)NTOK_CTX * 512 * 2, X_OC = X_OB + (size_t)NTOK_CTX * 512 * 2;
constexpr size_t X_GT = X_OC + (size_t)NTOK_CTX * 512 * 2, X_YMB = X_GT + (size_t)NTOK_CTX * 3072 * 2, X_END = X_YMB + (size_t)NTOK_CTX * 1024 * 2;
static_assert(X_END <= WS_END, "ctx-tail buffers fit inside HB_ALL");
static_assert(WS_END <= ((size_t)1 << 30), "workspace within 1 GiB");
constexpr int CW_BAR = 4096;
constexpr int CW_CNT = 16384;

constexpr int LDS_MISC = 143360;
constexpr int LDS_TAB = LDS_MISC + 256;
constexpr int LDS_BYTES = 147456;

__device__ __forceinline__ unsigned f2bf(float f) { unsigned u = __builtin_bit_cast(unsigned, f); return (u + 0x7fffu + ((u >> 16) & 1u)) >> 16; }
typedef __bf16 bf2n_t __attribute__((ext_vector_type(2)));
__device__ __forceinline__ unsigned pk2(float lo, float hi) { const f32x2 v = {lo, hi}; return __builtin_bit_cast(unsigned, __builtin_convertvector(v, bf2n_t)); }
__device__ __forceinline__ float bflo(unsigned u) { return __builtin_bit_cast(float, u << 16); }
__device__ __forceinline__ float bfhi(unsigned u) { return __builtin_bit_cast(float, u & 0xffff0000u); }
__device__ __forceinline__ float bf2f(bf16 h) { return __builtin_bit_cast(float, ((unsigned)h) << 16); }
template <class T> __device__ __forceinline__ T ldg(const void* p) { return *(const GAS T*)p; }
template <class T> __device__ __forceinline__ void stg(void* p, T v) { *(GAS T*)p = v; }
template <int K> __device__ __forceinline__ float shx_sum(float v) {
    if constexpr (K == 32) { float a = v, b = v; asm volatile("s_nop 1\n\tv_permlane32_swap_b32 %0, %1" : "+v"(a), "+v"(b)); return a + b; }
    else return v + __builtin_bit_cast(float, __builtin_amdgcn_ds_swizzle(__builtin_bit_cast(int, v), (K << 10) | 0x1f));
}
template <int K> __device__ __forceinline__ float shx_max(float v) {
    if constexpr (K == 32) { float a = v, b = v; asm volatile("s_nop 1\n\tv_permlane32_swap_b32 %0, %1" : "+v"(a), "+v"(b)); return fmaxf(a, b); }
    else return fmaxf(v, __builtin_bit_cast(float, __builtin_amdgcn_ds_swizzle(__builtin_bit_cast(int, v), (K << 10) | 0x1f)));
}
__device__ __forceinline__ float wave_sum(float v) { v = shx_sum<1>(v); v = shx_sum<2>(v); v = shx_sum<4>(v); v = shx_sum<8>(v); v = shx_sum<16>(v); return shx_sum<32>(v); }
__device__ __forceinline__ float hx32(float a, float b) { asm volatile("s_nop 1\n\tv_permlane32_swap_b32 %0, %1" : "+v"(a), "+v"(b)); return a + b; }
__device__ __forceinline__ float hx16(float a, float b) { asm volatile("s_nop 1\n\tv_permlane16_swap_b32 %0, %1" : "+v"(a), "+v"(b)); return a + b; }
template <int N> __device__ __forceinline__ float dpp_ror(float v) { return __builtin_bit_cast(float, __builtin_amdgcn_update_dpp(0, __builtin_bit_cast(int, v), 0x120 + N, 0xf, 0xf, false)); }
__device__ __forceinline__ float row_sum16(float v) { v += dpp_ror<8>(v); v += dpp_ror<4>(v); v += dpp_ror<2>(v); v += dpp_ror<1>(v); return v; }
__device__ __forceinline__ float red4(float v0, float v1, float v2, float v3) { return row_sum16(hx16(hx32(v0, v2), hx32(v1, v3))); }
__device__ __forceinline__ float lane_bcast(float v, int srclane) { return __builtin_bit_cast(float, __builtin_amdgcn_readlane(__builtin_bit_cast(int, v), srclane)); }
__device__ __forceinline__ float fast_exp2(float x) { return __builtin_amdgcn_exp2f(x); }
__device__ __forceinline__ float sigmoidf(float x) { return __builtin_amdgcn_rcpf(1.0f + __builtin_amdgcn_exp2f(-LOG2E * x)); }
__device__ __forceinline__ float gelu_tanh(float x) { const float u = 0.7978845608028654f * (x + 0.044715f * x * x * x); return x * sigmoidf(2.0f * u); }

#define XB_TMO      128
#define XB_XCNT(j)  (256  + 64 * (j))
#define XB_XSUB(j)  (1280 + 64 * (j))
#define XB_XGEN(j)  (2304 + 64 * (j))
#define XB_TOP      3328
#define XB_TOPGEN   3392
#define XCD_BAR_WORDS 3456
#define XB_SPIN_CAP (1u << 22)

__device__ __forceinline__ unsigned xb_ld(unsigned* p)              { return __hip_atomic_load(p, __ATOMIC_RELAXED, __HIP_MEMORY_SCOPE_AGENT); }
__device__ __forceinline__ unsigned xb_add(unsigned* p, unsigned v) { return __hip_atomic_fetch_add(p, v, __ATOMIC_RELAXED, __HIP_MEMORY_SCOPE_AGENT); }
__device__ __forceinline__ unsigned xb_xcc_id() { return (unsigned)__builtin_amdgcn_s_getreg((3 << 11) | 20) & 0xFu; }
#define XB_SPIN(cond, bar) do { unsigned _sp = 0; while (cond) { __builtin_amdgcn_s_sleep(1); \
    if ((++_sp & 255u) == 0u) { if (xb_ld(&(bar)[XB_TMO])) break; if (_sp > XB_SPIN_CAP) { atomicAdd(&(bar)[XB_TMO], 1u); break; } } } } while (0)

struct XcdBarrier { unsigned* bar; unsigned x; volatile LAS unsigned* st; };

__device__ __forceinline__ XcdBarrier xcd_barrier_post(unsigned* bar, volatile LAS unsigned* st) {
    XcdBarrier b; b.bar = bar; b.x = xb_xcc_id(); b.st = st;
    if (threadIdx.x == 0) (void)xb_add(&bar[XB_XCNT(b.x)], 1u);
    return b;
}
__device__ __forceinline__ void xcd_barrier_complete(unsigned* bar, unsigned x, unsigned& nloc, unsigned& nx) {
    const unsigned G = gridDim.x * gridDim.y * gridDim.z;
    unsigned sum, cnt, mine, sp = 0u;
    for (;;) {
        sum = 0u; cnt = 0u; mine = 0u;
#pragma unroll
        for (unsigned j = 0; j < 16; ++j) { const unsigned c = xb_ld(&bar[XB_XCNT(j)]); sum += c; cnt += (c > 0u) ? 1u : 0u; mine = (j == x) ? c : mine; }
        if (sum == G) break;
        __builtin_amdgcn_s_sleep(1);
        if ((++sp & 255u) == 0u) { if (xb_ld(&bar[XB_TMO])) break; if (sp > XB_SPIN_CAP) { atomicAdd(&bar[XB_TMO], 1u); break; } }
    }
    nloc = mine > 0u ? mine : 1u; nx = cnt > 0u ? cnt : 1u;
}
__device__ __forceinline__ void xcd_barrier(const XcdBarrier& b, bool thread0) {
    asm volatile("s_waitcnt vmcnt(0)" ::: "memory");
    __syncthreads();
    if (thread0) {
        unsigned* bar = b.bar;
        __builtin_amdgcn_s_waitcnt(0);
        unsigned nloc = b.st[0], nx = b.st[1];
        if (nloc == 0u) { xcd_barrier_complete(bar, b.x, nloc, nx); b.st[0] = nloc; b.st[1] = nx; }
        const unsigned old = xb_add(&bar[XB_XSUB(b.x)], 1u);
        const unsigned gen = old / nloc;
        if (old + 1u == (gen + 1u) * nloc) {
            __builtin_amdgcn_fence(__ATOMIC_RELEASE, "agent");
            asm volatile("s_waitcnt vmcnt(0)" ::: "memory");
            const unsigned og = xb_add(&bar[XB_TOP], 1u);
            const unsigned tg = og / nx;
            if (og + 1u == (tg + 1u) * nx) xb_add(&bar[XB_TOPGEN], 1u);
            else XB_SPIN(xb_ld(&bar[XB_TOPGEN]) == tg, bar);
            __builtin_amdgcn_fence(__ATOMIC_ACQUIRE, "agent");
            xb_add(&bar[XB_XGEN(b.x)], 1u);
            asm volatile("s_waitcnt vmcnt(0)" ::: "memory");
        } else {
            XB_SPIN(xb_ld(&bar[XB_XGEN(b.x)]) == gen, bar);
            __builtin_amdgcn_fence(__ATOMIC_ACQUIRE, "agent");
            asm volatile("s_waitcnt vmcnt(0)" ::: "memory");
        }
    }
    __syncthreads();
}

namespace pg8 {
constexpr int BM = 256, BK = 64, HALF = 128, HTB = HALF * BK * 2, STAGE_BYTES = 8 * HTB, NXCD = 8, WGM = 2;
__host__ __device__ __forceinline__ int lds_byte(int r, int c) { const int st = (r >> 4) * 2 + (c >> 5), rr = r & 15, cc = c & 31, ob = rr * 64 + cc * 2; return st * 1024 + (ob ^ (((ob >> 9) & 1) << 5)); }
__host__ __device__ __forceinline__ void stage_rc(int b, int& R, int& C) { const int st = b / 1024, sb = b % 1024, swz = sb ^ (((sb >> 9) & 1) << 5); R = (st >> 1) * 16 + swz / 64; C = (st & 1) * 32 + (swz % 64) / 2; }
__host__ __device__ __forceinline__ int perm32(int rho) { const int n = rho >> 4, i = rho & 15; return 8 * (i >> 2) + 4 * n + (i & 3); }
struct Unit { int pm, pn, z; };
__device__ __forceinline__ bool tile_map(long L, int nM, int nN, int& pm, int& pn) {
    const int nwg = nM * nN; if (L >= nwg) return false;
    int wgid = (int)L; { const int q = nwg / NXCD, r = nwg % NXCD, xcd = wgid % NXCD, off = wgid / NXCD; wgid = (xcd < r ? xcd * (q + 1) : r * (q + 1) + (xcd - r) * q) + off; }
    const int nig = WGM * nN, gid = wgid / nig, fm = gid * WGM, gsz = (nM - fm) < WGM ? (nM - fm) : WGM;
    pm = fm + ((wgid % nig) % gsz); pn = (wgid % nig) / gsz; return true;
}
typedef __bf16 bf2_t __attribute__((ext_vector_type(2)));
__device__ __forceinline__ unsigned cvt_pk_bf16(float lo, float hi) { const f32x2 v = {lo, hi}; return __builtin_bit_cast(unsigned, __builtin_convertvector(v, bf2_t)); }

template <class Prob, class Epi>
__device__ __forceinline__ void gemm_phase(LAS unsigned char* lds, const Prob& P, const Epi& E, int tid_in) {
    int tid_ = tid_in; asm volatile("" : "+v"(tid_));
    const int tid = tid_, wid = __builtin_amdgcn_readfirstlane(tid >> 6), lane = tid & 63, wr = wid >> 2, wc = wid & 3, fr = lane & 15, fq = lane >> 4;
    const int K = P.K, nt = K / BK;
    int sR[2], sC[2]; unsigned voffB[2], voffA[2];
#pragma unroll
    for (int i = 0; i < 2; ++i) { int R, C; stage_rc(tid * 16 + i * 8192, R, C); sR[i] = R; sC[i] = C; const int Rb = Epi::PERM ? ((R & ~31) + perm32(R & 31)) : R;
        voffA[i] = (unsigned)(R * P.lda + C) * 2u; voffB[i] = (unsigned)(Rb * P.ldb + C) * 2u; }
    const size_t kstep = (size_t)(BK * 2);
    const unsigned hstepA = (unsigned)HALF * (unsigned)P.lda * 2u; const size_t hstepB = (size_t)HALF * P.ldb * 2;
    const unsigned ldsw = (unsigned)wid * 1024u;
    const int aoff = lds_byte(wr * 64 + fr, fq * 8), boff = lds_byte(wc * 32 + fr, fq * 8);
#define PG8_SA(b, h) (((b) * 2 + (h)) * HTB)
#define PG8_SB(b, h) ((4 + (b) * 2 + (h)) * HTB)
#define PG8_STAGE2(bufoff, gbase, o0, o1) do { \
        __builtin_amdgcn_global_load_lds((const GAS unsigned*)((const char*)(gbase) + (o0)), (LAS unsigned*)(lds + (bufoff) + ldsw), 16, 0, 0); \
        __builtin_amdgcn_global_load_lds((const GAS unsigned*)((const char*)(gbase) + (o1)), (LAS unsigned*)(lds + (bufoff) + ldsw + 8192), 16, 0, 0); } while (0)
#define PG8_STAGEB(bufoff, gbase) PG8_STAGE2(bufoff, gbase, voffB[0], voffB[1])
#define PG8_STAGEA(bufoff, gbase, OA, h) do { if constexpr (Prob::GATHER) { PG8_STAGE2(bufoff, gbase, OA[h][0], OA[h][1]); } else { PG8_STAGE2(bufoff, (gbase) + (h) * (size_t)hstepA, voffA[0], voffA[1]); } } while (0)
#define PG8_LDA(dst, b, h) do { _Pragma("unroll") for (int m = 0; m < 4; ++m) _Pragma("unroll") for (int k = 0; k < 2; ++k) dst[m][k] = *(const LAS bf16x8*)(lds + PG8_SA(b, h) + aoff + m * 2048 + k * 1024); } while (0)
#define PG8_LDB(dst, b, h) do { _Pragma("unroll") for (int n = 0; n < 2; ++n) _Pragma("unroll") for (int k = 0; k < 2; ++k) dst[n][k] = *(const LAS bf16x8*)(lds + PG8_SB(b, h) + boff + n * 2048 + k * 1024); } while (0)
#define PG8_MMA(ai, bj, At, Bt) do { __builtin_amdgcn_s_setprio(1); _Pragma("unroll") for (int m = 0; m < 4; ++m) _Pragma("unroll") for (int n = 0; n < 2; ++n) _Pragma("unroll") for (int k = 0; k < 2; ++k) \
        acc[ai][bj][m][n] = __builtin_amdgcn_mfma_f32_16x16x32_bf16(Bt[n][k], At[m][k], acc[ai][bj][m][n], 0, 0, 0); __builtin_amdgcn_s_setprio(0); } while (0)
#define PG8_WAIT_V(n) asm volatile("s_waitcnt vmcnt(" #n ")" ::: "memory")
#define PG8_WAIT_L(n) asm volatile("s_waitcnt lgkmcnt(" #n ")" ::: "memory")
#define PG8_BAR __builtin_amdgcn_s_barrier()
#define PG8_SCHED __builtin_amdgcn_sched_barrier(0)
    Unit cur, nxt; int ui = 0;
    if (!P.next(0, cur)) return;
    f32x4 acc[2][2][4][2];
    bf16x8 At[4][2], B0[2][2], B1[2][2];
    const char* cA = P.a_base(cur); const char* cB = P.b_base(cur);
    unsigned cOA[2][2];
#pragma unroll
    for (int h = 0; h < 2; ++h)
#pragma unroll
        for (int i = 0; i < 2; ++i) {
            if constexpr (Prob::GATHER) cOA[h][i] = P.a_rowoff(cur, h * HALF + sR[i]) + (unsigned)sC[i] * 2u;
            else cOA[h][i] = 0u;
        }
    PG8_STAGEB(PG8_SB(0, 0), cB); PG8_STAGEB(PG8_SB(0, 1), cB + hstepB); PG8_STAGEA(PG8_SA(0, 0), cA, cOA, 0); PG8_STAGEA(PG8_SA(0, 1), cA, cOA, 1);
    if (wr == 1) PG8_BAR;
    PG8_WAIT_V(2); PG8_BAR;
    PG8_STAGEB(PG8_SB(1, 0), cB + kstep); PG8_STAGEA(PG8_SA(1, 0), cA + kstep, cOA, 0); PG8_STAGEB(PG8_SB(1, 1), cB + hstepB + kstep);
    PG8_WAIT_V(6); PG8_BAR;
    for (;;) {
        const bool has_next = P.next(ui + 1, nxt);
        const char* nA = has_next ? P.a_base(nxt) : cA; const char* nB = has_next ? P.b_base(nxt) : cB;
        if constexpr (Prob::GATHER) {
            u32x4 nv = (u32x4){cOA[0][0], cOA[0][1], cOA[1][0], cOA[1][1]};
            if (has_next) {
                int t2 = tid; asm volatile("" : "+v"(t2));
#pragma unroll
                for (int i = 0; i < 2; ++i) { int R2, C2; stage_rc(t2 * 16 + i * 8192, R2, C2);
                    nv[i] = P.a_rowoff(nxt, R2) + (unsigned)C2 * 2u; nv[2 + i] = P.a_rowoff(nxt, HALF + R2) + (unsigned)C2 * 2u; }
            }
            *(LAS u32x4*)(lds + STAGE_BYTES + tid * 16) = nv;
        }
        float zero_ = 0.f; asm volatile("" : "+v"(zero_));
#pragma unroll
        for (int a = 0; a < 2; ++a)
#pragma unroll
            for (int b = 0; b < 2; ++b)
#pragma unroll
                for (int m = 0; m < 4; ++m)
#pragma unroll
                    for (int n = 0; n < 2; ++n) acc[a][b][m][n] = (f32x4){zero_, zero_, zero_, zero_};
        asm volatile("" : "+v"(acc[0][0][0][0]), "+v"(acc[0][0][0][1]), "+v"(acc[0][0][1][0]), "+v"(acc[0][0][1][1]), "+v"(acc[0][0][2][0]), "+v"(acc[0][0][2][1]), "+v"(acc[0][0][3][0]), "+v"(acc[0][0][3][1]),
                          "+v"(acc[0][1][0][0]), "+v"(acc[0][1][0][1]), "+v"(acc[0][1][1][0]), "+v"(acc[0][1][1][1]), "+v"(acc[0][1][2][0]), "+v"(acc[0][1][2][1]), "+v"(acc[0][1][3][0]), "+v"(acc[0][1][3][1]));
        asm volatile(".p2align 6" : "+v"(acc[1][0][0][0]), "+v"(acc[1][0][0][1]), "+v"(acc[1][0][1][0]), "+v"(acc[1][0][1][1]), "+v"(acc[1][0][2][0]), "+v"(acc[1][0][2][1]), "+v"(acc[1][0][3][0]), "+v"(acc[1][0][3][1]),
                          "+v"(acc[1][1][0][0]), "+v"(acc[1][1][0][1]), "+v"(acc[1][1][1][0]), "+v"(acc[1][1][1][1]), "+v"(acc[1][1][2][0]), "+v"(acc[1][1][2][1]), "+v"(acc[1][1][3][0]), "+v"(acc[1][1][3][1]));
        for (int t = 0; t < nt; t += 2) {
            const bool last = (t == nt - 2);
            const char* a1 = cA + (size_t)(t + 1) * kstep;
            const char* a2 = last ? nA : cA + (size_t)(t + 2) * kstep; const char* b2 = last ? nB : cB + (size_t)(t + 2) * kstep;
            const char* a3 = a2 + kstep; const char* b3 = b2 + kstep;
            unsigned oa2[2][2];
#pragma unroll
            for (int h = 0; h < 2; ++h)
#pragma unroll
                for (int i = 0; i < 2; ++i) oa2[h][i] = Prob::GATHER ? cOA[h][i] : 0u;
            if constexpr (Prob::GATHER) { if (last) { const u32x4 nv = *(const LAS u32x4*)(lds + STAGE_BYTES + tid * 16); oa2[0][0] = nv.x; oa2[0][1] = nv.y; oa2[1][0] = nv.z; oa2[1][1] = nv.w; } }
            PG8_LDB(B0, 0, 0); PG8_LDB(B1, 0, 1); PG8_SCHED; PG8_LDA(At, 0, 0); PG8_STAGEA(PG8_SA(1, 1), a1, cOA, 1);
            PG8_WAIT_V(8); PG8_WAIT_L(0); PG8_BAR; PG8_MMA(0, 0, At, B0); PG8_MMA(0, 1, At, B1); PG8_BAR; PG8_SCHED;
            PG8_LDA(At, 0, 1); PG8_STAGEB(PG8_SB(0, 0), b2); PG8_STAGEB(PG8_SB(0, 1), b2 + hstepB); PG8_STAGEA(PG8_SA(0, 0), a2, oa2, 0);
            PG8_WAIT_V(8); PG8_WAIT_L(0); PG8_BAR; PG8_MMA(1, 0, At, B0); PG8_MMA(1, 1, At, B1); PG8_BAR; PG8_SCHED;
            PG8_LDB(B0, 1, 0); PG8_LDB(B1, 1, 1); PG8_SCHED; PG8_LDA(At, 1, 0); PG8_STAGEA(PG8_SA(0, 1), a2, oa2, 1);
            PG8_WAIT_V(8); PG8_WAIT_L(0); PG8_BAR; PG8_MMA(0, 0, At, B0); PG8_MMA(0, 1, At, B1); PG8_BAR; PG8_SCHED;
            PG8_LDA(At, 1, 1); PG8_STAGEB(PG8_SB(1, 0), b3); PG8_STAGEB(PG8_SB(1, 1), b3 + hstepB); PG8_STAGEA(PG8_SA(1, 0), a3, oa2, 0);
            PG8_WAIT_V(8); PG8_WAIT_L(0); PG8_BAR; PG8_MMA(1, 0, At, B0); PG8_MMA(1, 1, At, B1); PG8_BAR; PG8_SCHED;
        }
        if (wr == 0) PG8_BAR;
        E(acc, cur, wr, wc, fr, fq);
#if DBG_EPI_TWICE
        if constexpr (Epi::IDEMP) E(acc, cur, wr, wc, fr, fq);
#endif
        if (!has_next) break;
        cur = nxt; cA = nA; cB = nB; ++ui;
        if constexpr (Prob::GATHER) { const u32x4 nv = *(const LAS u32x4*)(lds + STAGE_BYTES + tid * 16); cOA[0][0] = nv.x; cOA[0][1] = nv.y; cOA[1][0] = nv.z; cOA[1][1] = nv.w; }
        if (wr == 1) PG8_BAR;
    }
    PG8_WAIT_V(0);
    PG8_BAR;
#undef PG8_SA
#undef PG8_SB
#undef PG8_STAGE2
#undef PG8_STAGEB
#undef PG8_STAGEA
#undef PG8_LDA
#undef PG8_LDB
#undef PG8_MMA
#undef PG8_WAIT_V
#undef PG8_WAIT_L
#undef PG8_BAR
#undef PG8_SCHED
}
}
using pg8::Unit;

struct Args { const float* in[35]; float* out; unsigned char* ws; int lo, hi; };

struct Frame {
    LAS unsigned char* lds;
    int tid, lane, wave, G, c;
    const float* const* in;
    float* out; unsigned char* ws; unsigned char* ck;
    float* MOD; float* XC;
};
__device__ __forceinline__ bool row_is_ctx(int row) { return row >= RL; }

struct ProbPlain {
    static constexpr bool GATHER = false;
    const bf16* A; const bf16* Bt; int K, lda, ldb, nM, nN, G, c, a_pn_stride;
    __device__ __forceinline__ bool next(int i, Unit& u) const { u.z = 0; return pg8::tile_map((long)i * G + c, nM, nN, u.pm, u.pn); }
    __device__ __forceinline__ const char* a_base(const Unit& u) const { return (const char*)(A + (size_t)u.pm * 256 * lda + (size_t)u.pn * a_pn_stride); }
    __device__ __forceinline__ const char* b_base(const Unit& u) const { return (const char*)(Bt + (size_t)u.pn * 256 * ldb); }
    __device__ __forceinline__ unsigned a_rowoff(const Unit&, int) const { return 0u; }
};
struct ProbG1 {
    static constexpr bool GATHER = false;
    const bf16* A; const bf16* Actx; const bf16* Bt; int K, lda, ldb, G, c, nctx;
    __device__ __forceinline__ bool next(int i, Unit& u) const {
        u.z = 0; const long L = (long)i * G + c; const int n1 = 64 * 25;
        if (L < n1) return pg8::tile_map(L, 64, 25, u.pm, u.pn);
        const int l2 = (int)(L - n1); if (l2 >= 8 * nctx) return false;
        u.pm = 64 + (l2 & 7); const int idx = l2 >> 3;
        u.pn = (nctx == 24) ? idx : (idx < 3 ? idx : (idx < 7 ? idx + 5 : 24));
        return true;
    }
    __device__ __forceinline__ const char* a_base(const Unit& u) const { return u.pm < 64 ? (const char*)(A + (size_t)u.pm * 256 * lda) : (const char*)(Actx + (size_t)(u.pm - 64) * 256 * lda); }
    __device__ __forceinline__ const char* b_base(const Unit& u) const { return (const char*)(Bt + (size_t)u.pn * 256 * ldb); }
    __device__ __forceinline__ unsigned a_rowoff(const Unit&, int) const { return 0u; }
};
struct ProbMerge {
    static constexpr bool GATHER = false;
    const bf16* O[3]; const bf16* Bt; int K, lda, ldb, nM, nN, G, c;
    __device__ __forceinline__ bool next(int i, Unit& u) const { u.z = i % 3; return pg8::tile_map((long)(i / 3) * G + c, nM, nN, u.pm, u.pn); }
    __device__ __forceinline__ const char* a_base(const Unit& u) const { const bf16* o = u.z == 0 ? O[0] : (u.z == 1 ? O[1] : O[2]); return (const char*)(o + (size_t)u.pm * 256 * lda); }
    __device__ __forceinline__ const char* b_base(const Unit& u) const { return (const char*)(Bt + ((size_t)u.z * 1024 + (size_t)u.pn * 256) * ldb); }
    __device__ __forceinline__ unsigned a_rowoff(const Unit&, int) const { return 0u; }
};
__device__ __forceinline__ void moe_tables(const unsigned* cnt, LAS int* T, int tid_in) {
    int t_ = tid_in; asm volatile("" : "+v"(t_));
    __syncthreads();
    if (t_ < 64) T[706 + t_] = (int)__hip_atomic_load(cnt + t_, __ATOMIC_RELAXED, __HIP_MEMORY_SCOPE_AGENT);
    __syncthreads();
    if (t_ == 0) {
        int row = 0, t = 0;
#pragma nounroll
        for (int ge = 0; ge < 64; ++ge) {
            const int cn = T[706 + ge];
            T[2 + ge] = row; const int nt = (cn + 255) >> 8;
#pragma nounroll
            for (int k = 0; k < nt && t < 640; ++k) T[66 + (t++)] = ge & 31;
            row += nt * 256;
            if (ge == 31) T[1] = t;
        }
        T[0] = t;
    }
    __syncthreads();
}
struct ProbUp {
    static constexpr bool GATHER = true;
    const bf16* A; const bf16* Bt; const int* rowtok; LAS int* T; int K, lda, ldb, G, c;
    __device__ __forceinline__ bool next(int i, Unit& u) const {
        const int nwg = T[0] * 4; const long L = (long)i * G + c; if (L >= nwg) return false;
        int w = (int)L; { const int q = nwg / 8, r = nwg % 8, xcd = w % 8, off = w / 8; w = (xcd < r ? xcd * (q + 1) : r * (q + 1) + (xcd - r) * q) + off; }
        u.pm = w >> 2; u.pn = w & 3; u.z = T[66 + u.pm]; return true;
    }
    __device__ __forceinline__ const char* a_base(const Unit&) const { return (const char*)A; }
    __device__ __forceinline__ const char* b_base(const Unit& u) const { return (const char*)(Bt + ((size_t)u.z * 1024 + (size_t)u.pn * 256) * ldb); }
    __device__ __forceinline__ unsigned a_rowoff(const Unit& u, int r) const { const GAS int* base = (const GAS int*)(rowtok + (size_t)u.pm * 256); int t = base[(unsigned)r]; t = t < 0 ? 0 : t; return (unsigned)t * (unsigned)lda * 2u; }
};
struct ProbDown {
    static constexpr bool GATHER = false;
    const bf16* A; const bf16* Bt; LAS int* T; int K, lda, ldb, G, c, t0, t1;
    __device__ __forceinline__ bool next(int i, Unit& u) const {
        const int nwg = (t1 - t0) * 4; const long L = (long)i * G + c; if (L >= nwg) return false;
        int w = (int)L; { const int q = nwg / 8, r = nwg % 8, xcd = w % 8, off = w / 8; w = (xcd < r ? xcd * (q + 1) : r * (q + 1) + (xcd - r) * q) + off; }
        u.pm = t0 + (w >> 2); u.pn = w & 3; u.z = T[66 + u.pm]; return true;
    }
    __device__ __forceinline__ const char* a_base(const Unit& u) const { return (const char*)(A + (size_t)u.pm * 256 * lda); }
    __device__ __forceinline__ const char* b_base(const Unit& u) const { return (const char*)(Bt + ((size_t)u.z * 1024 + (size_t)u.pn * 256) * ldb); }
    __device__ __forceinline__ unsigned a_rowoff(const Unit&, int) const { return 0u; }
};

typedef f32x4 AccT[2][2][4][2];
#define EPI_ROWS_BEGIN  _Pragma("unroll") for (int ai = 0; ai < 2; ++ai) _Pragma("unroll") for (int m = 0; m < 4; ++m) { const int row = row0 + ai * 128 + m * 16;
#define EPI_ROWS_END    }
__device__ __forceinline__ u32x4 pack8(const f32x4& a, const f32x4& b) { u32x4 w; w.x = pg8::cvt_pk_bf16(a[0], a[1]); w.y = pg8::cvt_pk_bf16(a[2], a[3]); w.z = pg8::cvt_pk_bf16(b[0], b[1]); w.w = pg8::cvt_pk_bf16(b[2], b[3]); return w; }

__device__ __forceinline__ void s5_row_of(int row, int& rho, int& s) {
    if (row < RL) { const int b = row >> 11, t = row & 2047; rho = b * 128 + (t >> 4); s = t & 15; }
    else { const int rc = row - RL, b = rc >> 8, t = rc & 255; rho = 1024 + b * 16 + (t >> 4); s = t & 15; }
}
struct EpiG1 {
    static constexpr bool IDEMP = true;
    static constexpr bool PERM = true;
    unsigned char* ck; const float* gqn; const float* gkn;
    bf16* gtc;
    __device__ __forceinline__ void operator()(const AccT& acc, const Unit& u, int wr, int wc, int fr, int fq) const {
        const int pn = u.pn, row0 = u.pm * 256 + wr * 64 + fr, cin = wc * 32 + 8 * fq;
        if (pn == 1 || pn == 2) {
            bf16* AS5 = (bf16*)(ck + C_AS5);
            EPI_ROWS_BEGIN
                int rho, s; s5_row_of(row, rho, s);
#pragma unroll
                for (int bj = 0; bj < 2; ++bj) { const int c512 = (pn - 1) * 256 + bj * 128 + cin, g = c512 >> 4, n0 = c512 & 15;
                    stg<u32x4>(AS5 + ((size_t)rho * 32 + g) * 512 + s * 16 + n0, pack8(acc[ai][bj][m][0], acc[ai][bj][m][1])); }
            EPI_ROWS_END
            return;
        }
        if (pn == 24) {
            bf16* KRP = (bf16*)(ck + C_KRP);
            if (wc == 0) { EPI_ROWS_BEGIN stg<u32x4>(KRP + (size_t)row * 32 + 8 * fq, pack8(acc[ai][0][m][0], acc[ai][0][m][1])); EPI_ROWS_END }
            return;
        }
        if (pn >= 6 && pn < 10) {
            const bool isq = pn < 8; const int head = 4 * (isq ? pn - 6 : pn - 8) + wc;
            bf16* dst = (bf16*)(ck + (isq ? C_NQ : C_NK)) + head * 64 + 8 * fq; const float* gn = isq ? gqn : gkn;
            f32x4 g[2][2];
#pragma unroll
            for (int bj = 0; bj < 2; ++bj)
#pragma unroll
                for (int n = 0; n < 2; ++n) g[bj][n] = ldg<f32x4>(gn + bj * 32 + 8 * fq + 4 * n);
            const float osc = isq ? 0.125f * LOG2E : 1.0f;
            EPI_ROWS_BEGIN
                float ss = 0.f;
#pragma unroll
                for (int bj = 0; bj < 2; ++bj)
#pragma unroll
                    for (int n = 0; n < 2; ++n) { const f32x4 v = acc[ai][bj][m][n]; ss += v[0] * v[0] + v[1] * v[1] + v[2] * v[2] + v[3] * v[3]; }
                ss = shx_sum<16>(ss); ss = shx_sum<32>(ss);
                const float sc = rsqrtf(ss * (1.0f / 64.0f) + RMS_EPS) * osc;
#pragma unroll
                for (int bj = 0; bj < 2; ++bj) stg<u32x4>(dst + (size_t)row * 512 + bj * 32, pack8(acc[ai][bj][m][0] * sc * g[bj][0], acc[ai][bj][m][1] * sc * g[bj][1]));
            EPI_ROWS_END
            return;
        }
        bf16* dst; int ld, col0; bool sig = false; float* ssq = nullptr; int ssld = 0;
        if (pn == 0) { dst = (bf16*)(ck + C_KVL); ld = 256; col0 = 0; ssq = (float*)(ck + C_SSKV) + wc; ssld = 4; }
        else if (pn < 6) { dst = (bf16*)(ck + C_QL); ld = 768; col0 = (pn - 3) * 256; ssq = (float*)(ck + C_SSQL) + (pn - 3) * 4 + wc; ssld = 12; }
        else if (pn < 12) { dst = (bf16*)(ck + C_NV); ld = 512; col0 = (pn - 10) * 256; }
        else { dst = u.pm >= 64 ? gtc : (bf16*)(ck + C_GT); ld = 3072; col0 = (pn - 12) * 256; sig = true; }
        EPI_ROWS_BEGIN
            float ss = 0.f;
#pragma unroll
            for (int bj = 0; bj < 2; ++bj) {
                f32x4 v0 = acc[ai][bj][m][0], v1 = acc[ai][bj][m][1];
                if (sig) {
#pragma unroll
                    for (int j = 0; j < 4; ++j) { v0[j] = sigmoidf(v0[j]); v1[j] = sigmoidf(v1[j]); } }
                ss += v0[0] * v0[0] + v0[1] * v0[1] + v0[2] * v0[2] + v0[3] * v0[3] + v1[0] * v1[0] + v1[1] * v1[1] + v1[2] * v1[2] + v1[3] * v1[3];
                stg<u32x4>(dst + (size_t)row * ld + col0 + bj * 128 + cin, pack8(v0, v1));
            }
            if (ssq) { ss = shx_sum<16>(ss); ss = shx_sum<32>(ss); if (fq == 0) stg<float>(ssq + (size_t)row * ssld, ss); }
        EPI_ROWS_END
    }
};
struct EpiStore {
    static constexpr bool IDEMP = true;
    static constexpr bool PERM = true;
    bf16* D0; bf16* D1; int ld, split;
    __device__ __forceinline__ void operator()(const AccT& acc, const Unit& u, int wr, int wc, int fr, int fq) const {
        const int row0 = u.pm * 256 + wr * 64 + fr, cin = wc * 32 + 8 * fq;
        bf16* dst = u.pn < split ? D0 : D1; const int col0 = (u.pn < split ? u.pn : u.pn - split) * 256;
        EPI_ROWS_BEGIN
#pragma unroll
            for (int bj = 0; bj < 2; ++bj) stg<u32x4>(dst + (size_t)row * ld + col0 + bj * 128 + cin, pack8(acc[ai][bj][m][0], acc[ai][bj][m][1]));
        EPI_ROWS_END
    }
};
template <int NP> struct EpiStoreRs {
    static constexpr bool IDEMP = true;
    static constexpr bool PERM = true;
    bf16* D0; bf16* D1; int ld, split; const float* ssq; float inv_width;
    __device__ __forceinline__ void operator()(const AccT& acc, const Unit& u, int wr, int wc, int fr, int fq) const {
        const int row0 = u.pm * 256 + wr * 64 + fr, cin = wc * 32 + 8 * fq;
        bf16* dst = u.pn < split ? D0 : D1; const int col0 = (u.pn < split ? u.pn : u.pn - split) * 256;
        float rs[2][4];
#pragma unroll
        for (int ai = 0; ai < 2; ++ai)
#pragma unroll
            for (int m = 0; m < 4; ++m) { const float* p = ssq + (size_t)(row0 + ai * 128 + m * 16) * NP; float t = 0.f;
#pragma unroll
                for (int k = 0; k < NP; k += 4) { const f32x4 q = ldg<f32x4>(p + k); t += (q[0] + q[1]) + (q[2] + q[3]); }
                rs[ai][m] = rsqrtf(t * inv_width + RMS_EPS); }
        EPI_ROWS_BEGIN
            const float r = rs[ai][m];
#pragma unroll
            for (int bj = 0; bj < 2; ++bj) stg<u32x4>(dst + (size_t)row * ld + col0 + bj * 128 + cin, pack8(acc[ai][bj][m][0] * r, acc[ai][bj][m][1] * r));
        EPI_ROWS_END
    }
};
struct EpiS5S {
    static constexpr bool IDEMP = true;
    static constexpr bool PERM = false;
    float* SS;
    __device__ __forceinline__ void operator()(const AccT& acc, const Unit& u, int wr, int wc, int fr, int fq) const {
        const int row0 = u.pm * 256 + wr * 64 + fr, cin = wc * 32 + 4 * fq;
        EPI_ROWS_BEGIN
#pragma unroll
            for (int bj = 0; bj < 2; ++bj)
#pragma unroll
                for (int n = 0; n < 2; ++n) stg<f32x4>(SS + ((size_t)row * 32 + u.pn) * 256 + bj * 128 + cin + 16 * n, acc[ai][bj][m][n]);
        EPI_ROWS_END
    }
};
struct EpiS5Y {
    static constexpr bool IDEMP = true;
    static constexpr bool PERM = true;
    bf16* YG; bf16* YGc;
    __device__ __forceinline__ void operator()(const AccT& acc, const Unit& u, int wr, int wc, int fr, int fq) const {
        const int row0 = u.pm * 256 + wr * 64 + fr, cin = wc * 32 + 8 * fq, g = u.pn;
        EPI_ROWS_BEGIN
            const int rho = row;
            if (rho < 1152) {
                int base; bf16* yg = YG; if (rho < 1024) base = (rho >> 7) * 2048 + (rho & 127) * 16; else { base = ((rho - 1024) >> 4) * 256 + ((rho - 1024) & 15) * 16; yg = YGc; }
#pragma unroll
                for (int bj = 0; bj < 2; ++bj) { const int col = bj * 128 + cin, t = col >> 4, n0 = col & 15;
                    f32x4 v0 = acc[ai][bj][m][0], v1 = acc[ai][bj][m][1];
#pragma unroll
                    for (int j = 0; j < 4; ++j) { v0[j] = gelu_tanh(v0[j]); v1[j] = gelu_tanh(v1[j]); }
                    stg<u32x4>(yg + (size_t)(base + t) * 512 + g * 16 + n0, pack8(v0, v1)); }
            }
        EPI_ROWS_END
    }
};
template <int MODE> struct EpiPair {
    static constexpr bool IDEMP = true;
    static constexpr bool PERM = true;
    bf16* Dst; int ld;
    __device__ __forceinline__ void operator()(const AccT& acc, const Unit& u, int wr, int wc, int fr, int fq) const {
        const int row0 = u.pm * 256 + wr * 64 + fr, cin = wc * 32 + 8 * fq;
        EPI_ROWS_BEGIN
            f32x4 r0, r1;
#pragma unroll
            for (int j = 0; j < 4; ++j) {
                const float a0 = acc[ai][0][m][0][j], a1 = acc[ai][0][m][1][j], b0 = acc[ai][1][m][0][j], b1 = acc[ai][1][m][1][j];
                if (MODE == 0) { r0[j] = a0 * sigmoidf(b0); r1[j] = a1 * sigmoidf(b1); }
                else { r0[j] = a0 * sigmoidf(a0) * b0; r1[j] = a1 * sigmoidf(a1) * b1; }
            }
            stg<u32x4>(Dst + (size_t)row * ld + u.pn * 128 + cin, pack8(r0, r1));
        EPI_ROWS_END
    }
};
struct EpiMerge {
    static constexpr bool IDEMP = false;
    static constexpr bool PERM = true;
    const bf16* GT; bf16* YMB;
    __device__ __forceinline__ void operator()(const AccT& acc, const Unit& u, int wr, int wc, int fr, int fq) const {
        const int row0 = u.pm * 256 + wr * 64 + fr, cin = wc * 32 + 8 * fq, z = u.z;
        if (z == 0) {
#pragma unroll
            for (int ai = 0; ai < 2; ++ai) {
                u32x4 gw[4][2];
#pragma unroll
                for (int m = 0; m < 4; ++m)
#pragma unroll
                    for (int bj = 0; bj < 2; ++bj) gw[m][bj] = ldg<u32x4>(GT + (size_t)(row0 + ai * 128 + m * 16) * 3072 + u.pn * 256 + bj * 128 + cin);
#pragma unroll
                for (int m = 0; m < 4; ++m)
#pragma unroll
                    for (int bj = 0; bj < 2; ++bj) { const u32x4 g = gw[m][bj]; f32x4 v0 = acc[ai][bj][m][0], v1 = acc[ai][bj][m][1];
                        v0[0] *= bflo(g.x); v0[1] *= bfhi(g.x); v0[2] *= bflo(g.y); v0[3] *= bfhi(g.y); v1[0] *= bflo(g.z); v1[1] *= bfhi(g.z); v1[2] *= bflo(g.w); v1[3] *= bfhi(g.w);
                        stg<u32x4>(YMB + (size_t)(row0 + ai * 128 + m * 16) * 1024 + u.pn * 256 + bj * 128 + cin, pack8(v0, v1)); }
            }
            return;
        }
#pragma unroll
        for (int ai = 0; ai < 2; ++ai) {
            u32x4 gw[4][2], yp[4][2];
#pragma unroll
            for (int m = 0; m < 4; ++m)
#pragma unroll
                for (int bj = 0; bj < 2; ++bj) { const int row = row0 + ai * 128 + m * 16, col = u.pn * 256 + bj * 128 + cin;
                    gw[m][bj] = ldg<u32x4>(GT + (size_t)row * 3072 + z * 1024 + col); yp[m][bj] = ldg<u32x4>(YMB + (size_t)row * 1024 + col); }
#pragma unroll
            for (int m = 0; m < 4; ++m)
#pragma unroll
                for (int bj = 0; bj < 2; ++bj) { const u32x4 g = gw[m][bj], y = yp[m][bj]; f32x4 v0 = acc[ai][bj][m][0], v1 = acc[ai][bj][m][1];
                    v0[0] = v0[0] * bflo(g.x) + bflo(y.x); v0[1] = v0[1] * bfhi(g.x) + bfhi(y.x); v0[2] = v0[2] * bflo(g.y) + bflo(y.y); v0[3] = v0[3] * bfhi(g.y) + bfhi(y.y);
                    v1[0] = v1[0] * bflo(g.z) + bflo(y.z); v1[1] = v1[1] * bfhi(g.z) + bfhi(y.z); v1[2] = v1[2] * bflo(g.w) + bflo(y.w); v1[3] = v1[3] * bfhi(g.w) + bfhi(y.w);
                    stg<u32x4>(YMB + (size_t)(row0 + ai * 128 + m * 16) * 1024 + u.pn * 256 + bj * 128 + cin, pack8(v0, v1)); }
        }
    }
};
struct EpiOut {
    static constexpr bool IDEMP = false;
    static constexpr bool PERM = false;
    const float* xl_old; const float* xc_old; float* xl_new; float* xc_new; const float* MODL; int b0;
    __device__ __forceinline__ void operator()(const AccT& acc, const Unit& u, int wr, int wc, int fr, int fq) const {
        const int row0 = u.pm * 256 + wr * 64 + fr, cin = wc * 32 + 4 * fq, trow = u.pm * 256;
        const float* xo; float* xn; int mrow;
        if (b0 < 0) { xo = xc_old + (size_t)trow * 1024; xn = xc_new + (size_t)trow * 1024; mrow = 32; }
        else if (trow < RL) { const size_t tok = (size_t)(b0 + (trow >> 11)) * 2048 + (trow & 2047); xo = xl_old + tok * 1024; xn = xl_new + tok * 1024; mrow = b0 + (trow >> 11); }
        else { const int rc = trow - RL; const size_t tok = (size_t)(b0 + (rc >> 8)) * 256 + (rc & 255); xo = xc_old + tok * 1024; xn = xc_new + tok * 1024; mrow = 32; }
        const float* gt = MODL + (size_t)mrow * 6144 + 2 * 1024 + u.pn * 256 + cin;
        f32x4 g[2][2];
#pragma unroll
        for (int bj = 0; bj < 2; ++bj)
#pragma unroll
            for (int n = 0; n < 2; ++n) g[bj][n] = ldg<f32x4>(gt + bj * 128 + 16 * n);
#pragma unroll
        for (int ai = 0; ai < 2; ++ai)
#pragma unroll
            for (int mp = 0; mp < 2; ++mp) {
                f32x4 xv[2][2][2];
#pragma unroll
                for (int mm = 0; mm < 2; ++mm)
#pragma unroll
                    for (int bj = 0; bj < 2; ++bj)
#pragma unroll
                        for (int n = 0; n < 2; ++n) xv[mm][bj][n] = ldg<f32x4>(xo + (size_t)(row0 - trow + ai * 128 + (2 * mp + mm) * 16) * 1024 + u.pn * 256 + bj * 128 + cin + 16 * n);
#pragma unroll
                for (int mm = 0; mm < 2; ++mm)
#pragma unroll
                    for (int bj = 0; bj < 2; ++bj)
#pragma unroll
                        for (int n = 0; n < 2; ++n) stg<f32x4>(xn + (size_t)(row0 - trow + ai * 128 + (2 * mp + mm) * 16) * 1024 + u.pn * 256 + bj * 128 + cin + 16 * n, xv[mm][bj][n] + g[bj][n] * acc[ai][bj][2 * mp + mm][n]);
            }
    }
};
struct EpiDown {
    static constexpr bool IDEMP = false;
    static constexpr bool PERM = false;
    const int* rowtok; const float* roww; float* xl; float* xc; const float* MODL; float wscale;
    __device__ __forceinline__ void operator()(const AccT& acc, const Unit& u, int wr, int wc, int fr, int fq) const {
        const int row0 = u.pm * 256 + wr * 64 + fr, cin = wc * 32 + 4 * fq, cbase = u.pn * 256 + cin;
        int tk[2][4]; float ww[2][4];
#pragma unroll
        for (int ai = 0; ai < 2; ++ai)
#pragma unroll
            for (int m = 0; m < 4; ++m) { const int row = row0 + ai * 128 + m * 16; tk[ai][m] = ldg<int>(rowtok + row); ww[ai][m] = ldg<float>(roww + row) * wscale; }
#pragma unroll
        for (int ai = 0; ai < 2; ++ai)
#pragma unroll
            for (int mp = 0; mp < 2; ++mp) {
                f32x4 xv[2][2][2], gv[2][2][2]; float* xp[2];
#pragma unroll
                for (int mm = 0; mm < 2; ++mm) { const int tok = tk[ai][2 * mp + mm]; const int t0 = tok < 0 ? 0 : tok;
                    int mrow; if (t0 < NTOK_LAT) { xp[mm] = xl + (size_t)t0 * 1024 + cbase; mrow = t0 >> 11; } else { xp[mm] = xc + (size_t)(t0 - NTOK_LAT) * 1024 + cbase; mrow = 32; }
                    const float* gt = MODL + (size_t)mrow * 6144 + 5 * 1024 + cbase;
#pragma unroll
                    for (int bj = 0; bj < 2; ++bj)
#pragma unroll
                        for (int n = 0; n < 2; ++n) { xv[mm][bj][n] = ldg<f32x4>(xp[mm] + bj * 128 + 16 * n); gv[mm][bj][n] = ldg<f32x4>(gt + bj * 128 + 16 * n); } }
#pragma unroll
                for (int mm = 0; mm < 2; ++mm) { const int m = 2 * mp + mm;
                    if (tk[ai][m] >= 0) { const float w = ww[ai][m];
#pragma unroll
                        for (int bj = 0; bj < 2; ++bj)
#pragma unroll
                            for (int n = 0; n < 2; ++n) stg<f32x4>(xp[mm] + bj * 128 + 16 * n, xv[mm][bj][n] + (gv[mm][bj][n] * w) * acc[ai][bj][m][n]); } }
            }
    }
};

struct EpiDownY {
    static constexpr bool IDEMP = true;
    static constexpr bool PERM = true;
    const int* rowtok; const float* roww; bf16* Y; int nt0;
    __device__ __forceinline__ void operator()(const AccT& acc, const Unit& u, int wr, int wc, int fr, int fq) const {
        const int row0 = u.pm * 256 + wr * 64 + fr, cin = wc * 32 + 8 * fq;
        bf16* Yp = Y + (u.pm < nt0 ? (size_t)0 : (size_t)NTOK * 1024) + u.pn * 256 + cin;
        int tk[2][4]; float ww[2][4];
#pragma unroll
        for (int ai = 0; ai < 2; ++ai)
#pragma unroll
            for (int m = 0; m < 4; ++m) { const int row = row0 + ai * 128 + m * 16; tk[ai][m] = ldg<int>(rowtok + row); ww[ai][m] = ldg<float>(roww + row); }
#pragma unroll
        for (int ai = 0; ai < 2; ++ai)
#pragma unroll
            for (int m = 0; m < 4; ++m) if (tk[ai][m] >= 0) { const float w = ww[ai][m];
#pragma unroll
                for (int bj = 0; bj < 2; ++bj) stg<u32x4>(Yp + (size_t)tk[ai][m] * 1024 + bj * 128, pack8(acc[ai][bj][m][0] * w, acc[ai][bj][m][1] * w)); }
    }
};

__device__ __forceinline__ void tr_item(const float* W, int K, int Nsrc, int scol0, const float* kscale, bf16* WT, int drow0, int k0, LAS float* scr, int lane) {
#pragma unroll
    for (int i = 0; i < 8; ++i) { const int kk = 8 * i + (lane >> 3), n4 = (lane & 7) * 4;
        f32x4 v = {0.f, 0.f, 0.f, 0.f}; if (scol0 >= 0) { v = ldg<f32x4>(W + (size_t)(k0 + kk) * Nsrc + scol0 + n4); if (kscale) v = v * ldg<float>(kscale + k0 + kk); }
        scr[kk * 33 + n4] = v[0]; scr[kk * 33 + n4 + 1] = v[1]; scr[kk * 33 + n4 + 2] = v[2]; scr[kk * 33 + n4 + 3] = v[3]; }
    asm volatile("s_waitcnt lgkmcnt(0)" ::: "memory");
    const int c = lane & 7;
#pragma unroll
    for (int j = 0; j < 4; ++j) { const int n = (lane >> 3) + 8 * j; const LAS float* s = scr + (8 * c) * 33 + n;
        u32x4 o; o.x = pk2(s[0 * 33], s[1 * 33]); o.y = pk2(s[2 * 33], s[3 * 33]); o.z = pk2(s[4 * 33], s[5 * 33]); o.w = pk2(s[6 * 33], s[7 * 33]);
        stg<u32x4>(WT + (size_t)(drow0 + n) * K + k0 + 8 * c, o); }
    asm volatile("s_waitcnt lgkmcnt(0)" ::: "memory");
}
__device__ __forceinline__ int win_src_col(int n) {
    if (n < 256) return n;
    if (n < 768) return 1312 + (n - 256);
    if (n < 1536) return 1824 + (n - 768);
    if (n < 2560) {
        const int base = n < 2048 ? 2592 : 288, r = n < 2048 ? n - 1536 : n - 2048, t = r >> 8, c = r & 255;
        return base + (4 * t + ((c & 127) >> 5)) * 64 + (c >> 7) * 32 + (c & 31); }
    if (n < 3072) return 800 + (n - 2560);
    if (n < 6144) return 3104 + (n - 3072);
    if (n < 6176) return 256 + (n - 6144);
    return -1;
}
__device__ __forceinline__ int pair_src_col(int n) { const int pn = n >> 8, jj = n & 255; return jj < 128 ? 128 * pn + jj : 512 + 128 * pn + (jj - 128); }

__device__ __forceinline__ void prologue_transposes(Frame& F, int cu_lo) {
    LAS float* scr = (LAS float*)(F.lds + F.wave * 16384);
    const int gw = (F.c - cu_lo) * 8 + F.wave, NGW = (F.G - cu_lo) * 8;
    constexpr int I_IN = (NINP / 32) * 16, I_UQ = 24 * 12, I_UKV = 32 * 4, I_GLU = 32 * 8, I_BR = 3 * 32 * 8, I_OUT = 32 * 16, I_UP = 32 * 32 * 16, I_DN = 32 * 32 * 8;
    constexpr int PER_L = I_IN + I_UQ + I_UKV + I_GLU + I_BR + I_OUT;
    for (int it = gw; it < 2 * PER_L; it += NGW) {
        const int l = it / PER_L; int r = it % PER_L;
        if (r < I_IN) { const int nb = r / 16, kb = r % 16; tr_item(F.in[7] + (size_t)l * 1024 * 6176, 1024, 6176, win_src_col(nb * 32), nullptr, (bf16*)(F.ws + WS_WINT) + (size_t)l * NINP * 1024, nb * 32, kb * 64, scr, F.lane); continue; } r -= I_IN;
        if (r < I_UQ) { const int nb = r / 12, kb = r % 12; tr_item(F.in[9] + (size_t)l * 768 * 768, 768, 768, nb * 32, F.in[8] + l * 768, (bf16*)(F.ws + WS_UQT) + (size_t)l * 768 * 768, nb * 32, kb * 64, scr, F.lane); continue; } r -= I_UQ;
        if (r < I_UKV) { const int nb = r / 4, kb = r % 4, n = nb * 32; const int sc = n < 512 ? (n >> 6) * 128 + (n & 63) : ((n - 512) >> 6) * 128 + 64 + (n & 63);
            tr_item(F.in[11] + (size_t)l * 256 * 1024, 256, 1024, sc, F.in[10] + l * 256, (bf16*)(F.ws + WS_UKVT) + (size_t)l * 1024 * 256, n, kb * 64, scr, F.lane); continue; } r -= I_UKV;
        if (r < I_GLU) { const int nb = r / 8, kb = r % 8; tr_item(F.in[25] + (size_t)l * 512 * 1024, 512, 1024, pair_src_col(nb * 32), nullptr, (bf16*)(F.ws + WS_GLUT) + (size_t)l * 1024 * 512, nb * 32, kb * 64, scr, F.lane); continue; } r -= I_GLU;
        if (r < I_BR) { const int z = r / 256, q = r % 256, nb = q / 8, kb = q % 8; tr_item(F.in[26] + ((size_t)l * 3 + z) * 512 * 1024, 512, 1024, nb * 32, nullptr, (bf16*)(F.ws + WS_BRT) + ((size_t)l * 3 + z) * 1024 * 512, nb * 32, kb * 64, scr, F.lane); continue; } r -= I_BR;
        { const int nb = r / 16, kb = r % 16; tr_item(F.in[27] + (size_t)l * 1024 * 1024, 1024, 1024, nb * 32, nullptr, (bf16*)(F.ws + WS_OUTT) + (size_t)l * 1024 * 1024, nb * 32, kb * 64, scr, F.lane); }
    }
}
constexpr int MOE_I_UP = 32 * 32 * 16, MOE_I_DN = 32 * 32 * 8, MOE_ITEMS = MOE_I_UP + MOE_I_DN;
__device__ __forceinline__ void tr_moe_items(Frame& F, int l, int first, int count, int cu_lo) {
    if (F.c < cu_lo) return;
    __syncthreads();
    LAS float* scr = (LAS float*)(F.lds + F.wave * 16384);
    const int gw = (F.c - cu_lo) * 8 + F.wave, NGW = (F.G - cu_lo) * 8;
#pragma nounroll
    for (int it = first + gw; it < first + count; it += NGW) {
        if (it < MOE_I_UP) { const int e = it / 512, q = it % 512, nb = q / 16, kb = q % 16; tr_item(F.in[33] + ((size_t)l * 32 + e) * 1024 * 1024, 1024, 1024, pair_src_col(nb * 32), nullptr, (bf16*)(F.ws + WS_UPT) + ((size_t)l * 32 + e) * 1024 * 1024, nb * 32, kb * 64, scr, F.lane); }
        else { const int r = it - MOE_I_UP, e = r / 256, q = r % 256, nb = q / 8, kb = q % 8; tr_item(F.in[34] + ((size_t)l * 32 + e) * 512 * 1024, 512, 1024, nb * 32, nullptr, (bf16*)(F.ws + WS_DOWNT) + ((size_t)l * 32 + e) * 1024 * 512, nb * 32, kb * 64, scr, F.lane); }
    }
}
__device__ __forceinline__ void prologue_small(Frame& F, int cu_lo) {
    const int gt = (F.c - cu_lo) * 512 + F.tid, NT = (F.G - cu_lo) * 512;
    float* ROPE = (float*)(F.ws + WS_ROPE);
    for (int i = gt; i < 2048 * 16; i += NT) { const int t = i >> 4, a = (i >> 3) & 1, f = i & 7;
        const float inv = powf(10000.0f, -(float)f / 8.0f); const float pos = a == 0 ? (float)(t >> 6) : (float)(t & 63); const float ang = pos * inv;
        ROPE[2 * i] = cosf(ang); ROPE[2 * i + 1] = sinf(ang); }
    float* WGT = (float*)(F.ws + WS_WGT); float* WET = (float*)(F.ws + WS_WET);
    for (int i = gt; i < 2 * 4 * 1024; i += NT) { const int l = i / 4096, e = (i >> 10) & 3, k = i & 1023; WGT[i] = F.in[29][((size_t)l * 1024 + k) * 4 + e]; }
    for (int i = gt; i < 2 * 32 * 1024; i += NT) { const int l = i / 32768, e = (i >> 10) & 31, k = i & 1023; WET[i] = F.in[31][((size_t)l * 1024 + k) * 32 + e]; }
}
__device__ __forceinline__ void prologue_mod(Frame& F, int cu_lo) {
    LAS float* SC = (LAS float*)F.lds;
    __syncthreads();
#pragma unroll 11
    for (int q = 0; q < 66; ++q) { const int i = F.tid + 512 * q, r = i >> 10, k = i & 1023; const float v = r < 32 ? ldg<float>(F.in[1] + r * 1024 + k) : ldg<float>(F.in[3] + k); SC[i] = v * sigmoidf(v); }
    __syncthreads();
    float* MODP = (float*)(F.ws + WS_MODP);
    const int gw = (F.c - cu_lo) * 8 + F.wave, NGW = (F.G - cu_lo) * 8;
    for (int task = gw; task < 2 * 96 * 8; task += NGW) {
        const int ks = task & 7, nb = (task >> 3) % 96, l = task / 768; const int n = nb * 64 + F.lane;
        f32x2 acc[33];
#pragma unroll
        for (int r = 0; r < 33; ++r) acc[r] = (f32x2){0.f, 0.f};
        const float* Wl = F.in[4] + (size_t)l * 1024 * 6144;
#pragma nounroll
        for (int kb = 0; kb < 4; ++kb) { const int k0 = ks * 128 + kb * 32;
            const float* Wk = Wl + (size_t)k0 * 6144;
            f32x2 w[16];
#pragma unroll
            for (int j = 0; j < 16; ++j) { w[j][0] = ldg<float>(Wk + (2 * j) * 6144 + n); w[j][1] = ldg<float>(Wk + (2 * j + 1) * 6144 + n); }
            const LAS float* s0 = SC + k0; const LAS float* s1 = s0 + 16 * 1024; const LAS float* s2 = s0 + 32 * 1024;
            asm volatile("" : "+v"(s0), "+v"(s1), "+v"(s2));
#pragma unroll
            for (int j4 = 0; j4 < 8; ++j4) {
#pragma unroll
                for (int r = 0; r < 33; ++r) { const f32x4 sv = *(const LAS f32x4*)((r < 16 ? s0 : (r < 32 ? s1 : s2)) + (r & 15) * 1024 + 4 * j4);
                    acc[r] += (f32x2){sv[0], sv[1]} * w[2 * j4]; acc[r] += (f32x2){sv[2], sv[3]} * w[2 * j4 + 1]; } } }
#pragma unroll
        for (int r = 0; r < 33; ++r) MODP[(((size_t)ks * 2 + l) * 33 + r) * 6144 + n] = acc[r][0] + acc[r][1];
    }
    __syncthreads();
}
__device__ __forceinline__ void prologue_mod_final(Frame& F) {
    const float* MODP = (const float*)(F.ws + WS_MODP);
    for (int i = F.c * 512 + F.tid; i < 2 * 33 * 6144; i += F.G * 512) { const int l = i / (33 * 6144), n = i % 6144;
        float s = F.in[5][l * 6144 + n];
#pragma unroll
        for (int ks = 0; ks < 8; ++ks) s += MODP[(size_t)ks * 2 * 33 * 6144 + i];
        F.MOD[i] = s; }
}
__device__ __forceinline__ void prologue_s5(Frame& F, int l, int g) {
    LAS float* AP = (LAS float*)F.lds;
    LAS float* BB = AP + 2 * 17 * 64 * 2;
    LAS float* CC = BB + 2 * 64 * 16 * 2;
    LAS float* KJ = CC + 2 * 16 * 64 * 2;
    __syncthreads();
    const float* a_re = F.in[17]; const float* a_im = F.in[18]; const float* ldt = F.in[19]; const float* b_re = F.in[20]; const float* b_im = F.in[21];
    const float* c_re = F.in[22]; const float* c_im = F.in[23]; const float* dsk = F.in[24];
    for (int i = F.tid; i < 2 * 17 * 64; i += 512) { const int dir = i / (17 * 64), j = (i / 64) % 17, p = i & 63;
        const size_t ia = (((size_t)l * 2 + dir) * 32 + g) * 64 + p;
        const float lre = fminf(a_re[ia], -1e-4f), lim = a_im[ia], dt = expf(ldt[((size_t)l * 2 + dir) * 32 + g]);
        const float mag = expf((float)j * (lre * dt)); const float ang = (float)j * (lim * dt);
        AP[2 * i] = mag * cosf(ang); AP[2 * i + 1] = mag * sinf(ang); }
    for (int i = F.tid; i < 2 * 64 * 16; i += 512) { const int dir = i / 1024, p = (i >> 4) & 63, m = i & 15;
        const size_t ia = (((size_t)l * 2 + dir) * 32 + g) * 64 + p;
        const float lre = fminf(a_re[ia], -1e-4f), lim = a_im[ia], dt = expf(ldt[((size_t)l * 2 + dir) * 32 + g]);
        const float mag = expf(lre * dt), abr = mag * cosf(lim * dt), abi = mag * sinf(lim * dt);
        const float den = lre * lre + lim * lim, nre = abr - 1.0f;
        const float fre = (nre * lre + abi * lim) / den, fim = (abi * lre - nre * lim) / den;
        const float br = b_re[ia * 16 + m], bi = b_im[ia * 16 + m];
        BB[2 * i] = fre * br - fim * bi; BB[2 * i + 1] = fre * bi + fim * br; }
    for (int i = F.tid; i < 2 * 16 * 64; i += 512) { const int dir = i / 1024, n = (i >> 6) & 15, p = i & 63;
        const size_t ic = ((((size_t)l * 2 + dir) * 32 + g) * 16 + n) * 64 + p;
        CC[2 * i] = c_re[ic]; CC[2 * i + 1] = c_im[ic]; }
    __syncthreads();
    { const int n = (F.tid >> 4) & 15, m = F.tid & 15, jh = F.tid >> 8;
#pragma nounroll
        for (int dir = 0; dir < 2; ++dir) {
            float sj[8];
#pragma unroll
            for (int q = 0; q < 8; ++q) sj[q] = 0.f;
#pragma unroll 4
            for (int p = 0; p < 64; ++p) {
                const f32x2 b = *(const LAS f32x2*)(BB + ((dir * 64 + p) * 16 + m) * 2), cc = *(const LAS f32x2*)(CC + ((dir * 16 + n) * 64 + p) * 2);
                const float tr = cc[0] * b[0] - cc[1] * b[1], ti = cc[0] * b[1] + cc[1] * b[0];
#pragma unroll
                for (int q = 0; q < 8; ++q) { const f32x2 a = *(const LAS f32x2*)(AP + ((dir * 17 + jh + 2 * q) * 64 + p) * 2); sj[q] += tr * a[0] - ti * a[1]; } }
#pragma unroll
            for (int q = 0; q < 8; ++q) KJ[((dir * 16 + jh + 2 * q) * 16 + n) * 16 + m] = sj[q]; } }
    __syncthreads();
    bf16* BTY = (bf16*)(F.ws + WS_BTY) + ((size_t)l * 32 + g) * 256 * 512;
    for (int i = F.tid; i < 256 * 512; i += 512) { const int row = i >> 9, k = i & 511, t = row >> 4, n = row & 15; float v;
        if (k < 256) { const int s = k >> 4, m = k & 15; v = 0.f;
            if (t >= s) v += KJ[((0 * 16 + (t - s)) * 16 + n) * 16 + m];
            if (s >= t) v += KJ[((1 * 16 + (s - t)) * 16 + n) * 16 + m];
            if (k == row) v += dsk[l * 512 + g * 16 + n]; }
        else { const int kk = k - 256, dir = kk >> 7, im = (kk >> 6) & 1, p = kk & 63, j = dir == 0 ? t + 1 : 16 - t;
            const float ar = AP[((dir * 17 + j) * 64 + p) * 2], ai = AP[((dir * 17 + j) * 64 + p) * 2 + 1];
            const float cr = CC[((dir * 16 + n) * 64 + p) * 2], ci = CC[((dir * 16 + n) * 64 + p) * 2 + 1];
            v = im == 0 ? (cr * ar - ci * ai) : -(cr * ai + ci * ar); }
        BTY[i] = (bf16)f2bf(v); }
    bf16* BTS = (bf16*)(F.ws + WS_BTS) + ((size_t)l * 32 + g) * 256 * 256;
    for (int i = F.tid; i < 256 * 256; i += 512) { const int row = i >> 8, k = i & 255, s = k >> 4, m = k & 15, dir = row >> 7, im = (row >> 6) & 1, p = row & 63, j = dir == 0 ? 15 - s : s;
        const float ar = AP[((dir * 17 + j) * 64 + p) * 2], ai = AP[((dir * 17 + j) * 64 + p) * 2 + 1];
        const float br = BB[((dir * 64 + p) * 16 + m) * 2], bi = BB[((dir * 64 + p) * 16 + m) * 2 + 1];
        const float v = im == 0 ? (ar * br - ai * bi) : (ar * bi + ai * br);
        BTS[i] = (bf16)f2bf(v); }
    float* A16 = (float*)(F.ws + WS_A16);
    for (int i = F.tid; i < 2 * 64; i += 512) { const int dir = i >> 6, p = i & 63;
        A16[((((size_t)l * 2 + dir) * 32 + g) * 64 + p) * 2] = AP[((dir * 17 + 16) * 64 + p) * 2];
        A16[((((size_t)l * 2 + dir) * 32 + g) * 64 + p) * 2 + 1] = AP[((dir * 17 + 16) * 64 + p) * 2 + 1]; }
    __syncthreads();
}

__device__ __forceinline__ void phase_h(Frame& F, int l, int b0, const float* xl, const float* xc, int nrows) {
    bf16* HB = (bf16*)(F.ck + C_HB);
    const float* g1 = F.in[6] + l * 1024;
    const int gw = F.c * 8 + F.wave, NGW = F.G * 8;
    for (int row = gw; row < nrows; row += NGW) {
        const float* xs; int mrow;
        if (row < RL) { mrow = b0 + (row >> 11); xs = xl + ((size_t)mrow * 2048 + (row & 2047)) * 1024; }
        else { const int rc = row - RL; xs = xc + ((size_t)(b0 + (rc >> 8)) * 256 + (rc & 255)) * 1024; mrow = 32; }
        const float* md = F.MOD + ((size_t)l * 33 + mrow) * 6144;
        f32x4 v[4]; float ss = 0.f;
#pragma unroll
        for (int j = 0; j < 4; ++j) { v[j] = ldg<f32x4>(xs + 4 * F.lane + 256 * j); ss += v[j][0] * v[j][0] + v[j][1] * v[j][1] + v[j][2] * v[j][2] + v[j][3] * v[j][3]; }
        const float rstd = rsqrtf(wave_sum(ss) * (1.0f / 1024.0f) + RMS_EPS);
#pragma unroll
        for (int j = 0; j < 4; ++j) { const int col = 4 * F.lane + 256 * j;
            const f32x4 g = ldg<f32x4>(g1 + col), sh = ldg<f32x4>(md + col), sc = ldg<f32x4>(md + 1024 + col);
            const f32x4 h = (v[j] * rstd * g) * (sc + 1.0f) + sh;
            u32x2 o; o.x = pk2(h[0], h[1]); o.y = pk2(h[2], h[3]); stg<u32x2>(HB + (size_t)row * 1024 + col, o); }
    }
}
__device__ __forceinline__ void vt_item(const bf16* src, int ldsrc, bf16* dst, LAS unsigned* scr, int lane) {
    const int r8 = lane >> 3, c8 = lane & 7;
#pragma unroll
    for (int i = 0; i < 8; ++i) { const int key = 8 * i + r8; const u32x4 v = ldg<u32x4>(src + (size_t)key * ldsrc + c8 * 8);
        scr[key * 33 + c8 * 4 + 0] = v.x; scr[key * 33 + c8 * 4 + 1] = v.y; scr[key * 33 + c8 * 4 + 2] = v.z; scr[key * 33 + c8 * 4 + 3] = v.w; }
    asm volatile("s_waitcnt lgkmcnt(0)" ::: "memory");
    const LAS unsigned short* s16 = (const LAS unsigned short*)scr;
#pragma unroll
    for (int i = 0; i < 8; ++i) { const int d = 8 * i + r8; unsigned w[4];
#pragma unroll
        for (int q = 0; q < 4; ++q) { const int k0 = c8 * 8 + q * 2; w[q] = (unsigned)s16[(k0 * 33) * 2 + d] | ((unsigned)s16[((k0 + 1) * 33) * 2 + d] << 16); }
        stg<u32x4>(dst + (size_t)d * KEYS + c8 * 8, (u32x4){w[0], w[1], w[2], w[3]}); }
    asm volatile("s_waitcnt lgkmcnt(0)" ::: "memory");
}
__device__ __forceinline__ void phase_p1(Frame& F, int l, bool ctx_q) {
    bf16* KVL = (bf16*)(F.ck + C_KVL); bf16* QL = (bf16*)(F.ck + C_QL); bf16* NQ = (bf16*)(F.ck + C_NQ); bf16* NK = (bf16*)(F.ck + C_NK);
    const float* gq = F.in[14] + l * 64; const float* gk = F.in[15] + l * 64;
    const int gw = F.c * 8 + F.wave, NGW = F.G * 8, lane = F.lane;
    for (int row = gw; row < RR; row += NGW) {
        { bf16* p = KVL + (size_t)row * 256 + 4 * lane; const u32x2 w = ldg<u32x2>(p);
          const float a = bflo(w.x), b = bfhi(w.x), c = bflo(w.y), d = bfhi(w.y);
          const float rstd = rsqrtf(wave_sum(a * a + b * b + c * c + d * d) * (1.0f / 256.0f) + RMS_EPS);
          stg<u32x2>(p, (u32x2){pk2(a * rstd, b * rstd), pk2(c * rstd, d * rstd)}); }
        { bf16* p = NK + (size_t)row * 512 + 8 * lane; const u32x4 w = ldg<u32x4>(p);
          float v[8] = {bflo(w.x), bfhi(w.x), bflo(w.y), bfhi(w.y), bflo(w.z), bfhi(w.z), bflo(w.w), bfhi(w.w)}; float ss = 0.f;
#pragma unroll
          for (int j = 0; j < 8; ++j) ss += v[j] * v[j];
          ss = shx_sum<1>(ss); ss = shx_sum<2>(ss); ss = shx_sum<4>(ss);
          const float rstd = rsqrtf(ss * (1.0f / 64.0f) + RMS_EPS); const int d0 = 8 * (lane & 7);
#pragma unroll
          for (int j = 0; j < 8; ++j) v[j] *= rstd * ldg<float>(gk + d0 + j);
          stg<u32x4>(p, (u32x4){pk2(v[0], v[1]), pk2(v[2], v[3]), pk2(v[4], v[5]), pk2(v[6], v[7])}); }
        if (row < RL || ctx_q) {
            { bf16* p = QL + (size_t)row * 768 + 12 * lane; u32x2 w[3]; float v[12]; float ss = 0.f;
#pragma unroll
              for (int j = 0; j < 3; ++j) { w[j] = ldg<u32x2>(p + 4 * j); v[4 * j] = bflo(w[j].x); v[4 * j + 1] = bfhi(w[j].x); v[4 * j + 2] = bflo(w[j].y); v[4 * j + 3] = bfhi(w[j].y); }
#pragma unroll
              for (int j = 0; j < 12; ++j) ss += v[j] * v[j];
              const float rstd = rsqrtf(wave_sum(ss) * (1.0f / 768.0f) + RMS_EPS);
#pragma unroll
              for (int j = 0; j < 3; ++j) stg<u32x2>(p + 4 * j, (u32x2){pk2(v[4 * j] * rstd, v[4 * j + 1] * rstd), pk2(v[4 * j + 2] * rstd, v[4 * j + 3] * rstd)}); }
            { bf16* p = NQ + (size_t)row * 512 + 8 * lane; const u32x4 w = ldg<u32x4>(p);
              float v[8] = {bflo(w.x), bfhi(w.x), bflo(w.y), bfhi(w.y), bflo(w.z), bfhi(w.z), bflo(w.w), bfhi(w.w)}; float ss = 0.f;
#pragma unroll
              for (int j = 0; j < 8; ++j) ss += v[j] * v[j];
              ss = shx_sum<1>(ss); ss = shx_sum<2>(ss); ss = shx_sum<4>(ss);
              const float rstd = rsqrtf(ss * (1.0f / 64.0f) + RMS_EPS) * (0.125f * LOG2E); const int d0 = 8 * (lane & 7);
#pragma unroll
              for (int j = 0; j < 8; ++j) v[j] *= rstd * ldg<float>(gq + d0 + j);
              stg<u32x4>(p, (u32x4){pk2(v[0], v[1]), pk2(v[2], v[3]), pk2(v[4], v[5]), pk2(v[6], v[7])}); }
        }
    }
    const bf16* NV = (const bf16*)(F.ck + C_NV); bf16* NVT = (bf16*)(F.ck + C_NVT);
    LAS unsigned* scr = (LAS unsigned*)(F.lds + F.wave * 16384);
    for (int it = gw; it < NB * 8 * 36; it += NGW) { const int kb = it % 36, h = (it / 36) & 7, b = it / 288;
        const int srow = kb < 32 ? b * 2048 + 64 * kb : RL + b * 256 + 64 * (kb - 32);
        vt_item(NV + (size_t)srow * 512 + h * 64, 512, NVT + ((size_t)(b * 8 + h) * 64) * KEYS + 64 * kb, scr, lane); }
}
__device__ __forceinline__ void ctx_krope(Frame& F, const bf16* HBc  , const bf16* WKR  ) {
    bf16* KRP = (bf16*)(F.ck + C_KRP); const int gw = F.c * 8 + F.wave, NGW = F.G * 8, lane = F.lane;
    for (int rc = gw; rc < RC; rc += NGW) {
        const u32x4 h0 = ldg<u32x4>(HBc + (size_t)rc * 1024 + 16 * lane), h1 = ldg<u32x4>(HBc + (size_t)rc * 1024 + 16 * lane + 8);
        float hv[16] = {bflo(h0.x), bfhi(h0.x), bflo(h0.y), bfhi(h0.y), bflo(h0.z), bfhi(h0.z), bflo(h0.w), bfhi(h0.w), bflo(h1.x), bfhi(h1.x), bflo(h1.y), bfhi(h1.y), bflo(h1.z), bfhi(h1.z), bflo(h1.w), bfhi(h1.w)};
        float p[32];
#pragma unroll
        for (int jb = 0; jb < 4; ++jb) {
            u32x4 w0[8], w1[8];
#pragma unroll
            for (int j8 = 0; j8 < 8; ++j8) { w0[j8] = ldg<u32x4>(WKR + (size_t)(jb * 8 + j8) * 1024 + 16 * lane); w1[j8] = ldg<u32x4>(WKR + (size_t)(jb * 8 + j8) * 1024 + 16 * lane + 8); }
#pragma unroll
            for (int j8 = 0; j8 < 8; ++j8) { const u32x4 a0 = w0[j8], a1 = w1[j8];
                p[jb * 8 + j8] = hv[0] * bflo(a0.x) + hv[1] * bfhi(a0.x) + hv[2] * bflo(a0.y) + hv[3] * bfhi(a0.y) + hv[4] * bflo(a0.z) + hv[5] * bfhi(a0.z) + hv[6] * bflo(a0.w) + hv[7] * bfhi(a0.w)
                                + hv[8] * bflo(a1.x) + hv[9] * bfhi(a1.x) + hv[10] * bflo(a1.y) + hv[11] * bfhi(a1.y) + hv[12] * bflo(a1.z) + hv[13] * bfhi(a1.z) + hv[14] * bflo(a1.w) + hv[15] * bfhi(a1.w); }
            __builtin_amdgcn_sched_barrier(0);
        }
        float r8[8];
#pragma unroll
        for (int k = 0; k < 8; ++k) r8[k] = row_sum16(hx16(hx32(p[k], p[k + 16]), hx32(p[k + 8], p[k + 24])));
        if ((lane & 15) == 0) stg<u32x4>(KRP + (size_t)(RL + rc) * 32 + 8 * (lane >> 4), (u32x4){pk2(r8[0], r8[1]), pk2(r8[2], r8[3]), pk2(r8[4], r8[5]), pk2(r8[6], r8[7])});
    }
}
__device__ __forceinline__ void phase_p2(Frame& F, int l, bool ctx_q) {
    const int gt = F.tid >= 128 ? F.c * 384 + (F.tid - 128) : 0x7fffffff - 1024, NT = F.G * 384;
    const float* ROPE = (const float*)(F.ws + WS_ROPE);
    if (F.tid < 128) { const float* SS = (const float*)(F.ck + C_SS); bf16* AS5 = (bf16*)(F.ck + C_AS5); const float* A16 = (const float*)(F.ws + WS_A16);
      for (int i = F.c * 128 + F.tid; i < NB * 32 * 2 * 64; i += F.G * 128) { const int p = i & 63, dir = (i >> 6) & 1, g = (i >> 7) & 31, b = i >> 12;
          const float ar = A16[((((size_t)l * 2 + dir) * 32 + g) * 64 + p) * 2], ai = A16[((((size_t)l * 2 + dir) * 32 + g) * 64 + p) * 2 + 1];
          float hr = 0.f, hi = 0.f;
          for (int c0 = 0; c0 < 144; c0 += 24) {
              float sr[24], si[24]; int rho[24];
#pragma unroll
              for (int k = 0; k < 24; ++k) { const int c = c0 + k;
                  rho[k] = dir == 0 ? (c < 16 ? 1024 + b * 16 + c : b * 128 + (c - 16)) : (c < 16 ? 1024 + b * 16 + (15 - c) : b * 128 + (127 - (c - 16)));
                  const float* sp = SS + ((size_t)rho[k] * 32 + g) * 256 + dir * 128 + p; sr[k] = ldg<float>(sp); si[k] = ldg<float>(sp + 64); }
#pragma unroll
              for (int k = 0; k < 24; ++k) { bf16* ap = AS5 + ((size_t)rho[k] * 32 + g) * 512 + 256 + dir * 128 + p;
                  ap[0] = (bf16)f2bf(hr); ap[64] = (bf16)f2bf(hi);
                  const float nr = ar * hr - ai * hi + sr[k], ni = ar * hi + ai * hr + si[k]; hr = nr; hi = ni; }
          } } }
#define UNPK(PW, FA) do { const u32x4 pw_ = (PW); FA[0] = bflo(pw_.x); FA[1] = bfhi(pw_.x); FA[2] = bflo(pw_.y); FA[3] = bfhi(pw_.y); FA[4] = bflo(pw_.z); FA[5] = bfhi(pw_.z); FA[6] = bflo(pw_.w); FA[7] = bfhi(pw_.w); } while (0)
#define PK8(FA) ((u32x4){pk2(FA[0], FA[1]), pk2(FA[2], FA[3]), pk2(FA[4], FA[5]), pk2(FA[6], FA[7])})
    { const bf16* QR = (const bf16*)(F.ck + C_QR); const bf16* KN = (const bf16*)(F.ck + C_KN); const bf16* KRP = (const bf16*)(F.ck + C_KRP);
      bf16* QF = (bf16*)(F.ck + C_QF); bf16* KF = (bf16*)(F.ck + C_KF);
      const int nq = 0, ntot = RR * 8;
      LAS unsigned char* st = F.lds + F.wave * 16384;
      for (int i = gt; i < ntot; i += NT) {
          const bool isq = __builtin_amdgcn_readfirstlane(i) < nq;
          const int ii = isq ? i : i - nq, row = ii >> 3, h = ii & 7;
          int ln = F.lane; asm volatile("" : "+v"(ln));
          const int i0 = ii - ln;
          const float* gn = isq ? F.in[12] + l * 96 : F.in[13] + l * 96;
          const float osc = isq ? 0.10206207261596575f * LOG2E : 1.0f;
          bf16* dst0 = (isq ? QF : KF) + (size_t)i0 * 96;
          u32x4 w[12];
          if (isq) { const bf16* s0 = QR + (size_t)i0 * 96;
#pragma unroll
              for (int j = 0; j < 12; ++j) { const int idx = j * 64 + ln; w[j] = ldg<u32x4>(s0 + idx * 8); }
#pragma unroll
              for (int j = 0; j < 12; ++j) { const int idx = j * 64 + ln; *(LAS u32x4*)(st + 16 * (idx + idx / 12)) = w[j]; }
          } else { const bf16* s0 = KN + (size_t)i0 * 64;
#pragma unroll
              for (int j = 0; j < 8; ++j) { const int idx = j * 64 + ln; w[j] = ldg<u32x4>(s0 + idx * 8); }
#pragma unroll
              for (int c = 0; c < 4; ++c) w[8 + c] = ldg<u32x4>(KRP + (size_t)row * 32 + c * 8);
#pragma unroll
              for (int j = 0; j < 8; ++j) { const int idx = j * 64 + ln; *(LAS u32x4*)(st + 16 * idx + 80 * (idx >> 3)) = w[j]; }
          }
          asm volatile("s_waitcnt lgkmcnt(0)" ::: "memory");
          if (isq) {
#pragma unroll
              for (int c = 0; c < 12; ++c) w[c] = *(const LAS u32x4*)(st + ln * 208 + c * 16);
          } else {
#pragma unroll
              for (int c = 0; c < 8; ++c) w[c] = *(const LAS u32x4*)(st + ln * 208 + c * 16);
          }
          float ss = 0.f;
#pragma unroll
          for (int c = 0; c < 12; ++c) { float f[8]; UNPK(w[c], f);
#pragma unroll
              for (int j = 0; j < 8; ++j) ss += f[j] * f[j]; }
          const float rstd = rsqrtf(ss * (1.0f / 96.0f) + RMS_EPS);
          LAS unsigned char* mine = st + ln * 208;
#pragma unroll
          for (int c = 0; c < 8; ++c) { float f[8]; UNPK(w[c], f);
#pragma unroll
              for (int j = 0; j < 8; ++j) f[j] *= rstd * gn[8 * c + j] * osc;
              *(LAS u32x4*)(mine + c * 16) = PK8(f); }
          const float* rp = ROPE + (size_t)(row & 2047) * 32; const bool rope = row < RL;
#pragma unroll
          for (int a = 0; a < 2; ++a) { float x1[8], x2[8]; UNPK(w[8 + 2 * a], x1); UNPK(w[9 + 2 * a], x2);
#pragma unroll
              for (int f = 0; f < 8; ++f) {
                  float cs = 1.0f, sn = 0.0f; if (rope) { const f32x2 t = ldg<f32x2>(rp + (a * 8 + f) * 2); cs = t[0]; sn = t[1]; }
                  const float v1 = x1[f] * rstd * gn[64 + a * 16 + f], v2 = x2[f] * rstd * gn[64 + a * 16 + 8 + f];
                  x1[f] = (v1 * cs - v2 * sn) * osc; x2[f] = (v1 * sn + v2 * cs) * osc; }
              *(LAS u32x4*)(mine + (8 + 2 * a) * 16) = PK8(x1); *(LAS u32x4*)(mine + (9 + 2 * a) * 16) = PK8(x2); }
          asm volatile("s_waitcnt lgkmcnt(0)" ::: "memory");
          int lo = ln; asm volatile("" : "+v"(lo));
#pragma unroll
          for (int j = 0; j < 12; ++j) { const int idx = j * 64 + lo; stg<u32x4>(dst0 + idx * 8, *(const LAS u32x4*)(st + 16 * (idx + idx / 12))); }
          asm volatile("s_waitcnt lgkmcnt(0)" ::: "memory");
      } }
#undef UNPK
#undef PK8
    { int lnv; asm volatile("v_mbcnt_lo_u32_b32 %0, -1, 0\n\tv_mbcnt_hi_u32_b32 %0, -1, %0" : "=v"(lnv));
      const bf16* VV = (const bf16*)(F.ck + C_VV); bf16* VT = (bf16*)(F.ck + C_VT); LAS unsigned* scr = (LAS unsigned*)(F.lds + F.wave * 16384);
      const int gw = F.wave >= 2 ? F.c * 6 + (F.wave - 2) : 0x7fffffff - 1024, NGW = F.G * 6;
      for (int it = gw; it < NB * 8 * 36; it += NGW) { const int kb = it % 36, h = (it / 36) & 7, b = it / 288;
          const int srow = kb < 32 ? b * 2048 + 64 * kb : RL + b * 256 + 64 * (kb - 32);
          vt_item(VV + (size_t)srow * 512 + h * 64, 512, VT + ((size_t)(b * 8 + h) * 64) * KEYS + 64 * kb, scr, lnv); }
      const bf16* NV = (const bf16*)(F.ck + C_NV); bf16* NVT = (bf16*)(F.ck + C_NVT);
      for (int it = gw; it < NB * 8 * 36; it += NGW) { const int kb = it % 36, h = (it / 36) & 7, b = it / 288;
          const int srow = kb < 32 ? b * 2048 + 64 * kb : RL + b * 256 + 64 * (kb - 32);
          vt_item(NV + (size_t)srow * 512 + h * 64, 512, NVT + ((size_t)(b * 8 + h) * 64) * KEYS + 64 * kb, scr, lnv); } }
}


constexpr int AT_KROW = 208, AT_VROW = 136, AT_KB = 64 * AT_KROW, AT_VB = 64 * AT_VROW, AT_SLOT = AT_KB + AT_VB;
__device__ __forceinline__ void mla_unit(Frame& F, const bf16* Qh  , const bf16* KFh  , const bf16* VTh  ,
                                         bf16* Oh  , int b, int kt0, int kt1, const float* gq  , const float* rope0  ) {
    int lane; asm volatile("v_mbcnt_lo_u32_b32 %0, -1, 0\n\tv_mbcnt_hi_u32_b32 %0, -1, %0" : "=v"(lane));
    LAS unsigned char* lds = F.lds; const int w = F.wave, tid = lane + 64 * w, r32 = lane & 31, hh = lane >> 5;
    const int kr0 = tid / 12, kc0 = tid % 12, kr1 = (tid + 512) / 12, kc1 = (tid + 512) % 12, vd = tid >> 3, vc = tid & 7;
    u32x4 sk0, sk1, sv;
#define AT_KROWIDX(kt) ((kt) < 32 ? b * 2048 + 64 * (kt) : RL + b * 256 + 64 * ((kt) - 32))
#define AT_LOAD(kt) do { const int kr_ = AT_KROWIDX(kt); sk0 = ldg<u32x4>(KFh + (size_t)(kr_ + kr0) * 768 + kc0 * 8); if (tid < 256) sk1 = ldg<u32x4>(KFh + (size_t)(kr_ + kr1) * 768 + kc1 * 8); \
        sv = ldg<u32x4>(VTh + (size_t)vd * KEYS + 64 * (kt) + vc * 8); } while (0)
#define AT_WRITE(slot) do { LAS unsigned char* s_ = lds + (slot) * AT_SLOT; *(LAS u32x4*)(s_ + kr0 * AT_KROW + kc0 * 16) = sk0; if (tid < 256) *(LAS u32x4*)(s_ + kr1 * AT_KROW + kc1 * 16) = sk1; \
        *(LAS u32x2*)(s_ + AT_KB + vd * AT_VROW + vc * 16) = (u32x2){sv.x, sv.y}; *(LAS u32x2*)(s_ + AT_KB + vd * AT_VROW + vc * 16 + 8) = (u32x2){sv.z, sv.w}; } while (0)
    bf16x8 qf[6];
    { u32x4 raw[6];
#pragma unroll
      for (int ks = 0; ks < 6; ++ks) raw[ks] = ldg<u32x4>(Qh + (size_t)(32 * w + r32) * 768 + 16 * ks + 8 * hh);
#define AT_UNPK(W, FA) do { FA[0] = bflo(W.x); FA[1] = bfhi(W.x); FA[2] = bflo(W.y); FA[3] = bfhi(W.y); FA[4] = bflo(W.z); FA[5] = bfhi(W.z); FA[6] = bflo(W.w); FA[7] = bfhi(W.w); } while (0)
#define AT_PK8(FA) __builtin_bit_cast(bf16x8, (u32x4){pk2(FA[0], FA[1]), pk2(FA[2], FA[3]), pk2(FA[4], FA[5]), pk2(FA[6], FA[7])})
      float ss = 0.f;
#pragma unroll
      for (int ks = 0; ks < 6; ++ks) { float f[8]; AT_UNPK(raw[ks], f);
#pragma unroll
          for (int j = 0; j < 8; ++j) ss += f[j] * f[j]; }
      ss = hx32(ss, ss);
      const float rq = rsqrtf(ss * (1.0f / 96.0f) + RMS_EPS) * (0.10206207261596575f * LOG2E);
#pragma unroll
      for (int ks = 0; ks < 4; ++ks) { float f[8]; AT_UNPK(raw[ks], f); const f32x4 g0 = ldg<f32x4>(gq + 16 * ks + 8 * hh), g1 = ldg<f32x4>(gq + 16 * ks + 8 * hh + 4);
#pragma unroll
          for (int j = 0; j < 4; ++j) { f[j] *= rq * g0[j]; f[4 + j] *= rq * g1[j]; }
          qf[ks] = AT_PK8(f); }
#pragma unroll
      for (int a = 0; a < 2; ++a) { float f[8]; AT_UNPK(raw[4 + a], f); const f32x4 g0 = ldg<f32x4>(gq + 64 + 16 * a + 8 * hh), g1 = ldg<f32x4>(gq + 64 + 16 * a + 8 * hh + 4);
#pragma unroll
          for (int j = 0; j < 4; ++j) { f[j] *= rq * g0[j]; f[4 + j] *= rq * g1[j]; }
          if (rope0) { const float* rp = rope0 + (size_t)(32 * w + r32) * 32 + a * 16;
#pragma unroll
              for (int j4 = 0; j4 < 4; ++j4) { const f32x4 cs = ldg<f32x4>(rp + 4 * j4);
#pragma unroll
                  for (int e = 0; e < 2; ++e) { const int j = 2 * j4 + e; float pa = f[j], pb = f[j];
                      asm volatile("s_nop 1\n\tv_permlane32_swap_b32 %0, %1" : "+v"(pa), "+v"(pb));
                      const float pv = hh ? pa : pb;
                      f[j] = f[j] * cs[2 * e] + (hh ? pv : -pv) * cs[2 * e + 1]; } } }
          qf[4 + a] = AT_PK8(f); }
#undef AT_UNPK
#undef AT_PK8
    }
    f32x16 o0, o1;
#pragma unroll
    for (int r = 0; r < 16; ++r) { o0[r] = 0.f; o1[r] = 0.f; }
    float mrun = 0.f, lrun = 0.f;
    __syncthreads();
    AT_LOAD(kt0); AT_WRITE(0);
    __syncthreads();
    asm volatile(".rept " STR(MLA_PAD_N) "\n\ts_nop 0\n\t.endr" ::: "memory");
    for (int kt = kt0; kt < kt1; ++kt) {
        const int slot = (kt - kt0) & 1;
        if (kt + 1 < kt1) AT_LOAD(kt + 1);
        const LAS unsigned char* ks_ = lds + slot * AT_SLOT; const LAS unsigned char* vs_ = ks_ + AT_KB;
        f32x16 s0, s1;
        bf16x8 kf[12];
#pragma unroll
        for (int ks = 0; ks < 6; ++ks) { kf[2 * ks] = *(const LAS bf16x8*)(ks_ + r32 * AT_KROW + (16 * ks + 8 * hh) * 2); kf[2 * ks + 1] = *(const LAS bf16x8*)(ks_ + (32 + r32) * AT_KROW + (16 * ks + 8 * hh) * 2); }
        __builtin_amdgcn_sched_barrier(0);
#pragma unroll
        for (int ks = 0; ks < 6; ++ks) {
            if (ks == 0) { const f32x16 z16 = {}; s0 = __builtin_amdgcn_mfma_f32_32x32x16_bf16(kf[0], qf[0], z16, 0, 0, 0); s1 = __builtin_amdgcn_mfma_f32_32x32x16_bf16(kf[1], qf[0], z16, 0, 0, 0); }
            else { s0 = __builtin_amdgcn_mfma_f32_32x32x16_bf16(kf[2 * ks], qf[ks], s0, 0, 0, 0); s1 = __builtin_amdgcn_mfma_f32_32x32x16_bf16(kf[2 * ks + 1], qf[ks], s1, 0, 0, 0); }
        }
        u32x2 vfa[4][2], vfc[4][2];
#pragma unroll
        for (int kh = 0; kh < 2; ++kh)
#pragma unroll
            for (int s = 0; s < 2; ++s) { const int kk = 32 * kh + 16 * s + 4 * hh;
#pragma unroll
                for (int dt = 0; dt < 2; ++dt) { vfa[kh * 2 + s][dt] = *(const LAS u32x2*)(vs_ + (32 * dt + r32) * AT_VROW + kk * 2); vfc[kh * 2 + s][dt] = *(const LAS u32x2*)(vs_ + (32 * dt + r32) * AT_VROW + (kk + 8) * 2); } }
        __builtin_amdgcn_sched_barrier(0);
        { const f32x2 m2 = {mrun, mrun};
#pragma unroll
          for (int r = 0; r < 16; r += 2) { const f32x2 a = (f32x2){s0[r], s0[r + 1]} - m2, c = (f32x2){s1[r], s1[r + 1]} - m2; s0[r] = a[0]; s0[r + 1] = a[1]; s1[r] = c[0]; s1[r + 1] = c[1]; } }
        float ma = fmaxf(fmaxf(s0[0], s0[1]), s0[2]), mb = fmaxf(fmaxf(s1[0], s1[1]), s1[2]);
#pragma unroll
        for (int r = 3; r < 15; r += 2) { ma = fmaxf(fmaxf(ma, s0[r]), s0[r + 1]); mb = fmaxf(fmaxf(mb, s1[r]), s1[r + 1]); }
        float mx = fmaxf(fmaxf(ma, mb), fmaxf(s0[15], s1[15]));
        mx = shx_max<32>(mx);
        if (kt == kt0 || __any(mx > 8.0f)) {
            const float d = kt == kt0 ? mx : fmaxf(mx, 0.0f), alpha = fast_exp2(-d); mrun += d; lrun *= alpha;
#pragma unroll
            for (int r = 0; r < 16; ++r) { o0[r] *= alpha; o1[r] *= alpha; s0[r] -= d; s1[r] -= d; }
        }
        f32x2 rs2 = {0.f, 0.f};
#pragma unroll
        for (int r = 0; r < 16; ++r) { s0[r] = fast_exp2(s0[r]); s1[r] = fast_exp2(s1[r]); }
#pragma unroll
        for (int r = 0; r < 16; r += 2) { rs2 += (f32x2){s0[r], s0[r + 1]}; rs2 += (f32x2){s1[r], s1[r + 1]}; }
        lrun += rs2[0] + rs2[1];
#pragma unroll
        for (int kh = 0; kh < 2; ++kh)
#pragma unroll
            for (int s = 0; s < 2; ++s) {
                u32x4 pw;
                if (kh == 0) { pw.x = pg8::cvt_pk_bf16(s0[8 * s], s0[8 * s + 1]); pw.y = pg8::cvt_pk_bf16(s0[8 * s + 2], s0[8 * s + 3]); pw.z = pg8::cvt_pk_bf16(s0[8 * s + 4], s0[8 * s + 5]); pw.w = pg8::cvt_pk_bf16(s0[8 * s + 6], s0[8 * s + 7]); }
                else { pw.x = pg8::cvt_pk_bf16(s1[8 * s], s1[8 * s + 1]); pw.y = pg8::cvt_pk_bf16(s1[8 * s + 2], s1[8 * s + 3]); pw.z = pg8::cvt_pk_bf16(s1[8 * s + 4], s1[8 * s + 5]); pw.w = pg8::cvt_pk_bf16(s1[8 * s + 6], s1[8 * s + 7]); }
                const bf16x8 pb = __builtin_bit_cast(bf16x8, pw);
                {   const u32x2 a = vfa[kh * 2 + s][0], c = vfc[kh * 2 + s][0];
                    const bf16x8 vf = __builtin_bit_cast(bf16x8, (u32x4){a.x, a.y, c.x, c.y});
                    o0 = __builtin_amdgcn_mfma_f32_32x32x16_bf16(vf, pb, o0, 0, 0, 0); }
                {   const u32x2 a = vfa[kh * 2 + s][1], c = vfc[kh * 2 + s][1];
                    const bf16x8 vf = __builtin_bit_cast(bf16x8, (u32x4){a.x, a.y, c.x, c.y});
                    o1 = __builtin_amdgcn_mfma_f32_32x32x16_bf16(vf, pb, o1, 0, 0, 0); }
            }
        if (kt + 1 < kt1) AT_WRITE(slot ^ 1);
        __syncthreads();
    }
    const float ltot = shx_sum<32>(lrun), inv = 1.0f / ltot;
    bf16* orow = Oh + (size_t)(32 * w + r32) * 512;
#pragma unroll
    for (int g4 = 0; g4 < 4; ++g4) {
        stg<u32x2>(orow + 8 * g4 + 4 * hh, (u32x2){pk2(o0[4 * g4] * inv, o0[4 * g4 + 1] * inv), pk2(o0[4 * g4 + 2] * inv, o0[4 * g4 + 3] * inv)});
        stg<u32x2>(orow + 32 + 8 * g4 + 4 * hh, (u32x2){pk2(o1[4 * g4] * inv, o1[4 * g4 + 1] * inv), pk2(o1[4 * g4 + 2] * inv, o1[4 * g4 + 3] * inv)});
    }
#undef AT_KROWIDX
#undef AT_LOAD
#undef AT_WRITE
}
__device__ __forceinline__ void phase_mla(Frame& F, int l, bool ctx_q, bf16* OAc  ) {
    const float* gq = F.in[12] + l * 96; const float* ROPE = (const float*)(F.ws + WS_ROPE);
    const bf16* QF = (const bf16*)(F.ck + C_QR);        const bf16* KF = (const bf16*)(F.ck + C_KF); const bf16* VT = (const bf16*)(F.ck + C_VT); bf16* OA = (bf16*)(F.ck + C_OA);
    const int nlat = NB * 8 * 8, ntot = nlat + (ctx_q ? NB * 8 : 0);
    for (int u0 = F.c; u0 < ntot; u0 += F.G) {
        int u = u0;
        if (F.G == 256 && u0 < nlat) { const int x = u0 & 7, slot = ((u0 & 255) >> 3) + 32 * (u0 >> 8); u = ((x * 8 + (slot >> 3)) << 3) | (slot & 7); }
        if (u < nlat) { const int b = u >> 6, h = (u >> 3) & 7, qb = u & 7; const int row0 = b * 2048 + qb * 256;
            mla_unit(F, QF + (size_t)row0 * 768 + h * 96, KF + h * 96, VT + ((size_t)(b * 8 + h) * 64) * KEYS, OA + (size_t)row0 * 512 + h * 64, b, 0, 36, gq, ROPE + (size_t)(qb * 256) * 32); }
        else { const int v = u - nlat, b = v >> 3, h = v & 7; const int row0 = RL + b * 256;
            mla_unit(F, QF + (size_t)row0 * 768 + h * 96, KF + h * 96, VT + ((size_t)(b * 8 + h) * 64) * KEYS, OAc + (size_t)(b * 256) * 512 + h * 64, b, 32, 36, gq, nullptr); }
    }
    __syncthreads();
}

struct NatOps { bf16x8 k[2][2]; u32x2 v[4][2]; };
__device__ __forceinline__ void nat_load(NatOps& o, const bf16* Kp  , const bf16* VTp  , int g) {
#pragma unroll
    for (int sub = 0; sub < 2; ++sub) { o.k[sub][0] = ldg<bf16x8>(Kp + (size_t)sub * 16 * 512 + 8 * g); o.k[sub][1] = ldg<bf16x8>(Kp + (size_t)sub * 16 * 512 + 32 + 8 * g); }
#pragma unroll
    for (int dt = 0; dt < 4; ++dt) { o.v[dt][0] = ldg<u32x2>(VTp + (size_t)dt * 16 * KEYS); o.v[dt][1] = ldg<u32x2>(VTp + (size_t)dt * 16 * KEYS + 16); }
}
__device__ __forceinline__ void nat_compute(const NatOps& ops, const bf16x8 (&qf)[2], f32x4 (&o)[4], float& mrun, float& lrun, const float (&bias)[2][4], const bool (&valid)[2][4], bool masked) {
    f32x4 s[2];
#pragma unroll
    for (int sub = 0; sub < 2; ++sub) {
        s[sub] = (f32x4){0.f, 0.f, 0.f, 0.f};
        s[sub] = __builtin_amdgcn_mfma_f32_16x16x32_bf16(ops.k[sub][0], qf[0], s[sub], 0, 0, 0);
        s[sub] = __builtin_amdgcn_mfma_f32_16x16x32_bf16(ops.k[sub][1], qf[1], s[sub], 0, 0, 0);
    }
    if (masked) {
#pragma unroll
        for (int sub = 0; sub < 2; ++sub)
#pragma unroll
            for (int r = 0; r < 4; ++r) s[sub][r] = valid[sub][r] ? s[sub][r] + bias[sub][r] : -1e30f;
    }
    float mx = fmaxf(fmaxf(fmaxf(s[0][0], s[0][1]), fmaxf(s[0][2], s[0][3])), fmaxf(fmaxf(s[1][0], s[1][1]), fmaxf(s[1][2], s[1][3])));
    mx = shx_max<16>(mx); mx = shx_max<32>(mx);
    const float mn = fmaxf(mrun, mx), alpha = fast_exp2(mrun - mn); mrun = mn;
    float rs = 0.f;
#pragma unroll
    for (int sub = 0; sub < 2; ++sub)
#pragma unroll
        for (int r = 0; r < 4; ++r) { s[sub][r] = fast_exp2(s[sub][r] - mn); rs += s[sub][r]; }
    lrun = lrun * alpha + rs;
    u32x4 pw; pw.x = pg8::cvt_pk_bf16(s[0][0], s[0][1]); pw.y = pg8::cvt_pk_bf16(s[0][2], s[0][3]); pw.z = pg8::cvt_pk_bf16(s[1][0], s[1][1]); pw.w = pg8::cvt_pk_bf16(s[1][2], s[1][3]);
    const bf16x8 pb = __builtin_bit_cast(bf16x8, pw);
#pragma unroll
    for (int dt = 0; dt < 4; ++dt) {
        const bf16x8 vf = __builtin_bit_cast(bf16x8, (u32x4){ops.v[dt][0].x, ops.v[dt][0].y, ops.v[dt][1].x, ops.v[dt][1].y});
        o[dt] = o[dt] * alpha;
        o[dt] = __builtin_amdgcn_mfma_f32_16x16x32_bf16(vf, pb, o[dt], 0, 0, 0);
    }
}
constexpr int NL_KS = 144, NL_CVS = 528;
constexpr int NL_CK = 0, NL_CV = 256 * NL_KS, NL_SLOT0 = NL_CV + 64 * NL_CVS, NL_SLOTB = 2 * 64 * NL_KS, NL_RPB = NL_SLOT0 + 2 * NL_SLOTB;
__device__ __forceinline__ void nat_lds_ops(NatOps& o, const LAS unsigned char* Kt  , const LAS unsigned char* Vt  , int vstride, int qi, int g) {
#pragma unroll
    for (int sub = 0; sub < 2; ++sub) { o.k[sub][0] = *(const LAS bf16x8*)(Kt + (16 * sub + qi) * NL_KS + 16 * g); o.k[sub][1] = *(const LAS bf16x8*)(Kt + (16 * sub + qi) * NL_KS + 64 + 16 * g); }
#pragma unroll
    for (int dt = 0; dt < 4; ++dt) { o.v[dt][0] = *(const LAS u32x2*)(Vt + (16 * dt + qi) * vstride + 8 * g); o.v[dt][1] = *(const LAS u32x2*)(Vt + (16 * dt + qi) * vstride + 32 + 8 * g); }
}
__device__ __forceinline__ void nat_unit(Frame& F, const bf16* NQ, const bf16* NK, const bf16* NVT, bf16* OB, bf16* OBc, const float* rpb_h  , int b, int h, int q, bool ctx_q) {
    LAS unsigned char* lds = F.lds; const int tid = F.tid, lane = F.lane, w = F.wave, qi = lane & 15, g = lane >> 4, j = w & 3;
    LAS float* RPB = (LAS float*)(lds + NL_RPB);
    const bf16* VTb = NVT + (size_t)(b * 8 + h) * 64 * KEYS;
    __syncthreads();
    { u32x4 ck[4], cv[4];
#pragma unroll
      for (int k = 0; k < 4; ++k) { const int idx = tid + 512 * k; ck[k] = ldg<u32x4>(NK + (size_t)(RL + b * 256 + (idx >> 3)) * 512 + h * 64 + (idx & 7) * 8); cv[k] = ldg<u32x4>(VTb + (size_t)(idx >> 5) * KEYS + 2048 + (idx & 31) * 8); }
#pragma unroll
      for (int k = 0; k < 4; ++k) { const int idx = tid + 512 * k; *(LAS u32x4*)(lds + NL_CK + (idx >> 3) * NL_KS + (idx & 7) * 16) = ck[k]; *(LAS u32x4*)(lds + NL_CV + (idx >> 5) * NL_CVS + (idx & 31) * 16) = cv[k]; }
      if (tid < 15 * 31) RPB[tid] = ldg<float>(rpb_h + tid) * LOG2E; }
    bf16x8 qf[4][2]; f32x4 o[4][4]; float mrun[4], lrun[4]; int rs_[4];
#pragma unroll
    for (int i = 0; i < 4; ++i) { const int row = 8 * q + (w >> 2) + 2 * i; rs_[i] = min(max(row - 4, 0), 24);
        const bf16* qp = NQ + (size_t)(b * 2048 + row * 64 + 16 * j + qi) * 512 + h * 64;
        qf[i][0] = ldg<bf16x8>(qp + 8 * g); qf[i][1] = ldg<bf16x8>(qp + 32 + 8 * g); mrun[i] = -1e30f; lrun[i] = 0.f;
#pragma unroll
        for (int dt = 0; dt < 4; ++dt) o[i][dt] = (f32x4){0.f, 0.f, 0.f, 0.f}; }
    const int bs = min(max(16 * j - 8, 0), 32), qc = 16 * j + qi, cs = min(max(qc - 8, 0), 48);
    bool valid[2][4]; int dcl[2][4];
#pragma unroll
    for (int sub = 0; sub < 2; ++sub)
#pragma unroll
        for (int rg = 0; rg < 4; ++rg) { const int kc = bs + 16 * sub + 4 * g + rg; valid[sub][rg] = (unsigned)(kc - cs) < 16u; dcl[sub][rg] = min(max(kc - qc + 15, 0), 30); }
    const int kr_lo = min(max(8 * q - 4, 0), 24), kr_hi = min(max(8 * q + 3, 0), 24) + 7, nkr = kr_hi - kr_lo + 1;
    const int tk = tid >> 3, tc = tid & 7;
    u32x4 sk, sv;
#define NL_LOAD(kr) do { sk = ldg<u32x4>(NK + (size_t)(b * 2048 + (kr) * 64 + tk) * 512 + h * 64 + tc * 8); sv = ldg<u32x4>(VTb + (size_t)tk * KEYS + (kr) * 64 + tc * 8); } while (0)
#define NL_WRITE(slot) do { *(LAS u32x4*)(lds + NL_SLOT0 + (slot) * NL_SLOTB + tk * NL_KS + tc * 16) = sk; *(LAS u32x4*)(lds + NL_SLOT0 + (slot) * NL_SLOTB + 64 * NL_KS + tk * NL_KS + tc * 16) = sv; } while (0)
    NL_LOAD(kr_lo); NL_WRITE(0);
    __syncthreads();
    asm volatile(".rept " STR(NAT_PAD_N) "\n\ts_nop 0\n\t.endr" ::: "memory");
    for (int t = 0; t < nkr; ++t) {
        const int kr = kr_lo + t, slot = t & 1;
        if (t + 1 < nkr) NL_LOAD(kr + 1);
        const LAS unsigned char* Kt = lds + NL_SLOT0 + slot * NL_SLOTB + bs * NL_KS; const LAS unsigned char* Vt = Kt - bs * NL_KS + 64 * NL_KS + bs * 2;
        if (kr >= rs_[0] && kr < rs_[3] + 8) {
            NatOps ops; nat_lds_ops(ops, Kt, Vt, NL_KS, qi, g);
#pragma unroll
            for (int i = 0; i < 4; ++i) {
                if (kr >= rs_[i] && kr < rs_[i] + 8) {
                    const int drow = kr - (8 * q + (w >> 2) + 2 * i) + 7;
                    float bias[2][4];
#pragma unroll
                    for (int sub = 0; sub < 2; ++sub)
#pragma unroll
                        for (int rg = 0; rg < 4; ++rg) bias[sub][rg] = RPB[drow * 31 + dcl[sub][rg]];
                    nat_compute(ops, qf[i], o[i], mrun[i], lrun[i], bias, valid, true);
                }
            }
        }
        if (t + 1 < nkr) NL_WRITE(slot ^ 1);
        __syncthreads();
    }
#undef NL_LOAD
#undef NL_WRITE
    { float bias[2][4];
#pragma unroll
      for (int sub = 0; sub < 2; ++sub)
#pragma unroll
          for (int rg = 0; rg < 4; ++rg) bias[sub][rg] = 0.f;
      for (int cb = 0; cb < 8; ++cb) {
          NatOps ops; nat_lds_ops(ops, lds + NL_CK + 32 * cb * NL_KS, lds + NL_CV + 64 * cb, NL_CVS, qi, g);
#pragma unroll
          for (int i = 0; i < 4; ++i) nat_compute(ops, qf[i], o[i], mrun[i], lrun[i], bias, valid, false);
      }
#pragma unroll
      for (int i = 0; i < 4; ++i) { const int row = 8 * q + (w >> 2) + 2 * i; const size_t qrow = (size_t)(b * 2048 + row * 64 + 16 * j + qi);
          float lt = shx_sum<32>(shx_sum<16>(lrun[i])); const float inv = 1.0f / lt;
#pragma unroll
          for (int dt = 0; dt < 4; ++dt) stg<u32x2>(OB + qrow * 512 + h * 64 + 16 * dt + 4 * g, (u32x2){pk2(o[i][dt][0] * inv, o[i][dt][1] * inv), pk2(o[i][dt][2] * inv, o[i][dt][3] * inv)}); }
      if (ctx_q && w < 4) {
          const size_t qrow = (size_t)(RL + b * 256 + 16 * (4 * q + w) + qi); const bf16* qp = NQ + qrow * 512 + h * 64;
          bf16x8 cq[2]; cq[0] = ldg<bf16x8>(qp + 8 * g); cq[1] = ldg<bf16x8>(qp + 32 + 8 * g);
          f32x4 co[4]; float cm = -1e30f, cl = 0.f;
#pragma unroll
          for (int dt = 0; dt < 4; ++dt) co[dt] = (f32x4){0.f, 0.f, 0.f, 0.f};
          for (int cb = 0; cb < 8; ++cb) { NatOps ops; nat_lds_ops(ops, lds + NL_CK + 32 * cb * NL_KS, lds + NL_CV + 64 * cb, NL_CVS, qi, g); nat_compute(ops, cq, co, cm, cl, bias, valid, false); }
          float lt = shx_sum<32>(shx_sum<16>(cl)); const float inv = 1.0f / lt;
#pragma unroll
          for (int dt = 0; dt < 4; ++dt) stg<u32x2>(OBc + (qrow - RL) * 512 + h * 64 + 16 * dt + 4 * g, (u32x2){pk2(co[dt][0] * inv, co[dt][1] * inv), pk2(co[dt][2] * inv, co[dt][3] * inv)});
      } }
}
__device__ __forceinline__ void phase_nat(Frame& F, int l, bool ctx_q, bf16* OBc) {
    const bf16* NQ = (const bf16*)(F.ck + C_NQ); const bf16* NK = (const bf16*)(F.ck + C_NK); const bf16* NVT = (const bf16*)(F.ck + C_NVT); bf16* OB = (bf16*)(F.ck + C_OB);
    for (int u0 = F.c; u0 < NB * 32; u0 += F.G) { int u = u0; if (F.G == 256) { const int x = u0 & 7, j = u0 >> 3; u = ((x * 8 + (j >> 2)) << 2) | (j & 3); }
        const int b = u >> 5, h = (u >> 2) & 7, q = u & 3;
        nat_unit(F, NQ, NK, NVT, OB, OBc, F.in[16] + ((size_t)l * 8 + h) * 15 * 31, b, h, q, ctx_q); }
    __syncthreads();
}

__device__ __forceinline__ void phase_router(Frame& F, int l, int ntok, int cnt_off = 0) {
    bf16* H2 = (bf16*)(F.ck + M_H2); int* ROWTOK = (int*)(F.ck + M_ROWTOK); i32x4* TOKE = (i32x4*)(F.ck + M_TOKE); f32x2* TOKW = (f32x2*)(F.ck + M_TOKW);
    unsigned* cnt = (unsigned*)(F.ws + WS_CTL) + CW_CNT + l * 64 + cnt_off;
    const float* g2 = F.in[28] + l * 1024; const float* WGT = (const float*)(F.ws + WS_WGT) + (size_t)l * 4 * 1024; const float* WET = (const float*)(F.ws + WS_WET) + (size_t)l * 32 * 1024;
    const float* bg = F.in[30] + l * 4; const float* be = F.in[32] + l * 32;
    for (int i = F.c * 512 + F.tid; i < MOE_ROWS; i += F.G * 512) ROWTOK[i] = -1;
    LAS float* WEL = (LAS float*)F.lds;
    LAS unsigned* LCNT = (LAS unsigned*)(F.lds + 131072);
    __syncthreads();
    for (int i = F.tid; i < 32 * 1024 / 4; i += 512) *(LAS f32x4*)(WEL + 4 * i) = ldg<f32x4>(WET + 4 * i);
    if (F.tid < 64) LCNT[F.tid] = 0u;
    __syncthreads();
    const int gw = F.c * 8 + F.wave, NGW = F.G * 8, lane = F.lane;
    for (int tok0 = gw * 4; tok0 < ntok; tok0 += NGW * 4) {
        const float* xs; int mrow;
        if (tok0 < NTOK_LAT) { xs = F.out + (size_t)tok0 * 1024; mrow = tok0 >> 11; } else { xs = F.XC + (size_t)(tok0 - NTOK_LAT) * 1024; mrow = 32; }
        const float* md = F.MOD + ((size_t)l * 33 + mrow) * 6144;
        f32x4 v[4][4]; float ss[4];
#pragma unroll
        for (int t = 0; t < 4; ++t) { ss[t] = 0.f;
#pragma unroll
            for (int j = 0; j < 4; ++j) { v[t][j] = ldg<f32x4>(xs + (size_t)t * 1024 + 4 * lane + 256 * j); ss[t] += v[t][j][0] * v[t][j][0] + v[t][j][1] * v[t][j][1] + v[t][j][2] * v[t][j][2] + v[t][j][3] * v[t][j][3]; } }
        float rstd[4];
        { const float rs_own = rsqrtf(red4(ss[0], ss[1], ss[2], ss[3]) * (1.0f / 1024.0f) + RMS_EPS);
#pragma unroll
          for (int t = 0; t < 4; ++t) rstd[t] = lane_bcast(rs_own, 16 * t); }
#pragma unroll
        for (int j = 0; j < 4; ++j) { const int col = 4 * lane + 256 * j;
            const f32x4 g = ldg<f32x4>(g2 + col), sh = ldg<f32x4>(md + 3 * 1024 + col), sc = ldg<f32x4>(md + 4 * 1024 + col) + 1.0f;
#pragma unroll
            for (int t = 0; t < 4; ++t) { v[t][j] = (v[t][j] * rstd[t] * g) * sc + sh;
                stg<u32x2>(H2 + (size_t)(tok0 + t) * 1024 + col, (u32x2){pk2(v[t][j][0], v[t][j][1]), pk2(v[t][j][2], v[t][j][3])}); } }
        float glo[4];
#pragma unroll
        for (int e = 0; e < 4; ++e) { float p[4] = {0.f, 0.f, 0.f, 0.f};
#pragma unroll
            for (int j = 0; j < 4; ++j) { const f32x4 w = ldg<f32x4>(WGT + e * 1024 + 4 * lane + 256 * j);
#pragma unroll
                for (int t = 0; t < 4; ++t) p[t] += v[t][j][0] * w[0] + v[t][j][1] * w[1] + v[t][j][2] * w[2] + v[t][j][3] * w[3]; }
            glo[e] = red4(p[0], p[1], p[2], p[3]) + bg[e]; }
        int gi = 0; float gm = glo[0];
#pragma unroll
        for (int e = 1; e < 4; ++e) if (glo[e] > gm) { gm = glo[e]; gi = e; }
        float gs = 0.f;
#pragma unroll
        for (int e = 0; e < 4; ++e) gs += __expf(glo[e] - gm);
        const float pgrp = 1.0f / gs;
        int grp[4];
#pragma unroll
        for (int t = 0; t < 4; ++t) grp[t] = __builtin_amdgcn_readlane(gi, 16 * t);
        float elo[8];
#pragma unroll
        for (int eh = 0; eh < 2; ++eh) {
            float p[4][4];
#pragma unroll
            for (int t = 0; t < 4; ++t)
#pragma unroll
                for (int e = 0; e < 4; ++e) { float q = 0.f; const LAS float* wr = WEL + (grp[t] * 8 + eh * 4 + e) * 1024;
#pragma unroll
                    for (int j = 0; j < 4; ++j) { const f32x4 w = *(const LAS f32x4*)(wr + 4 * lane + 256 * j); q += v[t][j][0] * w[0] + v[t][j][1] * w[1] + v[t][j][2] * w[2] + v[t][j][3] * w[3]; }
                    p[t][e] = q; }
#pragma unroll
            for (int e = 0; e < 4; ++e) elo[eh * 4 + e] = red4(p[0][e], p[1][e], p[2][e], p[3][e]);
            __builtin_amdgcn_sched_barrier(0);
        }
#pragma unroll
        for (int e = 0; e < 8; ++e) elo[e] += ldg<float>(be + gi * 8 + e);
        int i1 = 0; float v1 = elo[0];
#pragma unroll
        for (int e = 1; e < 8; ++e) if (elo[e] > v1) { v1 = elo[e]; i1 = e; }
        int i2 = -1; float v2 = -3.0e38f;
#pragma unroll
        for (int e = 0; e < 8; ++e) if (e != i1 && elo[e] > v2) { v2 = elo[e]; i2 = e; }
        const float ex = __expf(v2 - v1), mw1 = pgrp / (1.0f + ex), mw2 = pgrp * ex / (1.0f + ex);
        const int me1 = gi * 8 + i1, me2 = gi * 8 + i2;
        if ((lane & 15) == 0) {
            const int s1 = (int)__hip_atomic_fetch_add(LCNT + me1, 1u, __ATOMIC_RELAXED, __HIP_MEMORY_SCOPE_WORKGROUP), s2 = (int)__hip_atomic_fetch_add(LCNT + 32 + me2, 1u, __ATOMIC_RELAXED, __HIP_MEMORY_SCOPE_WORKGROUP);
            TOKE[tok0 + (lane >> 4)] = (i32x4){me1, s1, me2, s2}; TOKW[tok0 + (lane >> 4)] = (f32x2){mw1, mw2};
        }
    }
    __syncthreads();
    if (F.tid < 64) { const unsigned n = LCNT[F.tid]; const unsigned base = n ? atomicAdd(cnt + F.tid, n) : 0u; ((unsigned*)(F.ck + M_WGBASE))[(size_t)F.c * 64 + F.tid] = base; }
    __syncthreads();
}
__device__ __forceinline__ void phase_assign(Frame& F, int l, int ntok) {
    LAS int* T = (LAS int*)(F.lds + LDS_TAB);
    moe_tables((unsigned*)(F.ws + WS_CTL) + CW_CNT + l * 64, T, F.tid);
    int* ROWTOK = (int*)(F.ck + M_ROWTOK); float* ROWW = (float*)(F.ck + M_ROWW); const i32x4* TOKE = (const i32x4*)(F.ck + M_TOKE); const f32x2* TOKW = (const f32x2*)(F.ck + M_TOKW);
    for (int tok = F.c * 512 + F.tid; tok < ntok; tok += F.G * 512) {
        const i32x4 e = TOKE[tok]; const f32x2 w = TOKW[tok];
        const int wg = ((tok >> 2) % (F.G * 8)) >> 3;
        const unsigned* wb = (const unsigned*)(F.ck + M_WGBASE) + (size_t)wg * 64;
        const int r1 = T[2 + e.x] + (int)wb[e.x] + e.y, r2 = T[2 + 32 + e.z] + (int)wb[32 + e.z] + e.w;
        ROWTOK[r1] = tok; ROWW[r1] = w.x; ROWTOK[r2] = tok; ROWW[r2] = w.y;
    }
}

template <bool WITH_H>
__device__ __forceinline__ void phase_comb(Frame& F, int l, int ntok) {
    const bf16* Y = (const bf16*)(F.ck + M_Y); bf16* HBA = (bf16*)(F.ws + WS_HBALL);
    const float* g1n = F.in[6] + (l + 1 < DEPTH ? (l + 1) : l) * 1024;
    const int gw = F.c * 8 + F.wave, NGW = F.G * 8, lane = F.lane;
    for (int tok0 = gw * 4; tok0 < ntok; tok0 += NGW * 4) {
        float* xs; int mrow;
        if (tok0 < NTOK_LAT) { xs = F.out + (size_t)tok0 * 1024; mrow = tok0 >> 11; } else { xs = F.XC + (size_t)(tok0 - NTOK_LAT) * 1024; mrow = 32; }
        const float* gt2 = F.MOD + ((size_t)l * 33 + mrow) * 6144 + 5 * 1024;
        f32x4 v[4][4]; u32x2 y0[4][4], y1[4][4];
        f32x4 gv[4];
#pragma unroll
        for (int j = 0; j < 4; ++j) gv[j] = ldg<f32x4>(gt2 + 4 * lane + 256 * j);
#pragma unroll
        for (int t = 0; t < 4; ++t)
#pragma unroll
            for (int j = 0; j < 4; ++j) { const size_t o = (size_t)(tok0 + t) * 1024 + 4 * lane + 256 * j;
                v[t][j] = ldg<f32x4>(xs + (size_t)t * 1024 + 4 * lane + 256 * j); y0[t][j] = ldg<u32x2>(Y + o); y1[t][j] = ldg<u32x2>(Y + (size_t)NTOK * 1024 + o); }
        float ss[4];
#pragma unroll
        for (int t = 0; t < 4; ++t) { ss[t] = 0.f;
#pragma unroll
            for (int j = 0; j < 4; ++j) {
                f32x4 ysum; ysum[0] = bflo(y0[t][j].x) + bflo(y1[t][j].x); ysum[1] = bfhi(y0[t][j].x) + bfhi(y1[t][j].x); ysum[2] = bflo(y0[t][j].y) + bflo(y1[t][j].y); ysum[3] = bfhi(y0[t][j].y) + bfhi(y1[t][j].y);
                v[t][j] = v[t][j] + gv[j] * ysum;
                stg<f32x4>(xs + (size_t)t * 1024 + 4 * lane + 256 * j, v[t][j]);
                ss[t] += v[t][j][0] * v[t][j][0] + v[t][j][1] * v[t][j][1] + v[t][j][2] * v[t][j][2] + v[t][j][3] * v[t][j][3]; } }
        if constexpr (WITH_H) {
            const float* md = F.MOD + ((size_t)(l + 1) * 33 + mrow) * 6144;
#pragma unroll
            for (int t = 0; t < 4; ++t) ss[t] = rsqrtf(wave_sum(ss[t]) * (1.0f / 1024.0f) + RMS_EPS);
#pragma unroll
            for (int j = 0; j < 4; ++j) { const int col = 4 * lane + 256 * j;
                const f32x4 gg = ldg<f32x4>(g1n + col), sh = ldg<f32x4>(md + col), sc = ldg<f32x4>(md + 1024 + col) + 1.0f;
#pragma unroll
                for (int t = 0; t < 4; ++t) { const f32x4 h = (v[t][j] * ss[t] * gg) * sc + sh;
                    stg<u32x2>(HBA + (size_t)(tok0 + t) * 1024 + col, (u32x2){pk2(h[0], h[1]), pk2(h[2], h[3])}); } }
        }
    }
}

constexpr int MIX_PH = 8, MOE_PH = 5, NSTEPS = 2 + DEPTH * (NCH * MIX_PH + MOE_PH);
__global__ void __launch_bounds__(512, 2) fwd(Args args) {
    extern __shared__ __attribute__((aligned(16))) unsigned char lds_raw[];
    Frame F;
    F.lds = (LAS unsigned char*)lds_raw; F.tid = threadIdx.x; F.lane = F.tid & 63; F.wave = __builtin_amdgcn_readfirstlane(F.tid >> 6); F.G = gridDim.x; F.c = blockIdx.x;
    F.in = args.in; F.out = args.out; F.ws = args.ws; F.ck = args.ws + WS_CHUNK; F.MOD = (float*)(args.ws + WS_MOD); F.XC = (float*)(args.ws + WS_XC);
    for (int u = F.tid; u < (LDS_BYTES - LDS_MISC) / 4; u += 512) ((LAS unsigned*)(F.lds + LDS_MISC))[u] = 0u;
    __syncthreads();
    const int lo = args.lo, hi = args.hi;
    const int wave_id0 = __builtin_amdgcn_readfirstlane((int)threadIdx.x >> 6);
    XcdBarrier bar; bar.bar = (unsigned*)(F.ws + WS_CTL) + CW_BAR; bar.x = 0; bar.st = (volatile LAS unsigned*)(F.lds + LDS_MISC + 32);
    if (hi - lo > 1) bar = xcd_barrier_post((unsigned*)(F.ws + WS_CTL) + CW_BAR, (volatile LAS unsigned*)(F.lds + LDS_MISC + 32));
    int step = 0;
#ifndef SITE_ONLY
#define SITE_ONLY -1
#endif
#ifndef DBG_SKIP_MASK
#define DBG_SKIP_MASK 0u
#endif
#define SITE_ON(id) ((SITE_ONLY < 0 || SITE_ONLY == (id)) && !((DBG_SKIP_MASK >> (id)) & 1u))
#ifndef DBG_REPEAT_MASK
#define DBG_REPEAT_MASK 0x0u
#endif
#define SITE_REPS(id) (((DBG_REPEAT_MASK >> (id)) & 1u) ? 2 : 1)
#define PH_BEGIN(id) if (step >= lo && step < hi) { if (SITE_ON(id)) for (int rep_ = 0; rep_ < SITE_REPS(id); ++rep_) { if (rep_ > 0) xcd_barrier(bar, F.tid == 0); { int t_; asm volatile("v_mbcnt_lo_u32_b32 %0, -1, 0\n\tv_mbcnt_hi_u32_b32 %0, -1, %0" : "=v"(t_)); t_ += wave_id0 * 64; F.tid = t_; F.lane = t_ & 63; F.wave = __builtin_amdgcn_readfirstlane(t_ >> 6); \
        int c_ = blockIdx.x, g_ = gridDim.x; unsigned long long w_ = (unsigned long long)args.ws, o_ = (unsigned long long)args.out; asm volatile("" : "+s"(c_), "+s"(g_), "+s"(w_), "+s"(o_)); \
        F.c = c_; F.G = g_; F.ws = (unsigned char*)w_; F.out = (float*)o_; F.ck = F.ws + WS_CHUNK; F.MOD = (float*)(F.ws + WS_MOD); F.XC = (float*)(F.ws + WS_XC); }
#ifndef DBG_DOUBLE_BAR
#define DBG_DOUBLE_BAR 0
#endif
#define PH_END   } if (step + 1 < hi) { xcd_barrier(bar, F.tid == 0); if (DBG_DOUBLE_BAR) xcd_barrier(bar, F.tid == 0); } } ++step;
    LAS int* TAB = (LAS int*)(F.lds + LDS_TAB);

    PH_BEGIN(0)
        if (F.c < 64) prologue_s5(F, F.c >> 5, F.c & 31);
        else { prologue_mod(F, 64); prologue_transposes(F, 64); prologue_small(F, 64); }
    PH_END
    PH_BEGIN(1) prologue_mod_final(F); PH_END

    for (int l = 0; l < DEPTH; ++l) {
        const bool need_ctx = (l == 0);
        const float* xl_old = l == 0 ? F.in[0] : (const float*)F.out; const float* xc_old = l == 0 ? F.in[2] : (const float*)F.XC;
        const float* MODL = F.MOD + (size_t)l * 33 * 6144;
        const int nMrows = need_ctx ? 72 : 64;
        for (int ch = 0; ch < NCH; ++ch) {
            const int b0 = ch * NB;
            if (l == 0 && ch == 0) { PH_BEGIN(2) phase_h(F, l, b0, xl_old, xc_old, RR); PH_END }
            PH_BEGIN(3)
                const bf16* Alat = l == 0 ? (const bf16*)(F.ck + C_HB) : (const bf16*)(F.ws + WS_HBALL) + (size_t)b0 * 2048 * 1024;
                const bf16* Actx = l == 0 ? (const bf16*)(F.ck + C_HB) + (size_t)RL * 1024 : (const bf16*)(F.ws + WS_HBALL) + ((size_t)NTOK_LAT + (size_t)b0 * 256) * 1024;
                ProbG1 P{Alat, Actx, (const bf16*)(F.ws + WS_WINT) + (size_t)l * NINP * 1024, 1024, 1024, 1024, F.G, F.c, need_ctx ? 24 : 8};
                EpiG1 E{F.ck, F.in[14] + l * 64, F.in[15] + l * 64, (bf16*)(F.ws + X_GT) + ((ptrdiff_t)b0 * 256 - RL) * 3072};
                pg8::gemm_phase(F.lds, P, E, F.tid);
                if (l == 1) tr_moe_items(F, 1, ch * (MOE_ITEMS / 4), MOE_ITEMS / 4, 128);
            PH_END
            PH_BEGIN(5)
                if (need_ctx) ctx_krope(F, (const bf16*)(F.ck + C_HB) + (size_t)RL * 1024, (const bf16*)(F.ws + WS_WINT) + ((size_t)l * NINP + 6144) * 1024);
                { ProbPlain P{(const bf16*)(F.ck + C_KVL), (const bf16*)(F.ws + WS_UKVT) + (size_t)l * 1024 * 256, 256, 256, 256, 72, 4, F.G, F.c, 0};
                  EpiStoreRs<4> E{(bf16*)(F.ck + C_KN), (bf16*)(F.ck + C_VV), 512, 2, (const float*)(F.ck + C_SSKV), 1.0f / 256.0f}; pg8::gemm_phase(F.lds, P, E, F.tid); }
                { ProbPlain P{(const bf16*)(F.ck + C_QL), (const bf16*)(F.ws + WS_UQT) + (size_t)l * 768 * 768, 768, 768, 768, nMrows, 3, F.G, (F.c + F.G - 32) % F.G, 0};
                  EpiStoreRs<12> E{(bf16*)(F.ck + C_QR), (bf16*)(F.ck + C_QR), 768, 3, (const float*)(F.ck + C_SSQL), 1.0f / 768.0f}; pg8::gemm_phase(F.lds, P, E, F.tid); }
                { ProbPlain P{(const bf16*)(F.ck + C_AS5), (const bf16*)(F.ws + WS_BTS) + (size_t)l * 32 * 256 * 256, 256, 16384, 256, 5, 32, F.G, (F.c + 8) % F.G, 512};
                  EpiS5S E{(float*)(F.ck + C_SS)}; pg8::gemm_phase(F.lds, P, E, F.tid); }
            PH_END
            PH_BEGIN(6) phase_p2(F, l, need_ctx); PH_END
            PH_BEGIN(7)
#ifndef DBG_REP_MLA
#define DBG_REP_MLA 0
#endif
#ifndef DBG_REP_NAT
#define DBG_REP_NAT 0
#endif
                phase_mla(F, l, need_ctx, (bf16*)(F.ws + X_OA) + (size_t)b0 * 256 * 512); if (DBG_REP_MLA) phase_mla(F, l, need_ctx, (bf16*)(F.ws + X_OA) + (size_t)b0 * 256 * 512);
                phase_nat(F, l, need_ctx, (bf16*)(F.ws + X_OB) + (size_t)b0 * 256 * 512); if (DBG_REP_NAT) phase_nat(F, l, need_ctx, (bf16*)(F.ws + X_OB) + (size_t)b0 * 256 * 512);
                { ProbPlain P{(const bf16*)(F.ck + C_AS5), (const bf16*)(F.ws + WS_BTY) + (size_t)l * 32 * 256 * 512, 512, 16384, 512, need_ctx ? 5 : 4, 32, F.G, need_ctx ? (F.c + F.G - 64) % F.G : F.c, 512};
                  EpiS5Y E{(bf16*)(F.ck + C_YG), (bf16*)(F.ws + X_YG) + (size_t)b0 * 256 * 512}; pg8::gemm_phase(F.lds, P, E, F.tid); }
            PH_END
            PH_BEGIN(8)
                ProbPlain P{(const bf16*)(F.ck + C_YG), (const bf16*)(F.ws + WS_GLUT) + (size_t)l * 1024 * 512, 512, 512, 512, 64, 4, F.G, F.c, 0};
                EpiPair<0> E{(bf16*)(F.ck + C_OC), 512}; pg8::gemm_phase(F.lds, P, E, F.tid);
            PH_END
            PH_BEGIN(9)
                ProbMerge P{{(const bf16*)(F.ck + C_OA), (const bf16*)(F.ck + C_OB), (const bf16*)(F.ck + C_OC)}, (const bf16*)(F.ws + WS_BRT) + (size_t)l * 3 * 1024 * 512, 512, 512, 512, 64, 4, F.G, F.c};
                EpiMerge E{(const bf16*)(F.ck + C_GT), (bf16*)(F.ck + C_YMB)}; pg8::gemm_phase(F.lds, P, E, F.tid);
            PH_END
#ifndef DBG_REP_OUT0
#define DBG_REP_OUT0 0
#endif
            PH_BEGIN(10)
              for (int rr_ = 0; rr_ < ((DBG_REP_OUT0 && l == 0) ? 2 : 1); ++rr_) {
                if (rr_) xcd_barrier(bar, F.tid == 0);
                ProbPlain P{(const bf16*)(F.ck + C_YMB), (const bf16*)(F.ws + WS_OUTT) + (size_t)l * 1024 * 1024, 1024, 1024, 1024, 64, 4, F.G, F.c, 0};
                EpiOut E{xl_old, xc_old, F.out, F.XC, MODL, b0}; pg8::gemm_phase(F.lds, P, E, F.tid);
              }
              if (l == 0 && ch + 1 < NCH) phase_h(F, l, b0 + NB, xl_old, xc_old, RR);
            PH_END
        }
        if (need_ctx) {
            PH_BEGIN(16)
                ProbPlain P{(const bf16*)(F.ws + X_YG), (const bf16*)(F.ws + WS_GLUT) + (size_t)l * 1024 * 512, 512, 512, 512, 32, 4, F.G, F.c, 0};
                EpiPair<0> E{(bf16*)(F.ws + X_OC), 512}; pg8::gemm_phase(F.lds, P, E, F.tid);
                tr_moe_items(F, l, 12288, 2560, 128);
            PH_END
            PH_BEGIN(17)
                ProbMerge P{{(const bf16*)(F.ws + X_OA), (const bf16*)(F.ws + X_OB), (const bf16*)(F.ws + X_OC)}, (const bf16*)(F.ws + WS_BRT) + (size_t)l * 3 * 1024 * 512, 512, 512, 512, 32, 4, F.G, F.c};
                EpiMerge E{(const bf16*)(F.ws + X_GT), (bf16*)(F.ws + X_YMB)}; pg8::gemm_phase(F.lds, P, E, F.tid);
                tr_moe_items(F, l, 0, 12288, 128); tr_moe_items(F, l, 14848, 4864, 128);
            PH_END
            PH_BEGIN(18)
                ProbPlain P{(const bf16*)(F.ws + X_YMB), (const bf16*)(F.ws + WS_OUTT) + (size_t)l * 1024 * 1024, 1024, 1024, 1024, 32, 4, F.G, F.c, 0};
                EpiOut E{xl_old, xc_old, F.out, F.XC, MODL, -1}; pg8::gemm_phase(F.lds, P, E, F.tid);
                tr_moe_items(F, l, 19712, 4864, 128);
            PH_END
        }
        const int ntok = need_ctx ? NTOK : NTOK_LAT;
        unsigned* cnt = (unsigned*)(F.ws + WS_CTL) + CW_CNT + l * 64;
#ifndef DBG_ROUTER_DRY
#define DBG_ROUTER_DRY 0
#endif
        PH_BEGIN(11) if (DBG_ROUTER_DRY) { phase_router(F, l, ntok, 1024); xcd_barrier(bar, F.tid == 0); } phase_router(F, l, ntok); PH_END
        PH_BEGIN(12) phase_assign(F, l, ntok); PH_END
        PH_BEGIN(13)
            moe_tables(cnt, TAB, F.tid);
            ProbUp P{(const bf16*)(F.ck + M_H2), (const bf16*)(F.ws + WS_UPT) + (size_t)l * 32 * 1024 * 1024, (const int*)(F.ck + M_ROWTOK), TAB, 1024, 1024, 1024, F.G, F.c};
            EpiPair<1> E{(bf16*)(F.ck + M_HID), 512}; pg8::gemm_phase(F.lds, P, E, F.tid);
        PH_END
        PH_BEGIN(14)
            moe_tables(cnt, TAB, F.tid);
            ProbDown P{(const bf16*)(F.ck + M_HID), (const bf16*)(F.ws + WS_DOWNT) + (size_t)l * 32 * 1024 * 512, TAB, 512, 512, 512, F.G, F.c, 0, TAB[0]};
            EpiDownY E{(const int*)(F.ck + M_ROWTOK), (const float*)(F.ck + M_ROWW), (bf16*)(F.ck + M_Y), TAB[1]}; pg8::gemm_phase(F.lds, P, E, F.tid);
        PH_END
        PH_BEGIN(15) if (l + 1 < DEPTH) phase_comb<true>(F, l, ntok); else phase_comb<false>(F, l, ntok); PH_END
    }
#undef PH_BEGIN
#undef PH_END
}

extern "C" void kernel_launch(void* const* d_in, const int* in_sizes, int n_in, void* d_out, int out_size, void* d_ws, size_t ws_size, hipStream_t stream) {
    static int grid = 0;
    if (grid == 0) {
        if (n_in != 35 || out_size != BATCH * SEQ * D || ws_size < WS_END) { fprintf(stderr, "kernel_launch: unexpected shapes (n_in %d, out %d, ws %zu, need %zu)\n", n_in, out_size, ws_size, (size_t)WS_END); grid = -1; return; }
        int dev = 0, cus = 0, per_cu = 0;
        if (hipGetDevice(&dev) != hipSuccess || hipDeviceGetAttribute(&cus, hipDeviceAttributeMultiprocessorCount, dev) != hipSuccess) { grid = -1; return; }
        if (hipFuncSetAttribute((const void*)fwd, hipFuncAttributeMaxDynamicSharedMemorySize, LDS_BYTES) != hipSuccess) { fprintf(stderr, "kernel_launch: hipFuncSetAttribute failed\n"); grid = -1; return; }
        if (hipOccupancyMaxActiveBlocksPerMultiprocessor(&per_cu, (const void*)fwd, 512, LDS_BYTES) != hipSuccess || per_cu < 1) fprintf(stderr, "kernel_launch: occupancy query reports %d\n", per_cu);
        (void)hipGetLastError();
        grid = cus;
    }
    if (grid < 0) return;
    (void)in_sizes;
    hipMemsetAsync((char*)d_ws + WS_CTL, 0, CTL_BYTES, stream);
    Args a{};
    for (int i = 0; i < 35; ++i) a.in[i] = (const float*)d_in[i];
    a.out = (float*)d_out; a.ws = (unsigned char*)d_ws;
#if MK_SINGLE
    a.lo = 0; a.hi = NSTEPS;
    hipLaunchKernelGGL(fwd, dim3(grid), dim3(512), LDS_BYTES, stream, a);
#else
    for (int s = 0; s < NSTEPS; ++s) { a.lo = s; a.hi = s + 1; hipLaunchKernelGGL(fwd, dim3(grid), dim3(512), LDS_BYTES, stream, a);
    }
#endif
}
```

```cpp
#include <hip/hip_runtime.h>
#include <cstdio>
#include <cstdint>

#ifndef DBG_EPI_TWICE
#define DBG_EPI_TWICE 0
#endif
#ifndef MK_SINGLE
#define MK_SINGLE 1
#endif

#define GAS __attribute__((address_space(1)))
#define LAS __attribute__((address_space(3)))
typedef unsigned short bf16;
typedef short bf16x8 __attribute__((ext_vector_type(8)));
typedef short bf16x4 __attribute__((ext_vector_type(4)));
typedef float f32x4 __attribute__((ext_vector_type(4)));
typedef float f32x2 __attribute__((ext_vector_type(2)));
typedef float f32x16 __attribute__((ext_vector_type(16)));
typedef unsigned u32x4 __attribute__((ext_vector_type(4)));
typedef unsigned u32x2 __attribute__((ext_vector_type(2)));
typedef int i32x4 __attribute__((ext_vector_type(4)));

#define MLA_PAD_N 9
#define STR2(x) #x
#define STR(x) STR2(x)
constexpr int D = 1024, BATCH = 32, SEQ = 2048, CTXL = 256, DEPTH = 2;
constexpr int NB = 8, NCH = BATCH / NB;
constexpr int RL = NB * SEQ, RC = NB * CTXL, RR = RL + RC;
constexpr int NINP = 6400;
constexpr int NTOK_LAT = BATCH * SEQ, NTOK_CTX = BATCH * CTXL, NTOK = NTOK_LAT + NTOK_CTX;
constexpr int S5ROWS = 1280;
constexpr int KEYS = SEQ + CTXL;
constexpr int MOE_ROWS = 2 * NTOK + 64 * 256;
constexpr float RMS_EPS = 1e-6f;
constexpr float LOG2E = 1.4426950408889634f;

constexpr size_t al256(size_t x) { return (x + 255) & ~(size_t)255; }
constexpr size_t WS_CTL = 0, CTL_BYTES = 1u << 20;
constexpr size_t WS_WINT = WS_CTL + CTL_BYTES;
constexpr size_t WS_UQT = WS_WINT + (size_t)2 * NINP * 1024 * 2;
constexpr size_t WS_UKVT = WS_UQT + (size_t)2 * 768 * 768 * 2;
constexpr size_t WS_GLUT = WS_UKVT + (size_t)2 * 1024 * 256 * 2;
constexpr size_t WS_BRT = WS_GLUT + (size_t)2 * 1024 * 512 * 2;
constexpr size_t WS_OUTT = WS_BRT + (size_t)2 * 3 * 1024 * 512 * 2;
constexpr size_t WS_UPT = WS_OUTT + (size_t)2 * 1024 * 1024 * 2;
constexpr size_t WS_DOWNT = WS_UPT + (size_t)2 * 32 * 1024 * 1024 * 2;
constexpr size_t WS_BTY = WS_DOWNT + (size_t)2 * 32 * 1024 * 512 * 2;
constexpr size_t WS_BTS = WS_BTY + (size_t)2 * 32 * 256 * 512 * 2;
constexpr size_t WS_A16 = WS_BTS + (size_t)2 * 32 * 256 * 256 * 2;
constexpr size_t WS_MODP = WS_A16 + (size_t)2 * 2 * 32 * 64 * 2 * 4;
constexpr size_t WS_MOD = WS_MODP + (size_t)8 * 2 * 33 * 6144 * 4;
constexpr size_t WS_ROPE = WS_MOD + (size_t)2 * 33 * 6144 * 4;
constexpr size_t WS_WGT = WS_ROPE + (size_t)2048 * 32 * 4;
constexpr size_t WS_WET = WS_WGT + (size_t)2 * 4 * 1024 * 4;
constexpr size_t WS_XC = WS_WET + (size_t)2 * 32 * 1024 * 4;
constexpr size_t WS_CHUNK = al256(WS_XC + (size_t)NTOK_CTX * 1024 * 4);
constexpr size_t UB = (size_t)RR * 1024 * 2;
constexpr size_t C_HB = 0;
constexpr size_t C_KVL = C_HB + UB;
constexpr size_t C_QL = C_KVL + UB / 4;
constexpr size_t C_YM = C_HB;
constexpr size_t C_QR = C_QL + UB * 3 / 4;
constexpr size_t C_KN = C_QR + UB * 3 / 4;
constexpr size_t C_YMB = C_QR;
constexpr size_t C_KRP = C_KN + UB / 2;
constexpr size_t C_NQ = al256(C_KRP + (size_t)RR * 32 * 2);
constexpr size_t C_NK = C_NQ + UB / 2;
constexpr size_t C_NV = C_NK + UB / 2;
constexpr size_t C_GT = C_NV + UB / 2;
constexpr size_t C_AS5 = C_GT + UB * 3;
constexpr size_t C_SS = C_AS5 + (size_t)S5ROWS * 32 * 512 * 2;
constexpr size_t C_VV = C_SS + (size_t)S5ROWS * 32 * 256 * 4;
constexpr size_t C_QF = C_VV + UB / 2;
constexpr size_t C_KF = C_QF + UB * 3 / 4;
constexpr size_t C_VT = C_KF + UB * 3 / 4;
constexpr size_t C_NVT = C_VT + (size_t)NB * 8 * 64 * KEYS * 2;
constexpr size_t C_OA = C_NVT + (size_t)NB * 8 * 64 * KEYS * 2;
constexpr size_t C_OB = C_OA + UB / 2;
constexpr size_t C_OC = C_OB + UB / 2;
constexpr size_t C_YG = C_OC + UB / 2;
constexpr size_t C_SSKV = C_YG + UB / 2;
constexpr size_t C_SSQL = C_SSKV + (size_t)RR * 4 * 4;
constexpr size_t C_END = al256(C_SSQL + (size_t)RR * 12 * 4);
constexpr size_t M_HID = 0;
constexpr size_t M_Y = M_HID + (size_t)MOE_ROWS * 512 * 2;
constexpr size_t M_H2 = M_Y;
constexpr size_t M_ROWTOK = M_Y + (size_t)2 * NTOK * 1024 * 2;
constexpr size_t M_ROWW = M_ROWTOK + (size_t)MOE_ROWS * 4;
constexpr size_t M_TOKE = M_ROWW + (size_t)MOE_ROWS * 4;
constexpr size_t M_TOKW = M_TOKE + (size_t)NTOK * 16;
constexpr size_t M_WGBASE = M_TOKW + (size_t)NTOK * 8;
constexpr size_t M_END = M_WGBASE + (size_t)1024 * 64 * 4;
static_assert(M_END <= C_END, "MoE buffers fit in the chunk region");
constexpr size_t WS_HBALL = WS_CHUNK + C_END;
constexpr size_t WS_END = WS_HBALL + (size_t)NTOK * 1024 * 2;
constexpr size_t X_YG = WS_HBALL, X_OA = X_YG + (size_t)NTOK_CTX * 512 * 2, X_OB = X_OA + (size_t)NTOK_CTX * 512 * 2, X_OC = X_OB + (size_t)NTOK_CTX * 512 * 2;
constexpr size_t X_GT = X_OC + (size_t)NTOK_CTX * 512 * 2, X_YMB = X_GT + (size_t)NTOK_CTX * 3072 * 2, X_END = X_YMB + (size_t)NTOK_CTX * 1024 * 2;
static_assert(X_END <= WS_END, "ctx-tail buffers fit inside HB_ALL");
static_assert(WS_END <= ((size_t)1 << 30), "workspace within 1 GiB");
constexpr int CW_BAR = 4096;
constexpr int CW_CNT = 16384;

constexpr int LDS_MISC = 143360;
constexpr int LDS_TAB = LDS_MISC + 256;
constexpr int LDS_BYTES = 147456;

__device__ __forceinline__ unsigned f2bf(float f) { unsigned u = __builtin_bit_cast(unsigned, f); return (u + 0x7fffu + ((u >> 16) & 1u)) >> 16; }
typedef __bf16 bf2n_t __attribute__((ext_vector_type(2)));
__device__ __forceinline__ unsigned pk2(float lo, float hi) { const f32x2 v = {lo, hi}; return __builtin_bit_cast(unsigned, __builtin_convertvector(v, bf2n_t)); }
__device__ __forceinline__ float bflo(unsigned u) { return __builtin_bit_cast(float, u << 16); }
__device__ __forceinline__ float bfhi(unsigned u) { return __builtin_bit_cast(float, u & 0xffff0000u); }
__device__ __forceinline__ float bf2f(bf16 h) { return __builtin_bit_cast(float, ((unsigned)h) << 16); }
template <class T> __device__ __forceinline__ T ldg(const void* p) { return *(const GAS T*)p; }
template <class T> __device__ __forceinline__ void stg(void* p, T v) { *(GAS T*)p = v; }
template <int K> __device__ __forceinline__ float shx_sum(float v) {
    if constexpr (K == 32) { float a = v, b = v; asm volatile("s_nop 1\n\tv_permlane32_swap_b32 %0, %1" : "+v"(a), "+v"(b)); return a + b; }
    else return v + __builtin_bit_cast(float, __builtin_amdgcn_ds_swizzle(__builtin_bit_cast(int, v), (K << 10) | 0x1f));
}
template <int K> __device__ __forceinline__ float shx_max(float v) {
    if constexpr (K == 32) { float a = v, b = v; asm volatile("s_nop 1\n\tv_permlane32_swap_b32 %0, %1" : "+v"(a), "+v"(b)); return fmaxf(a, b); }
    else return fmaxf(v, __builtin_bit_cast(float, __builtin_amdgcn_ds_swizzle(__builtin_bit_cast(int, v), (K << 10) | 0x1f)));
}
__device__ __forceinline__ float wave_sum(float v) { v = shx_sum<1>(v); v = shx_sum<2>(v); v = shx_sum<4>(v); v = shx_sum<8>(v); v = shx_sum<16>(v); return shx_sum<32>(v); }
__device__ __forceinline__ float hx32(float a, float b) { asm volatile("s_nop 1\n\tv_permlane32_swap_b32 %0, %1" : "+v"(a), "+v"(b)); return a + b; }
__device__ __forceinline__ float hx16(float a, float b) { asm volatile("s_nop 1\n\tv_permlane16_swap_b32 %0, %1" : "+v"(a), "+v"(b)); return a + b; }
template <int N> __device__ __forceinline__ float dpp_ror(float v) { return __builtin_bit_cast(float, __builtin_amdgcn_update_dpp(0, __builtin_bit_cast(int, v), 0x120 + N, 0xf, 0xf, false)); }
__device__ __forceinline__ float row_sum16(float v) { v += dpp_ror<8>(v); v += dpp_ror<4>(v); v += dpp_ror<2>(v); v += dpp_ror<1>(v); return v; }
__device__ __forceinline__ float red4(float v0, float v1, float v2, float v3) { return row_sum16(hx16(hx32(v0, v2), hx32(v1, v3))); }
__device__ __forceinline__ float lane_bcast(float v, int srclane) { return __builtin_bit_cast(float, __builtin_amdgcn_readlane(__builtin_bit_cast(int, v), srclane)); }
__device__ __forceinline__ float fast_exp2(float x) { return __builtin_amdgcn_exp2f(x); }
__device__ __forceinline__ float sigmoidf(float x) { return __builtin_amdgcn_rcpf(1.0f + __builtin_amdgcn_exp2f(-LOG2E * x)); }
__device__ __forceinline__ float gelu_tanh(float x) { const float u = 0.7978845608028654f * (x + 0.044715f * x * x * x); return x * sigmoidf(2.0f * u); }

#define XB_TMO      128
#define XB_XCNT(j)  (256  + 64 * (j))
#define XB_XSUB(j)  (1280 + 64 * (j))
#define XB_XGEN(j)  (2304 + 64 * (j))
#define XB_TOP      3328
#define XB_TOPGEN   3392
#define XCD_BAR_WORDS 3456
#define XB_SPIN_CAP (1u << 22)

__device__ __forceinline__ unsigned xb_ld(unsigned* p)              { return __hip_atomic_load(p, __ATOMIC_RELAXED, __HIP_MEMORY_SCOPE_AGENT); }
__device__ __forceinline__ unsigned xb_add(unsigned* p, unsigned v) { return __hip_atomic_fetch_add(p, v, __ATOMIC_RELAXED, __HIP_MEMORY_SCOPE_AGENT); }
__device__ __forceinline__ unsigned xb_xcc_id() { return (unsigned)__builtin_amdgcn_s_getreg((3 << 11) | 20) & 0xFu; }
#define XB_SPIN(cond, bar) do { unsigned _sp = 0; while (cond) { __builtin_amdgcn_s_sleep(1); \
    if ((++_sp & 255u) == 0u) { if (xb_ld(&(bar)[XB_TMO])) break; if (_sp > XB_SPIN_CAP) { atomicAdd(&(bar)[XB_TMO], 1u); break; } } } } while (0)

struct XcdBarrier { unsigned* bar; unsigned x; volatile LAS unsigned* st; };

__device__ __forceinline__ XcdBarrier xcd_barrier_post(unsigned* bar, volatile LAS unsigned* st) {
    XcdBarrier b; b.bar = bar; b.x = xb_xcc_id(); b.st = st;
    if (threadIdx.x == 0) (void)xb_add(&bar[XB_XCNT(b.x)], 1u);
    return b;
}
__device__ __forceinline__ void xcd_barrier_complete(unsigned* bar, unsigned x, unsigned& nloc, unsigned& nx) {
    const unsigned G = gridDim.x * gridDim.y * gridDim.z;
    unsigned sum, cnt, mine, sp = 0u;
    for (;;) {
        sum = 0u; cnt = 0u; mine = 0u;
#pragma unroll
        for (unsigned j = 0; j < 16; ++j) { const unsigned c = xb_ld(&bar[XB_XCNT(j)]); sum += c; cnt += (c > 0u) ? 1u : 0u; mine = (j == x) ? c : mine; }
        if (sum == G) break;
        __builtin_amdgcn_s_sleep(1);
        if ((++sp & 255u) == 0u) { if (xb_ld(&bar[XB_TMO])) break; if (sp > XB_SPIN_CAP) { atomicAdd(&bar[XB_TMO], 1u); break; } }
    }
    nloc = mine > 0u ? mine : 1u; nx = cnt > 0u ? cnt : 1u;
}
__device__ __forceinline__ void xcd_barrier(const XcdBarrier& b, bool thread0) {
    asm volatile("s_waitcnt vmcnt(0)" ::: "memory");
    __syncthreads();
    if (thread0) {
        unsigned* bar = b.bar;
        __builtin_amdgcn_s_waitcnt(0);
        unsigned nloc = b.st[0], nx = b.st[1];
        if (nloc == 0u) { xcd_barrier_complete(bar, b.x, nloc, nx); b.st[0] = nloc; b.st[1] = nx; }
        const unsigned old = xb_add(&bar[XB_XSUB(b.x)], 1u);
        const unsigned gen = old / nloc;
        if (old + 1u == (gen + 1u) * nloc) {
            __builtin_amdgcn_fence(__ATOMIC_RELEASE, "agent");
            asm volatile("s_waitcnt vmcnt(0)" ::: "memory");
            const unsigned og = xb_add(&bar[XB_TOP], 1u);
            const unsigned tg = og / nx;
            if (og + 1u == (tg + 1u) * nx) xb_add(&bar[XB_TOPGEN], 1u);
            else XB_SPIN(xb_ld(&bar[XB_TOPGEN]) == tg, bar);
            __builtin_amdgcn_fence(__ATOMIC_ACQUIRE, "agent");
            xb_add(&bar[XB_XGEN(b.x)], 1u);
            asm volatile("s_waitcnt vmcnt(0)" ::: "memory");
        } else {
            XB_SPIN(xb_ld(&bar[XB_XGEN(b.x)]) == gen, bar);
            __builtin_amdgcn_fence(__ATOMIC_ACQUIRE, "agent");
            asm volatile("s_waitcnt vmcnt(0)" ::: "memory");
        }
    }
    __syncthreads();
}

namespace pg8 {
constexpr int BM = 256, BK = 64, HALF = 128, HTB = HALF * BK * 2, STAGE_BYTES = 8 * HTB, NXCD = 8, WGM = 2;
__host__ __device__ __forceinline__ int lds_byte(int r, int c) { const int st = (r >> 4) * 2 + (c >> 5), rr = r & 15, cc = c & 31, ob = rr * 64 + cc * 2; return st * 1024 + (ob ^ (((ob >> 9) & 1) << 5)); }
__host__ __device__ __forceinline__ void stage_rc(int b, int& R, int& C) { const int st = b / 1024, sb = b % 1024, swz = sb ^ (((sb >> 9) & 1) << 5); R = (st >> 1) * 16 + swz / 64; C = (st & 1) * 32 + (swz % 64) / 2; }
__host__ __device__ __forceinline__ int perm32(int rho) { const int n = rho >> 4, i = rho & 15; return 8 * (i >> 2) + 4 * n + (i & 3); }
struct Unit { int pm, pn, z; };
__device__ __forceinline__ bool tile_map(long L, int nM, int nN, int& pm, int& pn) {
    const int nwg = nM * nN; if (L >= nwg) return false;
    int wgid = (int)L; { const int q = nwg / NXCD, r = nwg % NXCD, xcd = wgid % NXCD, off = wgid / NXCD; wgid = (xcd < r ? xcd * (q + 1) : r * (q + 1) + (xcd - r) * q) + off; }
    const int nig = WGM * nN, gid = wgid / nig, fm = gid * WGM, gsz = (nM - fm) < WGM ? (nM - fm) : WGM;
    pm = fm + ((wgid % nig) % gsz); pn = (wgid % nig) / gsz; return true;
}
typedef __bf16 bf2_t __attribute__((ext_vector_type(2)));
__device__ __forceinline__ unsigned cvt_pk_bf16(float lo, float hi) { const f32x2 v = {lo, hi}; return __builtin_bit_cast(unsigned, __builtin_convertvector(v, bf2_t)); }

template <class Prob, class Epi>
__device__ __forceinline__ void gemm_phase(LAS unsigned char* lds, const Prob& P, const Epi& E, int tid_in) {
    int tid_ = tid_in; asm volatile("" : "+v"(tid_));
    const int tid = tid_, wid = __builtin_amdgcn_readfirstlane(tid >> 6), lane = tid & 63, wr = wid >> 2, wc = wid & 3, fr = lane & 15, fq = lane >> 4;
    const int K = P.K, nt = K / BK;
    int sR[2], sC[2]; unsigned voffB[2], voffA[2];
#pragma unroll
    for (int i = 0; i < 2; ++i) { int R, C; stage_rc(tid * 16 + i * 8192, R, C); sR[i] = R; sC[i] = C; const int Rb = Epi::PERM ? ((R & ~31) + perm32(R & 31)) : R;
        voffA[i] = (unsigned)(R * P.lda + C) * 2u; voffB[i] = (unsigned)(Rb * P.ldb + C) * 2u; }
    const size_t kstep = (size_t)(BK * 2);
    const unsigned hstepA = (unsigned)HALF * (unsigned)P.lda * 2u; const size_t hstepB = (size_t)HALF * P.ldb * 2;
    const unsigned ldsw = (unsigned)wid * 1024u;
    const int aoff = lds_byte(wr * 64 + fr, fq * 8), boff = lds_byte(wc * 32 + fr, fq * 8);
#define PG8_SA(b, h) (((b) * 2 + (h)) * HTB)
#define PG8_SB(b, h) ((4 + (b) * 2 + (h)) * HTB)
#define PG8_STAGE2(bufoff, gbase, o0, o1) do { \
        __builtin_amdgcn_global_load_lds((const GAS unsigned*)((const char*)(gbase) + (o0)), (LAS unsigned*)(lds + (bufoff) + ldsw), 16, 0, 0); \
        __builtin_amdgcn_global_load_lds((const GAS unsigned*)((const char*)(gbase) + (o1)), (LAS unsigned*)(lds + (bufoff) + ldsw + 8192), 16, 0, 0); } while (0)
#define PG8_STAGEB(bufoff, gbase) PG8_STAGE2(bufoff, gbase, voffB[0], voffB[1])
#define PG8_STAGEA(bufoff, gbase, OA, h) do { if constexpr (Prob::GATHER) { PG8_STAGE2(bufoff, gbase, OA[h][0], OA[h][1]); } else { PG8_STAGE2(bufoff, (gbase) + (h) * (size_t)hstepA, voffA[0], voffA[1]); } } while (0)
#define PG8_LDA(dst, b, h) do { _Pragma("unroll") for (int m = 0; m < 4; ++m) _Pragma("unroll") for (int k = 0; k < 2; ++k) dst[m][k] = *(const LAS bf16x8*)(lds + PG8_SA(b, h) + aoff + m * 2048 + k * 1024); } while (0)
#define PG8_LDB(dst, b, h) do { _Pragma("unroll") for (int n = 0; n < 2; ++n) _Pragma("unroll") for (int k = 0; k < 2; ++k) dst[n][k] = *(const LAS bf16x8*)(lds + PG8_SB(b, h) + boff + n * 2048 + k * 1024); } while (0)
#define PG8_MMA(ai, bj, At, Bt) do { __builtin_amdgcn_s_setprio(1); _Pragma("unroll") for (int m = 0; m < 4; ++m) _Pragma("unroll") for (int n = 0; n < 2; ++n) _Pragma("unroll") for (int k = 0; k < 2; ++k) \
        acc[ai][bj][m][n] = __builtin_amdgcn_mfma_f32_16x16x32_bf16(Bt[n][k], At[m][k], acc[ai][bj][m][n], 0, 0, 0); __builtin_amdgcn_s_setprio(0); } while (0)
#define PG8_WAIT_V(n) asm volatile("s_waitcnt vmcnt(" #n ")" ::: "memory")
#define PG8_WAIT_L(n) asm volatile("s_waitcnt lgkmcnt(" #n ")" ::: "memory")
#define PG8_BAR __builtin_amdgcn_s_barrier()
#define PG8_SCHED __builtin_amdgcn_sched_barrier(0)
    Unit cur, nxt; int ui = 0;
    if (!P.next(0, cur)) return;
    f32x4 acc[2][2][4][2];
    bf16x8 At[4][2], B0[2][2], B1[2][2];
    const char* cA = P.a_base(cur); const char* cB = P.b_base(cur);
    unsigned cOA[2][2];
#pragma unroll
    for (int h = 0; h < 2; ++h)
#pragma unroll
        for (int i = 0; i < 2; ++i) {
            if constexpr (Prob::GATHER) cOA[h][i] = P.a_rowoff(cur, h * HALF + sR[i]) + (unsigned)sC[i] * 2u;
            else cOA[h][i] = 0u;
        }
    PG8_STAGEB(PG8_SB(0, 0), cB); PG8_STAGEB(PG8_SB(0, 1), cB + hstepB); PG8_STAGEA(PG8_SA(0, 0), cA, cOA, 0); PG8_STAGEA(PG8_SA(0, 1), cA, cOA, 1);
    if (wr == 1) PG8_BAR;
    PG8_WAIT_V(2); PG8_BAR;
    PG8_STAGEB(PG8_SB(1, 0), cB + kstep); PG8_STAGEA(PG8_SA(1, 0), cA + kstep, cOA, 0); PG8_STAGEB(PG8_SB(1, 1), cB + hstepB + kstep);
    PG8_WAIT_V(6); PG8_BAR;
    for (;;) {
        const bool has_next = P.next(ui + 1, nxt);
        const char* nA = has_next ? P.a_base(nxt) : cA; const char* nB = has_next ? P.b_base(nxt) : cB;
        if constexpr (Prob::GATHER) {
            u32x4 nv = (u32x4){cOA[0][0], cOA[0][1], cOA[1][0], cOA[1][1]};
            if (has_next) {
                int t2 = tid; asm volatile("" : "+v"(t2));
#pragma unroll
                for (int i = 0; i < 2; ++i) { int R2, C2; stage_rc(t2 * 16 + i * 8192, R2, C2);
                    nv[i] = P.a_rowoff(nxt, R2) + (unsigned)C2 * 2u; nv[2 + i] = P.a_rowoff(nxt, HALF + R2) + (unsigned)C2 * 2u; }
            }
            *(LAS u32x4*)(lds + STAGE_BYTES + tid * 16) = nv;
        }
        float zero_ = 0.f; asm volatile("" : "+v"(zero_));
#pragma unroll
        for (int a = 0; a < 2; ++a)
#pragma unroll
            for (int b = 0; b < 2; ++b)
#pragma unroll
                for (int m = 0; m < 4; ++m)
#pragma unroll
                    for (int n = 0; n < 2; ++n) acc[a][b][m][n] = (f32x4){zero_, zero_, zero_, zero_};
        asm volatile("" : "+v"(acc[0][0][0][0]), "+v"(acc[0][0][0][1]), "+v"(acc[0][0][1][0]), "+v"(acc[0][0][1][1]), "+v"(acc[0][0][2][0]), "+v"(acc[0][0][2][1]), "+v"(acc[0][0][3][0]), "+v"(acc[0][0][3][1]),
                          "+v"(acc[0][1][0][0]), "+v"(acc[0][1][0][1]), "+v"(acc[0][1][1][0]), "+v"(acc[0][1][1][1]), "+v"(acc[0][1][2][0]), "+v"(acc[0][1][2][1]), "+v"(acc[0][1][3][0]), "+v"(acc[0][1][3][1]));
        asm volatile(".p2align 6" : "+v"(acc[1][0][0][0]), "+v"(acc[1][0][0][1]), "+v"(acc[1][0][1][0]), "+v"(acc[1][0][1][1]), "+v"(acc[1][0][2][0]), "+v"(acc[1][0][2][1]), "+v"(acc[1][0][3][0]), "+v"(acc[1][0][3][1]),
                          "+v"(acc[1][1][0][0]), "+v"(acc[1][1][0][1]), "+v"(acc[1][1][1][0]), "+v"(acc[1][1][1][1]), "+v"(acc[1][1][2][0]), "+v"(acc[1][1][2][1]), "+v"(acc[1][1][3][0]), "+v"(acc[1][1][3][1]));
        for (int t = 0; t < nt; t += 2) {
            const bool last = (t == nt - 2);
            const char* a1 = cA + (size_t)(t + 1) * kstep;
            const char* a2 = last ? nA : cA + (size_t)(t + 2) * kstep; const char* b2 = last ? nB : cB + (size_t)(t + 2) * kstep;
            const char* a3 = a2 + kstep; const char* b3 = b2 + kstep;
            unsigned oa2[2][2];
#pragma unroll
            for (int h = 0; h < 2; ++h)
#pragma unroll
                for (int i = 0; i < 2; ++i) oa2[h][i] = Prob::GATHER ? cOA[h][i] : 0u;
            if constexpr (Prob::GATHER) { if (last) { const u32x4 nv = *(const LAS u32x4*)(lds + STAGE_BYTES + tid * 16); oa2[0][0] = nv.x; oa2[0][1] = nv.y; oa2[1][0] = nv.z; oa2[1][1] = nv.w; } }
            PG8_LDB(B0, 0, 0); PG8_LDB(B1, 0, 1); PG8_SCHED; PG8_LDA(At, 0, 0); PG8_STAGEA(PG8_SA(1, 1), a1, cOA, 1);
            PG8_WAIT_V(8); PG8_WAIT_L(0); PG8_BAR; PG8_MMA(0, 0, At, B0); PG8_MMA(0, 1, At, B1); PG8_BAR; PG8_SCHED;
            PG8_LDA(At, 0, 1); PG8_STAGEB(PG8_SB(0, 0), b2); PG8_STAGEB(PG8_SB(0, 1), b2 + hstepB); PG8_STAGEA(PG8_SA(0, 0), a2, oa2, 0);
            PG8_WAIT_V(8); PG8_WAIT_L(0); PG8_BAR; PG8_MMA(1, 0, At, B0); PG8_MMA(1, 1, At, B1); PG8_BAR; PG8_SCHED;
            PG8_LDB(B0, 1, 0); PG8_LDB(B1, 1, 1); PG8_SCHED; PG8_LDA(At, 1, 0); PG8_STAGEA(PG8_SA(0, 1), a2, oa2, 1);
            PG8_WAIT_V(8); PG8_WAIT_L(0); PG8_BAR; PG8_MMA(0, 0, At, B0); PG8_MMA(0, 1, At, B1); PG8_BAR; PG8_SCHED;
            PG8_LDA(At, 1, 1); PG8_STAGEB(PG8_SB(1, 0), b3); PG8_STAGEB(PG8_SB(1, 1), b3 + hstepB); PG8_STAGEA(PG8_SA(1, 0), a3, oa2, 0);
            PG8_WAIT_V(8); PG8_WAIT_L(0); PG8_BAR; PG8_MMA(1, 0, At, B0); PG8_MMA(1, 1, At, B1); PG8_BAR; PG8_SCHED;
        }
        if (wr == 0) PG8_BAR;
        E(acc, cur, wr, wc, fr, fq);
#if DBG_EPI_TWICE
        if constexpr (Epi::IDEMP) E(acc, cur, wr, wc, fr, fq);
#endif
        if (!has_next) break;
        cur = nxt; cA = nA; cB = nB; ++ui;
        if constexpr (Prob::GATHER) { const u32x4 nv = *(const LAS u32x4*)(lds + STAGE_BYTES + tid * 16); cOA[0][0] = nv.x; cOA[0][1] = nv.y; cOA[1][0] = nv.z; cOA[1][1] = nv.w; }
        if (wr == 1) PG8_BAR;
    }
    PG8_WAIT_V(0);
    PG8_BAR;
#undef PG8_SA
#undef PG8_SB
#undef PG8_STAGE2
#undef PG8_STAGEB
#undef PG8_STAGEA
#undef PG8_LDA
#undef PG8_LDB
#undef PG8_MMA
#undef PG8_WAIT_V
#undef PG8_WAIT_L
#undef PG8_BAR
#undef PG8_SCHED
}
}
using pg8::Unit;

struct Args { const float* in[35]; float* out; unsigned char* ws; int lo, hi; };

struct Frame {
    LAS unsigned char* lds;
    int tid, lane, wave, G, c;
    const float* const* in;
    float* out; unsigned char* ws; unsigned char* ck;
    float* MOD; float* XC;
};
__device__ __forceinline__ bool row_is_ctx(int row) { return row >= RL; }

struct ProbPlain {
    static constexpr bool GATHER = false;
    const bf16* A; const bf16* Bt; int K, lda, ldb, nM, nN, G, c, a_pn_stride;
    __device__ __forceinline__ bool next(int i, Unit& u) const { u.z = 0; return pg8::tile_map((long)i * G + c, nM, nN, u.pm, u.pn); }
    __device__ __forceinline__ const char* a_base(const Unit& u) const { return (const char*)(A + (size_t)u.pm * 256 * lda + (size_t)u.pn * a_pn_stride); }
    __device__ __forceinline__ const char* b_base(const Unit& u) const { return (const char*)(Bt + (size_t)u.pn * 256 * ldb); }
    __device__ __forceinline__ unsigned a_rowoff(const Unit&, int) const { return 0u; }
};
struct ProbG1 {
    static constexpr bool GATHER = false;
    const bf16* A; const bf16* Actx; const bf16* Bt; int K, lda, ldb, G, c, nctx;
    __device__ __forceinline__ bool next(int i, Unit& u) const {
        u.z = 0; const long L = (long)i * G + c; const int n1 = 64 * 25;
        if (L < n1) return pg8::tile_map(L, 64, 25, u.pm, u.pn);
        const int l2 = (int)(L - n1); if (l2 >= 8 * nctx) return false;
        u.pm = 64 + (l2 & 7); const int idx = l2 >> 3;
        u.pn = (nctx == 24) ? idx : (idx < 3 ? idx : (idx < 7 ? idx + 5 : 24));
        return true;
    }
    __device__ __forceinline__ const char* a_base(const Unit& u) const { return u.pm < 64 ? (const char*)(A + (size_t)u.pm * 256 * lda) : (const char*)(Actx + (size_t)(u.pm - 64) * 256 * lda); }
    __device__ __forceinline__ const char* b_base(const Unit& u) const { return (const char*)(Bt + (size_t)u.pn * 256 * ldb); }
    __device__ __forceinline__ unsigned a_rowoff(const Unit&, int) const { return 0u; }
};
struct ProbMerge {
    static constexpr bool GATHER = false;
    const bf16* O[3]; const bf16* Bt; int K, lda, ldb, nM, nN, G, c;
    __device__ __forceinline__ bool next(int i, Unit& u) const { u.z = i % 3; return pg8::tile_map((long)(i / 3) * G + c, nM, nN, u.pm, u.pn); }
    __device__ __forceinline__ const char* a_base(const Unit& u) const { const bf16* o = u.z == 0 ? O[0] : (u.z == 1 ? O[1] : O[2]); return (const char*)(o + (size_t)u.pm * 256 * lda); }
    __device__ __forceinline__ const char* b_base(const Unit& u) const { return (const char*)(Bt + ((size_t)u.z * 1024 + (size_t)u.pn * 256) * ldb); }
    __device__ __forceinline__ unsigned a_rowoff(const Unit&, int) const { return 0u; }
};
__device__ __forceinline__ void moe_tables(const unsigned* cnt, LAS int* T, int tid_in) {
    int t_ = tid_in; asm volatile("" : "+v"(t_));
    __syncthreads();
    if (t_ < 64) T[706 + t_] = (int)__hip_atomic_load(cnt + t_, __ATOMIC_RELAXED, __HIP_MEMORY_SCOPE_AGENT);
    __syncthreads();
    if (t_ == 0) {
        int row = 0, t = 0;
#pragma nounroll
        for (int ge = 0; ge < 64; ++ge) {
            const int cn = T[706 + ge];
            T[2 + ge] = row; const int nt = (cn + 255) >> 8;
#pragma nounroll
            for (int k = 0; k < nt && t < 640; ++k) T[66 + (t++)] = ge & 31;
            row += nt * 256;
            if (ge == 31) T[1] = t;
        }
        T[0] = t;
    }
    __syncthreads();
}
struct ProbUp {
    static constexpr bool GATHER = true;
    const bf16* A; const bf16* Bt; const int* rowtok; LAS int* T; int K, lda, ldb, G, c;
    __device__ __forceinline__ bool next(int i, Unit& u) const {
        const int nwg = T[0] * 4; const long L = (long)i * G + c; if (L >= nwg) return false;
        int w = (int)L; { const int q = nwg / 8, r = nwg % 8, xcd = w % 8, off = w / 8; w = (xcd < r ? xcd * (q + 1) : r * (q + 1) + (xcd - r) * q) + off; }
        u.pm = w >> 2; u.pn = w & 3; u.z = T[66 + u.pm]; return true;
    }
    __device__ __forceinline__ const char* a_base(const Unit&) const { return (const char*)A; }
    __device__ __forceinline__ const char* b_base(const Unit& u) const { return (const char*)(Bt + ((size_t)u.z * 1024 + (size_t)u.pn * 256) * ldb); }
    __device__ __forceinline__ unsigned a_rowoff(const Unit& u, int r) const { const GAS int* base = (const GAS int*)(rowtok + (size_t)u.pm * 256); int t = base[(unsigned)r]; t = t < 0 ? 0 : t; return (unsigned)t * (unsigned)lda * 2u; }
};
struct ProbDown {
    static constexpr bool GATHER = false;
    const bf16* A; const bf16* Bt; LAS int* T; int K, lda, ldb, G, c, t0, t1;
    __device__ __forceinline__ bool next(int i, Unit& u) const {
        const int nwg = (t1 - t0) * 4; const long L = (long)i * G + c; if (L >= nwg) return false;
        int w = (int)L; { const int q = nwg / 8, r = nwg % 8, xcd = w % 8, off = w / 8; w = (xcd < r ? xcd * (q + 1) : r * (q + 1) + (xcd - r) * q) + off; }
        u.pm = t0 + (w >> 2); u.pn = w & 3; u.z = T[66 + u.pm]; return true;
    }
    __device__ __forceinline__ const char* a_base(const Unit& u) const { return (const char*)(A + (size_t)u.pm * 256 * lda); }
    __device__ __forceinline__ const char* b_base(const Unit& u) const { return (const char*)(Bt + ((size_t)u.z * 1024 + (size_t)u.pn * 256) * ldb); }
    __device__ __forceinline__ unsigned a_rowoff(const Unit&, int) const { return 0u; }
};

typedef f32x4 AccT[2][2][4][2];
#define EPI_ROWS_BEGIN  _Pragma("unroll") for (int ai = 0; ai < 2; ++ai) _Pragma("unroll") for (int m = 0; m < 4; ++m) { const int row = row0 + ai * 128 + m * 16;
#define EPI_ROWS_END    }
__device__ __forceinline__ u32x4 pack8(const f32x4& a, const f32x4& b) { u32x4 w; w.x = pg8::cvt_pk_bf16(a[0], a[1]); w.y = pg8::cvt_pk_bf16(a[2], a[3]); w.z = pg8::cvt_pk_bf16(b[0], b[1]); w.w = pg8::cvt_pk_bf16(b[2], b[3]); return w; }

__device__ __forceinline__ void s5_row_of(int row, int& rho, int& s) {
    if (row < RL) { const int b = row >> 11, t = row & 2047; rho = b * 128 + (t >> 4); s = t & 15; }
    else { const int rc = row - RL, b = rc >> 8, t = rc & 255; rho = 1024 + b * 16 + (t >> 4); s = t & 15; }
}
struct EpiG1 {
    static constexpr bool IDEMP = true;
    static constexpr bool PERM = true;
    unsigned char* ck; const float* gqn; const float* gkn;
    bf16* gtc;
    __device__ __forceinline__ void operator()(const AccT& acc, const Unit& u, int wr, int wc, int fr, int fq) const {
        const int pn = u.pn, row0 = u.pm * 256 + wr * 64 + fr, cin = wc * 32 + 8 * fq;
        if (pn == 1 || pn == 2) {
            bf16* AS5 = (bf16*)(ck + C_AS5);
            EPI_ROWS_BEGIN
                int rho, s; s5_row_of(row, rho, s);
#pragma unroll
                for (int bj = 0; bj < 2; ++bj) { const int c512 = (pn - 1) * 256 + bj * 128 + cin, g = c512 >> 4, n0 = c512 & 15;
                    stg<u32x4>(AS5 + ((size_t)rho * 32 + g) * 512 + s * 16 + n0, pack8(acc[ai][bj][m][0], acc[ai][bj][m][1])); }
            EPI_ROWS_END
            return;
        }
        if (pn == 24) {
            bf16* KRP = (bf16*)(ck + C_KRP);
            if (wc == 0) { EPI_ROWS_BEGIN stg<u32x4>(KRP + (size_t)row * 32 + 8 * fq, pack8(acc[ai][0][m][0], acc[ai][0][m][1])); EPI_ROWS_END }
            return;
        }
        if (pn >= 6 && pn < 10) {
            const bool isq = pn < 8; const int head = 4 * (isq ? pn - 6 : pn - 8) + wc;
            bf16* dst = (bf16*)(ck + (isq ? C_NQ : C_NK)) + head * 64 + 8 * fq; const float* gn = isq ? gqn : gkn;
            f32x4 g[2][2];
#pragma unroll
            for (int bj = 0; bj < 2; ++bj)
#pragma unroll
                for (int n = 0; n < 2; ++n) g[bj][n] = ldg<f32x4>(gn + bj * 32 + 8 * fq + 4 * n);
            const float osc = isq ? 0.125f * LOG2E : 1.0f;
            EPI_ROWS_BEGIN
                float ss = 0.f;
#pragma unroll
                for (int bj = 0; bj < 2; ++bj)
#pragma unroll
                    for (int n = 0; n < 2; ++n) { const f32x4 v = acc[ai][bj][m][n]; ss += v[0] * v[0] + v[1] * v[1] + v[2] * v[2] + v[3] * v[3]; }
                ss = shx_sum<16>(ss); ss = shx_sum<32>(ss);
                const float sc = rsqrtf(ss * (1.0f / 64.0f) + RMS_EPS) * osc;
#pragma unroll
                for (int bj = 0; bj < 2; ++bj) stg<u32x4>(dst + (size_t)row * 512 + bj * 32, pack8(acc[ai][bj][m][0] * sc * g[bj][0], acc[ai][bj][m][1] * sc * g[bj][1]));
            EPI_ROWS_END
            return;
        }
        bf16* dst; int ld, col0; bool sig = false; float* ssq = nullptr; int ssld = 0;
        if (pn == 0) { dst = (bf16*)(ck + C_KVL); ld = 256; col0 = 0; ssq = (float*)(ck + C_SSKV) + wc; ssld = 4; }
        else if (pn < 6) { dst = (bf16*)(ck + C_QL); ld = 768; col0 = (pn - 3) * 256; ssq = (float*)(ck + C_SSQL) + (pn - 3) * 4 + wc; ssld = 12; }
        else if (pn < 12) { dst = (bf16*)(ck + C_NV); ld = 512; col0 = (pn - 10) * 256; }
        else { dst = u.pm >= 64 ? gtc : (bf16*)(ck + C_GT); ld = 3072; col0 = (pn - 12) * 256; sig = true; }
        EPI_ROWS_BEGIN
            float ss = 0.f;
#pragma unroll
            for (int bj = 0; bj < 2; ++bj) {
                f32x4 v0 = acc[ai][bj][m][0], v1 = acc[ai][bj][m][1];
                if (sig) {
#pragma unroll
                    for (int j = 0; j < 4; ++j) { v0[j] = sigmoidf(v0[j]); v1[j] = sigmoidf(v1[j]); } }
                ss += v0[0] * v0[0] + v0[1] * v0[1] + v0[2] * v0[2] + v0[3] * v0[3] + v1[0] * v1[0] + v1[1] * v1[1] + v1[2] * v1[2] + v1[3] * v1[3];
                stg<u32x4>(dst + (size_t)row * ld + col0 + bj * 128 + cin, pack8(v0, v1));
            }
            if (ssq) { ss = shx_sum<16>(ss); ss = shx_sum<32>(ss); if (fq == 0) stg<float>(ssq + (size_t)row * ssld, ss); }
        EPI_ROWS_END
    }
};
struct EpiStore {
    static constexpr bool IDEMP = true;
    static constexpr bool PERM = true;
    bf16* D0; bf16* D1; int ld, split;
    __device__ __forceinline__ void operator()(const AccT& acc, const Unit& u, int wr, int wc, int fr, int fq) const {
        const int row0 = u.pm * 256 + wr * 64 + fr, cin = wc * 32 + 8 * fq;
        bf16* dst = u.pn < split ? D0 : D1; const int col0 = (u.pn < split ? u.pn : u.pn - split) * 256;
        EPI_ROWS_BEGIN
#pragma unroll
            for (int bj = 0; bj < 2; ++bj) stg<u32x4>(dst + (size_t)row * ld + col0 + bj * 128 + cin, pack8(acc[ai][bj][m][0], acc[ai][bj][m][1]));
        EPI_ROWS_END
    }
};
template <int NP> struct EpiStoreRs {
    static constexpr bool IDEMP = true;
    static constexpr bool PERM = true;
    bf16* D0; bf16* D1; int ld, split; const float* ssq; float inv_width;
    __device__ __forceinline__ void operator()(const AccT& acc, const Unit& u, int wr, int wc, int fr, int fq) const {
        const int row0 = u.pm * 256 + wr * 64 + fr, cin = wc * 32 + 8 * fq;
        bf16* dst = u.pn < split ? D0 : D1; const int col0 = (u.pn < split ? u.pn : u.pn - split) * 256;
        float rs[2][4];
#pragma unroll
        for (int ai = 0; ai < 2; ++ai)
#pragma unroll
            for (int m = 0; m < 4; ++m) { const float* p = ssq + (size_t)(row0 + ai * 128 + m * 16) * NP; float t = 0.f;
#pragma unroll
                for (int k = 0; k < NP; k += 4) { const f32x4 q = ldg<f32x4>(p + k); t += (q[0] + q[1]) + (q[2] + q[3]); }
                rs[ai][m] = rsqrtf(t * inv_width + RMS_EPS); }
        EPI_ROWS_BEGIN
            const float r = rs[ai][m];
#pragma unroll
            for (int bj = 0; bj < 2; ++bj) stg<u32x4>(dst + (size_t)row * ld + col0 + bj * 128 + cin, pack8(acc[ai][bj][m][0] * r, acc[ai][bj][m][1] * r));
        EPI_ROWS_END
    }
};
struct EpiS5S {
    static constexpr bool IDEMP = true;
    static constexpr bool PERM = false;
    float* SS;
    __device__ __forceinline__ void operator()(const AccT& acc, const Unit& u, int wr, int wc, int fr, int fq) const {
        const int row0 = u.pm * 256 + wr * 64 + fr, cin = wc * 32 + 4 * fq;
        EPI_ROWS_BEGIN
#pragma unroll
            for (int bj = 0; bj < 2; ++bj)
#pragma unroll
                for (int n = 0; n < 2; ++n) stg<f32x4>(SS + ((size_t)row * 32 + u.pn) * 256 + bj * 128 + cin + 16 * n, acc[ai][bj][m][n]);
        EPI_ROWS_END
    }
};
struct EpiS5Y {
    static constexpr bool IDEMP = true;
    static constexpr bool PERM = true;
    bf16* YG; bf16* YGc;
    __device__ __forceinline__ void operator()(const AccT& acc, const Unit& u, int wr, int wc, int fr, int fq) const {
        const int row0 = u.pm * 256 + wr * 64 + fr, cin = wc * 32 + 8 * fq, g = u.pn;
        EPI_ROWS_BEGIN
            const int rho = row;
            if (rho < 1152) {
                int base; bf16* yg = YG; if (rho < 1024) base = (rho >> 7) * 2048 + (rho & 127) * 16; else { base = ((rho - 1024) >> 4) * 256 + ((rho - 1024) & 15) * 16; yg = YGc; }
#pragma unroll
                for (int bj = 0; bj < 2; ++bj) { const int col = bj * 128 + cin, t = col >> 4, n0 = col & 15;
                    f32x4 v0 = acc[ai][bj][m][0], v1 = acc[ai][bj][m][1];
#pragma unroll
                    for (int j = 0; j < 4; ++j) { v0[j] = gelu_tanh(v0[j]); v1[j] = gelu_tanh(v1[j]); }
                    stg<u32x4>(yg + (size_t)(base + t) * 512 + g * 16 + n0, pack8(v0, v1)); }
            }
        EPI_ROWS_END
    }
};
template <int MODE> struct EpiPair {
    static constexpr bool IDEMP = true;
    static constexpr bool PERM = true;
    bf16* Dst; int ld;
    __device__ __forceinline__ void operator()(const AccT& acc, const Unit& u, int wr, int wc, int fr, int fq) const {
        const int row0 = u.pm * 256 + wr * 64 + fr, cin = wc * 32 + 8 * fq;
        EPI_ROWS_BEGIN
            f32x4 r0, r1;
#pragma unroll
            for (int j = 0; j < 4; ++j) {
                const float a0 = acc[ai][0][m][0][j], a1 = acc[ai][0][m][1][j], b0 = acc[ai][1][m][0][j], b1 = acc[ai][1][m][1][j];
                if (MODE == 0) { r0[j] = a0 * sigmoidf(b0); r1[j] = a1 * sigmoidf(b1); }
                else { r0[j] = a0 * sigmoidf(a0) * b0; r1[j] = a1 * sigmoidf(a1) * b1; }
            }
            stg<u32x4>(Dst + (size_t)row * ld + u.pn * 128 + cin, pack8(r0, r1));
        EPI_ROWS_END
    }
};
struct EpiMerge {
    static constexpr bool IDEMP = false;
    static constexpr bool PERM = true;
    const bf16* GT; bf16* YMB;
    __device__ __forceinline__ void operator()(const AccT& acc, const Unit& u, int wr, int wc, int fr, int fq) const {
        const int row0 = u.pm * 256 + wr * 64 + fr, cin = wc * 32 + 8 * fq, z = u.z;
        if (z == 0) {
#pragma unroll
            for (int ai = 0; ai < 2; ++ai) {
                u32x4 gw[4][2];
#pragma unroll
                for (int m = 0; m < 4; ++m)
#pragma unroll
                    for (int bj = 0; bj < 2; ++bj) gw[m][bj] = ldg<u32x4>(GT + (size_t)(row0 + ai * 128 + m * 16) * 3072 + u.pn * 256 + bj * 128 + cin);
#pragma unroll
                for (int m = 0; m < 4; ++m)
#pragma unroll
                    for (int bj = 0; bj < 2; ++bj) { const u32x4 g = gw[m][bj]; f32x4 v0 = acc[ai][bj][m][0], v1 = acc[ai][bj][m][1];
                        v0[0] *= bflo(g.x); v0[1] *= bfhi(g.x); v0[2] *= bflo(g.y); v0[3] *= bfhi(g.y); v1[0] *= bflo(g.z); v1[1] *= bfhi(g.z); v1[2] *= bflo(g.w); v1[3] *= bfhi(g.w);
                        stg<u32x4>(YMB + (size_t)(row0 + ai * 128 + m * 16) * 1024 + u.pn * 256 + bj * 128 + cin, pack8(v0, v1)); }
            }
            return;
        }
#pragma unroll
        for (int ai = 0; ai < 2; ++ai) {
            u32x4 gw[4][2], yp[4][2];
#pragma unroll
            for (int m = 0; m < 4; ++m)
#pragma unroll
                for (int bj = 0; bj < 2; ++bj) { const int row = row0 + ai * 128 + m * 16, col = u.pn * 256 + bj * 128 + cin;
                    gw[m][bj] = ldg<u32x4>(GT + (size_t)row * 3072 + z * 1024 + col); yp[m][bj] = ldg<u32x4>(YMB + (size_t)row * 1024 + col); }
#pragma unroll
            for (int m = 0; m < 4; ++m)
#pragma unroll
                for (int bj = 0; bj < 2; ++bj) { const u32x4 g = gw[m][bj], y = yp[m][bj]; f32x4 v0 = acc[ai][bj][m][0], v1 = acc[ai][bj][m][1];
                    v0[0] = v0[0] * bflo(g.x) + bflo(y.x); v0[1] = v0[1] * bfhi(g.x) + bfhi(y.x); v0[2] = v0[2] * bflo(g.y) + bflo(y.y); v0[3] = v0[3] * bfhi(g.y) + bfhi(y.y);
                    v1[0] = v1[0] * bflo(g.z) + bflo(y.z); v1[1] = v1[1] * bfhi(g.z) + bfhi(y.z); v1[2] = v1[2] * bflo(g.w) + bflo(y.w); v1[3] = v1[3] * bfhi(g.w) + bfhi(y.w);
                    stg<u32x4>(YMB + (size_t)(row0 + ai * 128 + m * 16) * 1024 + u.pn * 256 + bj * 128 + cin, pack8(v0, v1)); }
        }
    }
};
struct EpiOut {
    static constexpr bool IDEMP = false;
    static constexpr bool PERM = false;
    const float* xl_old; const float* xc_old; float* xl_new; float* xc_new; const float* MODL; int b0;
    __device__ __forceinline__ void operator()(const AccT& acc, const Unit& u, int wr, int wc, int fr, int fq) const {
        const int row0 = u.pm * 256 + wr * 64 + fr, cin = wc * 32 + 4 * fq, trow = u.pm * 256;
        const float* xo; float* xn; int mrow;
        if (b0 < 0) { xo = xc_old + (size_t)trow * 1024; xn = xc_new + (size_t)trow * 1024; mrow = 32; }
        else if (trow < RL) { const size_t tok = (size_t)(b0 + (trow >> 11)) * 2048 + (trow & 2047); xo = xl_old + tok * 1024; xn = xl_new + tok * 1024; mrow = b0 + (trow >> 11); }
        else { const int rc = trow - RL; const size_t tok = (size_t)(b0 + (rc >> 8)) * 256 + (rc & 255); xo = xc_old + tok * 1024; xn = xc_new + tok * 1024; mrow = 32; }
        const float* gt = MODL + (size_t)mrow * 6144 + 2 * 1024 + u.pn * 256 + cin;
        f32x4 g[2][2];
#pragma unroll
        for (int bj = 0; bj < 2; ++bj)
#pragma unroll
            for (int n = 0; n < 2; ++n) g[bj][n] = ldg<f32x4>(gt + bj * 128 + 16 * n);
#pragma unroll
        for (int ai = 0; ai < 2; ++ai)
#pragma unroll
            for (int mp = 0; mp < 2; ++mp) {
                f32x4 xv[2][2][2];
#pragma unroll
                for (int mm = 0; mm < 2; ++mm)
#pragma unroll
                    for (int bj = 0; bj < 2; ++bj)
#pragma unroll
                        for (int n = 0; n < 2; ++n) xv[mm][bj][n] = ldg<f32x4>(xo + (size_t)(row0 - trow + ai * 128 + (2 * mp + mm) * 16) * 1024 + u.pn * 256 + bj * 128 + cin + 16 * n);
#pragma unroll
                for (int mm = 0; mm < 2; ++mm)
#pragma unroll
                    for (int bj = 0; bj < 2; ++bj)
#pragma unroll
                        for (int n = 0; n < 2; ++n) stg<f32x4>(xn + (size_t)(row0 - trow + ai * 128 + (2 * mp + mm) * 16) * 1024 + u.pn * 256 + bj * 128 + cin + 16 * n, xv[mm][bj][n] + g[bj][n] * acc[ai][bj][2 * mp + mm][n]);
            }
    }
};
struct EpiDown {
    static constexpr bool IDEMP = false;
    static constexpr bool PERM = false;
    const int* rowtok; const float* roww; float* xl; float* xc; const float* MODL; float wscale;
    __device__ __forceinline__ void operator()(const AccT& acc, const Unit& u, int wr, int wc, int fr, int fq) const {
        const int row0 = u.pm * 256 + wr * 64 + fr, cin = wc * 32 + 4 * fq, cbase = u.pn * 256 + cin;
        int tk[2][4]; float ww[2][4];
#pragma unroll
        for (int ai = 0; ai < 2; ++ai)
#pragma unroll
            for (int m = 0; m < 4; ++m) { const int row = row0 + ai * 128 + m * 16; tk[ai][m] = ldg<int>(rowtok + row); ww[ai][m] = ldg<float>(roww + row) * wscale; }
#pragma unroll
        for (int ai = 0; ai < 2; ++ai)
#pragma unroll
            for (int mp = 0; mp < 2; ++mp) {
                f32x4 xv[2][2][2], gv[2][2][2]; float* xp[2];
#pragma unroll
                for (int mm = 0; mm < 2; ++mm) { const int tok = tk[ai][2 * mp + mm]; const int t0 = tok < 0 ? 0 : tok;
                    int mrow; if (t0 < NTOK_LAT) { xp[mm] = xl + (size_t)t0 * 1024 + cbase; mrow = t0 >> 11; } else { xp[mm] = xc + (size_t)(t0 - NTOK_LAT) * 1024 + cbase; mrow = 32; }
                    const float* gt = MODL + (size_t)mrow * 6144 + 5 * 1024 + cbase;
#pragma unroll
                    for (int bj = 0; bj < 2; ++bj)
#pragma unroll
                        for (int n = 0; n < 2; ++n) { xv[mm][bj][n] = ldg<f32x4>(xp[mm] + bj * 128 + 16 * n); gv[mm][bj][n] = ldg<f32x4>(gt + bj * 128 + 16 * n); } }
#pragma unroll
                for (int mm = 0; mm < 2; ++mm) { const int m = 2 * mp + mm;
                    if (tk[ai][m] >= 0) { const float w = ww[ai][m];
#pragma unroll
                        for (int bj = 0; bj < 2; ++bj)
#pragma unroll
                            for (int n = 0; n < 2; ++n) stg<f32x4>(xp[mm] + bj * 128 + 16 * n, xv[mm][bj][n] + (gv[mm][bj][n] * w) * acc[ai][bj][m][n]); } }
            }
    }
};

struct EpiDownY {
    static constexpr bool IDEMP = true;
    static constexpr bool PERM = true;
    const int* rowtok; const float* roww; bf16* Y; int nt0;
    __device__ __forceinline__ void operator()(const AccT& acc, const Unit& u, int wr, int wc, int fr, int fq) const {
        const int row0 = u.pm * 256 + wr * 64 + fr, cin = wc * 32 + 8 * fq;
        bf16* Yp = Y + (u.pm < nt0 ? (size_t)0 : (size_t)NTOK * 1024) + u.pn * 256 + cin;
        int tk[2][4]; float ww[2][4];
#pragma unroll
        for (int ai = 0; ai < 2; ++ai)
#pragma unroll
            for (int m = 0; m < 4; ++m) { const int row = row0 + ai * 128 + m * 16; tk[ai][m] = ldg<int>(rowtok + row); ww[ai][m] = ldg<float>(roww + row); }
#pragma unroll
        for (int ai = 0; ai < 2; ++ai)
#pragma unroll
            for (int m = 0; m < 4; ++m) if (tk[ai][m] >= 0) { const float w = ww[ai][m];
#pragma unroll
                for (int bj = 0; bj < 2; ++bj) stg<u32x4>(Yp + (size_t)tk[ai][m] * 1024 + bj * 128, pack8(acc[ai][bj][m][0] * w, acc[ai][bj][m][1] * w)); }
    }
};

__device__ __forceinline__ void tr_item(const float* W, int K, int Nsrc, int scol0, const float* kscale, bf16* WT, int drow0, int k0, LAS float* scr, int lane) {
#pragma unroll
    for (int i = 0; i < 8; ++i) { const int kk = 8 * i + (lane >> 3), n4 = (lane & 7) * 4;
        f32x4 v = {0.f, 0.f, 0.f, 0.f}; if (scol0 >= 0) { v = ldg<f32x4>(W + (size_t)(k0 + kk) * Nsrc + scol0 + n4); if (kscale) v = v * ldg<float>(kscale + k0 + kk); }
        scr[kk * 33 + n4] = v[0]; scr[kk * 33 + n4 + 1] = v[1]; scr[kk * 33 + n4 + 2] = v[2]; scr[kk * 33 + n4 + 3] = v[3]; }
    asm volatile("s_waitcnt lgkmcnt(0)" ::: "memory");
    const int c = lane & 7;
#pragma unroll
    for (int j = 0; j < 4; ++j) { const int n = (lane >> 3) + 8 * j; const LAS float* s = scr + (8 * c) * 33 + n;
        u32x4 o; o.x = pk2(s[0 * 33], s[1 * 33]); o.y = pk2(s[2 * 33], s[3 * 33]); o.z = pk2(s[4 * 33], s[5 * 33]); o.w = pk2(s[6 * 33], s[7 * 33]);
        stg<u32x4>(WT + (size_t)(drow0 + n) * K + k0 + 8 * c, o); }
    asm volatile("s_waitcnt lgkmcnt(0)" ::: "memory");
}
__device__ __forceinline__ int win_src_col(int n) {
    if (n < 256) return n;
    if (n < 768) return 1312 + (n - 256);
    if (n < 1536) return 1824 + (n - 768);
    if (n < 2560) {
        const int base = n < 2048 ? 2592 : 288, r = n < 2048 ? n - 1536 : n - 2048, t = r >> 8, c = r & 255;
        return base + (4 * t + ((c & 127) >> 5)) * 64 + (c >> 7) * 32 + (c & 31); }
    if (n < 3072) return 800 + (n - 2560);
    if (n < 6144) return 3104 + (n - 3072);
    if (n < 6176) return 256 + (n - 6144);
    return -1;
}
__device__ __forceinline__ int pair_src_col(int n) { const int pn = n >> 8, jj = n & 255; return jj < 128 ? 128 * pn + jj : 512 + 128 * pn + (jj - 128); }

__device__ __forceinline__ void prologue_transposes(Frame& F, int cu_lo) {
    LAS float* scr = (LAS float*)(F.lds + F.wave * 16384);
    const int gw = (F.c - cu_lo) * 8 + F.wave, NGW = (F.G - cu_lo) * 8;
    constexpr int I_IN = (NINP / 32) * 16, I_UQ = 24 * 12, I_UKV = 32 * 4, I_GLU = 32 * 8, I_BR = 3 * 32 * 8, I_OUT = 32 * 16, I_UP = 32 * 32 * 16, I_DN = 32 * 32 * 8;
    constexpr int PER_L = I_IN + I_UQ + I_UKV + I_GLU + I_BR + I_OUT;
    for (int it = gw; it < 2 * PER_L; it += NGW) {
        const int l = it / PER_L; int r = it % PER_L;
        if (r < I_IN) { const int nb = r / 16, kb = r % 16; tr_item(F.in[7] + (size_t)l * 1024 * 6176, 1024, 6176, win_src_col(nb * 32), nullptr, (bf16*)(F.ws + WS_WINT) + (size_t)l * NINP * 1024, nb * 32, kb * 64, scr, F.lane); continue; } r -= I_IN;
        if (r < I_UQ) { const int nb = r / 12, kb = r % 12; tr_item(F.in[9] + (size_t)l * 768 * 768, 768, 768, nb * 32, F.in[8] + l * 768, (bf16*)(F.ws + WS_UQT) + (size_t)l * 768 * 768, nb * 32, kb * 64, scr, F.lane); continue; } r -= I_UQ;
        if (r < I_UKV) { const int nb = r / 4, kb = r % 4, n = nb * 32; const int sc = n < 512 ? (n >> 6) * 128 + (n & 63) : ((n - 512) >> 6) * 128 + 64 + (n & 63);
            tr_item(F.in[11] + (size_t)l * 256 * 1024, 256, 1024, sc, F.in[10] + l * 256, (bf16*)(F.ws + WS_UKVT) + (size_t)l * 1024 * 256, n, kb * 64, scr, F.lane); continue; } r -= I_UKV;
        if (r < I_GLU) { const int nb = r / 8, kb = r % 8; tr_item(F.in[25] + (size_t)l * 512 * 1024, 512, 1024, pair_src_col(nb * 32), nullptr, (bf16*)(F.ws + WS_GLUT) + (size_t)l * 1024 * 512, nb * 32, kb * 64, scr, F.lane); continue; } r -= I_GLU;
        if (r < I_BR) { const int z = r / 256, q = r % 256, nb = q / 8, kb = q % 8; tr_item(F.in[26] + ((size_t)l * 3 + z) * 512 * 1024, 512, 1024, nb * 32, nullptr, (bf16*)(F.ws + WS_BRT) + ((size_t)l * 3 + z) * 1024 * 512, nb * 32, kb * 64, scr, F.lane); continue; } r -= I_BR;
        { const int nb = r / 16, kb = r % 16; tr_item(F.in[27] + (size_t)l * 1024 * 1024, 1024, 1024, nb * 32, nullptr, (bf16*)(F.ws + WS_OUTT) + (size_t)l * 1024 * 1024, nb * 32, kb * 64, scr, F.lane); }
    }
}
constexpr int MOE_I_UP = 32 * 32 * 16, MOE_I_DN = 32 * 32 * 8, MOE_ITEMS = MOE_I_UP + MOE_I_DN;
__device__ __forceinline__ void tr_moe_items(Frame& F, int l, int first, int count, int cu_lo) {
    if (F.c < cu_lo) return;
    __syncthreads();
    LAS float* scr = (LAS float*)(F.lds + F.wave * 16384);
    const int gw = (F.c - cu_lo) * 8 + F.wave, NGW = (F.G - cu_lo) * 8;
#pragma nounroll
    for (int it = first + gw; it < first + count; it += NGW) {
        if (it < MOE_I_UP) { const int e = it / 512, q = it % 512, nb = q / 16, kb = q % 16; tr_item(F.in[33] + ((size_t)l * 32 + e) * 1024 * 1024, 1024, 1024, pair_src_col(nb * 32), nullptr, (bf16*)(F.ws + WS_UPT) + ((size_t)l * 32 + e) * 1024 * 1024, nb * 32, kb * 64, scr, F.lane); }
        else { const int r = it - MOE_I_UP, e = r / 256, q = r % 256, nb = q / 8, kb = q % 8; tr_item(F.in[34] + ((size_t)l * 32 + e) * 512 * 1024, 512, 1024, nb * 32, nullptr, (bf16*)(F.ws + WS_DOWNT) + ((size_t)l * 32 + e) * 1024 * 512, nb * 32, kb * 64, scr, F.lane); }
    }
}
__device__ __forceinline__ void prologue_small(Frame& F, int cu_lo) {
    const int gt = (F.c - cu_lo) * 512 + F.tid, NT = (F.G - cu_lo) * 512;
    float* ROPE = (float*)(F.ws + WS_ROPE);
    for (int i = gt; i < 2048 * 16; i += NT) { const int t = i >> 4, a = (i >> 3) & 1, f = i & 7;
        const float inv = powf(10000.0f, -(float)f / 8.0f); const float pos = a == 0 ? (float)(t >> 6) : (float)(t & 63); const float ang = pos * inv;
        ROPE[2 * i] = cosf(ang); ROPE[2 * i + 1] = sinf(ang); }
    float* WGT = (float*)(F.ws + WS_WGT); float* WET = (float*)(F.ws + WS_WET);
    for (int i = gt; i < 2 * 4 * 1024; i += NT) { const int l = i / 4096, e = (i >> 10) & 3, k = i & 1023; WGT[i] = F.in[29][((size_t)l * 1024 + k) * 4 + e]; }
    for (int i = gt; i < 2 * 32 * 1024; i += NT) { const int l = i / 32768, e = (i >> 10) & 31, k = i & 1023; WET[i] = F.in[31][((size_t)l * 1024 + k) * 32 + e]; }
}
__device__ __forceinline__ void prologue_mod(Frame& F, int cu_lo) {
    LAS float* SC = (LAS float*)F.lds;
    __syncthreads();
#pragma unroll 11
    for (int q = 0; q < 66; ++q) { const int i = F.tid + 512 * q, r = i >> 10, k = i & 1023; const float v = r < 32 ? ldg<float>(F.in[1] + r * 1024 + k) : ldg<float>(F.in[3] + k); SC[i] = v * sigmoidf(v); }
    __syncthreads();
    float* MODP = (float*)(F.ws + WS_MODP);
    const int gw = (F.c - cu_lo) * 8 + F.wave, NGW = (F.G - cu_lo) * 8;
    for (int task = gw; task < 2 * 96 * 8; task += NGW) {
        const int ks = task & 7, nb = (task >> 3) % 96, l = task / 768; const int n = nb * 64 + F.lane;
        f32x2 acc[33];
#pragma unroll
        for (int r = 0; r < 33; ++r) acc[r] = (f32x2){0.f, 0.f};
        const float* Wl = F.in[4] + (size_t)l * 1024 * 6144;
#pragma nounroll
        for (int kb = 0; kb < 4; ++kb) { const int k0 = ks * 128 + kb * 32;
            const float* Wk = Wl + (size_t)k0 * 6144;
            f32x2 w[16];
#pragma unroll
            for (int j = 0; j < 16; ++j) { w[j][0] = ldg<float>(Wk + (2 * j) * 6144 + n); w[j][1] = ldg<float>(Wk + (2 * j + 1) * 6144 + n); }
            const LAS float* s0 = SC + k0; const LAS float* s1 = s0 + 16 * 1024; const LAS float* s2 = s0 + 32 * 1024;
            asm volatile("" : "+v"(s0), "+v"(s1), "+v"(s2));
#pragma unroll
            for (int j4 = 0; j4 < 8; ++j4) {
#pragma unroll
                for (int r = 0; r < 33; ++r) { const f32x4 sv = *(const LAS f32x4*)((r < 16 ? s0 : (r < 32 ? s1 : s2)) + (r & 15) * 1024 + 4 * j4);
                    acc[r] += (f32x2){sv[0], sv[1]} * w[2 * j4]; acc[r] += (f32x2){sv[2], sv[3]} * w[2 * j4 + 1]; } } }
#pragma unroll
        for (int r = 0; r < 33; ++r) MODP[(((size_t)ks * 2 + l) * 33 + r) * 6144 + n] = acc[r][0] + acc[r][1];
    }
    __syncthreads();
}
__device__ __forceinline__ void prologue_mod_final(Frame& F) {
    const float* MODP = (const float*)(F.ws + WS_MODP);
    for (int i = F.c * 512 + F.tid; i < 2 * 33 * 6144; i += F.G * 512) { const int l = i / (33 * 6144), n = i % 6144;
        float s = F.in[5][l * 6144 + n];
#pragma unroll
        for (int ks = 0; ks < 8; ++ks) s += MODP[(size_t)ks * 2 * 33 * 6144 + i];
        F.MOD[i] = s; }
}
__device__ __forceinline__ void prologue_s5(Frame& F, int l, int g) {
    LAS float* AP = (LAS float*)F.lds;
    LAS float* BB = AP + 2 * 17 * 64 * 2;
    LAS float* CC = BB + 2 * 64 * 16 * 2;
    LAS float* KJ = CC + 2 * 16 * 64 * 2;
    __syncthreads();
    const float* a_re = F.in[17]; const float* a_im = F.in[18]; const float* ldt = F.in[19]; const float* b_re = F.in[20]; const float* b_im = F.in[21];
    const float* c_re = F.in[22]; const float* c_im = F.in[23]; const float* dsk = F.in[24];
    for (int i = F.tid; i < 2 * 17 * 64; i += 512) { const int dir = i / (17 * 64), j = (i / 64) % 17, p = i & 63;
        const size_t ia = (((size_t)l * 2 + dir) * 32 + g) * 64 + p;
        const float lre = fminf(a_re[ia], -1e-4f), lim = a_im[ia], dt = expf(ldt[((size_t)l * 2 + dir) * 32 + g]);
        const float mag = expf((float)j * (lre * dt)); const float ang = (float)j * (lim * dt);
        AP[2 * i] = mag * cosf(ang); AP[2 * i + 1] = mag * sinf(ang); }
    for (int i = F.tid; i < 2 * 64 * 16; i += 512) { const int dir = i / 1024, p = (i >> 4) & 63, m = i & 15;
        const size_t ia = (((size_t)l * 2 + dir) * 32 + g) * 64 + p;
        const float lre = fminf(a_re[ia], -1e-4f), lim = a_im[ia], dt = expf(ldt[((size_t)l * 2 + dir) * 32 + g]);
        const float mag = expf(lre * dt), abr = mag * cosf(lim * dt), abi = mag * sinf(lim * dt);
        const float den = lre * lre + lim * lim, nre = abr - 1.0f;
        const float fre = (nre * lre + abi * lim) / den, fim = (abi * lre - nre * lim) / den;
        const float br = b_re[ia * 16 + m], bi = b_im[ia * 16 + m];
        BB[2 * i] = fre * br - fim * bi; BB[2 * i + 1] = fre * bi + fim * br; }
    for (int i = F.tid; i < 2 * 16 * 64; i += 512) { const int dir = i / 1024, n = (i >> 6) & 15, p = i & 63;
        const size_t ic = ((((size_t)l * 2 + dir) * 32 + g) * 16 + n) * 64 + p;
        CC[2 * i] = c_re[ic]; CC[2 * i + 1] = c_im[ic]; }
    __syncthreads();
    { const int n = (F.tid >> 4) & 15, m = F.tid & 15, jh = F.tid >> 8;
#pragma nounroll
        for (int dir = 0; dir < 2; ++dir) {
            float sj[8];
#pragma unroll
            for (int q = 0; q < 8; ++q) sj[q] = 0.f;
#pragma unroll 4
            for (int p = 0; p < 64; ++p) {
                const f32x2 b = *(const LAS f32x2*)(BB + ((dir * 64 + p) * 16 + m) * 2), cc = *(const LAS f32x2*)(CC + ((dir * 16 + n) * 64 + p) * 2);
                const float tr = cc[0] * b[0] - cc[1] * b[1], ti = cc[0] * b[1] + cc[1] * b[0];
#pragma unroll
                for (int q = 0; q < 8; ++q) { const f32x2 a = *(const LAS f32x2*)(AP + ((dir * 17 + jh + 2 * q) * 64 + p) * 2); sj[q] += tr * a[0] - ti * a[1]; } }
#pragma unroll
            for (int q = 0; q < 8; ++q) KJ[((dir * 16 + jh + 2 * q) * 16 + n) * 16 + m] = sj[q]; } }
    __syncthreads();
    bf16* BTY = (bf16*)(F.ws + WS_BTY) + ((size_t)l * 32 + g) * 256 * 512;
    for (int i = F.tid; i < 256 * 512; i += 512) { const int row = i >> 9, k = i & 511, t = row >> 4, n = row & 15; float v;
        if (k < 256) { const int s = k >> 4, m = k & 15; v = 0.f;
            if (t >= s) v += KJ[((0 * 16 + (t - s)) * 16 + n) * 16 + m];
            if (s >= t) v += KJ[((1 * 16 + (s - t)) * 16 + n) * 16 + m];
            if (k == row) v += dsk[l * 512 + g * 16 + n]; }
        else { const int kk = k - 256, dir = kk >> 7, im = (kk >> 6) & 1, p = kk & 63, j = dir == 0 ? t + 1 : 16 - t;
            const float ar = AP[((dir * 17 + j) * 64 + p) * 2], ai = AP[((dir * 17 + j) * 64 + p) * 2 + 1];
            const float cr = CC[((dir * 16 + n) * 64 + p) * 2], ci = CC[((dir * 16 + n) * 64 + p) * 2 + 1];
            v = im == 0 ? (cr * ar - ci * ai) : -(cr * ai + ci * ar); }
        BTY[i] = (bf16)f2bf(v); }
    bf16* BTS = (bf16*)(F.ws + WS_BTS) + ((size_t)l * 32 + g) * 256 * 256;
    for (int i = F.tid; i < 256 * 256; i += 512) { const int row = i >> 8, k = i & 255, s = k >> 4, m = k & 15, dir = row >> 7, im = (row >> 6) & 1, p = row & 63, j = dir == 0 ? 15 - s : s;
        const float ar = AP[((dir * 17 + j) * 64 + p) * 2], ai = AP[((dir * 17 + j) * 64 + p) * 2 + 1];
        const float br = BB[((dir * 64 + p) * 16 + m) * 2], bi = BB[((dir * 64 + p) * 16 + m) * 2 + 1];
        const float v = im == 0 ? (ar * br - ai * bi) : (ar * bi + ai * br);
        BTS[i] = (bf16)f2bf(v); }
    float* A16 = (float*)(F.ws + WS_A16);
    for (int i = F.tid; i < 2 * 64; i += 512) { const int dir = i >> 6, p = i & 63;
        A16[((((size_t)l * 2 + dir) * 32 + g) * 64 + p) * 2] = AP[((dir * 17 + 16) * 64 + p) * 2];
        A16[((((size_t)l * 2 + dir) * 32 + g) * 64 + p) * 2 + 1] = AP[((dir * 17 + 16) * 64 + p) * 2 + 1]; }
    __syncthreads();
}

__device__ __forceinline__ void phase_h(Frame& F, int l, int b0, const float* xl, const float* xc, int nrows) {
    bf16* HB = (bf16*)(F.ck + C_HB);
    const float* g1 = F.in[6] + l * 1024;
    const int gw = F.c * 8 + F.wave, NGW = F.G * 8;
    for (int row = gw; row < nrows; row += NGW) {
        const float* xs; int mrow;
        if (row < RL) { mrow = b0 + (row >> 11); xs = xl + ((size_t)mrow * 2048 + (row & 2047)) * 1024; }
        else { const int rc = row - RL; xs = xc + ((size_t)(b0 + (rc >> 8)) * 256 + (rc & 255)) * 1024; mrow = 32; }
        const float* md = F.MOD + ((size_t)l * 33 + mrow) * 6144;
        f32x4 v[4]; float ss = 0.f;
#pragma unroll
        for (int j = 0; j < 4; ++j) { v[j] = ldg<f32x4>(xs + 4 * F.lane + 256 * j); ss += v[j][0] * v[j][0] + v[j][1] * v[j][1] + v[j][2] * v[j][2] + v[j][3] * v[j][3]; }
        const float rstd = rsqrtf(wave_sum(ss) * (1.0f / 1024.0f) + RMS_EPS);
#pragma unroll
        for (int j = 0; j < 4; ++j) { const int col = 4 * F.lane + 256 * j;
            const f32x4 g = ldg<f32x4>(g1 + col), sh = ldg<f32x4>(md + col), sc = ldg<f32x4>(md + 1024 + col);
            const f32x4 h = (v[j] * rstd * g) * (sc + 1.0f) + sh;
            u32x2 o; o.x = pk2(h[0], h[1]); o.y = pk2(h[2], h[3]); stg<u32x2>(HB + (size_t)row * 1024 + col, o); }
    }
}
__device__ __forceinline__ void vt_item(const bf16* src, int ldsrc, bf16* dst, LAS unsigned* scr, int lane) {
    const int r8 = lane >> 3, c8 = lane & 7;
#pragma unroll
    for (int i = 0; i < 8; ++i) { const int key = 8 * i + r8; const u32x4 v = ldg<u32x4>(src + (size_t)key * ldsrc + c8 * 8);
        scr[key * 33 + c8 * 4 + 0] = v.x; scr[key * 33 + c8 * 4 + 1] = v.y; scr[key * 33 + c8 * 4 + 2] = v.z; scr[key * 33 + c8 * 4 + 3] = v.w; }
    asm volatile("s_waitcnt lgkmcnt(0)" ::: "memory");
    const LAS unsigned short* s16 = (const LAS unsigned short*)scr;
#pragma unroll
    for (int i = 0; i < 8; ++i) { const int d = 8 * i + r8; unsigned w[4];
#pragma unroll
        for (int q = 0; q < 4; ++q) { const int k0 = c8 * 8 + q * 2; w[q] = (unsigned)s16[(k0 * 33) * 2 + d] | ((unsigned)s16[((k0 + 1) * 33) * 2 + d] << 16); }
        stg<u32x4>(dst + (size_t)d * KEYS + c8 * 8, (u32x4){w[0], w[1], w[2], w[3]}); }
    asm volatile("s_waitcnt lgkmcnt(0)" ::: "memory");
}
__device__ __forceinline__ void phase_p1(Frame& F, int l, bool ctx_q) {
    bf16* KVL = (bf16*)(F.ck + C_KVL); bf16* QL = (bf16*)(F.ck + C_QL); bf16* NQ = (bf16*)(F.ck + C_NQ); bf16* NK = (bf16*)(F.ck + C_NK);
    const float* gq = F.in[14] + l * 64; const float* gk = F.in[15] + l * 64;
    const int gw = F.c * 8 + F.wave, NGW = F.G * 8, lane = F.lane;
    for (int row = gw; row < RR; row += NGW) {
        { bf16* p = KVL + (size_t)row * 256 + 4 * lane; const u32x2 w = ldg<u32x2>(p);
          const float a = bflo(w.x), b = bfhi(w.x), c = bflo(w.y), d = bfhi(w.y);
          const float rstd = rsqrtf(wave_sum(a * a + b * b + c * c + d * d) * (1.0f / 256.0f) + RMS_EPS);
          stg<u32x2>(p, (u32x2){pk2(a * rstd, b * rstd), pk2(c * rstd, d * rstd)}); }
        { bf16* p = NK + (size_t)row * 512 + 8 * lane; const u32x4 w = ldg<u32x4>(p);
          float v[8] = {bflo(w.x), bfhi(w.x), bflo(w.y), bfhi(w.y), bflo(w.z), bfhi(w.z), bflo(w.w), bfhi(w.w)}; float ss = 0.f;
#pragma unroll
          for (int j = 0; j < 8; ++j) ss += v[j] * v[j];
          ss = shx_sum<1>(ss); ss = shx_sum<2>(ss); ss = shx_sum<4>(ss);
          const float rstd = rsqrtf(ss * (1.0f / 64.0f) + RMS_EPS); const int d0 = 8 * (lane & 7);
#pragma unroll
          for (int j = 0; j < 8; ++j) v[j] *= rstd * ldg<float>(gk + d0 + j);
          stg<u32x4>(p, (u32x4){pk2(v[0], v[1]), pk2(v[2], v[3]), pk2(v[4], v[5]), pk2(v[6], v[7])}); }
        if (row < RL || ctx_q) {
            { bf16* p = QL + (size_t)row * 768 + 12 * lane; u32x2 w[3]; float v[12]; float ss = 0.f;
#pragma unroll
              for (int j = 0; j < 3; ++j) { w[j] = ldg<u32x2>(p + 4 * j); v[4 * j] = bflo(w[j].x); v[4 * j + 1] = bfhi(w[j].x); v[4 * j + 2] = bflo(w[j].y); v[4 * j + 3] = bfhi(w[j].y); }
#pragma unroll
              for (int j = 0; j < 12; ++j) ss += v[j] * v[j];
              const float rstd = rsqrtf(wave_sum(ss) * (1.0f / 768.0f) + RMS_EPS);
#pragma unroll
              for (int j = 0; j < 3; ++j) stg<u32x2>(p + 4 * j, (u32x2){pk2(v[4 * j] * rstd, v[4 * j + 1] * rstd), pk2(v[4 * j + 2] * rstd, v[4 * j + 3] * rstd)}); }
            { bf16* p = NQ + (size_t)row * 512 + 8 * lane; const u32x4 w = ldg<u32x4>(p);
              float v[8] = {bflo(w.x), bfhi(w.x), bflo(w.y), bfhi(w.y), bflo(w.z), bfhi(w.z), bflo(w.w), bfhi(w.w)}; float ss = 0.f;
#pragma unroll
              for (int j = 0; j < 8; ++j) ss += v[j] * v[j];
              ss = shx_sum<1>(ss); ss = shx_sum<2>(ss); ss = shx_sum<4>(ss);
              const float rstd = rsqrtf(ss * (1.0f / 64.0f) + RMS_EPS) * (0.125f * LOG2E); const int d0 = 8 * (lane & 7);
#pragma unroll
              for (int j = 0; j < 8; ++j) v[j] *= rstd * ldg<float>(gq + d0 + j);
              stg<u32x4>(p, (u32x4){pk2(v[0], v[1]), pk2(v[2], v[3]), pk2(v[4], v[5]), pk2(v[6], v[7])}); }
        }
    }
    const bf16* NV = (const bf16*)(F.ck + C_NV); bf16* NVT = (bf16*)(F.ck + C_NVT);
    LAS unsigned* scr = (LAS unsigned*)(F.lds + F.wave * 16384);
    for (int it = gw; it < NB * 8 * 36; it += NGW) { const int kb = it % 36, h = (it / 36) & 7, b = it / 288;
        const int srow = kb < 32 ? b * 2048 + 64 * kb : RL + b * 256 + 64 * (kb - 32);
        vt_item(NV + (size_t)srow * 512 + h * 64, 512, NVT + ((size_t)(b * 8 + h) * 64) * KEYS + 64 * kb, scr, lane); }
}
__device__ __forceinline__ void ctx_krope(Frame& F, const bf16* HBc  , const bf16* WKR  ) {
    bf16* KRP = (bf16*)(F.ck + C_KRP); const int gw = F.c * 8 + F.wave, NGW = F.G * 8, lane = F.lane;
    for (int rc = gw; rc < RC; rc += NGW) {
        const u32x4 h0 = ldg<u32x4>(HBc + (size_t)rc * 1024 + 16 * lane), h1 = ldg<u32x4>(HBc + (size_t)rc * 1024 + 16 * lane + 8);
        float hv[16] = {bflo(h0.x), bfhi(h0.x), bflo(h0.y), bfhi(h0.y), bflo(h0.z), bfhi(h0.z), bflo(h0.w), bfhi(h0.w), bflo(h1.x), bfhi(h1.x), bflo(h1.y), bfhi(h1.y), bflo(h1.z), bfhi(h1.z), bflo(h1.w), bfhi(h1.w)};
        float p[32];
#pragma unroll
        for (int jb = 0; jb < 4; ++jb) {
            u32x4 w0[8], w1[8];
#pragma unroll
            for (int j8 = 0; j8 < 8; ++j8) { w0[j8] = ldg<u32x4>(WKR + (size_t)(jb * 8 + j8) * 1024 + 16 * lane); w1[j8] = ldg<u32x4>(WKR + (size_t)(jb * 8 + j8) * 1024 + 16 * lane + 8); }
#pragma unroll
            for (int j8 = 0; j8 < 8; ++j8) { const u32x4 a0 = w0[j8], a1 = w1[j8];
                p[jb * 8 + j8] = hv[0] * bflo(a0.x) + hv[1] * bfhi(a0.x) + hv[2] * bflo(a0.y) + hv[3] * bfhi(a0.y) + hv[4] * bflo(a0.z) + hv[5] * bfhi(a0.z) + hv[6] * bflo(a0.w) + hv[7] * bfhi(a0.w)
                                + hv[8] * bflo(a1.x) + hv[9] * bfhi(a1.x) + hv[10] * bflo(a1.y) + hv[11] * bfhi(a1.y) + hv[12] * bflo(a1.z) + hv[13] * bfhi(a1.z) + hv[14] * bflo(a1.w) + hv[15] * bfhi(a1.w); }
            __builtin_amdgcn_sched_barrier(0);
        }
        float r8[8];
#pragma unroll
        for (int k = 0; k < 8; ++k) r8[k] = row_sum16(hx16(hx32(p[k], p[k + 16]), hx32(p[k + 8], p[k + 24])));
        if ((lane & 15) == 0) stg<u32x4>(KRP + (size_t)(RL + rc) * 32 + 8 * (lane >> 4), (u32x4){pk2(r8[0], r8[1]), pk2(r8[2], r8[3]), pk2(r8[4], r8[5]), pk2(r8[6], r8[7])});
    }
}
__device__ __forceinline__ void phase_p2(Frame& F, int l, bool ctx_q) {
    const int gt = F.tid >= 128 ? F.c * 384 + (F.tid - 128) : 0x7fffffff - 1024, NT = F.G * 384;
    const float* ROPE = (const float*)(F.ws + WS_ROPE);
    if (F.tid < 128) { const float* SS = (const float*)(F.ck + C_SS); bf16* AS5 = (bf16*)(F.ck + C_AS5); const float* A16 = (const float*)(F.ws + WS_A16);
      for (int i = F.c * 128 + F.tid; i < NB * 32 * 2 * 64; i += F.G * 128) { const int p = i & 63, dir = (i >> 6) & 1, g = (i >> 7) & 31, b = i >> 12;
          const float ar = A16[((((size_t)l * 2 + dir) * 32 + g) * 64 + p) * 2], ai = A16[((((size_t)l * 2 + dir) * 32 + g) * 64 + p) * 2 + 1];
          float hr = 0.f, hi = 0.f;
          for (int c0 = 0; c0 < 144; c0 += 24) {
              float sr[24], si[24]; int rho[24];
#pragma unroll
              for (int k = 0; k < 24; ++k) { const int c = c0 + k;
                  rho[k] = dir == 0 ? (c < 16 ? 1024 + b * 16 + c : b * 128 + (c - 16)) : (c < 16 ? 1024 + b * 16 + (15 - c) : b * 128 + (127 - (c - 16)));
                  const float* sp = SS + ((size_t)rho[k] * 32 + g) * 256 + dir * 128 + p; sr[k] = ldg<float>(sp); si[k] = ldg<float>(sp + 64); }
#pragma unroll
              for (int k = 0; k < 24; ++k) { bf16* ap = AS5 + ((size_t)rho[k] * 32 + g) * 512 + 256 + dir * 128 + p;
                  ap[0] = (bf16)f2bf(hr); ap[64] = (bf16)f2bf(hi);
                  const float nr = ar * hr - ai * hi + sr[k], ni = ar * hi + ai * hr + si[k]; hr = nr; hi = ni; }
          } } }
#define UNPK(PW, FA) do { const u32x4 pw_ = (PW); FA[0] = bflo(pw_.x); FA[1] = bfhi(pw_.x); FA[2] = bflo(pw_.y); FA[3] = bfhi(pw_.y); FA[4] = bflo(pw_.z); FA[5] = bfhi(pw_.z); FA[6] = bflo(pw_.w); FA[7] = bfhi(pw_.w); } while (0)
#define PK8(FA) ((u32x4){pk2(FA[0], FA[1]), pk2(FA[2], FA[3]), pk2(FA[4], FA[5]), pk2(FA[6], FA[7])})
    { const bf16* QR = (const bf16*)(F.ck + C_QR); const bf16* KN = (const bf16*)(F.ck + C_KN); const bf16* KRP = (const bf16*)(F.ck + C_KRP);
      bf16* QF = (bf16*)(F.ck + C_QF); bf16* KF = (bf16*)(F.ck + C_KF);
      const int nq = 0, ntot = RR * 8;
      LAS unsigned char* st = F.lds + F.wave * 16384;
      for (int i = gt; i < ntot; i += NT) {
          const bool isq = __builtin_amdgcn_readfirstlane(i) < nq;
          const int ii = isq ? i : i - nq, row = ii >> 3, h = ii & 7;
          int ln = F.lane; asm volatile("" : "+v"(ln));
          const int i0 = ii - ln;
          const float* gn = isq ? F.in[12] + l * 96 : F.in[13] + l * 96;
          const float osc = isq ? 0.10206207261596575f * LOG2E : 1.0f;
          bf16* dst0 = (isq ? QF : KF) + (size_t)i0 * 96;
          u32x4 w[12];
          if (isq) { const bf16* s0 = QR + (size_t)i0 * 96;
#pragma unroll
              for (int j = 0; j < 12; ++j) { const int idx = j * 64 + ln; w[j] = ldg<u32x4>(s0 + idx * 8); }
#pragma unroll
              for (int j = 0; j < 12; ++j) { const int idx = j * 64 + ln; *(LAS u32x4*)(st + 16 * (idx + idx / 12)) = w[j]; }
          } else { const bf16* s0 = KN + (size_t)i0 * 64;
#pragma unroll
              for (int j = 0; j < 8; ++j) { const int idx = j * 64 + ln; w[j] = ldg<u32x4>(s0 + idx * 8); }
#pragma unroll
              for (int c = 0; c < 4; ++c) w[8 + c] = ldg<u32x4>(KRP + (size_t)row * 32 + c * 8);
#pragma unroll
              for (int j = 0; j < 8; ++j) { const int idx = j * 64 + ln; *(LAS u32x4*)(st + 16 * idx + 80 * (idx >> 3)) = w[j]; }
          }
          asm volatile("s_waitcnt lgkmcnt(0)" ::: "memory");
          if (isq) {
#pragma unroll
              for (int c = 0; c < 12; ++c) w[c] = *(const LAS u32x4*)(st + ln * 208 + c * 16);
          } else {
#pragma unroll
              for (int c = 0; c < 8; ++c) w[c] = *(const LAS u32x4*)(st + ln * 208 + c * 16);
          }
          float ss = 0.f;
#pragma unroll
          for (int c = 0; c < 12; ++c) { float f[8]; UNPK(w[c], f);
#pragma unroll
              for (int j = 0; j < 8; ++j) ss += f[j] * f[j]; }
          const float rstd = rsqrtf(ss * (1.0f / 96.0f) + RMS_EPS);
          LAS unsigned char* mine = st + ln * 208;
#pragma unroll
          for (int c = 0; c < 8; ++c) { float f[8]; UNPK(w[c], f);
#pragma unroll
              for (int j = 0; j < 8; ++j) f[j] *= rstd * gn[8 * c + j] * osc;
              *(LAS u32x4*)(mine + c * 16) = PK8(f); }
          const float* rp = ROPE + (size_t)(row & 2047) * 32; const bool rope = row < RL;
#pragma unroll
          for (int a = 0; a < 2; ++a) { float x1[8], x2[8]; UNPK(w[8 + 2 * a], x1); UNPK(w[9 + 2 * a], x2);
#pragma unroll
              for (int f = 0; f < 8; ++f) {
                  float cs = 1.0f, sn = 0.0f; if (rope) { const f32x2 t = ldg<f32x2>(rp + (a * 8 + f) * 2); cs = t[0]; sn = t[1]; }
                  const float v1 = x1[f] * rstd * gn[64 + a * 16 + f], v2 = x2[f] * rstd * gn[64 + a * 16 + 8 + f];
                  x1[f] = (v1 * cs - v2 * sn) * osc; x2[f] = (v1 * sn + v2 * cs) * osc; }
              *(LAS u32x4*)(mine + (8 + 2 * a) * 16) = PK8(x1); *(LAS u32x4*)(mine + (9 + 2 * a) * 16) = PK8(x2); }
          asm volatile("s_waitcnt lgkmcnt(0)" ::: "memory");
          int lo = ln; asm volatile("" : "+v"(lo));
#pragma unroll
          for (int j = 0; j < 12; ++j) { const int idx = j * 64 + lo; stg<u32x4>(dst0 + idx * 8, *(const LAS u32x4*)(st + 16 * (idx + idx / 12))); }
          asm volatile("s_waitcnt lgkmcnt(0)" ::: "memory");
      } }
#undef UNPK
#undef PK8
    { int lnv; asm volatile("v_mbcnt_lo_u32_b32 %0, -1, 0\n\tv_mbcnt_hi_u32_b32 %0, -1, %0" : "=v"(lnv));
      const bf16* VV = (const bf16*)(F.ck + C_VV); bf16* VT = (bf16*)(F.ck + C_VT); LAS unsigned* scr = (LAS unsigned*)(F.lds + F.wave * 16384);
      const int gw = F.wave >= 2 ? F.c * 6 + (F.wave - 2) : 0x7fffffff - 1024, NGW = F.G * 6;
      const bf16* NV = (const bf16*)(F.ck + C_NV); bf16* NVT = (bf16*)(F.ck + C_NVT);
      for (int it = gw; it < NB * 8 * 36; it += NGW) { const int kb = it % 36, h = (it / 36) & 7, b = it / 288;
          const int srow = kb < 32 ? b * 2048 + 64 * kb : RL + b * 256 + 64 * (kb - 32);
          vt_item(NV + (size_t)srow * 512 + h * 64, 512, NVT + ((size_t)(b * 8 + h) * 64) * KEYS + 64 * kb, scr, lnv); } }
}


constexpr int AT_KROW = 208, AT_VROW = 192, AT_KB = 64 * AT_KROW, AT_VB = 64 * AT_VROW, AT_SLOT = AT_KB + AT_VB;
__device__ __forceinline__ void mla_unit(Frame& F, const bf16* Qh  , const bf16* KFh  , const bf16* VVh  ,
                                         bf16* Oh  , int b, int kt0, int kt1, const float* gq  , const float* rope0  ) {
    int lane; asm volatile("v_mbcnt_lo_u32_b32 %0, -1, 0\n\tv_mbcnt_hi_u32_b32 %0, -1, %0" : "=v"(lane));
    LAS unsigned char* lds = F.lds; const int w = F.wave, tid = lane + 64 * w, r32 = lane & 31, hh = lane >> 5;
    const unsigned vtr_off = (unsigned)((4 * hh + ((lane >> 2) & 3)) * AT_VROW + (16 * ((lane >> 4) & 1) + 4 * (lane & 3)) * 2);
    const int kr0 = tid / 12, kc0 = tid % 12, kr1 = (tid + 512) / 12, kc1 = (tid + 512) % 12, vd = tid >> 3, vc = tid & 7;
    u32x4 sk0, sk1, sv;
#define AT_KROWIDX(kt) ((kt) < 32 ? b * 2048 + 64 * (kt) : RL + b * 256 + 64 * ((kt) - 32))
#define AT_LOAD(kt) do { const int kr_ = AT_KROWIDX(kt); sk0 = ldg<u32x4>(KFh + (size_t)(kr_ + kr0) * 768 + kc0 * 8); if (tid < 256) sk1 = ldg<u32x4>(KFh + (size_t)(kr_ + kr1) * 768 + kc1 * 8); \
        sv = ldg<u32x4>(VVh + (size_t)(kr_ + vd) * 512 + vc * 8); } while (0)
#define AT_WRITE(slot) do { LAS unsigned char* s_ = lds + (slot) * AT_SLOT; *(LAS u32x4*)(s_ + kr0 * AT_KROW + kc0 * 16) = sk0; if (tid < 256) *(LAS u32x4*)(s_ + kr1 * AT_KROW + kc1 * 16) = sk1; \
        *(LAS u32x4*)(s_ + AT_KB + vd * AT_VROW + vc * 16) = sv; } while (0)
    bf16x8 qf[6];
    { u32x4 raw[6];
#pragma unroll
      for (int ks = 0; ks < 6; ++ks) raw[ks] = ldg<u32x4>(Qh + (size_t)(32 * w + r32) * 768 + 16 * ks + 8 * hh);
#define AT_UNPK(W, FA) do { FA[0] = bflo(W.x); FA[1] = bfhi(W.x); FA[2] = bflo(W.y); FA[3] = bfhi(W.y); FA[4] = bflo(W.z); FA[5] = bfhi(W.z); FA[6] = bflo(W.w); FA[7] = bfhi(W.w); } while (0)
#define AT_PK8(FA) __builtin_bit_cast(bf16x8, (u32x4){pk2(FA[0], FA[1]), pk2(FA[2], FA[3]), pk2(FA[4], FA[5]), pk2(FA[6], FA[7])})
      float ss = 0.f;
#pragma unroll
      for (int ks = 0; ks < 6; ++ks) { float f[8]; AT_UNPK(raw[ks], f);
#pragma unroll
          for (int j = 0; j < 8; ++j) ss += f[j] * f[j]; }
      ss = hx32(ss, ss);
      const float rq = rsqrtf(ss * (1.0f / 96.0f) + RMS_EPS) * (0.10206207261596575f * LOG2E);
#pragma unroll
      for (int ks = 0; ks < 4; ++ks) { float f[8]; AT_UNPK(raw[ks], f); const f32x4 g0 = ldg<f32x4>(gq + 16 * ks + 8 * hh), g1 = ldg<f32x4>(gq + 16 * ks + 8 * hh + 4);
#pragma unroll
          for (int j = 0; j < 4; ++j) { f[j] *= rq * g0[j]; f[4 + j] *= rq * g1[j]; }
          qf[ks] = AT_PK8(f); }
#pragma unroll
      for (int a = 0; a < 2; ++a) { float f[8]; AT_UNPK(raw[4 + a], f); const f32x4 g0 = ldg<f32x4>(gq + 64 + 16 * a + 8 * hh), g1 = ldg<f32x4>(gq + 64 + 16 * a + 8 * hh + 4);
#pragma unroll
          for (int j = 0; j < 4; ++j) { f[j] *= rq * g0[j]; f[4 + j] *= rq * g1[j]; }
          if (rope0) { const float* rp = rope0 + (size_t)(32 * w + r32) * 32 + a * 16;
#pragma unroll
              for (int j4 = 0; j4 < 4; ++j4) { const f32x4 cs = ldg<f32x4>(rp + 4 * j4);
#pragma unroll
                  for (int e = 0; e < 2; ++e) { const int j = 2 * j4 + e; float pa = f[j], pb = f[j];
                      asm volatile("s_nop 1\n\tv_permlane32_swap_b32 %0, %1" : "+v"(pa), "+v"(pb));
                      const float pv = hh ? pa : pb;
                      f[j] = f[j] * cs[2 * e] + (hh ? pv : -pv) * cs[2 * e + 1]; } } }
          qf[4 + a] = AT_PK8(f); }
#undef AT_UNPK
#undef AT_PK8
    }
    f32x16 o0, o1;
#pragma unroll
    for (int r = 0; r < 16; ++r) { o0[r] = 0.f; o1[r] = 0.f; }
    float mrun = 0.f, lrun = 0.f;
    __syncthreads();
    AT_LOAD(kt0); AT_WRITE(0);
    __syncthreads();
    asm volatile(".rept " STR(MLA_PAD_N) "\n\ts_nop 0\n\t.endr" ::: "memory");
    for (int kt = kt0; kt < kt1; ++kt) {
        const int slot = (kt - kt0) & 1;
        if (kt + 1 < kt1) AT_LOAD(kt + 1);
        const LAS unsigned char* ks_ = lds + slot * AT_SLOT; const LAS unsigned char* vs_ = ks_ + AT_KB;
        f32x16 s0, s1;
        bf16x8 kf[12];
#pragma unroll
        for (int ks = 0; ks < 6; ++ks) { kf[2 * ks] = *(const LAS bf16x8*)(ks_ + r32 * AT_KROW + (16 * ks + 8 * hh) * 2); kf[2 * ks + 1] = *(const LAS bf16x8*)(ks_ + (32 + r32) * AT_KROW + (16 * ks + 8 * hh) * 2); }
        __builtin_amdgcn_sched_barrier(0);
#pragma unroll
        for (int ks = 0; ks < 6; ++ks) {
            if (ks == 0) { const f32x16 z16 = {}; s0 = __builtin_amdgcn_mfma_f32_32x32x16_bf16(kf[0], qf[0], z16, 0, 0, 0); s1 = __builtin_amdgcn_mfma_f32_32x32x16_bf16(kf[1], qf[0], z16, 0, 0, 0); }
            else { s0 = __builtin_amdgcn_mfma_f32_32x32x16_bf16(kf[2 * ks], qf[ks], s0, 0, 0, 0); s1 = __builtin_amdgcn_mfma_f32_32x32x16_bf16(kf[2 * ks + 1], qf[ks], s1, 0, 0, 0); }
        }
        u32x2 vfa[4][2], vfc[4][2];
        { const unsigned va_ = (unsigned)(size_t)vs_ + vtr_off;
          asm volatile("ds_read_b64_tr_b16 %0, %16 offset:0\n\t" "ds_read_b64_tr_b16 %1, %16 offset:1536\n\t" "ds_read_b64_tr_b16 %2, %16 offset:64\n\t" "ds_read_b64_tr_b16 %3, %16 offset:1600\n\t" "ds_read_b64_tr_b16 %4, %16 offset:3072\n\t" "ds_read_b64_tr_b16 %5, %16 offset:4608\n\t" "ds_read_b64_tr_b16 %6, %16 offset:3136\n\t" "ds_read_b64_tr_b16 %7, %16 offset:4672\n\t" "ds_read_b64_tr_b16 %8, %16 offset:6144\n\t" "ds_read_b64_tr_b16 %9, %16 offset:7680\n\t" "ds_read_b64_tr_b16 %10, %16 offset:6208\n\t" "ds_read_b64_tr_b16 %11, %16 offset:7744\n\t" "ds_read_b64_tr_b16 %12, %16 offset:9216\n\t" "ds_read_b64_tr_b16 %13, %16 offset:10752\n\t" "ds_read_b64_tr_b16 %14, %16 offset:9280\n\t" "ds_read_b64_tr_b16 %15, %16 offset:10816\n\t" : "=&v"(vfa[0][0]), "=&v"(vfc[0][0]), "=&v"(vfa[0][1]), "=&v"(vfc[0][1]), "=&v"(vfa[1][0]), "=&v"(vfc[1][0]), "=&v"(vfa[1][1]), "=&v"(vfc[1][1]), "=&v"(vfa[2][0]), "=&v"(vfc[2][0]), "=&v"(vfa[2][1]), "=&v"(vfc[2][1]), "=&v"(vfa[3][0]), "=&v"(vfc[3][0]), "=&v"(vfa[3][1]), "=&v"(vfc[3][1]) : "v"(va_) : "memory"); }
        __builtin_amdgcn_sched_barrier(0);
        { const f32x2 m2 = {mrun, mrun};
#pragma unroll
          for (int r = 0; r < 16; r += 2) { const f32x2 a = (f32x2){s0[r], s0[r + 1]} - m2, c = (f32x2){s1[r], s1[r + 1]} - m2; s0[r] = a[0]; s0[r + 1] = a[1]; s1[r] = c[0]; s1[r + 1] = c[1]; } }
        float ma = fmaxf(fmaxf(s0[0], s0[1]), s0[2]), mb = fmaxf(fmaxf(s1[0], s1[1]), s1[2]);
#pragma unroll
        for (int r = 3; r < 15; r += 2) { ma = fmaxf(fmaxf(ma, s0[r]), s0[r + 1]); mb = fmaxf(fmaxf(mb, s1[r]), s1[r + 1]); }
        float mx = fmaxf(fmaxf(ma, mb), fmaxf(s0[15], s1[15]));
        mx = shx_max<32>(mx);
        if (kt == kt0 || __any(mx > 8.0f)) {
            const float d = kt == kt0 ? mx : fmaxf(mx, 0.0f), alpha = fast_exp2(-d); mrun += d; lrun *= alpha;
#pragma unroll
            for (int r = 0; r < 16; ++r) { o0[r] *= alpha; o1[r] *= alpha; s0[r] -= d; s1[r] -= d; }
        }
        f32x2 rs2 = {0.f, 0.f};
#pragma unroll
        for (int r = 0; r < 16; ++r) { s0[r] = fast_exp2(s0[r]); s1[r] = fast_exp2(s1[r]); }
#pragma unroll
        for (int r = 0; r < 16; r += 2) { rs2 += (f32x2){s0[r], s0[r + 1]}; rs2 += (f32x2){s1[r], s1[r + 1]}; }
        lrun += rs2[0] + rs2[1];
        asm volatile("s_waitcnt lgkmcnt(0)" : "+v"(vfa[0][0]), "+v"(vfc[0][0]), "+v"(vfa[0][1]), "+v"(vfc[0][1]), "+v"(vfa[1][0]), "+v"(vfc[1][0]), "+v"(vfa[1][1]), "+v"(vfc[1][1]), "+v"(vfa[2][0]), "+v"(vfc[2][0]), "+v"(vfa[2][1]), "+v"(vfc[2][1]), "+v"(vfa[3][0]), "+v"(vfc[3][0]), "+v"(vfa[3][1]), "+v"(vfc[3][1]) :: "memory");
#pragma unroll
        for (int kh = 0; kh < 2; ++kh)
#pragma unroll
            for (int s = 0; s < 2; ++s) {
                u32x4 pw;
                if (kh == 0) { pw.x = pg8::cvt_pk_bf16(s0[8 * s], s0[8 * s + 1]); pw.y = pg8::cvt_pk_bf16(s0[8 * s + 2], s0[8 * s + 3]); pw.z = pg8::cvt_pk_bf16(s0[8 * s + 4], s0[8 * s + 5]); pw.w = pg8::cvt_pk_bf16(s0[8 * s + 6], s0[8 * s + 7]); }
                else { pw.x = pg8::cvt_pk_bf16(s1[8 * s], s1[8 * s + 1]); pw.y = pg8::cvt_pk_bf16(s1[8 * s + 2], s1[8 * s + 3]); pw.z = pg8::cvt_pk_bf16(s1[8 * s + 4], s1[8 * s + 5]); pw.w = pg8::cvt_pk_bf16(s1[8 * s + 6], s1[8 * s + 7]); }
                const bf16x8 pb = __builtin_bit_cast(bf16x8, pw);
                {   const u32x2 a = vfa[kh * 2 + s][0], c = vfc[kh * 2 + s][0];
                    const bf16x8 vf = __builtin_bit_cast(bf16x8, (u32x4){a.x, a.y, c.x, c.y});
                    o0 = __builtin_amdgcn_mfma_f32_32x32x16_bf16(vf, pb, o0, 0, 0, 0); }
                {   const u32x2 a = vfa[kh * 2 + s][1], c = vfc[kh * 2 + s][1];
                    const bf16x8 vf = __builtin_bit_cast(bf16x8, (u32x4){a.x, a.y, c.x, c.y});
                    o1 = __builtin_amdgcn_mfma_f32_32x32x16_bf16(vf, pb, o1, 0, 0, 0); }
            }
        if (kt + 1 < kt1) AT_WRITE(slot ^ 1);
        __syncthreads();
    }
    const float ltot = shx_sum<32>(lrun), inv = 1.0f / ltot;
    bf16* orow = Oh + (size_t)(32 * w + r32) * 512;
#pragma unroll
    for (int g4 = 0; g4 < 4; ++g4) {
        stg<u32x2>(orow + 8 * g4 + 4 * hh, (u32x2){pk2(o0[4 * g4] * inv, o0[4 * g4 + 1] * inv), pk2(o0[4 * g4 + 2] * inv, o0[4 * g4 + 3] * inv)});
        stg<u32x2>(orow + 32 + 8 * g4 + 4 * hh, (u32x2){pk2(o1[4 * g4] * inv, o1[4 * g4 + 1] * inv), pk2(o1[4 * g4 + 2] * inv, o1[4 * g4 + 3] * inv)});
    }
#undef AT_KROWIDX
#undef AT_LOAD
#undef AT_WRITE
}
__device__ __forceinline__ void phase_mla(Frame& F, int l, bool ctx_q, bf16* OAc  ) {
    const float* gq = F.in[12] + l * 96; const float* ROPE = (const float*)(F.ws + WS_ROPE);
    const bf16* QF = (const bf16*)(F.ck + C_QR);        const bf16* KF = (const bf16*)(F.ck + C_KF); const bf16* VV = (const bf16*)(F.ck + C_VV); bf16* OA = (bf16*)(F.ck + C_OA);
    const int nlat = NB * 8 * 8, ntot = nlat + (ctx_q ? NB * 8 : 0);
    for (int u0 = F.c; u0 < ntot; u0 += F.G) {
        int u = u0;
        if (F.G == 256 && u0 < nlat) { const int x = u0 & 7, slot = ((u0 & 255) >> 3) + 32 * (u0 >> 8); u = ((x * 8 + (slot >> 3)) << 3) | (slot & 7); }
        if (u < nlat) { const int b = u >> 6, h = (u >> 3) & 7, qb = u & 7; const int row0 = b * 2048 + qb * 256;
            mla_unit(F, QF + (size_t)row0 * 768 + h * 96, KF + h * 96, VV + h * 64, OA + (size_t)row0 * 512 + h * 64, b, 0, 36, gq, ROPE + (size_t)(qb * 256) * 32); }
        else { const int v = u - nlat, b = v >> 3, h = v & 7; const int row0 = RL + b * 256;
            mla_unit(F, QF + (size_t)row0 * 768 + h * 96, KF + h * 96, VV + h * 64, OAc + (size_t)(b * 256) * 512 + h * 64, b, 32, 36, gq, nullptr); }
    }
    __syncthreads();
}

struct NatOps { bf16x8 k[2][2]; u32x2 v[4][2]; };
__device__ __forceinline__ void nat_load(NatOps& o, const bf16* Kp  , const bf16* VTp  , int g) {
#pragma unroll
    for (int sub = 0; sub < 2; ++sub) { o.k[sub][0] = ldg<bf16x8>(Kp + (size_t)sub * 16 * 512 + 8 * g); o.k[sub][1] = ldg<bf16x8>(Kp + (size_t)sub * 16 * 512 + 32 + 8 * g); }
#pragma unroll
    for (int dt = 0; dt < 4; ++dt) { o.v[dt][0] = ldg<u32x2>(VTp + (size_t)dt * 16 * KEYS); o.v[dt][1] = ldg<u32x2>(VTp + (size_t)dt * 16 * KEYS + 16); }
}
__device__ __forceinline__ void nat_compute(const NatOps& ops, const bf16x8 (&qf)[2], f32x4 (&o)[4], float& mrun, float& lrun, const float (&bias)[2][4], const bool (&valid)[2][4], bool masked) {
    f32x4 s[2];
#pragma unroll
    for (int sub = 0; sub < 2; ++sub) {
        s[sub] = (f32x4){0.f, 0.f, 0.f, 0.f};
        s[sub] = __builtin_amdgcn_mfma_f32_16x16x32_bf16(ops.k[sub][0], qf[0], s[sub], 0, 0, 0);
        s[sub] = __builtin_amdgcn_mfma_f32_16x16x32_bf16(ops.k[sub][1], qf[1], s[sub], 0, 0, 0);
    }
    if (masked) {
#pragma unroll
        for (int sub = 0; sub < 2; ++sub)
#pragma unroll
            for (int r = 0; r < 4; ++r) s[sub][r] = valid[sub][r] ? s[sub][r] + bias[sub][r] : -1e30f;
    }
    float mx = fmaxf(fmaxf(fmaxf(s[0][0], s[0][1]), fmaxf(s[0][2], s[0][3])), fmaxf(fmaxf(s[1][0], s[1][1]), fmaxf(s[1][2], s[1][3])));
    mx = shx_max<16>(mx); mx = shx_max<32>(mx);
    const float mn = fmaxf(mrun, mx), alpha = fast_exp2(mrun - mn); mrun = mn;
    float rs = 0.f;
#pragma unroll
    for (int sub = 0; sub < 2; ++sub)
#pragma unroll
        for (int r = 0; r < 4; ++r) { s[sub][r] = fast_exp2(s[sub][r] - mn); rs += s[sub][r]; }
    lrun = lrun * alpha + rs;
    u32x4 pw; pw.x = pg8::cvt_pk_bf16(s[0][0], s[0][1]); pw.y = pg8::cvt_pk_bf16(s[0][2], s[0][3]); pw.z = pg8::cvt_pk_bf16(s[1][0], s[1][1]); pw.w = pg8::cvt_pk_bf16(s[1][2], s[1][3]);
    const bf16x8 pb = __builtin_bit_cast(bf16x8, pw);
#pragma unroll
    for (int dt = 0; dt < 4; ++dt) {
        const bf16x8 vf = __builtin_bit_cast(bf16x8, (u32x4){ops.v[dt][0].x, ops.v[dt][0].y, ops.v[dt][1].x, ops.v[dt][1].y});
        o[dt] = o[dt] * alpha;
        o[dt] = __builtin_amdgcn_mfma_f32_16x16x32_bf16(vf, pb, o[dt], 0, 0, 0);
    }
}
constexpr int NL_KS = 144, NL_CVS = 528;
constexpr int NL_CK = 0, NL_CV = 256 * NL_KS, NL_SLOT0 = NL_CV + 64 * NL_CVS, NL_SLOTB = 2 * 64 * NL_KS, NL_RPB = NL_SLOT0 + 2 * NL_SLOTB;
__device__ __forceinline__ void nat_lds_ops(NatOps& o, const LAS unsigned char* Kt  , const LAS unsigned char* Vt  , int vstride, int qi, int g) {
#pragma unroll
    for (int sub = 0; sub < 2; ++sub) { o.k[sub][0] = *(const LAS bf16x8*)(Kt + (16 * sub + qi) * NL_KS + 16 * g); o.k[sub][1] = *(const LAS bf16x8*)(Kt + (16 * sub + qi) * NL_KS + 64 + 16 * g); }
#pragma unroll
    for (int dt = 0; dt < 4; ++dt) { o.v[dt][0] = *(const LAS u32x2*)(Vt + (16 * dt + qi) * vstride + 8 * g); o.v[dt][1] = *(const LAS u32x2*)(Vt + (16 * dt + qi) * vstride + 32 + 8 * g); }
}
__device__ __forceinline__ void nat_unit(Frame& F, const bf16* NQ, const bf16* NK, const bf16* NVT, bf16* OB, bf16* OBc, const float* rpb_h  , int b, int h, int q, bool ctx_q) {
    LAS unsigned char* lds = F.lds; const int tid = F.tid, lane = F.lane, w = F.wave, qi = lane & 15, g = lane >> 4, j = w & 3;
    LAS float* RPB = (LAS float*)(lds + NL_RPB);
    const bf16* VTb = NVT + (size_t)(b * 8 + h) * 64 * KEYS;
    __syncthreads();
    { u32x4 ck[4], cv[4];
#pragma unroll
      for (int k = 0; k < 4; ++k) { const int idx = tid + 512 * k; ck[k] = ldg<u32x4>(NK + (size_t)(RL + b * 256 + (idx >> 3)) * 512 + h * 64 + (idx & 7) * 8); cv[k] = ldg<u32x4>(VTb + (size_t)(idx >> 5) * KEYS + 2048 + (idx & 31) * 8); }
#pragma unroll
      for (int k = 0; k < 4; ++k) { const int idx = tid + 512 * k; *(LAS u32x4*)(lds + NL_CK + (idx >> 3) * NL_KS + (idx & 7) * 16) = ck[k]; *(LAS u32x4*)(lds + NL_CV + (idx >> 5) * NL_CVS + (idx & 31) * 16) = cv[k]; }
      if (tid < 15 * 31) RPB[tid] = ldg<float>(rpb_h + tid) * LOG2E; }
    bf16x8 qf[4][2]; f32x4 o[4][4]; float mrun[4], lrun[4]; int rs_[4];
#pragma unroll
    for (int i = 0; i < 4; ++i) { const int row = 8 * q + (w >> 2) + 2 * i; rs_[i] = min(max(row - 4, 0), 24);
        const bf16* qp = NQ + (size_t)(b * 2048 + row * 64 + 16 * j + qi) * 512 + h * 64;
        qf[i][0] = ldg<bf16x8>(qp + 8 * g); qf[i][1] = ldg<bf16x8>(qp + 32 + 8 * g); mrun[i] = -1e30f; lrun[i] = 0.f;
#pragma unroll
        for (int dt = 0; dt < 4; ++dt) o[i][dt] = (f32x4){0.f, 0.f, 0.f, 0.f}; }
    const int bs = min(max(16 * j - 8, 0), 32), qc = 16 * j + qi, cs = min(max(qc - 8, 0), 48);
    bool valid[2][4]; int dcl[2][4];
#pragma unroll
    for (int sub = 0; sub < 2; ++sub)
#pragma unroll
        for (int rg = 0; rg < 4; ++rg) { const int kc = bs + 16 * sub + 4 * g + rg; valid[sub][rg] = (unsigned)(kc - cs) < 16u; dcl[sub][rg] = min(max(kc - qc + 15, 0), 30); }
    const int kr_lo = min(max(8 * q - 4, 0), 24), kr_hi = min(max(8 * q + 3, 0), 24) + 7, nkr = kr_hi - kr_lo + 1;
    const int tk = tid >> 3, tc = tid & 7;
    u32x4 sk, sv;
#define NL_LOAD(kr) do { sk = ldg<u32x4>(NK + (size_t)(b * 2048 + (kr) * 64 + tk) * 512 + h * 64 + tc * 8); sv = ldg<u32x4>(VTb + (size_t)tk * KEYS + (kr) * 64 + tc * 8); } while (0)
#define NL_WRITE(slot) do { *(LAS u32x4*)(lds + NL_SLOT0 + (slot) * NL_SLOTB + tk * NL_KS + tc * 16) = sk; *(LAS u32x4*)(lds + NL_SLOT0 + (slot) * NL_SLOTB + 64 * NL_KS + tk * NL_KS + tc * 16) = sv; } while (0)
    NL_LOAD(kr_lo); NL_WRITE(0);
    __syncthreads();
    for (int t = 0; t < nkr; ++t) {
        const int kr = kr_lo + t, slot = t & 1;
        if (t + 1 < nkr) NL_LOAD(kr + 1);
        const LAS unsigned char* Kt = lds + NL_SLOT0 + slot * NL_SLOTB + bs * NL_KS; const LAS unsigned char* Vt = Kt - bs * NL_KS + 64 * NL_KS + bs * 2;
        if (kr >= rs_[0] && kr < rs_[3] + 8) {
            NatOps ops; nat_lds_ops(ops, Kt, Vt, NL_KS, qi, g);
#pragma unroll
            for (int i = 0; i < 4; ++i) {
                if (kr >= rs_[i] && kr < rs_[i] + 8) {
                    const int drow = kr - (8 * q + (w >> 2) + 2 * i) + 7;
                    float bias[2][4];
#pragma unroll
                    for (int sub = 0; sub < 2; ++sub)
#pragma unroll
                        for (int rg = 0; rg < 4; ++rg) bias[sub][rg] = RPB[drow * 31 + dcl[sub][rg]];
                    nat_compute(ops, qf[i], o[i], mrun[i], lrun[i], bias, valid, true);
                }
            }
        }
        if (t + 1 < nkr) NL_WRITE(slot ^ 1);
        __syncthreads();
    }
#undef NL_LOAD
#undef NL_WRITE
    { float bias[2][4];
#pragma unroll
      for (int sub = 0; sub < 2; ++sub)
#pragma unroll
          for (int rg = 0; rg < 4; ++rg) bias[sub][rg] = 0.f;
      for (int cb = 0; cb < 8; ++cb) {
          NatOps ops; nat_lds_ops(ops, lds + NL_CK + 32 * cb * NL_KS, lds + NL_CV + 64 * cb, NL_CVS, qi, g);
#pragma unroll
          for (int i = 0; i < 4; ++i) nat_compute(ops, qf[i], o[i], mrun[i], lrun[i], bias, valid, false);
      }
#pragma unroll
      for (int i = 0; i < 4; ++i) { const int row = 8 * q + (w >> 2) + 2 * i; const size_t qrow = (size_t)(b * 2048 + row * 64 + 16 * j + qi);
          float lt = shx_sum<32>(shx_sum<16>(lrun[i])); const float inv = 1.0f / lt;
#pragma unroll
          for (int dt = 0; dt < 4; ++dt) stg<u32x2>(OB + qrow * 512 + h * 64 + 16 * dt + 4 * g, (u32x2){pk2(o[i][dt][0] * inv, o[i][dt][1] * inv), pk2(o[i][dt][2] * inv, o[i][dt][3] * inv)}); }
      if (ctx_q && w < 4) {
          const size_t qrow = (size_t)(RL + b * 256 + 16 * (4 * q + w) + qi); const bf16* qp = NQ + qrow * 512 + h * 64;
          bf16x8 cq[2]; cq[0] = ldg<bf16x8>(qp + 8 * g); cq[1] = ldg<bf16x8>(qp + 32 + 8 * g);
          f32x4 co[4]; float cm = -1e30f, cl = 0.f;
#pragma unroll
          for (int dt = 0; dt < 4; ++dt) co[dt] = (f32x4){0.f, 0.f, 0.f, 0.f};
          for (int cb = 0; cb < 8; ++cb) { NatOps ops; nat_lds_ops(ops, lds + NL_CK + 32 * cb * NL_KS, lds + NL_CV + 64 * cb, NL_CVS, qi, g); nat_compute(ops, cq, co, cm, cl, bias, valid, false); }
          float lt = shx_sum<32>(shx_sum<16>(cl)); const float inv = 1.0f / lt;
#pragma unroll
          for (int dt = 0; dt < 4; ++dt) stg<u32x2>(OBc + (qrow - RL) * 512 + h * 64 + 16 * dt + 4 * g, (u32x2){pk2(co[dt][0] * inv, co[dt][1] * inv), pk2(co[dt][2] * inv, co[dt][3] * inv)});
      } }
}
__device__ __forceinline__ void phase_nat(Frame& F, int l, bool ctx_q, bf16* OBc) {
    const bf16* NQ = (const bf16*)(F.ck + C_NQ); const bf16* NK = (const bf16*)(F.ck + C_NK); const bf16* NVT = (const bf16*)(F.ck + C_NVT); bf16* OB = (bf16*)(F.ck + C_OB);
    for (int u0 = F.c; u0 < NB * 32; u0 += F.G) { int u = u0; if (F.G == 256) { const int x = u0 & 7, j = u0 >> 3; u = ((x * 8 + (j >> 2)) << 2) | (j & 3); }
        const int b = u >> 5, h = (u >> 2) & 7, q = u & 3;
        nat_unit(F, NQ, NK, NVT, OB, OBc, F.in[16] + ((size_t)l * 8 + h) * 15 * 31, b, h, q, ctx_q); }
    __syncthreads();
}

__device__ __forceinline__ void phase_router(Frame& F, int l, int ntok, int cnt_off = 0) {
    bf16* H2 = (bf16*)(F.ck + M_H2); int* ROWTOK = (int*)(F.ck + M_ROWTOK); i32x4* TOKE = (i32x4*)(F.ck + M_TOKE); f32x2* TOKW = (f32x2*)(F.ck + M_TOKW);
    unsigned* cnt = (unsigned*)(F.ws + WS_CTL) + CW_CNT + l * 64 + cnt_off;
    const float* g2 = F.in[28] + l * 1024; const float* WGT = (const float*)(F.ws + WS_WGT) + (size_t)l * 4 * 1024; const float* WET = (const float*)(F.ws + WS_WET) + (size_t)l * 32 * 1024;
    const float* bg = F.in[30] + l * 4; const float* be = F.in[32] + l * 32;
    for (int i = F.c * 512 + F.tid; i < MOE_ROWS; i += F.G * 512) ROWTOK[i] = -1;
    LAS float* WEL = (LAS float*)F.lds;
    LAS unsigned* LCNT = (LAS unsigned*)(F.lds + 131072);
    __syncthreads();
    for (int i = F.tid; i < 32 * 1024 / 4; i += 512) *(LAS f32x4*)(WEL + 4 * i) = ldg<f32x4>(WET + 4 * i);
    if (F.tid < 64) LCNT[F.tid] = 0u;
    __syncthreads();
    const int gw = F.c * 8 + F.wave, NGW = F.G * 8, lane = F.lane;
    for (int tok0 = gw * 4; tok0 < ntok; tok0 += NGW * 4) {
        const float* xs; int mrow;
        if (tok0 < NTOK_LAT) { xs = F.out + (size_t)tok0 * 1024; mrow = tok0 >> 11; } else { xs = F.XC + (size_t)(tok0 - NTOK_LAT) * 1024; mrow = 32; }
        const float* md = F.MOD + ((size_t)l * 33 + mrow) * 6144;
        f32x4 v[4][4]; float ss[4];
#pragma unroll
        for (int t = 0; t < 4; ++t) { ss[t] = 0.f;
#pragma unroll
            for (int j = 0; j < 4; ++j) { v[t][j] = ldg<f32x4>(xs + (size_t)t * 1024 + 4 * lane + 256 * j); ss[t] += v[t][j][0] * v[t][j][0] + v[t][j][1] * v[t][j][1] + v[t][j][2] * v[t][j][2] + v[t][j][3] * v[t][j][3]; } }
        float rstd[4];
        { const float rs_own = rsqrtf(red4(ss[0], ss[1], ss[2], ss[3]) * (1.0f / 1024.0f) + RMS_EPS);
#pragma unroll
          for (int t = 0; t < 4; ++t) rstd[t] = lane_bcast(rs_own, 16 * t); }
#pragma unroll
        for (int j = 0; j < 4; ++j) { const int col = 4 * lane + 256 * j;
            const f32x4 g = ldg<f32x4>(g2 + col), sh = ldg<f32x4>(md + 3 * 1024 + col), sc = ldg<f32x4>(md + 4 * 1024 + col) + 1.0f;
#pragma unroll
            for (int t = 0; t < 4; ++t) { v[t][j] = (v[t][j] * rstd[t] * g) * sc + sh;
                stg<u32x2>(H2 + (size_t)(tok0 + t) * 1024 + col, (u32x2){pk2(v[t][j][0], v[t][j][1]), pk2(v[t][j][2], v[t][j][3])}); } }
        float glo[4];
#pragma unroll
        for (int e = 0; e < 4; ++e) { float p[4] = {0.f, 0.f, 0.f, 0.f};
#pragma unroll
            for (int j = 0; j < 4; ++j) { const f32x4 w = ldg<f32x4>(WGT + e * 1024 + 4 * lane + 256 * j);
#pragma unroll
                for (int t = 0; t < 4; ++t) p[t] += v[t][j][0] * w[0] + v[t][j][1] * w[1] + v[t][j][2] * w[2] + v[t][j][3] * w[3]; }
            glo[e] = red4(p[0], p[1], p[2], p[3]) + bg[e]; }
        int gi = 0; float gm = glo[0];
#pragma unroll
        for (int e = 1; e < 4; ++e) if (glo[e] > gm) { gm = glo[e]; gi = e; }
        float gs = 0.f;
#pragma unroll
        for (int e = 0; e < 4; ++e) gs += __expf(glo[e] - gm);
        const float pgrp = 1.0f / gs;
        int grp[4];
#pragma unroll
        for (int t = 0; t < 4; ++t) grp[t] = __builtin_amdgcn_readlane(gi, 16 * t);
        float elo[8];
#pragma unroll
        for (int eh = 0; eh < 2; ++eh) {
            float p[4][4];
#pragma unroll
            for (int t = 0; t < 4; ++t)
#pragma unroll
                for (int e = 0; e < 4; ++e) { float q = 0.f; const LAS float* wr = WEL + (grp[t] * 8 + eh * 4 + e) * 1024;
#pragma unroll
                    for (int j = 0; j < 4; ++j) { const f32x4 w = *(const LAS f32x4*)(wr + 4 * lane + 256 * j); q += v[t][j][0] * w[0] + v[t][j][1] * w[1] + v[t][j][2] * w[2] + v[t][j][3] * w[3]; }
                    p[t][e] = q; }
#pragma unroll
            for (int e = 0; e < 4; ++e) elo[eh * 4 + e] = red4(p[0][e], p[1][e], p[2][e], p[3][e]);
            __builtin_amdgcn_sched_barrier(0);
        }
#pragma unroll
        for (int e = 0; e < 8; ++e) elo[e] += ldg<float>(be + gi * 8 + e);
        int i1 = 0; float v1 = elo[0];
#pragma unroll
        for (int e = 1; e < 8; ++e) if (elo[e] > v1) { v1 = elo[e]; i1 = e; }
        int i2 = -1; float v2 = -3.0e38f;
#pragma unroll
        for (int e = 0; e < 8; ++e) if (e != i1 && elo[e] > v2) { v2 = elo[e]; i2 = e; }
        const float ex = __expf(v2 - v1), mw1 = pgrp / (1.0f + ex), mw2 = pgrp * ex / (1.0f + ex);
        const int me1 = gi * 8 + i1, me2 = gi * 8 + i2;
        if ((lane & 15) == 0) {
            const int s1 = (int)__hip_atomic_fetch_add(LCNT + me1, 1u, __ATOMIC_RELAXED, __HIP_MEMORY_SCOPE_WORKGROUP), s2 = (int)__hip_atomic_fetch_add(LCNT + 32 + me2, 1u, __ATOMIC_RELAXED, __HIP_MEMORY_SCOPE_WORKGROUP);
            TOKE[tok0 + (lane >> 4)] = (i32x4){me1, s1, me2, s2}; TOKW[tok0 + (lane >> 4)] = (f32x2){mw1, mw2};
        }
    }
    __syncthreads();
    if (F.tid < 64) { const unsigned n = LCNT[F.tid]; const unsigned base = n ? atomicAdd(cnt + F.tid, n) : 0u; ((unsigned*)(F.ck + M_WGBASE))[(size_t)F.c * 64 + F.tid] = base; }
    __syncthreads();
}
__device__ __forceinline__ void phase_assign(Frame& F, int l, int ntok) {
    LAS int* T = (LAS int*)(F.lds + LDS_TAB);
    moe_tables((unsigned*)(F.ws + WS_CTL) + CW_CNT + l * 64, T, F.tid);
    int* ROWTOK = (int*)(F.ck + M_ROWTOK); float* ROWW = (float*)(F.ck + M_ROWW); const i32x4* TOKE = (const i32x4*)(F.ck + M_TOKE); const f32x2* TOKW = (const f32x2*)(F.ck + M_TOKW);
    for (int tok = F.c * 512 + F.tid; tok < ntok; tok += F.G * 512) {
        const i32x4 e = TOKE[tok]; const f32x2 w = TOKW[tok];
        const int wg = ((tok >> 2) % (F.G * 8)) >> 3;
        const unsigned* wb = (const unsigned*)(F.ck + M_WGBASE) + (size_t)wg * 64;
        const int r1 = T[2 + e.x] + (int)wb[e.x] + e.y, r2 = T[2 + 32 + e.z] + (int)wb[32 + e.z] + e.w;
        ROWTOK[r1] = tok; ROWW[r1] = w.x; ROWTOK[r2] = tok; ROWW[r2] = w.y;
    }
}

template <bool WITH_H>
__device__ __forceinline__ void phase_comb(Frame& F, int l, int ntok) {
    const bf16* Y = (const bf16*)(F.ck + M_Y); bf16* HBA = (bf16*)(F.ws + WS_HBALL);
    const float* g1n = F.in[6] + (l + 1 < DEPTH ? (l + 1) : l) * 1024;
    const int gw = F.c * 8 + F.wave, NGW = F.G * 8, lane = F.lane;
    for (int tok0 = gw * 4; tok0 < ntok; tok0 += NGW * 4) {
        float* xs; int mrow;
        if (tok0 < NTOK_LAT) { xs = F.out + (size_t)tok0 * 1024; mrow = tok0 >> 11; } else { xs = F.XC + (size_t)(tok0 - NTOK_LAT) * 1024; mrow = 32; }
        const float* gt2 = F.MOD + ((size_t)l * 33 + mrow) * 6144 + 5 * 1024;
        f32x4 v[4][4]; u32x2 y0[4][4], y1[4][4];
        f32x4 gv[4];
#pragma unroll
        for (int j = 0; j < 4; ++j) gv[j] = ldg<f32x4>(gt2 + 4 * lane + 256 * j);
#pragma unroll
        for (int t = 0; t < 4; ++t)
#pragma unroll
            for (int j = 0; j < 4; ++j) { const size_t o = (size_t)(tok0 + t) * 1024 + 4 * lane + 256 * j;
                v[t][j] = ldg<f32x4>(xs + (size_t)t * 1024 + 4 * lane + 256 * j); y0[t][j] = ldg<u32x2>(Y + o); y1[t][j] = ldg<u32x2>(Y + (size_t)NTOK * 1024 + o); }
        float ss[4];
#pragma unroll
        for (int t = 0; t < 4; ++t) { ss[t] = 0.f;
#pragma unroll
            for (int j = 0; j < 4; ++j) {
                f32x4 ysum; ysum[0] = bflo(y0[t][j].x) + bflo(y1[t][j].x); ysum[1] = bfhi(y0[t][j].x) + bfhi(y1[t][j].x); ysum[2] = bflo(y0[t][j].y) + bflo(y1[t][j].y); ysum[3] = bfhi(y0[t][j].y) + bfhi(y1[t][j].y);
                v[t][j] = v[t][j] + gv[j] * ysum;
                stg<f32x4>(xs + (size_t)t * 1024 + 4 * lane + 256 * j, v[t][j]);
                ss[t] += v[t][j][0] * v[t][j][0] + v[t][j][1] * v[t][j][1] + v[t][j][2] * v[t][j][2] + v[t][j][3] * v[t][j][3]; } }
        if constexpr (WITH_H) {
            const float* md = F.MOD + ((size_t)(l + 1) * 33 + mrow) * 6144;
#pragma unroll
            for (int t = 0; t < 4; ++t) ss[t] = rsqrtf(wave_sum(ss[t]) * (1.0f / 1024.0f) + RMS_EPS);
#pragma unroll
            for (int j = 0; j < 4; ++j) { const int col = 4 * lane + 256 * j;
                const f32x4 gg = ldg<f32x4>(g1n + col), sh = ldg<f32x4>(md + col), sc = ldg<f32x4>(md + 1024 + col) + 1.0f;
#pragma unroll
                for (int t = 0; t < 4; ++t) { const f32x4 h = (v[t][j] * ss[t] * gg) * sc + sh;
                    stg<u32x2>(HBA + (size_t)(tok0 + t) * 1024 + col, (u32x2){pk2(h[0], h[1]), pk2(h[2], h[3])}); } }
        }
    }
}

constexpr int MIX_PH = 8, MOE_PH = 5, NSTEPS = 2 + DEPTH * (NCH * MIX_PH + MOE_PH);
__global__ void __launch_bounds__(512, 2) fwd(Args args) {
    extern __shared__ __attribute__((aligned(16))) unsigned char lds_raw[];
    Frame F;
    F.lds = (LAS unsigned char*)lds_raw; F.tid = threadIdx.x; F.lane = F.tid & 63; F.wave = __builtin_amdgcn_readfirstlane(F.tid >> 6); F.G = gridDim.x; F.c = blockIdx.x;
    F.in = args.in; F.out = args.out; F.ws = args.ws; F.ck = args.ws + WS_CHUNK; F.MOD = (float*)(args.ws + WS_MOD); F.XC = (float*)(args.ws + WS_XC);
    for (int u = F.tid; u < (LDS_BYTES - LDS_MISC) / 4; u += 512) ((LAS unsigned*)(F.lds + LDS_MISC))[u] = 0u;
    __syncthreads();
    const int lo = args.lo, hi = args.hi;
    const int wave_id0 = __builtin_amdgcn_readfirstlane((int)threadIdx.x >> 6);
    XcdBarrier bar; bar.bar = (unsigned*)(F.ws + WS_CTL) + CW_BAR; bar.x = 0; bar.st = (volatile LAS unsigned*)(F.lds + LDS_MISC + 32);
    if (hi - lo > 1) bar = xcd_barrier_post((unsigned*)(F.ws + WS_CTL) + CW_BAR, (volatile LAS unsigned*)(F.lds + LDS_MISC + 32));
    int step = 0;
#ifndef SITE_ONLY
#define SITE_ONLY -1
#endif
#ifndef DBG_SKIP_MASK
#define DBG_SKIP_MASK 0u
#endif
#define SITE_ON(id) ((SITE_ONLY < 0 || SITE_ONLY == (id)) && !((DBG_SKIP_MASK >> (id)) & 1u))
#ifndef DBG_REPEAT_MASK
#define DBG_REPEAT_MASK 0x0u
#endif
#define SITE_REPS(id) (((DBG_REPEAT_MASK >> (id)) & 1u) ? 2 : 1)
#define PH_BEGIN(id) if (step >= lo && step < hi) { if (SITE_ON(id)) for (int rep_ = 0; rep_ < SITE_REPS(id); ++rep_) { if (rep_ > 0) xcd_barrier(bar, F.tid == 0); { int t_; asm volatile("v_mbcnt_lo_u32_b32 %0, -1, 0\n\tv_mbcnt_hi_u32_b32 %0, -1, %0" : "=v"(t_)); t_ += wave_id0 * 64; F.tid = t_; F.lane = t_ & 63; F.wave = __builtin_amdgcn_readfirstlane(t_ >> 6); \
        int c_ = blockIdx.x, g_ = gridDim.x; unsigned long long w_ = (unsigned long long)args.ws, o_ = (unsigned long long)args.out; asm volatile("" : "+s"(c_), "+s"(g_), "+s"(w_), "+s"(o_)); \
        F.c = c_; F.G = g_; F.ws = (unsigned char*)w_; F.out = (float*)o_; F.ck = F.ws + WS_CHUNK; F.MOD = (float*)(F.ws + WS_MOD); F.XC = (float*)(F.ws + WS_XC); }
#ifndef DBG_DOUBLE_BAR
#define DBG_DOUBLE_BAR 0
#endif
#define PH_END   } if (step + 1 < hi) { xcd_barrier(bar, F.tid == 0); if (DBG_DOUBLE_BAR) xcd_barrier(bar, F.tid == 0); } } ++step;
    LAS int* TAB = (LAS int*)(F.lds + LDS_TAB);

    PH_BEGIN(0)
        if (F.c < 64) prologue_s5(F, F.c >> 5, F.c & 31);
        else { prologue_mod(F, 64); prologue_transposes(F, 64); prologue_small(F, 64); }
    PH_END
    PH_BEGIN(1) prologue_mod_final(F); PH_END

    for (int l = 0; l < DEPTH; ++l) {
        const bool need_ctx = (l == 0);
        const float* xl_old = l == 0 ? F.in[0] : (const float*)F.out; const float* xc_old = l == 0 ? F.in[2] : (const float*)F.XC;
        const float* MODL = F.MOD + (size_t)l * 33 * 6144;
        const int nMrows = need_ctx ? 72 : 64;
        for (int ch = 0; ch < NCH; ++ch) {
            const int b0 = ch * NB;
            if (l == 0 && ch == 0) { PH_BEGIN(2) phase_h(F, l, b0, xl_old, xc_old, RR); PH_END }
            PH_BEGIN(3)
                const bf16* Alat = l == 0 ? (const bf16*)(F.ck + C_HB) : (const bf16*)(F.ws + WS_HBALL) + (size_t)b0 * 2048 * 1024;
                const bf16* Actx = l == 0 ? (const bf16*)(F.ck + C_HB) + (size_t)RL * 1024 : (const bf16*)(F.ws + WS_HBALL) + ((size_t)NTOK_LAT + (size_t)b0 * 256) * 1024;
                ProbG1 P{Alat, Actx, (const bf16*)(F.ws + WS_WINT) + (size_t)l * NINP * 1024, 1024, 1024, 1024, F.G, F.c, need_ctx ? 24 : 8};
                EpiG1 E{F.ck, F.in[14] + l * 64, F.in[15] + l * 64, (bf16*)(F.ws + X_GT) + ((ptrdiff_t)b0 * 256 - RL) * 3072};
                pg8::gemm_phase(F.lds, P, E, F.tid);
                if (l == 1) tr_moe_items(F, 1, ch * (MOE_ITEMS / 4), MOE_ITEMS / 4, 128);
            PH_END
            PH_BEGIN(5)
                if (need_ctx) ctx_krope(F, (const bf16*)(F.ck + C_HB) + (size_t)RL * 1024, (const bf16*)(F.ws + WS_WINT) + ((size_t)l * NINP + 6144) * 1024);
                { ProbPlain P{(const bf16*)(F.ck + C_KVL), (const bf16*)(F.ws + WS_UKVT) + (size_t)l * 1024 * 256, 256, 256, 256, 72, 4, F.G, F.c, 0};
                  EpiStoreRs<4> E{(bf16*)(F.ck + C_KN), (bf16*)(F.ck + C_VV), 512, 2, (const float*)(F.ck + C_SSKV), 1.0f / 256.0f}; pg8::gemm_phase(F.lds, P, E, F.tid); }
                { ProbPlain P{(const bf16*)(F.ck + C_QL), (const bf16*)(F.ws + WS_UQT) + (size_t)l * 768 * 768, 768, 768, 768, nMrows, 3, F.G, (F.c + F.G - 32) % F.G, 0};
                  EpiStoreRs<12> E{(bf16*)(F.ck + C_QR), (bf16*)(F.ck + C_QR), 768, 3, (const float*)(F.ck + C_SSQL), 1.0f / 768.0f}; pg8::gemm_phase(F.lds, P, E, F.tid); }
                { ProbPlain P{(const bf16*)(F.ck + C_AS5), (const bf16*)(F.ws + WS_BTS) + (size_t)l * 32 * 256 * 256, 256, 16384, 256, 5, 32, F.G, (F.c + 8) % F.G, 512};
                  EpiS5S E{(float*)(F.ck + C_SS)}; pg8::gemm_phase(F.lds, P, E, F.tid); }
            PH_END
            PH_BEGIN(6) phase_p2(F, l, need_ctx); PH_END
            PH_BEGIN(7)
#ifndef DBG_REP_MLA
#define DBG_REP_MLA 0
#endif
#ifndef DBG_REP_NAT
#define DBG_REP_NAT 0
#endif
                phase_mla(F, l, need_ctx, (bf16*)(F.ws + X_OA) + (size_t)b0 * 256 * 512); if (DBG_REP_MLA) phase_mla(F, l, need_ctx, (bf16*)(F.ws + X_OA) + (size_t)b0 * 256 * 512);
                phase_nat(F, l, need_ctx, (bf16*)(F.ws + X_OB) + (size_t)b0 * 256 * 512); if (DBG_REP_NAT) phase_nat(F, l, need_ctx, (bf16*)(F.ws + X_OB) + (size_t)b0 * 256 * 512);
                { ProbPlain P{(const bf16*)(F.ck + C_AS5), (const bf16*)(F.ws + WS_BTY) + (size_t)l * 32 * 256 * 512, 512, 16384, 512, need_ctx ? 5 : 4, 32, F.G, need_ctx ? (F.c + F.G - 64) % F.G : F.c, 512};
                  EpiS5Y E{(bf16*)(F.ck + C_YG), (bf16*)(F.ws + X_YG) + (size_t)b0 * 256 * 512}; pg8::gemm_phase(F.lds, P, E, F.tid); }
            PH_END
            PH_BEGIN(8)
                ProbPlain P{(const bf16*)(F.ck + C_YG), (const bf16*)(F.ws + WS_GLUT) + (size_t)l * 1024 * 512, 512, 512, 512, 64, 4, F.G, F.c, 0};
                EpiPair<0> E{(bf16*)(F.ck + C_OC), 512}; pg8::gemm_phase(F.lds, P, E, F.tid);
            PH_END
            PH_BEGIN(9)
                ProbMerge P{{(const bf16*)(F.ck + C_OA), (const bf16*)(F.ck + C_OB), (const bf16*)(F.ck + C_OC)}, (const bf16*)(F.ws + WS_BRT) + (size_t)l * 3 * 1024 * 512, 512, 512, 512, 64, 4, F.G, F.c};
                EpiMerge E{(const bf16*)(F.ck + C_GT), (bf16*)(F.ck + C_YMB)}; pg8::gemm_phase(F.lds, P, E, F.tid);
            PH_END
#ifndef DBG_REP_OUT0
#define DBG_REP_OUT0 0
#endif
            PH_BEGIN(10)
              for (int rr_ = 0; rr_ < ((DBG_REP_OUT0 && l == 0) ? 2 : 1); ++rr_) {
                if (rr_) xcd_barrier(bar, F.tid == 0);
                ProbPlain P{(const bf16*)(F.ck + C_YMB), (const bf16*)(F.ws + WS_OUTT) + (size_t)l * 1024 * 1024, 1024, 1024, 1024, 64, 4, F.G, F.c, 0};
                EpiOut E{xl_old, xc_old, F.out, F.XC, MODL, b0}; pg8::gemm_phase(F.lds, P, E, F.tid);
              }
              if (l == 0 && ch + 1 < NCH) phase_h(F, l, b0 + NB, xl_old, xc_old, RR);
            PH_END
        }
        if (need_ctx) {
            PH_BEGIN(16)
                ProbPlain P{(const bf16*)(F.ws + X_YG), (const bf16*)(F.ws + WS_GLUT) + (size_t)l * 1024 * 512, 512, 512, 512, 32, 4, F.G, F.c, 0};
                EpiPair<0> E{(bf16*)(F.ws + X_OC), 512}; pg8::gemm_phase(F.lds, P, E, F.tid);
                tr_moe_items(F, l, 12288, 2560, 128);
            PH_END
            PH_BEGIN(17)
                ProbMerge P{{(const bf16*)(F.ws + X_OA), (const bf16*)(F.ws + X_OB), (const bf16*)(F.ws + X_OC)}, (const bf16*)(F.ws + WS_BRT) + (size_t)l * 3 * 1024 * 512, 512, 512, 512, 32, 4, F.G, F.c};
                EpiMerge E{(const bf16*)(F.ws + X_GT), (bf16*)(F.ws + X_YMB)}; pg8::gemm_phase(F.lds, P, E, F.tid);
                tr_moe_items(F, l, 0, 12288, 128); tr_moe_items(F, l, 14848, 4864, 128);
            PH_END
            PH_BEGIN(18)
                ProbPlain P{(const bf16*)(F.ws + X_YMB), (const bf16*)(F.ws + WS_OUTT) + (size_t)l * 1024 * 1024, 1024, 1024, 1024, 32, 4, F.G, F.c, 0};
                EpiOut E{xl_old, xc_old, F.out, F.XC, MODL, -1}; pg8::gemm_phase(F.lds, P, E, F.tid);
                tr_moe_items(F, l, 19712, 4864, 128);
            PH_END
        }
        const int ntok = need_ctx ? NTOK : NTOK_LAT;
        unsigned* cnt = (unsigned*)(F.ws + WS_CTL) + CW_CNT + l * 64;
#ifndef DBG_ROUTER_DRY
#define DBG_ROUTER_DRY 0
#endif
        PH_BEGIN(11) if (DBG_ROUTER_DRY) { phase_router(F, l, ntok, 1024); xcd_barrier(bar, F.tid == 0); } phase_router(F, l, ntok); PH_END
        PH_BEGIN(12) phase_assign(F, l, ntok); PH_END
        PH_BEGIN(13)
            moe_tables(cnt, TAB, F.tid);
            ProbUp P{(const bf16*)(F.ck + M_H2), (const bf16*)(F.ws + WS_UPT) + (size_t)l * 32 * 1024 * 1024, (const int*)(F.ck + M_ROWTOK), TAB, 1024, 1024, 1024, F.G, F.c};
            EpiPair<1> E{(bf16*)(F.ck + M_HID), 512}; pg8::gemm_phase(F.lds, P, E, F.tid);
        PH_END
        PH_BEGIN(14)
            moe_tables(cnt, TAB, F.tid);
            ProbDown P{(const bf16*)(F.ck + M_HID), (const bf16*)(F.ws + WS_DOWNT) + (size_t)l * 32 * 1024 * 512, TAB, 512, 512, 512, F.G, F.c, 0, TAB[0]};
            EpiDownY E{(const int*)(F.ck + M_ROWTOK), (const float*)(F.ck + M_ROWW), (bf16*)(F.ck + M_Y), TAB[1]}; pg8::gemm_phase(F.lds, P, E, F.tid);
        PH_END
        PH_BEGIN(15) if (l + 1 < DEPTH) phase_comb<true>(F, l, ntok); else phase_comb<false>(F, l, ntok); PH_END
    }
#undef PH_BEGIN
#undef PH_END
}

extern "C" void kernel_launch(void* const* d_in, const int* in_sizes, int n_in, void* d_out, int out_size, void* d_ws, size_t ws_size, hipStream_t stream) {
    static int grid = 0;
    if (grid == 0) {
        if (n_in != 35 || out_size != BATCH * SEQ * D || ws_size < WS_END) { fprintf(stderr, "kernel_launch: unexpected shapes (n_in %d, out %d, ws %zu, need %zu)\n", n_in, out_size, ws_size, (size_t)WS_END); grid = -1; return; }
        int dev = 0, cus = 0, per_cu = 0;
        if (hipGetDevice(&dev) != hipSuccess || hipDeviceGetAttribute(&cus, hipDeviceAttributeMultiprocessorCount, dev) != hipSuccess) { grid = -1; return; }
        if (hipFuncSetAttribute((const void*)fwd, hipFuncAttributeMaxDynamicSharedMemorySize, LDS_BYTES) != hipSuccess) { fprintf(stderr, "kernel_launch: hipFuncSetAttribute failed\n"); grid = -1; return; }
        if (hipOccupancyMaxActiveBlocksPerMultiprocessor(&per_cu, (const void*)fwd, 512, LDS_BYTES) != hipSuccess || per_cu < 1) fprintf(stderr, "kernel_launch: occupancy query reports %d\n", per_cu);
        (void)hipGetLastError();
        grid = cus;
    }
    if (grid < 0) return;
    (void)in_sizes;
    hipMemsetAsync((char*)d_ws + WS_CTL, 0, CTL_BYTES, stream);
    Args a{};
    for (int i = 0; i < 35; ++i) a.in[i] = (const float*)d_in[i];
    a.out = (float*)d_out; a.ws = (unsigned char*)d_ws;
#if MK_SINGLE
    a.lo = 0; a.hi = NSTEPS;
    hipLaunchKernelGGL(fwd, dim3(grid), dim3(512), LDS_BYTES, stream, a);
#else
    for (int s = 0; s < NSTEPS; ++s) { a.lo = s; a.hi = s + 1; hipLaunchKernelGGL(fwd, dim3(grid), dim3(512), LDS_BYTES, stream, a);
    }
#endif
}
```

```cpp
#include <hip/hip_runtime.h>
#include <cstdio>
#include <cstdint>

#ifndef DBG_EPI_TWICE
#define DBG_EPI_TWICE 0
#endif
#ifndef MK_SINGLE
#define MK_SINGLE 1
#endif

#define GAS __attribute__((address_space(1)))
#define LAS __attribute__((address_space(3)))
typedef unsigned short bf16;
typedef short bf16x8 __attribute__((ext_vector_type(8)));
typedef short bf16x4 __attribute__((ext_vector_type(4)));
typedef float f32x4 __attribute__((ext_vector_type(4)));
typedef float f32x2 __attribute__((ext_vector_type(2)));
typedef float f32x16 __attribute__((ext_vector_type(16)));
typedef unsigned u32x4 __attribute__((ext_vector_type(4)));
typedef unsigned u32x2 __attribute__((ext_vector_type(2)));
typedef int i32x4 __attribute__((ext_vector_type(4)));

#define MLA_PAD_N 14
#define STR2(x) #x
#define STR(x) STR2(x)
constexpr int D = 1024, BATCH = 32, SEQ = 2048, CTXL = 256, DEPTH = 2;
constexpr int NB = 8, NCH = BATCH / NB;
constexpr int RL = NB * SEQ, RC = NB * CTXL, RR = RL + RC;
constexpr int NINP = 6400;
constexpr int NTOK_LAT = BATCH * SEQ, NTOK_CTX = BATCH * CTXL, NTOK = NTOK_LAT + NTOK_CTX;
constexpr int S5ROWS = 1280;
constexpr int KEYS = SEQ + CTXL;
constexpr int MOE_ROWS = 2 * NTOK + 64 * 256;
constexpr float RMS_EPS = 1e-6f;
constexpr float LOG2E = 1.4426950408889634f;

constexpr size_t al256(size_t x) { return (x + 255) & ~(size_t)255; }
constexpr size_t WS_CTL = 0, CTL_BYTES = 1u << 20;
constexpr size_t WS_WINT = WS_CTL + CTL_BYTES;
constexpr size_t WS_UQT = WS_WINT + (size_t)2 * NINP * 1024 * 2;
constexpr size_t WS_UKVT = WS_UQT + (size_t)2 * 768 * 768 * 2;
constexpr size_t WS_GLUT = WS_UKVT + (size_t)2 * 1024 * 256 * 2;
constexpr size_t WS_BRT = WS_GLUT + (size_t)2 * 1024 * 512 * 2;
constexpr size_t WS_OUTT = WS_BRT + (size_t)2 * 3 * 1024 * 512 * 2;
constexpr size_t WS_UPT = WS_OUTT + (size_t)2 * 1024 * 1024 * 2;
constexpr size_t WS_DOWNT = WS_UPT + (size_t)2 * 32 * 1024 * 1024 * 2;
constexpr size_t WS_BTY = WS_DOWNT + (size_t)2 * 32 * 1024 * 512 * 2;
constexpr size_t WS_BTS = WS_BTY + (size_t)2 * 32 * 256 * 512 * 2;
constexpr size_t WS_A16 = WS_BTS + (size_t)2 * 32 * 256 * 256 * 2;
constexpr size_t WS_MODP = WS_A16 + (size_t)2 * 2 * 32 * 64 * 2 * 4;
constexpr size_t WS_MOD = WS_MODP + (size_t)8 * 2 * 33 * 6144 * 4;
constexpr size_t WS_ROPE = WS_MOD + (size_t)2 * 33 * 6144 * 4;
constexpr size_t WS_WGT = WS_ROPE + (size_t)2048 * 32 * 4;
constexpr size_t WS_WET = WS_WGT + (size_t)2 * 4 * 1024 * 4;
constexpr size_t WS_XC = WS_WET + (size_t)2 * 32 * 1024 * 4;
constexpr size_t WS_CHUNK = al256(WS_XC + (size_t)NTOK_CTX * 1024 * 4);
constexpr size_t UB = (size_t)RR * 1024 * 2;
constexpr size_t C_HB = 0;
constexpr size_t C_KVL = C_HB + UB;
constexpr size_t C_QL = C_KVL + UB / 4;
constexpr size_t C_YM = C_HB;
constexpr size_t C_QR = C_QL + UB * 3 / 4;
constexpr size_t C_KN = C_QR + UB * 3 / 4;
constexpr size_t C_YMB = C_QR;
constexpr size_t C_KRP = C_KN + UB / 2;
constexpr size_t C_NQ = al256(C_KRP + (size_t)RR * 32 * 2);
constexpr size_t C_NK = C_NQ + UB / 2;
constexpr size_t C_NV = C_NK + UB / 2;
constexpr size_t C_GT = C_NV + UB / 2;
constexpr size_t C_AS5 = C_GT + UB * 3;
constexpr size_t C_SS = C_AS5 + (size_t)S5ROWS * 32 * 512 * 2;
constexpr size_t C_VV = C_SS + (size_t)S5ROWS * 32 * 256 * 4;
constexpr size_t C_QF = C_VV + UB / 2;
constexpr size_t C_KF = C_QF + UB * 3 / 4;
constexpr size_t C_VT = C_KF + UB * 3 / 4;
constexpr size_t C_NVT = C_VT + (size_t)NB * 8 * 64 * KEYS * 2;
constexpr size_t C_OA = C_NVT + (size_t)NB * 8 * 64 * KEYS * 2;
constexpr size_t C_OB = C_OA + UB / 2;
constexpr size_t C_OC = C_OB + UB / 2;
constexpr size_t C_YG = C_OC + UB / 2;
constexpr size_t C_SSKV = C_YG + UB / 2;
constexpr size_t C_SSQL = C_SSKV + (size_t)RR * 4 * 4;
constexpr size_t C_END = al256(C_SSQL + (size_t)RR * 12 * 4);
constexpr size_t M_HID = 0;
constexpr size_t M_Y = M_HID + (size_t)MOE_ROWS * 512 * 2;
constexpr size_t M_H2 = M_Y;
constexpr size_t M_ROWTOK = M_Y + (size_t)2 * NTOK * 1024 * 2;
constexpr size_t M_ROWW = M_ROWTOK + (size_t)MOE_ROWS * 4;
constexpr size_t M_TOKE = M_ROWW + (size_t)MOE_ROWS * 4;
constexpr size_t M_TOKW = M_TOKE + (size_t)NTOK * 16;
constexpr size_t M_WGBASE = M_TOKW + (size_t)NTOK * 8;
constexpr size_t M_END = M_WGBASE + (size_t)1024 * 64 * 4;
static_assert(M_END <= C_END, "MoE buffers fit in the chunk region");
constexpr size_t WS_HBALL = WS_CHUNK + C_END;
constexpr size_t WS_END = WS_HBALL + (size_t)NTOK * 1024 * 2;
constexpr size_t X_YG = WS_HBALL, X_OA = X_YG + (size_t)NTOK_CTX * 512 * 2, X_OB = X_OA + (size_t)NTOK_CTX * 512 * 2, X_OC = X_OB + (size_t)NTOK_CTX * 512 * 2;
constexpr size_t X_GT = X_OC + (size_t)NTOK_CTX * 512 * 2, X_YMB = X_GT + (size_t)NTOK_CTX * 3072 * 2, X_END = X_YMB + (size_t)NTOK_CTX * 1024 * 2;
static_assert(X_END <= WS_END, "ctx-tail buffers fit inside HB_ALL");
static_assert(WS_END <= ((size_t)1 << 30), "workspace within 1 GiB");
constexpr int CW_BAR = 4096;
constexpr int CW_CNT = 16384;

constexpr int LDS_MISC = 143360;
constexpr int LDS_TAB = LDS_MISC + 256;
constexpr int LDS_BYTES = 147456;

__device__ __forceinline__ unsigned f2bf(float f) { unsigned u = __builtin_bit_cast(unsigned, f); return (u + 0x7fffu + ((u >> 16) & 1u)) >> 16; }
typedef __bf16 bf2n_t __attribute__((ext_vector_type(2)));
__device__ __forceinline__ unsigned pk2(float lo, float hi) { const f32x2 v = {lo, hi}; return __builtin_bit_cast(unsigned, __builtin_convertvector(v, bf2n_t)); }
__device__ __forceinline__ float bflo(unsigned u) { return __builtin_bit_cast(float, u << 16); }
__device__ __forceinline__ float bfhi(unsigned u) { return __builtin_bit_cast(float, u & 0xffff0000u); }
__device__ __forceinline__ float bf2f(bf16 h) { return __builtin_bit_cast(float, ((unsigned)h) << 16); }
template <class T> __device__ __forceinline__ T ldg(const void* p) { return *(const GAS T*)p; }
template <class T> __device__ __forceinline__ void stg(void* p, T v) { *(GAS T*)p = v; }
template <int K> __device__ __forceinline__ float shx_sum(float v) {
    if constexpr (K == 32) { float a = v, b = v; asm volatile("s_nop 1\n\tv_permlane32_swap_b32 %0, %1" : "+v"(a), "+v"(b)); return a + b; }
    else return v + __builtin_bit_cast(float, __builtin_amdgcn_ds_swizzle(__builtin_bit_cast(int, v), (K << 10) | 0x1f));
}
template <int K> __device__ __forceinline__ float shx_max(float v) {
    if constexpr (K == 32) { float a = v, b = v; asm volatile("s_nop 1\n\tv_permlane32_swap_b32 %0, %1" : "+v"(a), "+v"(b)); return fmaxf(a, b); }
    else return fmaxf(v, __builtin_bit_cast(float, __builtin_amdgcn_ds_swizzle(__builtin_bit_cast(int, v), (K << 10) | 0x1f)));
}
__device__ __forceinline__ float wave_sum(float v) { v = shx_sum<1>(v); v = shx_sum<2>(v); v = shx_sum<4>(v); v = shx_sum<8>(v); v = shx_sum<16>(v); return shx_sum<32>(v); }
__device__ __forceinline__ float hx32(float a, float b) { asm volatile("s_nop 1\n\tv_permlane32_swap_b32 %0, %1" : "+v"(a), "+v"(b)); return a + b; }
__device__ __forceinline__ float hx16(float a, float b) { asm volatile("s_nop 1\n\tv_permlane16_swap_b32 %0, %1" : "+v"(a), "+v"(b)); return a + b; }
template <int N> __device__ __forceinline__ float dpp_ror(float v) { return __builtin_bit_cast(float, __builtin_amdgcn_update_dpp(0, __builtin_bit_cast(int, v), 0x120 + N, 0xf, 0xf, false)); }
__device__ __forceinline__ float row_sum16(float v) { v += dpp_ror<8>(v); v += dpp_ror<4>(v); v += dpp_ror<2>(v); v += dpp_ror<1>(v); return v; }
__device__ __forceinline__ float red4(float v0, float v1, float v2, float v3) { return row_sum16(hx16(hx32(v0, v2), hx32(v1, v3))); }
__device__ __forceinline__ float lane_bcast(float v, int srclane) { return __builtin_bit_cast(float, __builtin_amdgcn_readlane(__builtin_bit_cast(int, v), srclane)); }
__device__ __forceinline__ float fast_exp2(float x) { return __builtin_amdgcn_exp2f(x); }
__device__ __forceinline__ float sigmoidf(float x) { return __builtin_amdgcn_rcpf(1.0f + __builtin_amdgcn_exp2f(-LOG2E * x)); }
__device__ __forceinline__ float gelu_tanh(float x) { const float u = 0.7978845608028654f * (x + 0.044715f * x * x * x); return x * sigmoidf(2.0f * u); }

#define XB_TMO      128
#define XB_XCNT(j)  (256  + 64 * (j))
#define XB_XSUB(j)  (1280 + 64 * (j))
#define XB_XGEN(j)  (2304 + 64 * (j))
#define XB_TOP      3328
#define XB_TOPGEN   3392
#define XCD_BAR_WORDS 3456
#define XB_SPIN_CAP (1u << 22)

__device__ __forceinline__ unsigned xb_ld(unsigned* p)              { return __hip_atomic_load(p, __ATOMIC_RELAXED, __HIP_MEMORY_SCOPE_AGENT); }
__device__ __forceinline__ unsigned xb_add(unsigned* p, unsigned v) { return __hip_atomic_fetch_add(p, v, __ATOMIC_RELAXED, __HIP_MEMORY_SCOPE_AGENT); }
__device__ __forceinline__ unsigned xb_xcc_id() { return (unsigned)__builtin_amdgcn_s_getreg((3 << 11) | 20) & 0xFu; }
#define XB_SPIN(cond, bar) do { unsigned _sp = 0; while (cond) { __builtin_amdgcn_s_sleep(1); \
    if ((++_sp & 255u) == 0u) { if (xb_ld(&(bar)[XB_TMO])) break; if (_sp > XB_SPIN_CAP) { atomicAdd(&(bar)[XB_TMO], 1u); break; } } } } while (0)

struct XcdBarrier { unsigned* bar; unsigned x; volatile LAS unsigned* st; };

__device__ __forceinline__ XcdBarrier xcd_barrier_post(unsigned* bar, volatile LAS unsigned* st) {
    XcdBarrier b; b.bar = bar; b.x = xb_xcc_id(); b.st = st;
    if (threadIdx.x == 0) (void)xb_add(&bar[XB_XCNT(b.x)], 1u);
    return b;
}
__device__ __forceinline__ void xcd_barrier_complete(unsigned* bar, unsigned x, unsigned& nloc, unsigned& nx) {
    const unsigned G = gridDim.x * gridDim.y * gridDim.z;
    unsigned sum, cnt, mine, sp = 0u;
    for (;;) {
        sum = 0u; cnt = 0u; mine = 0u;
#pragma unroll
        for (unsigned j = 0; j < 16; ++j) { const unsigned c = xb_ld(&bar[XB_XCNT(j)]); sum += c; cnt += (c > 0u) ? 1u : 0u; mine = (j == x) ? c : mine; }
        if (sum == G) break;
        __builtin_amdgcn_s_sleep(1);
        if ((++sp & 255u) == 0u) { if (xb_ld(&bar[XB_TMO])) break; if (sp > XB_SPIN_CAP) { atomicAdd(&bar[XB_TMO], 1u); break; } }
    }
    nloc = mine > 0u ? mine : 1u; nx = cnt > 0u ? cnt : 1u;
}
__device__ __forceinline__ void xcd_barrier(const XcdBarrier& b, bool thread0) {
    asm volatile("s_waitcnt vmcnt(0)" ::: "memory");
    __syncthreads();
    if (thread0) {
        unsigned* bar = b.bar;
        __builtin_amdgcn_s_waitcnt(0);
        unsigned nloc = b.st[0], nx = b.st[1];
        if (nloc == 0u) { xcd_barrier_complete(bar, b.x, nloc, nx); b.st[0] = nloc; b.st[1] = nx; }
        const unsigned old = xb_add(&bar[XB_XSUB(b.x)], 1u);
        const unsigned gen = old / nloc;
        if (old + 1u == (gen + 1u) * nloc) {
            __builtin_amdgcn_fence(__ATOMIC_RELEASE, "agent");
            asm volatile("s_waitcnt vmcnt(0)" ::: "memory");
            const unsigned og = xb_add(&bar[XB_TOP], 1u);
            const unsigned tg = og / nx;
            if (og + 1u == (tg + 1u) * nx) xb_add(&bar[XB_TOPGEN], 1u);
            else XB_SPIN(xb_ld(&bar[XB_TOPGEN]) == tg, bar);
            __builtin_amdgcn_fence(__ATOMIC_ACQUIRE, "agent");
            xb_add(&bar[XB_XGEN(b.x)], 1u);
            asm volatile("s_waitcnt vmcnt(0)" ::: "memory");
        } else {
            XB_SPIN(xb_ld(&bar[XB_XGEN(b.x)]) == gen, bar);
            __builtin_amdgcn_fence(__ATOMIC_ACQUIRE, "agent");
            asm volatile("s_waitcnt vmcnt(0)" ::: "memory");
        }
    }
    __syncthreads();
}

namespace pg8 {
constexpr int BM = 256, BK = 64, HALF = 128, HTB = HALF * BK * 2, STAGE_BYTES = 8 * HTB, NXCD = 8, WGM = 2;
__host__ __device__ __forceinline__ int lds_byte(int r, int c) { const int st = (r >> 4) * 2 + (c >> 5), rr = r & 15, cc = c & 31, ob = rr * 64 + cc * 2; return st * 1024 + (ob ^ (((ob >> 9) & 1) << 5)); }
__host__ __device__ __forceinline__ void stage_rc(int b, int& R, int& C) { const int st = b / 1024, sb = b % 1024, swz = sb ^ (((sb >> 9) & 1) << 5); R = (st >> 1) * 16 + swz / 64; C = (st & 1) * 32 + (swz % 64) / 2; }
__host__ __device__ __forceinline__ int perm32(int rho) { const int n = rho >> 4, i = rho & 15; return 8 * (i >> 2) + 4 * n + (i & 3); }
struct Unit { int pm, pn, z; };
__device__ __forceinline__ bool tile_map(long L, int nM, int nN, int& pm, int& pn) {
    const int nwg = nM * nN; if (L >= nwg) return false;
    int wgid = (int)L; { const int q = nwg / NXCD, r = nwg % NXCD, xcd = wgid % NXCD, off = wgid / NXCD; wgid = (xcd < r ? xcd * (q + 1) : r * (q + 1) + (xcd - r) * q) + off; }
    const int nig = WGM * nN, gid = wgid / nig, fm = gid * WGM, gsz = (nM - fm) < WGM ? (nM - fm) : WGM;
    pm = fm + ((wgid % nig) % gsz); pn = (wgid % nig) / gsz; return true;
}
typedef __bf16 bf2_t __attribute__((ext_vector_type(2)));
__device__ __forceinline__ unsigned cvt_pk_bf16(float lo, float hi) { const f32x2 v = {lo, hi}; return __builtin_bit_cast(unsigned, __builtin_convertvector(v, bf2_t)); }

template <class Prob, class Epi>
__device__ __forceinline__ void gemm_phase(LAS unsigned char* lds, const Prob& P, const Epi& E, int tid_in) {
    int tid_ = tid_in; asm volatile("" : "+v"(tid_));
    const int tid = tid_, wid = __builtin_amdgcn_readfirstlane(tid >> 6), lane = tid & 63, wr = wid >> 2, wc = wid & 3, fr = lane & 15, fq = lane >> 4;
    const int K = P.K, nt = K / BK;
    int sR[2], sC[2]; unsigned voffB[2], voffA[2];
#pragma unroll
    for (int i = 0; i < 2; ++i) { int R, C; stage_rc(tid * 16 + i * 8192, R, C); sR[i] = R; sC[i] = C; const int Rb = Epi::PERM ? ((R & ~31) + perm32(R & 31)) : R;
        voffA[i] = (unsigned)(R * P.lda + C) * 2u; voffB[i] = (unsigned)(Rb * P.ldb + C) * 2u; }
    const size_t kstep = (size_t)(BK * 2);
    const unsigned hstepA = (unsigned)HALF * (unsigned)P.lda * 2u; const size_t hstepB = (size_t)HALF * P.ldb * 2;
    const unsigned ldsw = (unsigned)wid * 1024u;
    const int aoff = lds_byte(wr * 64 + fr, fq * 8), boff = lds_byte(wc * 32 + fr, fq * 8);
#define PG8_SA(b, h) (((b) * 2 + (h)) * HTB)
#define PG8_SB(b, h) ((4 + (b) * 2 + (h)) * HTB)
#define PG8_STAGE2(bufoff, gbase, o0, o1) do { \
        __builtin_amdgcn_global_load_lds((const GAS unsigned*)((const char*)(gbase) + (o0)), (LAS unsigned*)(lds + (bufoff) + ldsw), 16, 0, 0); \
        __builtin_amdgcn_global_load_lds((const GAS unsigned*)((const char*)(gbase) + (o1)), (LAS unsigned*)(lds + (bufoff) + ldsw + 8192), 16, 0, 0); } while (0)
#define PG8_STAGEB(bufoff, gbase) PG8_STAGE2(bufoff, gbase, voffB[0], voffB[1])
#define PG8_STAGEA(bufoff, gbase, OA, h) do { if constexpr (Prob::GATHER) { PG8_STAGE2(bufoff, gbase, OA[h][0], OA[h][1]); } else { PG8_STAGE2(bufoff, (gbase) + (h) * (size_t)hstepA, voffA[0], voffA[1]); } } while (0)
#define PG8_LDA(dst, b, h) do { _Pragma("unroll") for (int m = 0; m < 4; ++m) _Pragma("unroll") for (int k = 0; k < 2; ++k) dst[m][k] = *(const LAS bf16x8*)(lds + PG8_SA(b, h) + aoff + m * 2048 + k * 1024); } while (0)
#define PG8_LDB(dst, b, h) do { _Pragma("unroll") for (int n = 0; n < 2; ++n) _Pragma("unroll") for (int k = 0; k < 2; ++k) dst[n][k] = *(const LAS bf16x8*)(lds + PG8_SB(b, h) + boff + n * 2048 + k * 1024); } while (0)
#define PG8_MMA(ai, bj, At, Bt) do { __builtin_amdgcn_s_setprio(1); _Pragma("unroll") for (int m = 0; m < 4; ++m) _Pragma("unroll") for (int n = 0; n < 2; ++n) _Pragma("unroll") for (int k = 0; k < 2; ++k) \
        acc[ai][bj][m][n] = __builtin_amdgcn_mfma_f32_16x16x32_bf16(Bt[n][k], At[m][k], acc[ai][bj][m][n], 0, 0, 0); __builtin_amdgcn_s_setprio(0); } while (0)
#define PG8_WAIT_V(n) asm volatile("s_waitcnt vmcnt(" #n ")" ::: "memory")
#define PG8_WAIT_L(n) asm volatile("s_waitcnt lgkmcnt(" #n ")" ::: "memory")
#define PG8_BAR __builtin_amdgcn_s_barrier()
#define PG8_SCHED __builtin_amdgcn_sched_barrier(0)
    Unit cur, nxt; int ui = 0;
    if (!P.next(0, cur)) return;
    f32x4 acc[2][2][4][2];
    bf16x8 At[4][2], B0[2][2], B1[2][2];
    const char* cA = P.a_base(cur); const char* cB = P.b_base(cur);
    unsigned cOA[2][2];
#pragma unroll
    for (int h = 0; h < 2; ++h)
#pragma unroll
        for (int i = 0; i < 2; ++i) {
            if constexpr (Prob::GATHER) cOA[h][i] = P.a_rowoff(cur, h * HALF + sR[i]) + (unsigned)sC[i] * 2u;
            else cOA[h][i] = 0u;
        }
    PG8_STAGEB(PG8_SB(0, 0), cB); PG8_STAGEB(PG8_SB(0, 1), cB + hstepB); PG8_STAGEA(PG8_SA(0, 0), cA, cOA, 0); PG8_STAGEA(PG8_SA(0, 1), cA, cOA, 1);
    if (wr == 1) PG8_BAR;
    PG8_WAIT_V(2); PG8_BAR;
    PG8_STAGEB(PG8_SB(1, 0), cB + kstep); PG8_STAGEA(PG8_SA(1, 0), cA + kstep, cOA, 0); PG8_STAGEB(PG8_SB(1, 1), cB + hstepB + kstep);
    PG8_WAIT_V(6); PG8_BAR;
    for (;;) {
        const bool has_next = P.next(ui + 1, nxt);
        const char* nA = has_next ? P.a_base(nxt) : cA; const char* nB = has_next ? P.b_base(nxt) : cB;
        if constexpr (Prob::GATHER) {
            u32x4 nv = (u32x4){cOA[0][0], cOA[0][1], cOA[1][0], cOA[1][1]};
            if (has_next) {
                int t2 = tid; asm volatile("" : "+v"(t2));
#pragma unroll
                for (int i = 0; i < 2; ++i) { int R2, C2; stage_rc(t2 * 16 + i * 8192, R2, C2);
                    nv[i] = P.a_rowoff(nxt, R2) + (unsigned)C2 * 2u; nv[2 + i] = P.a_rowoff(nxt, HALF + R2) + (unsigned)C2 * 2u; }
            }
            *(LAS u32x4*)(lds + STAGE_BYTES + tid * 16) = nv;
        }
        float zero_ = 0.f; asm volatile("" : "+v"(zero_));
#pragma unroll
        for (int a = 0; a < 2; ++a)
#pragma unroll
            for (int b = 0; b < 2; ++b)
#pragma unroll
                for (int m = 0; m < 4; ++m)
#pragma unroll
                    for (int n = 0; n < 2; ++n) acc[a][b][m][n] = (f32x4){zero_, zero_, zero_, zero_};
        asm volatile("" : "+v"(acc[0][0][0][0]), "+v"(acc[0][0][0][1]), "+v"(acc[0][0][1][0]), "+v"(acc[0][0][1][1]), "+v"(acc[0][0][2][0]), "+v"(acc[0][0][2][1]), "+v"(acc[0][0][3][0]), "+v"(acc[0][0][3][1]),
                          "+v"(acc[0][1][0][0]), "+v"(acc[0][1][0][1]), "+v"(acc[0][1][1][0]), "+v"(acc[0][1][1][1]), "+v"(acc[0][1][2][0]), "+v"(acc[0][1][2][1]), "+v"(acc[0][1][3][0]), "+v"(acc[0][1][3][1]));
        asm volatile(".p2align 6" : "+v"(acc[1][0][0][0]), "+v"(acc[1][0][0][1]), "+v"(acc[1][0][1][0]), "+v"(acc[1][0][1][1]), "+v"(acc[1][0][2][0]), "+v"(acc[1][0][2][1]), "+v"(acc[1][0][3][0]), "+v"(acc[1][0][3][1]),
                          "+v"(acc[1][1][0][0]), "+v"(acc[1][1][0][1]), "+v"(acc[1][1][1][0]), "+v"(acc[1][1][1][1]), "+v"(acc[1][1][2][0]), "+v"(acc[1][1][2][1]), "+v"(acc[1][1][3][0]), "+v"(acc[1][1][3][1]));
        for (int t = 0; t < nt; t += 2) {
            const bool last = (t == nt - 2);
            const char* a1 = cA + (size_t)(t + 1) * kstep;
            const char* a2 = last ? nA : cA + (size_t)(t + 2) * kstep; const char* b2 = last ? nB : cB + (size_t)(t + 2) * kstep;
            const char* a3 = a2 + kstep; const char* b3 = b2 + kstep;
            unsigned oa2[2][2];
#pragma unroll
            for (int h = 0; h < 2; ++h)
#pragma unroll
                for (int i = 0; i < 2; ++i) oa2[h][i] = Prob::GATHER ? cOA[h][i] : 0u;
            if constexpr (Prob::GATHER) { if (last) { const u32x4 nv = *(const LAS u32x4*)(lds + STAGE_BYTES + tid * 16); oa2[0][0] = nv.x; oa2[0][1] = nv.y; oa2[1][0] = nv.z; oa2[1][1] = nv.w; } }
            PG8_LDB(B0, 0, 0); PG8_LDB(B1, 0, 1); PG8_SCHED; PG8_LDA(At, 0, 0); PG8_STAGEA(PG8_SA(1, 1), a1, cOA, 1);
            PG8_WAIT_V(8); PG8_WAIT_L(0); PG8_BAR; PG8_MMA(0, 0, At, B0); PG8_MMA(0, 1, At, B1); PG8_BAR; PG8_SCHED;
            PG8_LDA(At, 0, 1); PG8_STAGEB(PG8_SB(0, 0), b2); PG8_STAGEB(PG8_SB(0, 1), b2 + hstepB); PG8_STAGEA(PG8_SA(0, 0), a2, oa2, 0);
            PG8_WAIT_V(8); PG8_WAIT_L(0); PG8_BAR; PG8_MMA(1, 0, At, B0); PG8_MMA(1, 1, At, B1); PG8_BAR; PG8_SCHED;
            PG8_LDB(B0, 1, 0); PG8_LDB(B1, 1, 1); PG8_SCHED; PG8_LDA(At, 1, 0); PG8_STAGEA(PG8_SA(0, 1), a2, oa2, 1);
            PG8_WAIT_V(8); PG8_WAIT_L(0); PG8_BAR; PG8_MMA(0, 0, At, B0); PG8_MMA(0, 1, At, B1); PG8_BAR; PG8_SCHED;
            PG8_LDA(At, 1, 1); PG8_STAGEB(PG8_SB(1, 0), b3); PG8_STAGEB(PG8_SB(1, 1), b3 + hstepB); PG8_STAGEA(PG8_SA(1, 0), a3, oa2, 0);
            PG8_WAIT_V(8); PG8_WAIT_L(0); PG8_BAR; PG8_MMA(1, 0, At, B0); PG8_MMA(1, 1, At, B1); PG8_BAR; PG8_SCHED;
        }
        if (wr == 0) PG8_BAR;
        E(acc, cur, wr, wc, fr, fq);
#if DBG_EPI_TWICE
        if constexpr (Epi::IDEMP) E(acc, cur, wr, wc, fr, fq);
#endif
        if (!has_next) break;
        cur = nxt; cA = nA; cB = nB; ++ui;
        if constexpr (Prob::GATHER) { const u32x4 nv = *(const LAS u32x4*)(lds + STAGE_BYTES + tid * 16); cOA[0][0] = nv.x; cOA[0][1] = nv.y; cOA[1][0] = nv.z; cOA[1][1] = nv.w; }
        if (wr == 1) PG8_BAR;
    }
    PG8_WAIT_V(0);
    PG8_BAR;
#undef PG8_SA
#undef PG8_SB
#undef PG8_STAGE2
#undef PG8_STAGEB
#undef PG8_STAGEA
#undef PG8_LDA
#undef PG8_LDB
#undef PG8_MMA
#undef PG8_WAIT_V
#undef PG8_WAIT_L
#undef PG8_BAR
#undef PG8_SCHED
}
}
using pg8::Unit;

struct Args { const float* in[35]; float* out; unsigned char* ws; int lo, hi; };

struct Frame {
    LAS unsigned char* lds;
    int tid, lane, wave, G, c;
    const float* const* in;
    float* out; unsigned char* ws; unsigned char* ck;
    float* MOD; float* XC;
};
__device__ __forceinline__ bool row_is_ctx(int row) { return row >= RL; }

struct ProbPlain {
    static constexpr bool GATHER = false;
    const bf16* A; const bf16* Bt; int K, lda, ldb, nM, nN, G, c, a_pn_stride;
    __device__ __forceinline__ bool next(int i, Unit& u) const { u.z = 0; return pg8::tile_map((long)i * G + c, nM, nN, u.pm, u.pn); }
    __device__ __forceinline__ const char* a_base(const Unit& u) const { return (const char*)(A + (size_t)u.pm * 256 * lda + (size_t)u.pn * a_pn_stride); }
    __device__ __forceinline__ const char* b_base(const Unit& u) const { return (const char*)(Bt + (size_t)u.pn * 256 * ldb); }
    __device__ __forceinline__ unsigned a_rowoff(const Unit&, int) const { return 0u; }
};
struct ProbG1 {
    static constexpr bool GATHER = false;
    const bf16* A; const bf16* Actx; const bf16* Bt; int K, lda, ldb, G, c, nctx;
    __device__ __forceinline__ bool next(int i, Unit& u) const {
        u.z = 0; const long L = (long)i * G + c; const int n1 = 64 * 25;
        if (L < n1) return pg8::tile_map(L, 64, 25, u.pm, u.pn);
        const int l2 = (int)(L - n1); if (l2 >= 8 * nctx) return false;
        u.pm = 64 + (l2 & 7); const int idx = l2 >> 3;
        u.pn = (nctx == 24) ? idx : (idx < 3 ? idx : (idx < 7 ? idx + 5 : 24));
        return true;
    }
    __device__ __forceinline__ const char* a_base(const Unit& u) const { return u.pm < 64 ? (const char*)(A + (size_t)u.pm * 256 * lda) : (const char*)(Actx + (size_t)(u.pm - 64) * 256 * lda); }
    __device__ __forceinline__ const char* b_base(const Unit& u) const { return (const char*)(Bt + (size_t)u.pn * 256 * ldb); }
    __device__ __forceinline__ unsigned a_rowoff(const Unit&, int) const { return 0u; }
};
struct ProbMerge {
    static constexpr bool GATHER = false;
    const bf16* O[3]; const bf16* Bt; int K, lda, ldb, nM, nN, G, c;
    __device__ __forceinline__ bool next(int i, Unit& u) const { u.z = i % 3; return pg8::tile_map((long)(i / 3) * G + c, nM, nN, u.pm, u.pn); }
    __device__ __forceinline__ const char* a_base(const Unit& u) const { const bf16* o = u.z == 0 ? O[0] : (u.z == 1 ? O[1] : O[2]); return (const char*)(o + (size_t)u.pm * 256 * lda); }
    __device__ __forceinline__ const char* b_base(const Unit& u) const { return (const char*)(Bt + ((size_t)u.z * 1024 + (size_t)u.pn * 256) * ldb); }
    __device__ __forceinline__ unsigned a_rowoff(const Unit&, int) const { return 0u; }
};
__device__ __forceinline__ void moe_tables(const unsigned* cnt, LAS int* T, int tid_in) {
    int t_ = tid_in; asm volatile("" : "+v"(t_));
    __syncthreads();
    if (t_ < 64) T[706 + t_] = (int)__hip_atomic_load(cnt + t_, __ATOMIC_RELAXED, __HIP_MEMORY_SCOPE_AGENT);
    __syncthreads();
    if (t_ == 0) {
        int row = 0, t = 0;
#pragma nounroll
        for (int ge = 0; ge < 64; ++ge) {
            const int cn = T[706 + ge];
            T[2 + ge] = row; const int nt = (cn + 255) >> 8;
#pragma nounroll
            for (int k = 0; k < nt && t < 640; ++k) T[66 + (t++)] = ge & 31;
            row += nt * 256;
            if (ge == 31) T[1] = t;
        }
        T[0] = t;
    }
    __syncthreads();
}
struct ProbUp {
    static constexpr bool GATHER = true;
    const bf16* A; const bf16* Bt; const int* rowtok; LAS int* T; int K, lda, ldb, G, c;
    __device__ __forceinline__ bool next(int i, Unit& u) const {
        const int nwg = T[0] * 4; const long L = (long)i * G + c; if (L >= nwg) return false;
        int w = (int)L; { const int q = nwg / 8, r = nwg % 8, xcd = w % 8, off = w / 8; w = (xcd < r ? xcd * (q + 1) : r * (q + 1) + (xcd - r) * q) + off; }
        u.pm = w >> 2; u.pn = w & 3; u.z = T[66 + u.pm]; return true;
    }
    __device__ __forceinline__ const char* a_base(const Unit&) const { return (const char*)A; }
    __device__ __forceinline__ const char* b_base(const Unit& u) const { return (const char*)(Bt + ((size_t)u.z * 1024 + (size_t)u.pn * 256) * ldb); }
    __device__ __forceinline__ unsigned a_rowoff(const Unit& u, int r) const { const GAS int* base = (const GAS int*)(rowtok + (size_t)u.pm * 256); int t = base[(unsigned)r]; t = t < 0 ? 0 : t; return (unsigned)t * (unsigned)lda * 2u; }
};
struct ProbDown {
    static constexpr bool GATHER = false;
    const bf16* A; const bf16* Bt; LAS int* T; int K, lda, ldb, G, c, t0, t1;
    __device__ __forceinline__ bool next(int i, Unit& u) const {
        const int nwg = (t1 - t0) * 4; const long L = (long)i * G + c; if (L >= nwg) return false;
        int w = (int)L; { const int q = nwg / 8, r = nwg % 8, xcd = w % 8, off = w / 8; w = (xcd < r ? xcd * (q + 1) : r * (q + 1) + (xcd - r) * q) + off; }
        u.pm = t0 + (w >> 2); u.pn = w & 3; u.z = T[66 + u.pm]; return true;
    }
    __device__ __forceinline__ const char* a_base(const Unit& u) const { return (const char*)(A + (size_t)u.pm * 256 * lda); }
    __device__ __forceinline__ const char* b_base(const Unit& u) const { return (const char*)(Bt + ((size_t)u.z * 1024 + (size_t)u.pn * 256) * ldb); }
    __device__ __forceinline__ unsigned a_rowoff(const Unit&, int) const { return 0u; }
};

typedef f32x4 AccT[2][2][4][2];
#define EPI_ROWS_BEGIN  _Pragma("unroll") for (int ai = 0; ai < 2; ++ai) _Pragma("unroll") for (int m = 0; m < 4; ++m) { const int row = row0 + ai * 128 + m * 16;
#define EPI_ROWS_END    }
__device__ __forceinline__ u32x4 pack8(const f32x4& a, const f32x4& b) { u32x4 w; w.x = pg8::cvt_pk_bf16(a[0], a[1]); w.y = pg8::cvt_pk_bf16(a[2], a[3]); w.z = pg8::cvt_pk_bf16(b[0], b[1]); w.w = pg8::cvt_pk_bf16(b[2], b[3]); return w; }

__device__ __forceinline__ void s5_row_of(int row, int& rho, int& s) {
    if (row < RL) { const int b = row >> 11, t = row & 2047; rho = b * 128 + (t >> 4); s = t & 15; }
    else { const int rc = row - RL, b = rc >> 8, t = rc & 255; rho = 1024 + b * 16 + (t >> 4); s = t & 15; }
}
struct EpiG1 {
    static constexpr bool IDEMP = true;
    static constexpr bool PERM = true;
    unsigned char* ck; const float* gqn; const float* gkn;
    bf16* gtc;
    __device__ __forceinline__ void operator()(const AccT& acc, const Unit& u, int wr, int wc, int fr, int fq) const {
        const int pn = u.pn, row0 = u.pm * 256 + wr * 64 + fr, cin = wc * 32 + 8 * fq;
        if (pn == 1 || pn == 2) {
            bf16* AS5 = (bf16*)(ck + C_AS5);
            EPI_ROWS_BEGIN
                int rho, s; s5_row_of(row, rho, s);
#pragma unroll
                for (int bj = 0; bj < 2; ++bj) { const int c512 = (pn - 1) * 256 + bj * 128 + cin, g = c512 >> 4, n0 = c512 & 15;
                    stg<u32x4>(AS5 + ((size_t)rho * 32 + g) * 512 + s * 16 + n0, pack8(acc[ai][bj][m][0], acc[ai][bj][m][1])); }
            EPI_ROWS_END
            return;
        }
        if (pn == 24) {
            bf16* KRP = (bf16*)(ck + C_KRP);
            if (wc == 0) { EPI_ROWS_BEGIN stg<u32x4>(KRP + (size_t)row * 32 + 8 * fq, pack8(acc[ai][0][m][0], acc[ai][0][m][1])); EPI_ROWS_END }
            return;
        }
        if (pn >= 6 && pn < 10) {
            const bool isq = pn < 8; const int head = 4 * (isq ? pn - 6 : pn - 8) + wc;
            bf16* dst = (bf16*)(ck + (isq ? C_NQ : C_NK)) + head * 64 + 8 * fq; const float* gn = isq ? gqn : gkn;
            f32x4 g[2][2];
#pragma unroll
            for (int bj = 0; bj < 2; ++bj)
#pragma unroll
                for (int n = 0; n < 2; ++n) g[bj][n] = ldg<f32x4>(gn + bj * 32 + 8 * fq + 4 * n);
            const float osc = isq ? 0.125f * LOG2E : 1.0f;
            EPI_ROWS_BEGIN
                float ss = 0.f;
#pragma unroll
                for (int bj = 0; bj < 2; ++bj)
#pragma unroll
                    for (int n = 0; n < 2; ++n) { const f32x4 v = acc[ai][bj][m][n]; ss += v[0] * v[0] + v[1] * v[1] + v[2] * v[2] + v[3] * v[3]; }
                ss = shx_sum<16>(ss); ss = shx_sum<32>(ss);
                const float sc = rsqrtf(ss * (1.0f / 64.0f) + RMS_EPS) * osc;
#pragma unroll
                for (int bj = 0; bj < 2; ++bj) stg<u32x4>(dst + (size_t)row * 512 + bj * 32, pack8(acc[ai][bj][m][0] * sc * g[bj][0], acc[ai][bj][m][1] * sc * g[bj][1]));
            EPI_ROWS_END
            return;
        }
        bf16* dst; int ld, col0; bool sig = false; float* ssq = nullptr; int ssld = 0;
        if (pn == 0) { dst = (bf16*)(ck + C_KVL); ld = 256; col0 = 0; ssq = (float*)(ck + C_SSKV) + wc; ssld = 4; }
        else if (pn < 6) { dst = (bf16*)(ck + C_QL); ld = 768; col0 = (pn - 3) * 256; ssq = (float*)(ck + C_SSQL) + (pn - 3) * 4 + wc; ssld = 12; }
        else if (pn < 12) { dst = (bf16*)(ck + C_NV); ld = 512; col0 = (pn - 10) * 256; }
        else { dst = u.pm >= 64 ? gtc : (bf16*)(ck + C_GT); ld = 3072; col0 = (pn - 12) * 256; sig = true; }
        EPI_ROWS_BEGIN
            float ss = 0.f;
#pragma unroll
            for (int bj = 0; bj < 2; ++bj) {
                f32x4 v0 = acc[ai][bj][m][0], v1 = acc[ai][bj][m][1];
                if (sig) {
#pragma unroll
                    for (int j = 0; j < 4; ++j) { v0[j] = sigmoidf(v0[j]); v1[j] = sigmoidf(v1[j]); } }
                ss += v0[0] * v0[0] + v0[1] * v0[1] + v0[2] * v0[2] + v0[3] * v0[3] + v1[0] * v1[0] + v1[1] * v1[1] + v1[2] * v1[2] + v1[3] * v1[3];
                stg<u32x4>(dst + (size_t)row * ld + col0 + bj * 128 + cin, pack8(v0, v1));
            }
            if (ssq) { ss = shx_sum<16>(ss); ss = shx_sum<32>(ss); if (fq == 0) stg<float>(ssq + (size_t)row * ssld, ss); }
        EPI_ROWS_END
    }
};
struct EpiStore {
    static constexpr bool IDEMP = true;
    static constexpr bool PERM = true;
    bf16* D0; bf16* D1; int ld, split;
    __device__ __forceinline__ void operator()(const AccT& acc, const Unit& u, int wr, int wc, int fr, int fq) const {
        const int row0 = u.pm * 256 + wr * 64 + fr, cin = wc * 32 + 8 * fq;
        bf16* dst = u.pn < split ? D0 : D1; const int col0 = (u.pn < split ? u.pn : u.pn - split) * 256;
        EPI_ROWS_BEGIN
#pragma unroll
            for (int bj = 0; bj < 2; ++bj) stg<u32x4>(dst + (size_t)row * ld + col0 + bj * 128 + cin, pack8(acc[ai][bj][m][0], acc[ai][bj][m][1]));
        EPI_ROWS_END
    }
};
template <int NP> struct EpiStoreRs {
    static constexpr bool IDEMP = true;
    static constexpr bool PERM = true;
    bf16* D0; bf16* D1; int ld, split; const float* ssq; float inv_width;
    __device__ __forceinline__ void operator()(const AccT& acc, const Unit& u, int wr, int wc, int fr, int fq) const {
        const int row0 = u.pm * 256 + wr * 64 + fr, cin = wc * 32 + 8 * fq;
        bf16* dst = u.pn < split ? D0 : D1; const int col0 = (u.pn < split ? u.pn : u.pn - split) * 256;
        float rs[2][4];
#pragma unroll
        for (int ai = 0; ai < 2; ++ai)
#pragma unroll
            for (int m = 0; m < 4; ++m) { const float* p = ssq + (size_t)(row0 + ai * 128 + m * 16) * NP; float t = 0.f;
#pragma unroll
                for (int k = 0; k < NP; k += 4) { const f32x4 q = ldg<f32x4>(p + k); t += (q[0] + q[1]) + (q[2] + q[3]); }
                rs[ai][m] = rsqrtf(t * inv_width + RMS_EPS); }
        EPI_ROWS_BEGIN
            const float r = rs[ai][m];
#pragma unroll
            for (int bj = 0; bj < 2; ++bj) stg<u32x4>(dst + (size_t)row * ld + col0 + bj * 128 + cin, pack8(acc[ai][bj][m][0] * r, acc[ai][bj][m][1] * r));
        EPI_ROWS_END
    }
};
struct EpiS5S {
    static constexpr bool IDEMP = true;
    static constexpr bool PERM = false;
    float* SS;
    __device__ __forceinline__ void operator()(const AccT& acc, const Unit& u, int wr, int wc, int fr, int fq) const {
        const int row0 = u.pm * 256 + wr * 64 + fr, cin = wc * 32 + 4 * fq;
        EPI_ROWS_BEGIN
#pragma unroll
            for (int bj = 0; bj < 2; ++bj)
#pragma unroll
                for (int n = 0; n < 2; ++n) stg<f32x4>(SS + ((size_t)row * 32 + u.pn) * 256 + bj * 128 + cin + 16 * n, acc[ai][bj][m][n]);
        EPI_ROWS_END
    }
};
struct EpiS5Y {
    static constexpr bool IDEMP = true;
    static constexpr bool PERM = true;
    bf16* YG; bf16* YGc;
    __device__ __forceinline__ void operator()(const AccT& acc, const Unit& u, int wr, int wc, int fr, int fq) const {
        const int row0 = u.pm * 256 + wr * 64 + fr, cin = wc * 32 + 8 * fq, g = u.pn;
        EPI_ROWS_BEGIN
            const int rho = row;
            if (rho < 1152) {
                int base; bf16* yg = YG; if (rho < 1024) base = (rho >> 7) * 2048 + (rho & 127) * 16; else { base = ((rho - 1024) >> 4) * 256 + ((rho - 1024) & 15) * 16; yg = YGc; }
#pragma unroll
                for (int bj = 0; bj < 2; ++bj) { const int col = bj * 128 + cin, t = col >> 4, n0 = col & 15;
                    f32x4 v0 = acc[ai][bj][m][0], v1 = acc[ai][bj][m][1];
#pragma unroll
                    for (int j = 0; j < 4; ++j) { v0[j] = gelu_tanh(v0[j]); v1[j] = gelu_tanh(v1[j]); }
                    stg<u32x4>(yg + (size_t)(base + t) * 512 + g * 16 + n0, pack8(v0, v1)); }
            }
        EPI_ROWS_END
    }
};
template <int MODE> struct EpiPair {
    static constexpr bool IDEMP = true;
    static constexpr bool PERM = true;
    bf16* Dst; int ld;
    __device__ __forceinline__ void operator()(const AccT& acc, const Unit& u, int wr, int wc, int fr, int fq) const {
        const int row0 = u.pm * 256 + wr * 64 + fr, cin = wc * 32 + 8 * fq;
        EPI_ROWS_BEGIN
            f32x4 r0, r1;
#pragma unroll
            for (int j = 0; j < 4; ++j) {
                const float a0 = acc[ai][0][m][0][j], a1 = acc[ai][0][m][1][j], b0 = acc[ai][1][m][0][j], b1 = acc[ai][1][m][1][j];
                if (MODE == 0) { r0[j] = a0 * sigmoidf(b0); r1[j] = a1 * sigmoidf(b1); }
                else { r0[j] = a0 * sigmoidf(a0) * b0; r1[j] = a1 * sigmoidf(a1) * b1; }
            }
            stg<u32x4>(Dst + (size_t)row * ld + u.pn * 128 + cin, pack8(r0, r1));
        EPI_ROWS_END
    }
};
struct EpiMerge {
    static constexpr bool IDEMP = false;
    static constexpr bool PERM = true;
    const bf16* GT; bf16* YMB;
    __device__ __forceinline__ void operator()(const AccT& acc, const Unit& u, int wr, int wc, int fr, int fq) const {
        const int row0 = u.pm * 256 + wr * 64 + fr, cin = wc * 32 + 8 * fq, z = u.z;
        if (z == 0) {
#pragma unroll
            for (int ai = 0; ai < 2; ++ai) {
                u32x4 gw[4][2];
#pragma unroll
                for (int m = 0; m < 4; ++m)
#pragma unroll
                    for (int bj = 0; bj < 2; ++bj) gw[m][bj] = ldg<u32x4>(GT + (size_t)(row0 + ai * 128 + m * 16) * 3072 + u.pn * 256 + bj * 128 + cin);
#pragma unroll
                for (int m = 0; m < 4; ++m)
#pragma unroll
                    for (int bj = 0; bj < 2; ++bj) { const u32x4 g = gw[m][bj]; f32x4 v0 = acc[ai][bj][m][0], v1 = acc[ai][bj][m][1];
                        v0[0] *= bflo(g.x); v0[1] *= bfhi(g.x); v0[2] *= bflo(g.y); v0[3] *= bfhi(g.y); v1[0] *= bflo(g.z); v1[1] *= bfhi(g.z); v1[2] *= bflo(g.w); v1[3] *= bfhi(g.w);
                        stg<u32x4>(YMB + (size_t)(row0 + ai * 128 + m * 16) * 1024 + u.pn * 256 + bj * 128 + cin, pack8(v0, v1)); }
            }
            return;
        }
#pragma unroll
        for (int ai = 0; ai < 2; ++ai) {
            u32x4 gw[4][2], yp[4][2];
#pragma unroll
            for (int m = 0; m < 4; ++m)
#pragma unroll
                for (int bj = 0; bj < 2; ++bj) { const int row = row0 + ai * 128 + m * 16, col = u.pn * 256 + bj * 128 + cin;
                    gw[m][bj] = ldg<u32x4>(GT + (size_t)row * 3072 + z * 1024 + col); yp[m][bj] = ldg<u32x4>(YMB + (size_t)row * 1024 + col); }
#pragma unroll
            for (int m = 0; m < 4; ++m)
#pragma unroll
                for (int bj = 0; bj < 2; ++bj) { const u32x4 g = gw[m][bj], y = yp[m][bj]; f32x4 v0 = acc[ai][bj][m][0], v1 = acc[ai][bj][m][1];
                    v0[0] = v0[0] * bflo(g.x) + bflo(y.x); v0[1] = v0[1] * bfhi(g.x) + bfhi(y.x); v0[2] = v0[2] * bflo(g.y) + bflo(y.y); v0[3] = v0[3] * bfhi(g.y) + bfhi(y.y);
                    v1[0] = v1[0] * bflo(g.z) + bflo(y.z); v1[1] = v1[1] * bfhi(g.z) + bfhi(y.z); v1[2] = v1[2] * bflo(g.w) + bflo(y.w); v1[3] = v1[3] * bfhi(g.w) + bfhi(y.w);
                    stg<u32x4>(YMB + (size_t)(row0 + ai * 128 + m * 16) * 1024 + u.pn * 256 + bj * 128 + cin, pack8(v0, v1)); }
        }
    }
};
struct EpiOut {
    static constexpr bool IDEMP = false;
    static constexpr bool PERM = false;
    const float* xl_old; const float* xc_old; float* xl_new; float* xc_new; const float* MODL; int b0;
    __device__ __forceinline__ void operator()(const AccT& acc, const Unit& u, int wr, int wc, int fr, int fq) const {
        const int row0 = u.pm * 256 + wr * 64 + fr, cin = wc * 32 + 4 * fq, trow = u.pm * 256;
        const float* xo; float* xn; int mrow;
        if (b0 < 0) { xo = xc_old + (size_t)trow * 1024; xn = xc_new + (size_t)trow * 1024; mrow = 32; }
        else if (trow < RL) { const size_t tok = (size_t)(b0 + (trow >> 11)) * 2048 + (trow & 2047); xo = xl_old + tok * 1024; xn = xl_new + tok * 1024; mrow = b0 + (trow >> 11); }
        else { const int rc = trow - RL; const size_t tok = (size_t)(b0 + (rc >> 8)) * 256 + (rc & 255); xo = xc_old + tok * 1024; xn = xc_new + tok * 1024; mrow = 32; }
        const float* gt = MODL + (size_t)mrow * 6144 + 2 * 1024 + u.pn * 256 + cin;
        f32x4 g[2][2];
#pragma unroll
        for (int bj = 0; bj < 2; ++bj)
#pragma unroll
            for (int n = 0; n < 2; ++n) g[bj][n] = ldg<f32x4>(gt + bj * 128 + 16 * n);
#pragma unroll
        for (int ai = 0; ai < 2; ++ai)
#pragma unroll
            for (int mp = 0; mp < 2; ++mp) {
                f32x4 xv[2][2][2];
#pragma unroll
                for (int mm = 0; mm < 2; ++mm)
#pragma unroll
                    for (int bj = 0; bj < 2; ++bj)
#pragma unroll
                        for (int n = 0; n < 2; ++n) xv[mm][bj][n] = ldg<f32x4>(xo + (size_t)(row0 - trow + ai * 128 + (2 * mp + mm) * 16) * 1024 + u.pn * 256 + bj * 128 + cin + 16 * n);
#pragma unroll
                for (int mm = 0; mm < 2; ++mm)
#pragma unroll
                    for (int bj = 0; bj < 2; ++bj)
#pragma unroll
                        for (int n = 0; n < 2; ++n) stg<f32x4>(xn + (size_t)(row0 - trow + ai * 128 + (2 * mp + mm) * 16) * 1024 + u.pn * 256 + bj * 128 + cin + 16 * n, xv[mm][bj][n] + g[bj][n] * acc[ai][bj][2 * mp + mm][n]);
            }
    }
};
struct EpiDown {
    static constexpr bool IDEMP = false;
    static constexpr bool PERM = false;
    const int* rowtok; const float* roww; float* xl; float* xc; const float* MODL; float wscale;
    __device__ __forceinline__ void operator()(const AccT& acc, const Unit& u, int wr, int wc, int fr, int fq) const {
        const int row0 = u.pm * 256 + wr * 64 + fr, cin = wc * 32 + 4 * fq, cbase = u.pn * 256 + cin;
        int tk[2][4]; float ww[2][4];
#pragma unroll
        for (int ai = 0; ai < 2; ++ai)
#pragma unroll
            for (int m = 0; m < 4; ++m) { const int row = row0 + ai * 128 + m * 16; tk[ai][m] = ldg<int>(rowtok + row); ww[ai][m] = ldg<float>(roww + row) * wscale; }
#pragma unroll
        for (int ai = 0; ai < 2; ++ai)
#pragma unroll
            for (int mp = 0; mp < 2; ++mp) {
                f32x4 xv[2][2][2], gv[2][2][2]; float* xp[2];
#pragma unroll
                for (int mm = 0; mm < 2; ++mm) { const int tok = tk[ai][2 * mp + mm]; const int t0 = tok < 0 ? 0 : tok;
                    int mrow; if (t0 < NTOK_LAT) { xp[mm] = xl + (size_t)t0 * 1024 + cbase; mrow = t0 >> 11; } else { xp[mm] = xc + (size_t)(t0 - NTOK_LAT) * 1024 + cbase; mrow = 32; }
                    const float* gt = MODL + (size_t)mrow * 6144 + 5 * 1024 + cbase;
#pragma unroll
                    for (int bj = 0; bj < 2; ++bj)
#pragma unroll
                        for (int n = 0; n < 2; ++n) { xv[mm][bj][n] = ldg<f32x4>(xp[mm] + bj * 128 + 16 * n); gv[mm][bj][n] = ldg<f32x4>(gt + bj * 128 + 16 * n); } }
#pragma unroll
                for (int mm = 0; mm < 2; ++mm) { const int m = 2 * mp + mm;
                    if (tk[ai][m] >= 0) { const float w = ww[ai][m];
#pragma unroll
                        for (int bj = 0; bj < 2; ++bj)
#pragma unroll
                            for (int n = 0; n < 2; ++n) stg<f32x4>(xp[mm] + bj * 128 + 16 * n, xv[mm][bj][n] + (gv[mm][bj][n] * w) * acc[ai][bj][m][n]); } }
            }
    }
};

struct EpiDownY {
    static constexpr bool IDEMP = true;
    static constexpr bool PERM = true;
    const int* rowtok; const float* roww; bf16* Y; int nt0;
    __device__ __forceinline__ void operator()(const AccT& acc, const Unit& u, int wr, int wc, int fr, int fq) const {
        const int row0 = u.pm * 256 + wr * 64 + fr, cin = wc * 32 + 8 * fq;
        bf16* Yp = Y + (u.pm < nt0 ? (size_t)0 : (size_t)NTOK * 1024) + u.pn * 256 + cin;
        int tk[2][4]; float ww[2][4];
#pragma unroll
        for (int ai = 0; ai < 2; ++ai)
#pragma unroll
            for (int m = 0; m < 4; ++m) { const int row = row0 + ai * 128 + m * 16; tk[ai][m] = ldg<int>(rowtok + row); ww[ai][m] = ldg<float>(roww + row); }
#pragma unroll
        for (int ai = 0; ai < 2; ++ai)
#pragma unroll
            for (int m = 0; m < 4; ++m) if (tk[ai][m] >= 0) { const float w = ww[ai][m];
#pragma unroll
                for (int bj = 0; bj < 2; ++bj) stg<u32x4>(Yp + (size_t)tk[ai][m] * 1024 + bj * 128, pack8(acc[ai][bj][m][0] * w, acc[ai][bj][m][1] * w)); }
    }
};

__device__ __forceinline__ void tr_item(const float* W, int K, int Nsrc, int scol0, const float* kscale, bf16* WT, int drow0, int k0, LAS float* scr, int lane) {
#pragma unroll
    for (int i = 0; i < 8; ++i) { const int kk = 8 * i + (lane >> 3), n4 = (lane & 7) * 4;
        f32x4 v = {0.f, 0.f, 0.f, 0.f}; if (scol0 >= 0) { v = ldg<f32x4>(W + (size_t)(k0 + kk) * Nsrc + scol0 + n4); if (kscale) v = v * ldg<float>(kscale + k0 + kk); }
        scr[kk * 33 + n4] = v[0]; scr[kk * 33 + n4 + 1] = v[1]; scr[kk * 33 + n4 + 2] = v[2]; scr[kk * 33 + n4 + 3] = v[3]; }
    asm volatile("s_waitcnt lgkmcnt(0)" ::: "memory");
    const int c = lane & 7;
#pragma unroll
    for (int j = 0; j < 4; ++j) { const int n = (lane >> 3) + 8 * j; const LAS float* s = scr + (8 * c) * 33 + n;
        u32x4 o; o.x = pk2(s[0 * 33], s[1 * 33]); o.y = pk2(s[2 * 33], s[3 * 33]); o.z = pk2(s[4 * 33], s[5 * 33]); o.w = pk2(s[6 * 33], s[7 * 33]);
        stg<u32x4>(WT + (size_t)(drow0 + n) * K + k0 + 8 * c, o); }
    asm volatile("s_waitcnt lgkmcnt(0)" ::: "memory");
}
__device__ __forceinline__ int win_src_col(int n) {
    if (n < 256) return n;
    if (n < 768) return 1312 + (n - 256);
    if (n < 1536) return 1824 + (n - 768);
    if (n < 2560) {
        const int base = n < 2048 ? 2592 : 288, r = n < 2048 ? n - 1536 : n - 2048, t = r >> 8, c = r & 255;
        return base + (4 * t + ((c & 127) >> 5)) * 64 + (c >> 7) * 32 + (c & 31); }
    if (n < 3072) return 800 + (n - 2560);
    if (n < 6144) return 3104 + (n - 3072);
    if (n < 6176) return 256 + (n - 6144);
    return -1;
}
__device__ __forceinline__ int pair_src_col(int n) { const int pn = n >> 8, jj = n & 255; return jj < 128 ? 128 * pn + jj : 512 + 128 * pn + (jj - 128); }

__device__ __forceinline__ void prologue_transposes(Frame& F, int cu_lo) {
    LAS float* scr = (LAS float*)(F.lds + F.wave * 16384);
    const int gw = (F.c - cu_lo) * 8 + F.wave, NGW = (F.G - cu_lo) * 8;
    constexpr int I_IN = (NINP / 32) * 16, I_UQ = 24 * 12, I_UKV = 32 * 4, I_GLU = 32 * 8, I_BR = 3 * 32 * 8, I_OUT = 32 * 16, I_UP = 32 * 32 * 16, I_DN = 32 * 32 * 8;
    constexpr int PER_L = I_IN + I_UQ + I_UKV + I_GLU + I_BR + I_OUT;
    for (int it = gw; it < 2 * PER_L; it += NGW) {
        const int l = it / PER_L; int r = it % PER_L;
        if (r < I_IN) { const int nb = r / 16, kb = r % 16; tr_item(F.in[7] + (size_t)l * 1024 * 6176, 1024, 6176, win_src_col(nb * 32), nullptr, (bf16*)(F.ws + WS_WINT) + (size_t)l * NINP * 1024, nb * 32, kb * 64, scr, F.lane); continue; } r -= I_IN;
        if (r < I_UQ) { const int nb = r / 12, kb = r % 12; tr_item(F.in[9] + (size_t)l * 768 * 768, 768, 768, nb * 32, F.in[8] + l * 768, (bf16*)(F.ws + WS_UQT) + (size_t)l * 768 * 768, nb * 32, kb * 64, scr, F.lane); continue; } r -= I_UQ;
        if (r < I_UKV) { const int nb = r / 4, kb = r % 4, n = nb * 32; const int sc = n < 512 ? (n >> 6) * 128 + (n & 63) : ((n - 512) >> 6) * 128 + 64 + (n & 63);
            tr_item(F.in[11] + (size_t)l * 256 * 1024, 256, 1024, sc, F.in[10] + l * 256, (bf16*)(F.ws + WS_UKVT) + (size_t)l * 1024 * 256, n, kb * 64, scr, F.lane); continue; } r -= I_UKV;
        if (r < I_GLU) { const int nb = r / 8, kb = r % 8; tr_item(F.in[25] + (size_t)l * 512 * 1024, 512, 1024, pair_src_col(nb * 32), nullptr, (bf16*)(F.ws + WS_GLUT) + (size_t)l * 1024 * 512, nb * 32, kb * 64, scr, F.lane); continue; } r -= I_GLU;
        if (r < I_BR) { const int z = r / 256, q = r % 256, nb = q / 8, kb = q % 8; tr_item(F.in[26] + ((size_t)l * 3 + z) * 512 * 1024, 512, 1024, nb * 32, nullptr, (bf16*)(F.ws + WS_BRT) + ((size_t)l * 3 + z) * 1024 * 512, nb * 32, kb * 64, scr, F.lane); continue; } r -= I_BR;
        { const int nb = r / 16, kb = r % 16; tr_item(F.in[27] + (size_t)l * 1024 * 1024, 1024, 1024, nb * 32, nullptr, (bf16*)(F.ws + WS_OUTT) + (size_t)l * 1024 * 1024, nb * 32, kb * 64, scr, F.lane); }
    }
}
constexpr int MOE_I_UP = 32 * 32 * 16, MOE_I_DN = 32 * 32 * 8, MOE_ITEMS = MOE_I_UP + MOE_I_DN;
__device__ __forceinline__ void tr_moe_items(Frame& F, int l, int first, int count, int cu_lo) {
    if (F.c < cu_lo) return;
    __syncthreads();
    LAS float* scr = (LAS float*)(F.lds + F.wave * 16384);
    const int gw = (F.c - cu_lo) * 8 + F.wave, NGW = (F.G - cu_lo) * 8;
#pragma nounroll
    for (int it = first + gw; it < first + count; it += NGW) {
        if (it < MOE_I_UP) { const int e = it / 512, q = it % 512, nb = q / 16, kb = q % 16; tr_item(F.in[33] + ((size_t)l * 32 + e) * 1024 * 1024, 1024, 1024, pair_src_col(nb * 32), nullptr, (bf16*)(F.ws + WS_UPT) + ((size_t)l * 32 + e) * 1024 * 1024, nb * 32, kb * 64, scr, F.lane); }
        else { const int r = it - MOE_I_UP, e = r / 256, q = r % 256, nb = q / 8, kb = q % 8; tr_item(F.in[34] + ((size_t)l * 32 + e) * 512 * 1024, 512, 1024, nb * 32, nullptr, (bf16*)(F.ws + WS_DOWNT) + ((size_t)l * 32 + e) * 1024 * 512, nb * 32, kb * 64, scr, F.lane); }
    }
}
__device__ __forceinline__ void prologue_small(Frame& F, int cu_lo) {
    const int gt = (F.c - cu_lo) * 512 + F.tid, NT = (F.G - cu_lo) * 512;
    float* ROPE = (float*)(F.ws + WS_ROPE);
    for (int i = gt; i < 2048 * 16; i += NT) { const int t = i >> 4, a = (i >> 3) & 1, f = i & 7;
        const float inv = powf(10000.0f, -(float)f / 8.0f); const float pos = a == 0 ? (float)(t >> 6) : (float)(t & 63); const float ang = pos * inv;
        ROPE[2 * i] = cosf(ang); ROPE[2 * i + 1] = sinf(ang); }
    float* WGT = (float*)(F.ws + WS_WGT); float* WET = (float*)(F.ws + WS_WET);
    for (int i = gt; i < 2 * 4 * 1024; i += NT) { const int l = i / 4096, e = (i >> 10) & 3, k = i & 1023; WGT[i] = F.in[29][((size_t)l * 1024 + k) * 4 + e]; }
    for (int i = gt; i < 2 * 32 * 1024; i += NT) { const int l = i / 32768, e = (i >> 10) & 31, k = i & 1023; WET[i] = F.in[31][((size_t)l * 1024 + k) * 32 + e]; }
}
__device__ __forceinline__ void prologue_mod(Frame& F, int cu_lo) {
    LAS float* SC = (LAS float*)F.lds;
    __syncthreads();
#pragma unroll 11
    for (int q = 0; q < 66; ++q) { const int i = F.tid + 512 * q, r = i >> 10, k = i & 1023; const float v = r < 32 ? ldg<float>(F.in[1] + r * 1024 + k) : ldg<float>(F.in[3] + k); SC[i] = v * sigmoidf(v); }
    __syncthreads();
    float* MODP = (float*)(F.ws + WS_MODP);
    const int gw = (F.c - cu_lo) * 8 + F.wave, NGW = (F.G - cu_lo) * 8;
    for (int task = gw; task < 2 * 96 * 8; task += NGW) {
        const int ks = task & 7, nb = (task >> 3) % 96, l = task / 768; const int n = nb * 64 + F.lane;
        f32x2 acc[33];
#pragma unroll
        for (int r = 0; r < 33; ++r) acc[r] = (f32x2){0.f, 0.f};
        const float* Wl = F.in[4] + (size_t)l * 1024 * 6144;
#pragma nounroll
        for (int kb = 0; kb < 4; ++kb) { const int k0 = ks * 128 + kb * 32;
            const float* Wk = Wl + (size_t)k0 * 6144;
            f32x2 w[16];
#pragma unroll
            for (int j = 0; j < 16; ++j) { w[j][0] = ldg<float>(Wk + (2 * j) * 6144 + n); w[j][1] = ldg<float>(Wk + (2 * j + 1) * 6144 + n); }
            const LAS float* s0 = SC + k0; const LAS float* s1 = s0 + 16 * 1024; const LAS float* s2 = s0 + 32 * 1024;
            asm volatile("" : "+v"(s0), "+v"(s1), "+v"(s2));
#pragma unroll
            for (int j4 = 0; j4 < 8; ++j4) {
#pragma unroll
                for (int r = 0; r < 33; ++r) { const f32x4 sv = *(const LAS f32x4*)((r < 16 ? s0 : (r < 32 ? s1 : s2)) + (r & 15) * 1024 + 4 * j4);
                    acc[r] += (f32x2){sv[0], sv[1]} * w[2 * j4]; acc[r] += (f32x2){sv[2], sv[3]} * w[2 * j4 + 1]; } } }
#pragma unroll
        for (int r = 0; r < 33; ++r) MODP[(((size_t)ks * 2 + l) * 33 + r) * 6144 + n] = acc[r][0] + acc[r][1];
    }
    __syncthreads();
}
__device__ __forceinline__ void prologue_mod_final(Frame& F) {
    const float* MODP = (const float*)(F.ws + WS_MODP);
    for (int i = F.c * 512 + F.tid; i < 2 * 33 * 6144; i += F.G * 512) { const int l = i / (33 * 6144), n = i % 6144;
        float s = F.in[5][l * 6144 + n];
#pragma unroll
        for (int ks = 0; ks < 8; ++ks) s += MODP[(size_t)ks * 2 * 33 * 6144 + i];
        F.MOD[i] = s; }
}
__device__ __forceinline__ void prologue_s5(Frame& F, int l, int g) {
    LAS float* AP = (LAS float*)F.lds;
    LAS float* BB = AP + 2 * 17 * 64 * 2;
    LAS float* CC = BB + 2 * 64 * 16 * 2;
    LAS float* KJ = CC + 2 * 16 * 64 * 2;
    __syncthreads();
    const float* a_re = F.in[17]; const float* a_im = F.in[18]; const float* ldt = F.in[19]; const float* b_re = F.in[20]; const float* b_im = F.in[21];
    const float* c_re = F.in[22]; const float* c_im = F.in[23]; const float* dsk = F.in[24];
    for (int i = F.tid; i < 2 * 17 * 64; i += 512) { const int dir = i / (17 * 64), j = (i / 64) % 17, p = i & 63;
        const size_t ia = (((size_t)l * 2 + dir) * 32 + g) * 64 + p;
        const float lre = fminf(a_re[ia], -1e-4f), lim = a_im[ia], dt = expf(ldt[((size_t)l * 2 + dir) * 32 + g]);
        const float mag = expf((float)j * (lre * dt)); const float ang = (float)j * (lim * dt);
        AP[2 * i] = mag * cosf(ang); AP[2 * i + 1] = mag * sinf(ang); }
    for (int i = F.tid; i < 2 * 64 * 16; i += 512) { const int dir = i / 1024, p = (i >> 4) & 63, m = i & 15;
        const size_t ia = (((size_t)l * 2 + dir) * 32 + g) * 64 + p;
        const float lre = fminf(a_re[ia], -1e-4f), lim = a_im[ia], dt = expf(ldt[((size_t)l * 2 + dir) * 32 + g]);
        const float mag = expf(lre * dt), abr = mag * cosf(lim * dt), abi = mag * sinf(lim * dt);
        const float den = lre * lre + lim * lim, nre = abr - 1.0f;
        const float fre = (nre * lre + abi * lim) / den, fim = (abi * lre - nre * lim) / den;
        const float br = b_re[ia * 16 + m], bi = b_im[ia * 16 + m];
        BB[2 * i] = fre * br - fim * bi; BB[2 * i + 1] = fre * bi + fim * br; }
    for (int i = F.tid; i < 2 * 16 * 64; i += 512) { const int dir = i / 1024, n = (i >> 6) & 15, p = i & 63;
        const size_t ic = ((((size_t)l * 2 + dir) * 32 + g) * 16 + n) * 64 + p;
        CC[2 * i] = c_re[ic]; CC[2 * i + 1] = c_im[ic]; }
    __syncthreads();
    { const int n = (F.tid >> 4) & 15, m = F.tid & 15, jh = F.tid >> 8;
#pragma nounroll
        for (int dir = 0; dir < 2; ++dir) {
            float sj[8];
#pragma unroll
            for (int q = 0; q < 8; ++q) sj[q] = 0.f;
#pragma unroll 4
            for (int p = 0; p < 64; ++p) {
                const f32x2 b = *(const LAS f32x2*)(BB + ((dir * 64 + p) * 16 + m) * 2), cc = *(const LAS f32x2*)(CC + ((dir * 16 + n) * 64 + p) * 2);
                const float tr = cc[0] * b[0] - cc[1] * b[1], ti = cc[0] * b[1] + cc[1] * b[0];
#pragma unroll
                for (int q = 0; q < 8; ++q) { const f32x2 a = *(const LAS f32x2*)(AP + ((dir * 17 + jh + 2 * q) * 64 + p) * 2); sj[q] += tr * a[0] - ti * a[1]; } }
#pragma unroll
            for (int q = 0; q < 8; ++q) KJ[((dir * 16 + jh + 2 * q) * 16 + n) * 16 + m] = sj[q]; } }
    __syncthreads();
    bf16* BTY = (bf16*)(F.ws + WS_BTY) + ((size_t)l * 32 + g) * 256 * 512;
    for (int i = F.tid; i < 256 * 512; i += 512) { const int row = i >> 9, k = i & 511, t = row >> 4, n = row & 15; float v;
        if (k < 256) { const int s = k >> 4, m = k & 15; v = 0.f;
            if (t >= s) v += KJ[((0 * 16 + (t - s)) * 16 + n) * 16 + m];
            if (s >= t) v += KJ[((1 * 16 + (s - t)) * 16 + n) * 16 + m];
            if (k == row) v += dsk[l * 512 + g * 16 + n]; }
        else { const int kk = k - 256, dir = kk >> 7, im = (kk >> 6) & 1, p = kk & 63, j = dir == 0 ? t + 1 : 16 - t;
            const float ar = AP[((dir * 17 + j) * 64 + p) * 2], ai = AP[((dir * 17 + j) * 64 + p) * 2 + 1];
            const float cr = CC[((dir * 16 + n) * 64 + p) * 2], ci = CC[((dir * 16 + n) * 64 + p) * 2 + 1];
            v = im == 0 ? (cr * ar - ci * ai) : -(cr * ai + ci * ar); }
        BTY[i] = (bf16)f2bf(v); }
    bf16* BTS = (bf16*)(F.ws + WS_BTS) + ((size_t)l * 32 + g) * 256 * 256;
    for (int i = F.tid; i < 256 * 256; i += 512) { const int row = i >> 8, k = i & 255, s = k >> 4, m = k & 15, dir = row >> 7, im = (row >> 6) & 1, p = row & 63, j = dir == 0 ? 15 - s : s;
        const float ar = AP[((dir * 17 + j) * 64 + p) * 2], ai = AP[((dir * 17 + j) * 64 + p) * 2 + 1];
        const float br = BB[((dir * 64 + p) * 16 + m) * 2], bi = BB[((dir * 64 + p) * 16 + m) * 2 + 1];
        const float v = im == 0 ? (ar * br - ai * bi) : (ar * bi + ai * br);
        BTS[i] = (bf16)f2bf(v); }
    float* A16 = (float*)(F.ws + WS_A16);
    for (int i = F.tid; i < 2 * 64; i += 512) { const int dir = i >> 6, p = i & 63;
        A16[((((size_t)l * 2 + dir) * 32 + g) * 64 + p) * 2] = AP[((dir * 17 + 16) * 64 + p) * 2];
        A16[((((size_t)l * 2 + dir) * 32 + g) * 64 + p) * 2 + 1] = AP[((dir * 17 + 16) * 64 + p) * 2 + 1]; }
    __syncthreads();
}

__device__ __forceinline__ void phase_h(Frame& F, int l, int b0, const float* xl, const float* xc, int nrows) {
    bf16* HB = (bf16*)(F.ck + C_HB);
    const float* g1 = F.in[6] + l * 1024;
    const int gw = F.c * 8 + F.wave, NGW = F.G * 8;
    for (int row = gw; row < nrows; row += NGW) {
        const float* xs; int mrow;
        if (row < RL) { mrow = b0 + (row >> 11); xs = xl + ((size_t)mrow * 2048 + (row & 2047)) * 1024; }
        else { const int rc = row - RL; xs = xc + ((size_t)(b0 + (rc >> 8)) * 256 + (rc & 255)) * 1024; mrow = 32; }
        const float* md = F.MOD + ((size_t)l * 33 + mrow) * 6144;
        f32x4 v[4]; float ss = 0.f;
#pragma unroll
        for (int j = 0; j < 4; ++j) { v[j] = ldg<f32x4>(xs + 4 * F.lane + 256 * j); ss += v[j][0] * v[j][0] + v[j][1] * v[j][1] + v[j][2] * v[j][2] + v[j][3] * v[j][3]; }
        const float rstd = rsqrtf(wave_sum(ss) * (1.0f / 1024.0f) + RMS_EPS);
#pragma unroll
        for (int j = 0; j < 4; ++j) { const int col = 4 * F.lane + 256 * j;
            const f32x4 g = ldg<f32x4>(g1 + col), sh = ldg<f32x4>(md + col), sc = ldg<f32x4>(md + 1024 + col);
            const f32x4 h = (v[j] * rstd * g) * (sc + 1.0f) + sh;
            u32x2 o; o.x = pk2(h[0], h[1]); o.y = pk2(h[2], h[3]); stg<u32x2>(HB + (size_t)row * 1024 + col, o); }
    }
}
__device__ __forceinline__ void vt_item(const bf16* src, int ldsrc, bf16* dst, LAS unsigned* scr, int lane) {
    const int r8 = lane >> 3, c8 = lane & 7;
#pragma unroll
    for (int i = 0; i < 8; ++i) { const int key = 8 * i + r8; const u32x4 v = ldg<u32x4>(src + (size_t)key * ldsrc + c8 * 8);
        scr[key * 33 + c8 * 4 + 0] = v.x; scr[key * 33 + c8 * 4 + 1] = v.y; scr[key * 33 + c8 * 4 + 2] = v.z; scr[key * 33 + c8 * 4 + 3] = v.w; }
    asm volatile("s_waitcnt lgkmcnt(0)" ::: "memory");
    const LAS unsigned short* s16 = (const LAS unsigned short*)scr;
#pragma unroll
    for (int i = 0; i < 8; ++i) { const int d = 8 * i + r8; unsigned w[4];
#pragma unroll
        for (int q = 0; q < 4; ++q) { const int k0 = c8 * 8 + q * 2; w[q] = (unsigned)s16[(k0 * 33) * 2 + d] | ((unsigned)s16[((k0 + 1) * 33) * 2 + d] << 16); }
        stg<u32x4>(dst + (size_t)d * KEYS + c8 * 8, (u32x4){w[0], w[1], w[2], w[3]}); }
    asm volatile("s_waitcnt lgkmcnt(0)" ::: "memory");
}
__device__ __forceinline__ void phase_p1(Frame& F, int l, bool ctx_q) {
    bf16* KVL = (bf16*)(F.ck + C_KVL); bf16* QL = (bf16*)(F.ck + C_QL); bf16* NQ = (bf16*)(F.ck + C_NQ); bf16* NK = (bf16*)(F.ck + C_NK);
    const float* gq = F.in[14] + l * 64; const float* gk = F.in[15] + l * 64;
    const int gw = F.c * 8 + F.wave, NGW = F.G * 8, lane = F.lane;
    for (int row = gw; row < RR; row += NGW) {
        { bf16* p = KVL + (size_t)row * 256 + 4 * lane; const u32x2 w = ldg<u32x2>(p);
          const float a = bflo(w.x), b = bfhi(w.x), c = bflo(w.y), d = bfhi(w.y);
          const float rstd = rsqrtf(wave_sum(a * a + b * b + c * c + d * d) * (1.0f / 256.0f) + RMS_EPS);
          stg<u32x2>(p, (u32x2){pk2(a * rstd, b * rstd), pk2(c * rstd, d * rstd)}); }
        { bf16* p = NK + (size_t)row * 512 + 8 * lane; const u32x4 w = ldg<u32x4>(p);
          float v[8] = {bflo(w.x), bfhi(w.x), bflo(w.y), bfhi(w.y), bflo(w.z), bfhi(w.z), bflo(w.w), bfhi(w.w)}; float ss = 0.f;
#pragma unroll
          for (int j = 0; j < 8; ++j) ss += v[j] * v[j];
          ss = shx_sum<1>(ss); ss = shx_sum<2>(ss); ss = shx_sum<4>(ss);
          const float rstd = rsqrtf(ss * (1.0f / 64.0f) + RMS_EPS); const int d0 = 8 * (lane & 7);
#pragma unroll
          for (int j = 0; j < 8; ++j) v[j] *= rstd * ldg<float>(gk + d0 + j);
          stg<u32x4>(p, (u32x4){pk2(v[0], v[1]), pk2(v[2], v[3]), pk2(v[4], v[5]), pk2(v[6], v[7])}); }
        if (row < RL || ctx_q) {
            { bf16* p = QL + (size_t)row * 768 + 12 * lane; u32x2 w[3]; float v[12]; float ss = 0.f;
#pragma unroll
              for (int j = 0; j < 3; ++j) { w[j] = ldg<u32x2>(p + 4 * j); v[4 * j] = bflo(w[j].x); v[4 * j + 1] = bfhi(w[j].x); v[4 * j + 2] = bflo(w[j].y); v[4 * j + 3] = bfhi(w[j].y); }
#pragma unroll
              for (int j = 0; j < 12; ++j) ss += v[j] * v[j];
              const float rstd = rsqrtf(wave_sum(ss) * (1.0f / 768.0f) + RMS_EPS);
#pragma unroll
              for (int j = 0; j < 3; ++j) stg<u32x2>(p + 4 * j, (u32x2){pk2(v[4 * j] * rstd, v[4 * j + 1] * rstd), pk2(v[4 * j + 2] * rstd, v[4 * j + 3] * rstd)}); }
            { bf16* p = NQ + (size_t)row * 512 + 8 * lane; const u32x4 w = ldg<u32x4>(p);
              float v[8] = {bflo(w.x), bfhi(w.x), bflo(w.y), bfhi(w.y), bflo(w.z), bfhi(w.z), bflo(w.w), bfhi(w.w)}; float ss = 0.f;
#pragma unroll
              for (int j = 0; j < 8; ++j) ss += v[j] * v[j];
              ss = shx_sum<1>(ss); ss = shx_sum<2>(ss); ss = shx_sum<4>(ss);
              const float rstd = rsqrtf(ss * (1.0f / 64.0f) + RMS_EPS) * (0.125f * LOG2E); const int d0 = 8 * (lane & 7);
#pragma unroll
              for (int j = 0; j < 8; ++j) v[j] *= rstd * ldg<float>(gq + d0 + j);
              stg<u32x4>(p, (u32x4){pk2(v[0], v[1]), pk2(v[2], v[3]), pk2(v[4], v[5]), pk2(v[6], v[7])}); }
        }
    }
    const bf16* NV = (const bf16*)(F.ck + C_NV); bf16* NVT = (bf16*)(F.ck + C_NVT);
    LAS unsigned* scr = (LAS unsigned*)(F.lds + F.wave * 16384);
    for (int it = gw; it < NB * 8 * 36; it += NGW) { const int kb = it % 36, h = (it / 36) & 7, b = it / 288;
        const int srow = kb < 32 ? b * 2048 + 64 * kb : RL + b * 256 + 64 * (kb - 32);
        vt_item(NV + (size_t)srow * 512 + h * 64, 512, NVT + ((size_t)(b * 8 + h) * 64) * KEYS + 64 * kb, scr, lane); }
}
__device__ __forceinline__ void ctx_krope(Frame& F, const bf16* HBc  , const bf16* WKR  ) {
    bf16* KRP = (bf16*)(F.ck + C_KRP); const int gw = F.c * 8 + F.wave, NGW = F.G * 8, lane = F.lane;
    for (int rc = gw; rc < RC; rc += NGW) {
        const u32x4 h0 = ldg<u32x4>(HBc + (size_t)rc * 1024 + 16 * lane), h1 = ldg<u32x4>(HBc + (size_t)rc * 1024 + 16 * lane + 8);
        float hv[16] = {bflo(h0.x), bfhi(h0.x), bflo(h0.y), bfhi(h0.y), bflo(h0.z), bfhi(h0.z), bflo(h0.w), bfhi(h0.w), bflo(h1.x), bfhi(h1.x), bflo(h1.y), bfhi(h1.y), bflo(h1.z), bfhi(h1.z), bflo(h1.w), bfhi(h1.w)};
        float p[32];
#pragma unroll
        for (int jb = 0; jb < 4; ++jb) {
            u32x4 w0[8], w1[8];
#pragma unroll
            for (int j8 = 0; j8 < 8; ++j8) { w0[j8] = ldg<u32x4>(WKR + (size_t)(jb * 8 + j8) * 1024 + 16 * lane); w1[j8] = ldg<u32x4>(WKR + (size_t)(jb * 8 + j8) * 1024 + 16 * lane + 8); }
#pragma unroll
            for (int j8 = 0; j8 < 8; ++j8) { const u32x4 a0 = w0[j8], a1 = w1[j8];
                p[jb * 8 + j8] = hv[0] * bflo(a0.x) + hv[1] * bfhi(a0.x) + hv[2] * bflo(a0.y) + hv[3] * bfhi(a0.y) + hv[4] * bflo(a0.z) + hv[5] * bfhi(a0.z) + hv[6] * bflo(a0.w) + hv[7] * bfhi(a0.w)
                                + hv[8] * bflo(a1.x) + hv[9] * bfhi(a1.x) + hv[10] * bflo(a1.y) + hv[11] * bfhi(a1.y) + hv[12] * bflo(a1.z) + hv[13] * bfhi(a1.z) + hv[14] * bflo(a1.w) + hv[15] * bfhi(a1.w); }
            __builtin_amdgcn_sched_barrier(0);
        }
        float r8[8];
#pragma unroll
        for (int k = 0; k < 8; ++k) r8[k] = row_sum16(hx16(hx32(p[k], p[k + 16]), hx32(p[k + 8], p[k + 24])));
        if ((lane & 15) == 0) stg<u32x4>(KRP + (size_t)(RL + rc) * 32 + 8 * (lane >> 4), (u32x4){pk2(r8[0], r8[1]), pk2(r8[2], r8[3]), pk2(r8[4], r8[5]), pk2(r8[6], r8[7])});
    }
}
__device__ __forceinline__ void phase_p2(Frame& F, int l, bool ctx_q) {
    const int gt = F.tid >= 128 ? F.c * 384 + (F.tid - 128) : 0x7fffffff - 1024, NT = F.G * 384;
    const float* ROPE = (const float*)(F.ws + WS_ROPE);
    if (F.tid < 128) { const float* SS = (const float*)(F.ck + C_SS); bf16* AS5 = (bf16*)(F.ck + C_AS5); const float* A16 = (const float*)(F.ws + WS_A16);
      for (int i = F.c * 128 + F.tid; i < NB * 32 * 2 * 64; i += F.G * 128) { const int p = i & 63, dir = (i >> 6) & 1, g = (i >> 7) & 31, b = i >> 12;
          const float ar = A16[((((size_t)l * 2 + dir) * 32 + g) * 64 + p) * 2], ai = A16[((((size_t)l * 2 + dir) * 32 + g) * 64 + p) * 2 + 1];
          float hr = 0.f, hi = 0.f;
          for (int c0 = 0; c0 < 144; c0 += 24) {
              float sr[24], si[24]; int rho[24];
#pragma unroll
              for (int k = 0; k < 24; ++k) { const int c = c0 + k;
                  rho[k] = dir == 0 ? (c < 16 ? 1024 + b * 16 + c : b * 128 + (c - 16)) : (c < 16 ? 1024 + b * 16 + (15 - c) : b * 128 + (127 - (c - 16)));
                  const float* sp = SS + ((size_t)rho[k] * 32 + g) * 256 + dir * 128 + p; sr[k] = ldg<float>(sp); si[k] = ldg<float>(sp + 64); }
#pragma unroll
              for (int k = 0; k < 24; ++k) { bf16* ap = AS5 + ((size_t)rho[k] * 32 + g) * 512 + 256 + dir * 128 + p;
                  ap[0] = (bf16)f2bf(hr); ap[64] = (bf16)f2bf(hi);
                  const float nr = ar * hr - ai * hi + sr[k], ni = ar * hi + ai * hr + si[k]; hr = nr; hi = ni; }
          } } }
#define UNPK(PW, FA) do { const u32x4 pw_ = (PW); FA[0] = bflo(pw_.x); FA[1] = bfhi(pw_.x); FA[2] = bflo(pw_.y); FA[3] = bfhi(pw_.y); FA[4] = bflo(pw_.z); FA[5] = bfhi(pw_.z); FA[6] = bflo(pw_.w); FA[7] = bfhi(pw_.w); } while (0)
#define PK8(FA) ((u32x4){pk2(FA[0], FA[1]), pk2(FA[2], FA[3]), pk2(FA[4], FA[5]), pk2(FA[6], FA[7])})
    { const bf16* QR = (const bf16*)(F.ck + C_QR); const bf16* KN = (const bf16*)(F.ck + C_KN); const bf16* KRP = (const bf16*)(F.ck + C_KRP);
      bf16* QF = (bf16*)(F.ck + C_QF); bf16* KF = (bf16*)(F.ck + C_KF);
      const int nq = 0, ntot = RR * 8;
      LAS unsigned char* st = F.lds + F.wave * 16384;
      for (int i = gt; i < ntot; i += NT) {
          const bool isq = __builtin_amdgcn_readfirstlane(i) < nq;
          const int ii = isq ? i : i - nq, row = ii >> 3, h = ii & 7;
          int ln = F.lane; asm volatile("" : "+v"(ln));
          const int i0 = ii - ln;
          const float* gn = isq ? F.in[12] + l * 96 : F.in[13] + l * 96;
          const float osc = isq ? 0.10206207261596575f * LOG2E : 1.0f;
          bf16* dst0 = (isq ? QF : KF) + (size_t)i0 * 96;
          u32x4 w[12];
          if (isq) { const bf16* s0 = QR + (size_t)i0 * 96;
#pragma unroll
              for (int j = 0; j < 12; ++j) { const int idx = j * 64 + ln; w[j] = ldg<u32x4>(s0 + idx * 8); }
#pragma unroll
              for (int j = 0; j < 12; ++j) { const int idx = j * 64 + ln; *(LAS u32x4*)(st + 16 * (idx + idx / 12)) = w[j]; }
          } else { const bf16* s0 = KN + (size_t)i0 * 64;
#pragma unroll
              for (int j = 0; j < 8; ++j) { const int idx = j * 64 + ln; w[j] = ldg<u32x4>(s0 + idx * 8); }
#pragma unroll
              for (int c = 0; c < 4; ++c) w[8 + c] = ldg<u32x4>(KRP + (size_t)row * 32 + c * 8);
#pragma unroll
              for (int j = 0; j < 8; ++j) { const int idx = j * 64 + ln; *(LAS u32x4*)(st + 16 * idx + 80 * (idx >> 3)) = w[j]; }
          }
          asm volatile("s_waitcnt lgkmcnt(0)" ::: "memory");
          if (isq) {
#pragma unroll
              for (int c = 0; c < 12; ++c) w[c] = *(const LAS u32x4*)(st + ln * 208 + c * 16);
          } else {
#pragma unroll
              for (int c = 0; c < 8; ++c) w[c] = *(const LAS u32x4*)(st + ln * 208 + c * 16);
          }
          float ss = 0.f;
#pragma unroll
          for (int c = 0; c < 12; ++c) { float f[8]; UNPK(w[c], f);
#pragma unroll
              for (int j = 0; j < 8; ++j) ss += f[j] * f[j]; }
          const float rstd = rsqrtf(ss * (1.0f / 96.0f) + RMS_EPS);
          LAS unsigned char* mine = st + ln * 208;
#pragma unroll
          for (int c = 0; c < 8; ++c) { float f[8]; UNPK(w[c], f);
#pragma unroll
              for (int j = 0; j < 8; ++j) f[j] *= rstd * gn[8 * c + j] * osc;
              *(LAS u32x4*)(mine + c * 16) = PK8(f); }
          const float* rp = ROPE + (size_t)(row & 2047) * 32; const bool rope = row < RL;
#pragma unroll
          for (int a = 0; a < 2; ++a) { float x1[8], x2[8]; UNPK(w[8 + 2 * a], x1); UNPK(w[9 + 2 * a], x2);
#pragma unroll
              for (int f = 0; f < 8; ++f) {
                  float cs = 1.0f, sn = 0.0f; if (rope) { const f32x2 t = ldg<f32x2>(rp + (a * 8 + f) * 2); cs = t[0]; sn = t[1]; }
                  const float v1 = x1[f] * rstd * gn[64 + a * 16 + f], v2 = x2[f] * rstd * gn[64 + a * 16 + 8 + f];
                  x1[f] = (v1 * cs - v2 * sn) * osc; x2[f] = (v1 * sn + v2 * cs) * osc; }
              *(LAS u32x4*)(mine + (8 + 2 * a) * 16) = PK8(x1); *(LAS u32x4*)(mine + (9 + 2 * a) * 16) = PK8(x2); }
          asm volatile("s_waitcnt lgkmcnt(0)" ::: "memory");
          int lo = ln; asm volatile("" : "+v"(lo));
#pragma unroll
          for (int j = 0; j < 12; ++j) { const int idx = j * 64 + lo; stg<u32x4>(dst0 + idx * 8, *(const LAS u32x4*)(st + 16 * (idx + idx / 12))); }
          asm volatile("s_waitcnt lgkmcnt(0)" ::: "memory");
      } }
#undef UNPK
#undef PK8
}


constexpr int AT_KROW = 208, AT_VROW = 192, AT_KB = 64 * AT_KROW, AT_VB = 64 * AT_VROW, AT_SLOT = AT_KB + AT_VB;
__device__ __forceinline__ void mla_unit(Frame& F, const bf16* Qh  , const bf16* KFh  , const bf16* VVh  ,
                                         bf16* Oh  , int b, int kt0, int kt1, const float* gq  , const float* rope0  ) {
    int lane; asm volatile("v_mbcnt_lo_u32_b32 %0, -1, 0\n\tv_mbcnt_hi_u32_b32 %0, -1, %0" : "=v"(lane));
    LAS unsigned char* lds = F.lds; const int w = F.wave, tid = lane + 64 * w, r32 = lane & 31, hh = lane >> 5;
    const unsigned vtr_off = (unsigned)((4 * hh + ((lane >> 2) & 3)) * AT_VROW + (16 * ((lane >> 4) & 1) + 4 * (lane & 3)) * 2);
    const int kr0 = tid / 12, kc0 = tid % 12, kr1 = (tid + 512) / 12, kc1 = (tid + 512) % 12, vd = tid >> 3, vc = tid & 7;
    u32x4 sk0, sk1, sv;
#define AT_KROWIDX(kt) ((kt) < 32 ? b * 2048 + 64 * (kt) : RL + b * 256 + 64 * ((kt) - 32))
#define AT_LOAD(kt) do { const int kr_ = AT_KROWIDX(kt); sk0 = ldg<u32x4>(KFh + (size_t)(kr_ + kr0) * 768 + kc0 * 8); if (tid < 256) sk1 = ldg<u32x4>(KFh + (size_t)(kr_ + kr1) * 768 + kc1 * 8); \
        sv = ldg<u32x4>(VVh + (size_t)(kr_ + vd) * 512 + vc * 8); } while (0)
#define AT_WRITE(slot) do { LAS unsigned char* s_ = lds + (slot) * AT_SLOT; *(LAS u32x4*)(s_ + kr0 * AT_KROW + kc0 * 16) = sk0; if (tid < 256) *(LAS u32x4*)(s_ + kr1 * AT_KROW + kc1 * 16) = sk1; \
        *(LAS u32x4*)(s_ + AT_KB + vd * AT_VROW + vc * 16) = sv; } while (0)
    bf16x8 qf[6];
    { u32x4 raw[6];
#pragma unroll
      for (int ks = 0; ks < 6; ++ks) raw[ks] = ldg<u32x4>(Qh + (size_t)(32 * w + r32) * 768 + 16 * ks + 8 * hh);
#define AT_UNPK(W, FA) do { FA[0] = bflo(W.x); FA[1] = bfhi(W.x); FA[2] = bflo(W.y); FA[3] = bfhi(W.y); FA[4] = bflo(W.z); FA[5] = bfhi(W.z); FA[6] = bflo(W.w); FA[7] = bfhi(W.w); } while (0)
#define AT_PK8(FA) __builtin_bit_cast(bf16x8, (u32x4){pk2(FA[0], FA[1]), pk2(FA[2], FA[3]), pk2(FA[4], FA[5]), pk2(FA[6], FA[7])})
      float ss = 0.f;
#pragma unroll
      for (int ks = 0; ks < 6; ++ks) { float f[8]; AT_UNPK(raw[ks], f);
#pragma unroll
          for (int j = 0; j < 8; ++j) ss += f[j] * f[j]; }
      ss = hx32(ss, ss);
      const float rq = rsqrtf(ss * (1.0f / 96.0f) + RMS_EPS) * (0.10206207261596575f * LOG2E);
#pragma unroll
      for (int ks = 0; ks < 4; ++ks) { float f[8]; AT_UNPK(raw[ks], f); const f32x4 g0 = ldg<f32x4>(gq + 16 * ks + 8 * hh), g1 = ldg<f32x4>(gq + 16 * ks + 8 * hh + 4);
#pragma unroll
          for (int j = 0; j < 4; ++j) { f[j] *= rq * g0[j]; f[4 + j] *= rq * g1[j]; }
          qf[ks] = AT_PK8(f); }
#pragma unroll
      for (int a = 0; a < 2; ++a) { float f[8]; AT_UNPK(raw[4 + a], f); const f32x4 g0 = ldg<f32x4>(gq + 64 + 16 * a + 8 * hh), g1 = ldg<f32x4>(gq + 64 + 16 * a + 8 * hh + 4);
#pragma unroll
          for (int j = 0; j < 4; ++j) { f[j] *= rq * g0[j]; f[4 + j] *= rq * g1[j]; }
          if (rope0) { const float* rp = rope0 + (size_t)(32 * w + r32) * 32 + a * 16;
#pragma unroll
              for (int j4 = 0; j4 < 4; ++j4) { const f32x4 cs = ldg<f32x4>(rp + 4 * j4);
#pragma unroll
                  for (int e = 0; e < 2; ++e) { const int j = 2 * j4 + e; float pa = f[j], pb = f[j];
                      asm volatile("s_nop 1\n\tv_permlane32_swap_b32 %0, %1" : "+v"(pa), "+v"(pb));
                      const float pv = hh ? pa : pb;
                      f[j] = f[j] * cs[2 * e] + (hh ? pv : -pv) * cs[2 * e + 1]; } } }
          qf[4 + a] = AT_PK8(f); }
#undef AT_UNPK
#undef AT_PK8
    }
    f32x16 o0, o1;
#pragma unroll
    for (int r = 0; r < 16; ++r) { o0[r] = 0.f; o1[r] = 0.f; }
    float mrun = 0.f, lrun = 0.f;
    __syncthreads();
    AT_LOAD(kt0); AT_WRITE(0);
    __syncthreads();
    asm volatile(".rept " STR(MLA_PAD_N) "\n\ts_nop 0\n\t.endr" ::: "memory");
    for (int kt = kt0; kt < kt1; ++kt) {
        const int slot = (kt - kt0) & 1;
        if (kt + 1 < kt1) AT_LOAD(kt + 1);
        const LAS unsigned char* ks_ = lds + slot * AT_SLOT; const LAS unsigned char* vs_ = ks_ + AT_KB;
        f32x16 s0, s1;
        bf16x8 kf[12];
#pragma unroll
        for (int ks = 0; ks < 6; ++ks) { kf[2 * ks] = *(const LAS bf16x8*)(ks_ + r32 * AT_KROW + (16 * ks + 8 * hh) * 2); kf[2 * ks + 1] = *(const LAS bf16x8*)(ks_ + (32 + r32) * AT_KROW + (16 * ks + 8 * hh) * 2); }
        __builtin_amdgcn_sched_barrier(0);
#pragma unroll
        for (int ks = 0; ks < 6; ++ks) {
            if (ks == 0) { const f32x16 z16 = {}; s0 = __builtin_amdgcn_mfma_f32_32x32x16_bf16(kf[0], qf[0], z16, 0, 0, 0); s1 = __builtin_amdgcn_mfma_f32_32x32x16_bf16(kf[1], qf[0], z16, 0, 0, 0); }
            else { s0 = __builtin_amdgcn_mfma_f32_32x32x16_bf16(kf[2 * ks], qf[ks], s0, 0, 0, 0); s1 = __builtin_amdgcn_mfma_f32_32x32x16_bf16(kf[2 * ks + 1], qf[ks], s1, 0, 0, 0); }
        }
        u32x2 vfa[4][2], vfc[4][2];
        { const unsigned va_ = (unsigned)(size_t)vs_ + vtr_off;
          asm volatile("ds_read_b64_tr_b16 %0, %16 offset:0\n\t" "ds_read_b64_tr_b16 %1, %16 offset:1536\n\t" "ds_read_b64_tr_b16 %2, %16 offset:64\n\t" "ds_read_b64_tr_b16 %3, %16 offset:1600\n\t" "ds_read_b64_tr_b16 %4, %16 offset:3072\n\t" "ds_read_b64_tr_b16 %5, %16 offset:4608\n\t" "ds_read_b64_tr_b16 %6, %16 offset:3136\n\t" "ds_read_b64_tr_b16 %7, %16 offset:4672\n\t" "ds_read_b64_tr_b16 %8, %16 offset:6144\n\t" "ds_read_b64_tr_b16 %9, %16 offset:7680\n\t" "ds_read_b64_tr_b16 %10, %16 offset:6208\n\t" "ds_read_b64_tr_b16 %11, %16 offset:7744\n\t" "ds_read_b64_tr_b16 %12, %16 offset:9216\n\t" "ds_read_b64_tr_b16 %13, %16 offset:10752\n\t" "ds_read_b64_tr_b16 %14, %16 offset:9280\n\t" "ds_read_b64_tr_b16 %15, %16 offset:10816\n\t" : "=&v"(vfa[0][0]), "=&v"(vfc[0][0]), "=&v"(vfa[0][1]), "=&v"(vfc[0][1]), "=&v"(vfa[1][0]), "=&v"(vfc[1][0]), "=&v"(vfa[1][1]), "=&v"(vfc[1][1]), "=&v"(vfa[2][0]), "=&v"(vfc[2][0]), "=&v"(vfa[2][1]), "=&v"(vfc[2][1]), "=&v"(vfa[3][0]), "=&v"(vfc[3][0]), "=&v"(vfa[3][1]), "=&v"(vfc[3][1]) : "v"(va_) : "memory"); }
        __builtin_amdgcn_sched_barrier(0);
        { const f32x2 m2 = {mrun, mrun};
#pragma unroll
          for (int r = 0; r < 16; r += 2) { const f32x2 a = (f32x2){s0[r], s0[r + 1]} - m2, c = (f32x2){s1[r], s1[r + 1]} - m2; s0[r] = a[0]; s0[r + 1] = a[1]; s1[r] = c[0]; s1[r + 1] = c[1]; } }
        float ma = fmaxf(fmaxf(s0[0], s0[1]), s0[2]), mb = fmaxf(fmaxf(s1[0], s1[1]), s1[2]);
#pragma unroll
        for (int r = 3; r < 15; r += 2) { ma = fmaxf(fmaxf(ma, s0[r]), s0[r + 1]); mb = fmaxf(fmaxf(mb, s1[r]), s1[r + 1]); }
        float mx = fmaxf(fmaxf(ma, mb), fmaxf(s0[15], s1[15]));
        mx = shx_max<32>(mx);
        if (kt == kt0 || __any(mx > 8.0f)) {
            const float d = kt == kt0 ? mx : fmaxf(mx, 0.0f), alpha = fast_exp2(-d); mrun += d; lrun *= alpha;
#pragma unroll
            for (int r = 0; r < 16; ++r) { o0[r] *= alpha; o1[r] *= alpha; s0[r] -= d; s1[r] -= d; }
        }
        f32x2 rs2 = {0.f, 0.f};
#pragma unroll
        for (int r = 0; r < 16; ++r) { s0[r] = fast_exp2(s0[r]); s1[r] = fast_exp2(s1[r]); }
#pragma unroll
        for (int r = 0; r < 16; r += 2) { rs2 += (f32x2){s0[r], s0[r + 1]}; rs2 += (f32x2){s1[r], s1[r + 1]}; }
        lrun += rs2[0] + rs2[1];
        asm volatile("s_waitcnt lgkmcnt(0)" : "+v"(vfa[0][0]), "+v"(vfc[0][0]), "+v"(vfa[0][1]), "+v"(vfc[0][1]), "+v"(vfa[1][0]), "+v"(vfc[1][0]), "+v"(vfa[1][1]), "+v"(vfc[1][1]), "+v"(vfa[2][0]), "+v"(vfc[2][0]), "+v"(vfa[2][1]), "+v"(vfc[2][1]), "+v"(vfa[3][0]), "+v"(vfc[3][0]), "+v"(vfa[3][1]), "+v"(vfc[3][1]) :: "memory");
#pragma unroll
        for (int kh = 0; kh < 2; ++kh)
#pragma unroll
            for (int s = 0; s < 2; ++s) {
                u32x4 pw;
                if (kh == 0) { pw.x = pg8::cvt_pk_bf16(s0[8 * s], s0[8 * s + 1]); pw.y = pg8::cvt_pk_bf16(s0[8 * s + 2], s0[8 * s + 3]); pw.z = pg8::cvt_pk_bf16(s0[8 * s + 4], s0[8 * s + 5]); pw.w = pg8::cvt_pk_bf16(s0[8 * s + 6], s0[8 * s + 7]); }
                else { pw.x = pg8::cvt_pk_bf16(s1[8 * s], s1[8 * s + 1]); pw.y = pg8::cvt_pk_bf16(s1[8 * s + 2], s1[8 * s + 3]); pw.z = pg8::cvt_pk_bf16(s1[8 * s + 4], s1[8 * s + 5]); pw.w = pg8::cvt_pk_bf16(s1[8 * s + 6], s1[8 * s + 7]); }
                const bf16x8 pb = __builtin_bit_cast(bf16x8, pw);
                {   const u32x2 a = vfa[kh * 2 + s][0], c = vfc[kh * 2 + s][0];
                    const bf16x8 vf = __builtin_bit_cast(bf16x8, (u32x4){a.x, a.y, c.x, c.y});
                    o0 = __builtin_amdgcn_mfma_f32_32x32x16_bf16(vf, pb, o0, 0, 0, 0); }
                {   const u32x2 a = vfa[kh * 2 + s][1], c = vfc[kh * 2 + s][1];
                    const bf16x8 vf = __builtin_bit_cast(bf16x8, (u32x4){a.x, a.y, c.x, c.y});
                    o1 = __builtin_amdgcn_mfma_f32_32x32x16_bf16(vf, pb, o1, 0, 0, 0); }
            }
        if (kt + 1 < kt1) AT_WRITE(slot ^ 1);
        __syncthreads();
    }
    const float ltot = shx_sum<32>(lrun), inv = 1.0f / ltot;
    bf16* orow = Oh + (size_t)(32 * w + r32) * 512;
#pragma unroll
    for (int g4 = 0; g4 < 4; ++g4) {
        stg<u32x2>(orow + 8 * g4 + 4 * hh, (u32x2){pk2(o0[4 * g4] * inv, o0[4 * g4 + 1] * inv), pk2(o0[4 * g4 + 2] * inv, o0[4 * g4 + 3] * inv)});
        stg<u32x2>(orow + 32 + 8 * g4 + 4 * hh, (u32x2){pk2(o1[4 * g4] * inv, o1[4 * g4 + 1] * inv), pk2(o1[4 * g4 + 2] * inv, o1[4 * g4 + 3] * inv)});
    }
#undef AT_KROWIDX
#undef AT_LOAD
#undef AT_WRITE
}
__device__ __forceinline__ void phase_mla(Frame& F, int l, bool ctx_q, bf16* OAc  ) {
    const float* gq = F.in[12] + l * 96; const float* ROPE = (const float*)(F.ws + WS_ROPE);
    const bf16* QF = (const bf16*)(F.ck + C_QR);        const bf16* KF = (const bf16*)(F.ck + C_KF); const bf16* VV = (const bf16*)(F.ck + C_VV); bf16* OA = (bf16*)(F.ck + C_OA);
    const int nlat = NB * 8 * 8, ntot = nlat + (ctx_q ? NB * 8 : 0);
    for (int u0 = F.c; u0 < ntot; u0 += F.G) {
        int u = u0;
        if (F.G == 256 && u0 < nlat) { const int x = u0 & 7, slot = ((u0 & 255) >> 3) + 32 * (u0 >> 8); u = ((x * 8 + (slot >> 3)) << 3) | (slot & 7); }
        if (u < nlat) { const int b = u >> 6, h = (u >> 3) & 7, qb = u & 7; const int row0 = b * 2048 + qb * 256;
            mla_unit(F, QF + (size_t)row0 * 768 + h * 96, KF + h * 96, VV + h * 64, OA + (size_t)row0 * 512 + h * 64, b, 0, 36, gq, ROPE + (size_t)(qb * 256) * 32); }
        else { const int v = u - nlat, b = v >> 3, h = v & 7; const int row0 = RL + b * 256;
            mla_unit(F, QF + (size_t)row0 * 768 + h * 96, KF + h * 96, VV + h * 64, OAc + (size_t)(b * 256) * 512 + h * 64, b, 32, 36, gq, nullptr); }
    }
    __syncthreads();
}

struct NatOps { bf16x8 k[2][2]; u32x2 v[4][2]; };
__device__ __forceinline__ void nat_load(NatOps& o, const bf16* Kp  , const bf16* VTp  , int g) {
#pragma unroll
    for (int sub = 0; sub < 2; ++sub) { o.k[sub][0] = ldg<bf16x8>(Kp + (size_t)sub * 16 * 512 + 8 * g); o.k[sub][1] = ldg<bf16x8>(Kp + (size_t)sub * 16 * 512 + 32 + 8 * g); }
#pragma unroll
    for (int dt = 0; dt < 4; ++dt) { o.v[dt][0] = ldg<u32x2>(VTp + (size_t)dt * 16 * KEYS); o.v[dt][1] = ldg<u32x2>(VTp + (size_t)dt * 16 * KEYS + 16); }
}
__device__ __forceinline__ void nat_compute(NatOps& ops, const bf16x8 (&qf)[2], f32x4 (&o)[4], float& mrun, float& lrun, const float (&bias)[2][4], const bool (&valid)[2][4], bool masked) {
    f32x4 s[2];
#pragma unroll
    for (int sub = 0; sub < 2; ++sub) {
        s[sub] = (f32x4){0.f, 0.f, 0.f, 0.f};
        s[sub] = __builtin_amdgcn_mfma_f32_16x16x32_bf16(ops.k[sub][0], qf[0], s[sub], 0, 0, 0);
        s[sub] = __builtin_amdgcn_mfma_f32_16x16x32_bf16(ops.k[sub][1], qf[1], s[sub], 0, 0, 0);
    }
    if (masked) {
#pragma unroll
        for (int sub = 0; sub < 2; ++sub)
#pragma unroll
            for (int r = 0; r < 4; ++r) s[sub][r] = valid[sub][r] ? s[sub][r] + bias[sub][r] : -1e30f;
    }
    float mx = fmaxf(fmaxf(fmaxf(s[0][0], s[0][1]), fmaxf(s[0][2], s[0][3])), fmaxf(fmaxf(s[1][0], s[1][1]), fmaxf(s[1][2], s[1][3])));
    mx = shx_max<16>(mx); mx = shx_max<32>(mx);
    const float mn = fmaxf(mrun, mx), alpha = fast_exp2(mrun - mn); mrun = mn;
    float rs = 0.f;
#pragma unroll
    for (int sub = 0; sub < 2; ++sub)
#pragma unroll
        for (int r = 0; r < 4; ++r) { s[sub][r] = fast_exp2(s[sub][r] - mn); rs += s[sub][r]; }
    lrun = lrun * alpha + rs;
    u32x4 pw; pw.x = pg8::cvt_pk_bf16(s[0][0], s[0][1]); pw.y = pg8::cvt_pk_bf16(s[0][2], s[0][3]); pw.z = pg8::cvt_pk_bf16(s[1][0], s[1][1]); pw.w = pg8::cvt_pk_bf16(s[1][2], s[1][3]);
    const bf16x8 pb = __builtin_bit_cast(bf16x8, pw);
    asm volatile("s_waitcnt lgkmcnt(0)" : "+v"(ops.v[0][0]), "+v"(ops.v[0][1]), "+v"(ops.v[1][0]), "+v"(ops.v[1][1]), "+v"(ops.v[2][0]), "+v"(ops.v[2][1]), "+v"(ops.v[3][0]), "+v"(ops.v[3][1]) :: "memory");
#pragma unroll
    for (int dt = 0; dt < 4; ++dt) {
        const bf16x8 vf = __builtin_bit_cast(bf16x8, (u32x4){ops.v[dt][0].x, ops.v[dt][0].y, ops.v[dt][1].x, ops.v[dt][1].y});
        o[dt] = o[dt] * alpha;
        o[dt] = __builtin_amdgcn_mfma_f32_16x16x32_bf16(vf, pb, o[dt], 0, 0, 0);
    }
}
constexpr int NL_KS = 144, NL_VS = 160;
constexpr int NL_CK = 0, NL_CV = 256 * NL_KS, NL_SLOT0 = NL_CV + 256 * NL_VS, NL_SLOTB = 64 * NL_KS + 64 * NL_VS, NL_RPB = NL_SLOT0 + 2 * NL_SLOTB;
__device__ __forceinline__ void nat_lds_ops(NatOps& o, const LAS unsigned char* Kt  , const LAS unsigned char* Vt  , int qi, int g) {
#pragma unroll
    for (int sub = 0; sub < 2; ++sub) { o.k[sub][0] = *(const LAS bf16x8*)(Kt + (16 * sub + qi) * NL_KS + 16 * g); o.k[sub][1] = *(const LAS bf16x8*)(Kt + (16 * sub + qi) * NL_KS + 64 + 16 * g); }
    const unsigned va_ = (unsigned)(size_t)Vt + (unsigned)((4 * g + (qi >> 2)) * NL_VS + (qi & 3) * 8);
    asm volatile("ds_read_b64_tr_b16 %0, %8 offset:0\n\t" "ds_read_b64_tr_b16 %1, %8 offset:2560\n\t" "ds_read_b64_tr_b16 %2, %8 offset:32\n\t" "ds_read_b64_tr_b16 %3, %8 offset:2592\n\t" "ds_read_b64_tr_b16 %4, %8 offset:64\n\t" "ds_read_b64_tr_b16 %5, %8 offset:2624\n\t" "ds_read_b64_tr_b16 %6, %8 offset:96\n\t" "ds_read_b64_tr_b16 %7, %8 offset:2656\n\t" : "=&v"(o.v[0][0]), "=&v"(o.v[0][1]), "=&v"(o.v[1][0]), "=&v"(o.v[1][1]), "=&v"(o.v[2][0]), "=&v"(o.v[2][1]), "=&v"(o.v[3][0]), "=&v"(o.v[3][1]) : "v"(va_) : "memory");
}
__device__ __forceinline__ void nat_unit(Frame& F, const bf16* NQ, const bf16* NK, const bf16* NV  , bf16* OB, bf16* OBc, const float* rpb_h  , int b, int h, int q, bool ctx_q) {
    LAS unsigned char* lds = F.lds; const int tid = F.tid, lane = F.lane, w = F.wave, qi = lane & 15, g = lane >> 4, j = w & 3;
    LAS float* RPB = (LAS float*)(lds + NL_RPB);
    __syncthreads();
    { u32x4 ck[4], cv[4];
#pragma unroll
      for (int k = 0; k < 4; ++k) { const int idx = tid + 512 * k; ck[k] = ldg<u32x4>(NK + (size_t)(RL + b * 256 + (idx >> 3)) * 512 + h * 64 + (idx & 7) * 8); cv[k] = ldg<u32x4>(NV + (size_t)(RL + b * 256 + (idx >> 3)) * 512 + h * 64 + (idx & 7) * 8); }
#pragma unroll
      for (int k = 0; k < 4; ++k) { const int idx = tid + 512 * k; *(LAS u32x4*)(lds + NL_CK + (idx >> 3) * NL_KS + (idx & 7) * 16) = ck[k]; *(LAS u32x4*)(lds + NL_CV + (idx >> 3) * NL_VS + (idx & 7) * 16) = cv[k]; }
      if (tid < 15 * 31) RPB[tid] = ldg<float>(rpb_h + tid) * LOG2E; }
    bf16x8 qf[4][2]; f32x4 o[4][4]; float mrun[4], lrun[4]; int rs_[4];
#pragma unroll
    for (int i = 0; i < 4; ++i) { const int row = 8 * q + (w >> 2) + 2 * i; rs_[i] = min(max(row - 4, 0), 24);
        const bf16* qp = NQ + (size_t)(b * 2048 + row * 64 + 16 * j + qi) * 512 + h * 64;
        qf[i][0] = ldg<bf16x8>(qp + 8 * g); qf[i][1] = ldg<bf16x8>(qp + 32 + 8 * g); mrun[i] = -1e30f; lrun[i] = 0.f;
#pragma unroll
        for (int dt = 0; dt < 4; ++dt) o[i][dt] = (f32x4){0.f, 0.f, 0.f, 0.f}; }
    const int bs = min(max(16 * j - 8, 0), 32), qc = 16 * j + qi, cs = min(max(qc - 8, 0), 48);
    bool valid[2][4]; int dcl[2][4];
#pragma unroll
    for (int sub = 0; sub < 2; ++sub)
#pragma unroll
        for (int rg = 0; rg < 4; ++rg) { const int kc = bs + 16 * sub + 4 * g + rg; valid[sub][rg] = (unsigned)(kc - cs) < 16u; dcl[sub][rg] = min(max(kc - qc + 15, 0), 30); }
    const int kr_lo = min(max(8 * q - 4, 0), 24), kr_hi = min(max(8 * q + 3, 0), 24) + 7, nkr = kr_hi - kr_lo + 1;
    const int tk = tid >> 3, tc = tid & 7;
    u32x4 sk, sv;
#define NL_LOAD(kr) do { sk = ldg<u32x4>(NK + (size_t)(b * 2048 + (kr) * 64 + tk) * 512 + h * 64 + tc * 8); sv = ldg<u32x4>(NV + (size_t)(b * 2048 + (kr) * 64 + tk) * 512 + h * 64 + tc * 8); } while (0)
#define NL_WRITE(slot) do { *(LAS u32x4*)(lds + NL_SLOT0 + (slot) * NL_SLOTB + tk * NL_KS + tc * 16) = sk; *(LAS u32x4*)(lds + NL_SLOT0 + (slot) * NL_SLOTB + 64 * NL_KS + tk * NL_VS + tc * 16) = sv; } while (0)
    NL_LOAD(kr_lo); NL_WRITE(0);
    __syncthreads();
    for (int t = 0; t < nkr; ++t) {
        const int kr = kr_lo + t, slot = t & 1;
        if (t + 1 < nkr) NL_LOAD(kr + 1);
        const LAS unsigned char* Kt = lds + NL_SLOT0 + slot * NL_SLOTB + bs * NL_KS; const LAS unsigned char* Vt = Kt - bs * NL_KS + 64 * NL_KS + bs * NL_VS;
        if (kr >= rs_[0] && kr < rs_[3] + 8) {
            NatOps ops; nat_lds_ops(ops, Kt, Vt, qi, g);
#pragma unroll
            for (int i = 0; i < 4; ++i) {
                if (kr >= rs_[i] && kr < rs_[i] + 8) {
                    const int drow = kr - (8 * q + (w >> 2) + 2 * i) + 7;
                    float bias[2][4];
#pragma unroll
                    for (int sub = 0; sub < 2; ++sub)
#pragma unroll
                        for (int rg = 0; rg < 4; ++rg) bias[sub][rg] = RPB[drow * 31 + dcl[sub][rg]];
                    nat_compute(ops, qf[i], o[i], mrun[i], lrun[i], bias, valid, true);
                }
            }
        }
        if (t + 1 < nkr) NL_WRITE(slot ^ 1);
        __syncthreads();
    }
#undef NL_LOAD
#undef NL_WRITE
    { float bias[2][4];
#pragma unroll
      for (int sub = 0; sub < 2; ++sub)
#pragma unroll
          for (int rg = 0; rg < 4; ++rg) bias[sub][rg] = 0.f;
      for (int cb = 0; cb < 8; ++cb) {
          NatOps ops; nat_lds_ops(ops, lds + NL_CK + 32 * cb * NL_KS, lds + NL_CV + 32 * cb * NL_VS, qi, g);
#pragma unroll
          for (int i = 0; i < 4; ++i) nat_compute(ops, qf[i], o[i], mrun[i], lrun[i], bias, valid, false);
      }
#pragma unroll
      for (int i = 0; i < 4; ++i) { const int row = 8 * q + (w >> 2) + 2 * i; const size_t qrow = (size_t)(b * 2048 + row * 64 + 16 * j + qi);
          float lt = shx_sum<32>(shx_sum<16>(lrun[i])); const float inv = 1.0f / lt;
#pragma unroll
          for (int dt = 0; dt < 4; ++dt) stg<u32x2>(OB + qrow * 512 + h * 64 + 16 * dt + 4 * g, (u32x2){pk2(o[i][dt][0] * inv, o[i][dt][1] * inv), pk2(o[i][dt][2] * inv, o[i][dt][3] * inv)}); }
      if (ctx_q && w < 4) {
          const size_t qrow = (size_t)(RL + b * 256 + 16 * (4 * q + w) + qi); const bf16* qp = NQ + qrow * 512 + h * 64;
          bf16x8 cq[2]; cq[0] = ldg<bf16x8>(qp + 8 * g); cq[1] = ldg<bf16x8>(qp + 32 + 8 * g);
          f32x4 co[4]; float cm = -1e30f, cl = 0.f;
#pragma unroll
          for (int dt = 0; dt < 4; ++dt) co[dt] = (f32x4){0.f, 0.f, 0.f, 0.f};
          for (int cb = 0; cb < 8; ++cb) { NatOps ops; nat_lds_ops(ops, lds + NL_CK + 32 * cb * NL_KS, lds + NL_CV + 32 * cb * NL_VS, qi, g); nat_compute(ops, cq, co, cm, cl, bias, valid, false); }
          float lt = shx_sum<32>(shx_sum<16>(cl)); const float inv = 1.0f / lt;
#pragma unroll
          for (int dt = 0; dt < 4; ++dt) stg<u32x2>(OBc + (qrow - RL) * 512 + h * 64 + 16 * dt + 4 * g, (u32x2){pk2(co[dt][0] * inv, co[dt][1] * inv), pk2(co[dt][2] * inv, co[dt][3] * inv)});
      } }
}
__device__ __forceinline__ void phase_nat(Frame& F, int l, bool ctx_q, bf16* OBc) {
    const bf16* NQ = (const bf16*)(F.ck + C_NQ); const bf16* NK = (const bf16*)(F.ck + C_NK); const bf16* NV = (const bf16*)(F.ck + C_NV); bf16* OB = (bf16*)(F.ck + C_OB);
    for (int u0 = F.c; u0 < NB * 32; u0 += F.G) { int u = u0; if (F.G == 256) { const int x = u0 & 7, j = u0 >> 3; u = ((x * 8 + (j >> 2)) << 2) | (j & 3); }
        const int b = u >> 5, h = (u >> 2) & 7, q = u & 3;
        nat_unit(F, NQ, NK, NV, OB, OBc, F.in[16] + ((size_t)l * 8 + h) * 15 * 31, b, h, q, ctx_q); }
    __syncthreads();
}

__device__ __forceinline__ void phase_router(Frame& F, int l, int ntok, int cnt_off = 0) {
    bf16* H2 = (bf16*)(F.ck + M_H2); int* ROWTOK = (int*)(F.ck + M_ROWTOK); i32x4* TOKE = (i32x4*)(F.ck + M_TOKE); f32x2* TOKW = (f32x2*)(F.ck + M_TOKW);
    unsigned* cnt = (unsigned*)(F.ws + WS_CTL) + CW_CNT + l * 64 + cnt_off;
    const float* g2 = F.in[28] + l * 1024; const float* WGT = (const float*)(F.ws + WS_WGT) + (size_t)l * 4 * 1024; const float* WET = (const float*)(F.ws + WS_WET) + (size_t)l * 32 * 1024;
    const float* bg = F.in[30] + l * 4; const float* be = F.in[32] + l * 32;
    for (int i = F.c * 512 + F.tid; i < MOE_ROWS; i += F.G * 512) ROWTOK[i] = -1;
    LAS float* WEL = (LAS float*)F.lds;
    LAS unsigned* LCNT = (LAS unsigned*)(F.lds + 131072);
    __syncthreads();
    for (int i = F.tid; i < 32 * 1024 / 4; i += 512) *(LAS f32x4*)(WEL + 4 * i) = ldg<f32x4>(WET + 4 * i);
    if (F.tid < 64) LCNT[F.tid] = 0u;
    __syncthreads();
    const int gw = F.c * 8 + F.wave, NGW = F.G * 8, lane = F.lane;
    for (int tok0 = gw * 4; tok0 < ntok; tok0 += NGW * 4) {
        const float* xs; int mrow;
        if (tok0 < NTOK_LAT) { xs = F.out + (size_t)tok0 * 1024; mrow = tok0 >> 11; } else { xs = F.XC + (size_t)(tok0 - NTOK_LAT) * 1024; mrow = 32; }
        const float* md = F.MOD + ((size_t)l * 33 + mrow) * 6144;
        f32x4 v[4][4]; float ss[4];
#pragma unroll
        for (int t = 0; t < 4; ++t) { ss[t] = 0.f;
#pragma unroll
            for (int j = 0; j < 4; ++j) { v[t][j] = ldg<f32x4>(xs + (size_t)t * 1024 + 4 * lane + 256 * j); ss[t] += v[t][j][0] * v[t][j][0] + v[t][j][1] * v[t][j][1] + v[t][j][2] * v[t][j][2] + v[t][j][3] * v[t][j][3]; } }
        float rstd[4];
        { const float rs_own = rsqrtf(red4(ss[0], ss[1], ss[2], ss[3]) * (1.0f / 1024.0f) + RMS_EPS);
#pragma unroll
          for (int t = 0; t < 4; ++t) rstd[t] = lane_bcast(rs_own, 16 * t); }
#pragma unroll
        for (int j = 0; j < 4; ++j) { const int col = 4 * lane + 256 * j;
            const f32x4 g = ldg<f32x4>(g2 + col), sh = ldg<f32x4>(md + 3 * 1024 + col), sc = ldg<f32x4>(md + 4 * 1024 + col) + 1.0f;
#pragma unroll
            for (int t = 0; t < 4; ++t) { v[t][j] = (v[t][j] * rstd[t] * g) * sc + sh;
                stg<u32x2>(H2 + (size_t)(tok0 + t) * 1024 + col, (u32x2){pk2(v[t][j][0], v[t][j][1]), pk2(v[t][j][2], v[t][j][3])}); } }
        float glo[4];
#pragma unroll
        for (int e = 0; e < 4; ++e) { float p[4] = {0.f, 0.f, 0.f, 0.f};
#pragma unroll
            for (int j = 0; j < 4; ++j) { const f32x4 w = ldg<f32x4>(WGT + e * 1024 + 4 * lane + 256 * j);
#pragma unroll
                for (int t = 0; t < 4; ++t) p[t] += v[t][j][0] * w[0] + v[t][j][1] * w[1] + v[t][j][2] * w[2] + v[t][j][3] * w[3]; }
            glo[e] = red4(p[0], p[1], p[2], p[3]) + bg[e]; }
        int gi = 0; float gm = glo[0];
#pragma unroll
        for (int e = 1; e < 4; ++e) if (glo[e] > gm) { gm = glo[e]; gi = e; }
        float gs = 0.f;
#pragma unroll
        for (int e = 0; e < 4; ++e) gs += __expf(glo[e] - gm);
        const float pgrp = 1.0f / gs;
        int grp[4];
#pragma unroll
        for (int t = 0; t < 4; ++t) grp[t] = __builtin_amdgcn_readlane(gi, 16 * t);
        float elo[8];
#pragma unroll
        for (int eh = 0; eh < 2; ++eh) {
            float p[4][4];
#pragma unroll
            for (int t = 0; t < 4; ++t)
#pragma unroll
                for (int e = 0; e < 4; ++e) { float q = 0.f; const LAS float* wr = WEL + (grp[t] * 8 + eh * 4 + e) * 1024;
#pragma unroll
                    for (int j = 0; j < 4; ++j) { const f32x4 w = *(const LAS f32x4*)(wr + 4 * lane + 256 * j); q += v[t][j][0] * w[0] + v[t][j][1] * w[1] + v[t][j][2] * w[2] + v[t][j][3] * w[3]; }
                    p[t][e] = q; }
#pragma unroll
            for (int e = 0; e < 4; ++e) elo[eh * 4 + e] = red4(p[0][e], p[1][e], p[2][e], p[3][e]);
            __builtin_amdgcn_sched_barrier(0);
        }
#pragma unroll
        for (int e = 0; e < 8; ++e) elo[e] += ldg<float>(be + gi * 8 + e);
        int i1 = 0; float v1 = elo[0];
#pragma unroll
        for (int e = 1; e < 8; ++e) if (elo[e] > v1) { v1 = elo[e]; i1 = e; }
        int i2 = -1; float v2 = -3.0e38f;
#pragma unroll
        for (int e = 0; e < 8; ++e) if (e != i1 && elo[e] > v2) { v2 = elo[e]; i2 = e; }
        const float ex = __expf(v2 - v1), mw1 = pgrp / (1.0f + ex), mw2 = pgrp * ex / (1.0f + ex);
        const int me1 = gi * 8 + i1, me2 = gi * 8 + i2;
        if ((lane & 15) == 0) {
            const int s1 = (int)__hip_atomic_fetch_add(LCNT + me1, 1u, __ATOMIC_RELAXED, __HIP_MEMORY_SCOPE_WORKGROUP), s2 = (int)__hip_atomic_fetch_add(LCNT + 32 + me2, 1u, __ATOMIC_RELAXED, __HIP_MEMORY_SCOPE_WORKGROUP);
            TOKE[tok0 + (lane >> 4)] = (i32x4){me1, s1, me2, s2}; TOKW[tok0 + (lane >> 4)] = (f32x2){mw1, mw2};
        }
    }
    __syncthreads();
    if (F.tid < 64) { const unsigned n = LCNT[F.tid]; const unsigned base = n ? atomicAdd(cnt + F.tid, n) : 0u; ((unsigned*)(F.ck + M_WGBASE))[(size_t)F.c * 64 + F.tid] = base; }
    __syncthreads();
}
__device__ __forceinline__ void phase_assign(Frame& F, int l, int ntok) {
    LAS int* T = (LAS int*)(F.lds + LDS_TAB);
    moe_tables((unsigned*)(F.ws + WS_CTL) + CW_CNT + l * 64, T, F.tid);
    int* ROWTOK = (int*)(F.ck + M_ROWTOK); float* ROWW = (float*)(F.ck + M_ROWW); const i32x4* TOKE = (const i32x4*)(F.ck + M_TOKE); const f32x2* TOKW = (const f32x2*)(F.ck + M_TOKW);
    for (int tok = F.c * 512 + F.tid; tok < ntok; tok += F.G * 512) {
        const i32x4 e = TOKE[tok]; const f32x2 w = TOKW[tok];
        const int wg = ((tok >> 2) % (F.G * 8)) >> 3;
        const unsigned* wb = (const unsigned*)(F.ck + M_WGBASE) + (size_t)wg * 64;
        const int r1 = T[2 + e.x] + (int)wb[e.x] + e.y, r2 = T[2 + 32 + e.z] + (int)wb[32 + e.z] + e.w;
        ROWTOK[r1] = tok; ROWW[r1] = w.x; ROWTOK[r2] = tok; ROWW[r2] = w.y;
    }
}

template <bool WITH_H>
__device__ __forceinline__ void phase_comb(Frame& F, int l, int ntok) {
    const bf16* Y = (const bf16*)(F.ck + M_Y); bf16* HBA = (bf16*)(F.ws + WS_HBALL);
    const float* g1n = F.in[6] + (l + 1 < DEPTH ? (l + 1) : l) * 1024;
    const int gw = F.c * 8 + F.wave, NGW = F.G * 8, lane = F.lane;
    for (int tok0 = gw * 4; tok0 < ntok; tok0 += NGW * 4) {
        float* xs; int mrow;
        if (tok0 < NTOK_LAT) { xs = F.out + (size_t)tok0 * 1024; mrow = tok0 >> 11; } else { xs = F.XC + (size_t)(tok0 - NTOK_LAT) * 1024; mrow = 32; }
        const float* gt2 = F.MOD + ((size_t)l * 33 + mrow) * 6144 + 5 * 1024;
        f32x4 v[4][4]; u32x2 y0[4][4], y1[4][4];
        f32x4 gv[4];
#pragma unroll
        for (int j = 0; j < 4; ++j) gv[j] = ldg<f32x4>(gt2 + 4 * lane + 256 * j);
#pragma unroll
        for (int t = 0; t < 4; ++t)
#pragma unroll
            for (int j = 0; j < 4; ++j) { const size_t o = (size_t)(tok0 + t) * 1024 + 4 * lane + 256 * j;
                v[t][j] = ldg<f32x4>(xs + (size_t)t * 1024 + 4 * lane + 256 * j); y0[t][j] = ldg<u32x2>(Y + o); y1[t][j] = ldg<u32x2>(Y + (size_t)NTOK * 1024 + o); }
        float ss[4];
#pragma unroll
        for (int t = 0; t < 4; ++t) { ss[t] = 0.f;
#pragma unroll
            for (int j = 0; j < 4; ++j) {
                f32x4 ysum; ysum[0] = bflo(y0[t][j].x) + bflo(y1[t][j].x); ysum[1] = bfhi(y0[t][j].x) + bfhi(y1[t][j].x); ysum[2] = bflo(y0[t][j].y) + bflo(y1[t][j].y); ysum[3] = bfhi(y0[t][j].y) + bfhi(y1[t][j].y);
                v[t][j] = v[t][j] + gv[j] * ysum;
                stg<f32x4>(xs + (size_t)t * 1024 + 4 * lane + 256 * j, v[t][j]);
                ss[t] += v[t][j][0] * v[t][j][0] + v[t][j][1] * v[t][j][1] + v[t][j][2] * v[t][j][2] + v[t][j][3] * v[t][j][3]; } }
        if constexpr (WITH_H) {
            const float* md = F.MOD + ((size_t)(l + 1) * 33 + mrow) * 6144;
#pragma unroll
            for (int t = 0; t < 4; ++t) ss[t] = rsqrtf(wave_sum(ss[t]) * (1.0f / 1024.0f) + RMS_EPS);
#pragma unroll
            for (int j = 0; j < 4; ++j) { const int col = 4 * lane + 256 * j;
                const f32x4 gg = ldg<f32x4>(g1n + col), sh = ldg<f32x4>(md + col), sc = ldg<f32x4>(md + 1024 + col) + 1.0f;
#pragma unroll
                for (int t = 0; t < 4; ++t) { const f32x4 h = (v[t][j] * ss[t] * gg) * sc + sh;
                    stg<u32x2>(HBA + (size_t)(tok0 + t) * 1024 + col, (u32x2){pk2(h[0], h[1]), pk2(h[2], h[3])}); } }
        }
    }
}

constexpr int MIX_PH = 8, MOE_PH = 5, NSTEPS = 2 + DEPTH * (NCH * MIX_PH + MOE_PH);
__global__ void __launch_bounds__(512, 2) fwd(Args args) {
    extern __shared__ __attribute__((aligned(16))) unsigned char lds_raw[];
    Frame F;
    F.lds = (LAS unsigned char*)lds_raw; F.tid = threadIdx.x; F.lane = F.tid & 63; F.wave = __builtin_amdgcn_readfirstlane(F.tid >> 6); F.G = gridDim.x; F.c = blockIdx.x;
    F.in = args.in; F.out = args.out; F.ws = args.ws; F.ck = args.ws + WS_CHUNK; F.MOD = (float*)(args.ws + WS_MOD); F.XC = (float*)(args.ws + WS_XC);
    for (int u = F.tid; u < (LDS_BYTES - LDS_MISC) / 4; u += 512) ((LAS unsigned*)(F.lds + LDS_MISC))[u] = 0u;
    __syncthreads();
    const int lo = args.lo, hi = args.hi;
    const int wave_id0 = __builtin_amdgcn_readfirstlane((int)threadIdx.x >> 6);
    XcdBarrier bar; bar.bar = (unsigned*)(F.ws + WS_CTL) + CW_BAR; bar.x = 0; bar.st = (volatile LAS unsigned*)(F.lds + LDS_MISC + 32);
    if (hi - lo > 1) bar = xcd_barrier_post((unsigned*)(F.ws + WS_CTL) + CW_BAR, (volatile LAS unsigned*)(F.lds + LDS_MISC + 32));
    int step = 0;
#ifndef SITE_ONLY
#define SITE_ONLY -1
#endif
#ifndef DBG_SKIP_MASK
#define DBG_SKIP_MASK 0u
#endif
#define SITE_ON(id) ((SITE_ONLY < 0 || SITE_ONLY == (id)) && !((DBG_SKIP_MASK >> (id)) & 1u))
#ifndef DBG_REPEAT_MASK
#define DBG_REPEAT_MASK 0x0u
#endif
#define SITE_REPS(id) (((DBG_REPEAT_MASK >> (id)) & 1u) ? 2 : 1)
#define PH_BEGIN(id) if (step >= lo && step < hi) { if (SITE_ON(id)) for (int rep_ = 0; rep_ < SITE_REPS(id); ++rep_) { if (rep_ > 0) xcd_barrier(bar, F.tid == 0); { int t_; asm volatile("v_mbcnt_lo_u32_b32 %0, -1, 0\n\tv_mbcnt_hi_u32_b32 %0, -1, %0" : "=v"(t_)); t_ += wave_id0 * 64; F.tid = t_; F.lane = t_ & 63; F.wave = __builtin_amdgcn_readfirstlane(t_ >> 6); \
        int c_ = blockIdx.x, g_ = gridDim.x; unsigned long long w_ = (unsigned long long)args.ws, o_ = (unsigned long long)args.out; asm volatile("" : "+s"(c_), "+s"(g_), "+s"(w_), "+s"(o_)); \
        F.c = c_; F.G = g_; F.ws = (unsigned char*)w_; F.out = (float*)o_; F.ck = F.ws + WS_CHUNK; F.MOD = (float*)(F.ws + WS_MOD); F.XC = (float*)(F.ws + WS_XC); }
#ifndef DBG_DOUBLE_BAR
#define DBG_DOUBLE_BAR 0
#endif
#define PH_END   } if (step + 1 < hi) { xcd_barrier(bar, F.tid == 0); if (DBG_DOUBLE_BAR) xcd_barrier(bar, F.tid == 0); } } ++step;
    LAS int* TAB = (LAS int*)(F.lds + LDS_TAB);

    PH_BEGIN(0)
        if (F.c < 64) prologue_s5(F, F.c >> 5, F.c & 31);
        else { prologue_mod(F, 64); prologue_transposes(F, 64); prologue_small(F, 64); }
    PH_END
    PH_BEGIN(1) prologue_mod_final(F); PH_END

    for (int l = 0; l < DEPTH; ++l) {
        const bool need_ctx = (l == 0);
        const float* xl_old = l == 0 ? F.in[0] : (const float*)F.out; const float* xc_old = l == 0 ? F.in[2] : (const float*)F.XC;
        const float* MODL = F.MOD + (size_t)l * 33 * 6144;
        const int nMrows = need_ctx ? 72 : 64;
        for (int ch = 0; ch < NCH; ++ch) {
            const int b0 = ch * NB;
            if (l == 0 && ch == 0) { PH_BEGIN(2) phase_h(F, l, b0, xl_old, xc_old, RR); PH_END }
            PH_BEGIN(3)
                const bf16* Alat = l == 0 ? (const bf16*)(F.ck + C_HB) : (const bf16*)(F.ws + WS_HBALL) + (size_t)b0 * 2048 * 1024;
                const bf16* Actx = l == 0 ? (const bf16*)(F.ck + C_HB) + (size_t)RL * 1024 : (const bf16*)(F.ws + WS_HBALL) + ((size_t)NTOK_LAT + (size_t)b0 * 256) * 1024;
                ProbG1 P{Alat, Actx, (const bf16*)(F.ws + WS_WINT) + (size_t)l * NINP * 1024, 1024, 1024, 1024, F.G, F.c, need_ctx ? 24 : 8};
                EpiG1 E{F.ck, F.in[14] + l * 64, F.in[15] + l * 64, (bf16*)(F.ws + X_GT) + ((ptrdiff_t)b0 * 256 - RL) * 3072};
                pg8::gemm_phase(F.lds, P, E, F.tid);
                if (l == 1) tr_moe_items(F, 1, ch * (MOE_ITEMS / 4), MOE_ITEMS / 4, 128);
            PH_END
            PH_BEGIN(5)
                if (need_ctx) ctx_krope(F, (const bf16*)(F.ck + C_HB) + (size_t)RL * 1024, (const bf16*)(F.ws + WS_WINT) + ((size_t)l * NINP + 6144) * 1024);
                { ProbPlain P{(const bf16*)(F.ck + C_KVL), (const bf16*)(F.ws + WS_UKVT) + (size_t)l * 1024 * 256, 256, 256, 256, 72, 4, F.G, F.c, 0};
                  EpiStoreRs<4> E{(bf16*)(F.ck + C_KN), (bf16*)(F.ck + C_VV), 512, 2, (const float*)(F.ck + C_SSKV), 1.0f / 256.0f}; pg8::gemm_phase(F.lds, P, E, F.tid); }
                { ProbPlain P{(const bf16*)(F.ck + C_QL), (const bf16*)(F.ws + WS_UQT) + (size_t)l * 768 * 768, 768, 768, 768, nMrows, 3, F.G, (F.c + F.G - 32) % F.G, 0};
                  EpiStoreRs<12> E{(bf16*)(F.ck + C_QR), (bf16*)(F.ck + C_QR), 768, 3, (const float*)(F.ck + C_SSQL), 1.0f / 768.0f}; pg8::gemm_phase(F.lds, P, E, F.tid); }
                { ProbPlain P{(const bf16*)(F.ck + C_AS5), (const bf16*)(F.ws + WS_BTS) + (size_t)l * 32 * 256 * 256, 256, 16384, 256, 5, 32, F.G, (F.c + 8) % F.G, 512};
                  EpiS5S E{(float*)(F.ck + C_SS)}; pg8::gemm_phase(F.lds, P, E, F.tid); }
            PH_END
            PH_BEGIN(6) phase_p2(F, l, need_ctx); PH_END
            PH_BEGIN(7)
#ifndef DBG_REP_MLA
#define DBG_REP_MLA 0
#endif
#ifndef DBG_REP_NAT
#define DBG_REP_NAT 0
#endif
                phase_mla(F, l, need_ctx, (bf16*)(F.ws + X_OA) + (size_t)b0 * 256 * 512); if (DBG_REP_MLA) phase_mla(F, l, need_ctx, (bf16*)(F.ws + X_OA) + (size_t)b0 * 256 * 512);
                phase_nat(F, l, need_ctx, (bf16*)(F.ws + X_OB) + (size_t)b0 * 256 * 512); if (DBG_REP_NAT) phase_nat(F, l, need_ctx, (bf16*)(F.ws + X_OB) + (size_t)b0 * 256 * 512);
                { ProbPlain P{(const bf16*)(F.ck + C_AS5), (const bf16*)(F.ws + WS_BTY) + (size_t)l * 32 * 256 * 512, 512, 16384, 512, need_ctx ? 5 : 4, 32, F.G, need_ctx ? (F.c + F.G - 64) % F.G : F.c, 512};
                  EpiS5Y E{(bf16*)(F.ck + C_YG), (bf16*)(F.ws + X_YG) + (size_t)b0 * 256 * 512}; pg8::gemm_phase(F.lds, P, E, F.tid); }
            PH_END
            PH_BEGIN(8)
                ProbPlain P{(const bf16*)(F.ck + C_YG), (const bf16*)(F.ws + WS_GLUT) + (size_t)l * 1024 * 512, 512, 512, 512, 64, 4, F.G, F.c, 0};
                EpiPair<0> E{(bf16*)(F.ck + C_OC), 512}; pg8::gemm_phase(F.lds, P, E, F.tid);
            PH_END
            PH_BEGIN(9)
                ProbMerge P{{(const bf16*)(F.ck + C_OA), (const bf16*)(F.ck + C_OB), (const bf16*)(F.ck + C_OC)}, (const bf16*)(F.ws + WS_BRT) + (size_t)l * 3 * 1024 * 512, 512, 512, 512, 64, 4, F.G, F.c};
                EpiMerge E{(const bf16*)(F.ck + C_GT), (bf16*)(F.ck + C_YMB)}; pg8::gemm_phase(F.lds, P, E, F.tid);
            PH_END
#ifndef DBG_REP_OUT0
#define DBG_REP_OUT0 0
#endif
            PH_BEGIN(10)
              for (int rr_ = 0; rr_ < ((DBG_REP_OUT0 && l == 0) ? 2 : 1); ++rr_) {
                if (rr_) xcd_barrier(bar, F.tid == 0);
                ProbPlain P{(const bf16*)(F.ck + C_YMB), (const bf16*)(F.ws + WS_OUTT) + (size_t)l * 1024 * 1024, 1024, 1024, 1024, 64, 4, F.G, F.c, 0};
                EpiOut E{xl_old, xc_old, F.out, F.XC, MODL, b0}; pg8::gemm_phase(F.lds, P, E, F.tid);
              }
              if (l == 0 && ch + 1 < NCH) phase_h(F, l, b0 + NB, xl_old, xc_old, RR);
            PH_END
        }
        if (need_ctx) {
            PH_BEGIN(16)
                ProbPlain P{(const bf16*)(F.ws + X_YG), (const bf16*)(F.ws + WS_GLUT) + (size_t)l * 1024 * 512, 512, 512, 512, 32, 4, F.G, F.c, 0};
                EpiPair<0> E{(bf16*)(F.ws + X_OC), 512}; pg8::gemm_phase(F.lds, P, E, F.tid);
                tr_moe_items(F, l, 12288, 2560, 128);
            PH_END
            PH_BEGIN(17)
                ProbMerge P{{(const bf16*)(F.ws + X_OA), (const bf16*)(F.ws + X_OB), (const bf16*)(F.ws + X_OC)}, (const bf16*)(F.ws + WS_BRT) + (size_t)l * 3 * 1024 * 512, 512, 512, 512, 32, 4, F.G, F.c};
                EpiMerge E{(const bf16*)(F.ws + X_GT), (bf16*)(F.ws + X_YMB)}; pg8::gemm_phase(F.lds, P, E, F.tid);
                tr_moe_items(F, l, 0, 12288, 128); tr_moe_items(F, l, 14848, 4864, 128);
            PH_END
            PH_BEGIN(18)
                ProbPlain P{(const bf16*)(F.ws + X_YMB), (const bf16*)(F.ws + WS_OUTT) + (size_t)l * 1024 * 1024, 1024, 1024, 1024, 32, 4, F.G, F.c, 0};
                EpiOut E{xl_old, xc_old, F.out, F.XC, MODL, -1}; pg8::gemm_phase(F.lds, P, E, F.tid);
                tr_moe_items(F, l, 19712, 4864, 128);
            PH_END
        }
        const int ntok = need_ctx ? NTOK : NTOK_LAT;
        unsigned* cnt = (unsigned*)(F.ws + WS_CTL) + CW_CNT + l * 64;
#ifndef DBG_ROUTER_DRY
#define DBG_ROUTER_DRY 0
#endif
        PH_BEGIN(11) if (DBG_ROUTER_DRY) { phase_router(F, l, ntok, 1024); xcd_barrier(bar, F.tid == 0); } phase_router(F, l, ntok); PH_END
        PH_BEGIN(12) phase_assign(F, l, ntok); PH_END
        PH_BEGIN(13)
            moe_tables(cnt, TAB, F.tid);
            ProbUp P{(const bf16*)(F.ck + M_H2), (const bf16*)(F.ws + WS_UPT) + (size_t)l * 32 * 1024 * 1024, (const int*)(F.ck + M_ROWTOK), TAB, 1024, 1024, 1024, F.G, F.c};
            EpiPair<1> E{(bf16*)(F.ck + M_HID), 512}; pg8::gemm_phase(F.lds, P, E, F.tid);
        PH_END
        PH_BEGIN(14)
            moe_tables(cnt, TAB, F.tid);
            ProbDown P{(const bf16*)(F.ck + M_HID), (const bf16*)(F.ws + WS_DOWNT) + (size_t)l * 32 * 1024 * 512, TAB, 512, 512, 512, F.G, F.c, 0, TAB[0]};
            EpiDownY E{(const int*)(F.ck + M_ROWTOK), (const float*)(F.ck + M_ROWW), (bf16*)(F.ck + M_Y), TAB[1]}; pg8::gemm_phase(F.lds, P, E, F.tid);
        PH_END
        PH_BEGIN(15) if (l + 1 < DEPTH) phase_comb<true>(F, l, ntok); else phase_comb<false>(F, l, ntok); PH_END
    }
#undef PH_BEGIN
#undef PH_END
}

extern "C" void kernel_launch(void* const* d_in, const int* in_sizes, int n_in, void* d_out, int out_size, void* d_ws, size_t ws_size, hipStream_t stream) {
    static int grid = 0;
    if (grid == 0) {
        if (n_in != 35 || out_size != BATCH * SEQ * D || ws_size < WS_END) { fprintf(stderr, "kernel_launch: unexpected shapes (n_in %d, out %d, ws %zu, need %zu)\n", n_in, out_size, ws_size, (size_t)WS_END); grid = -1; return; }
        int dev = 0, cus = 0, per_cu = 0;
        if (hipGetDevice(&dev) != hipSuccess || hipDeviceGetAttribute(&cus, hipDeviceAttributeMultiprocessorCount, dev) != hipSuccess) { grid = -1; return; }
        if (hipFuncSetAttribute((const void*)fwd, hipFuncAttributeMaxDynamicSharedMemorySize, LDS_BYTES) != hipSuccess) { fprintf(stderr, "kernel_launch: hipFuncSetAttribute failed\n"); grid = -1; return; }
        if (hipOccupancyMaxActiveBlocksPerMultiprocessor(&per_cu, (const void*)fwd, 512, LDS_BYTES) != hipSuccess || per_cu < 1) fprintf(stderr, "kernel_launch: occupancy query reports %d\n", per_cu);
        (void)hipGetLastError();
        grid = cus;
    }
    if (grid < 0) return;
    (void)in_sizes;
    hipMemsetAsync((char*)d_ws + WS_CTL, 0, CTL_BYTES, stream);
    Args a{};
    for (int i = 0; i < 35; ++i) a.in[i] = (const float*)d_in[i];
    a.out = (float*)d_out; a.ws = (unsigned char*)d_ws;
#if MK_SINGLE
    a.lo = 0; a.hi = NSTEPS;
    hipLaunchKernelGGL(fwd, dim3(grid), dim3(512), LDS_BYTES, stream, a);
#else
    for (int s = 0; s < NSTEPS; ++s) { a.lo = s; a.hi = s + 1; hipLaunchKernelGGL(fwd, dim3(grid), dim3(512), LDS_BYTES, stream, a);
    }
#endif
}
```
